# Optimizing an MI355X kernel written in HIP

```python
import math
import jax, jax.numpy as jnp
from jax import lax
import numpy as np


D_MODEL = 1024
BATCH = 2
SEQ = 8192
DEPTH = 2

D_MIX = D_MODEL
N_MIXERS = 4
GROUP_W = D_MIX // N_MIXERS
Q_BLOCK = 128
EPS = 1e-6

MOBA_HEADS = 4
MOBA_HD = GROUP_W // MOBA_HEADS
MOBA_BLOCK = 256
MOBA_TOPK = 3

SSM_HEADS = 4
SSM_HD = GROUP_W // SSM_HEADS
SSM_STATE = 128
SSM_GROUPS = 2
SSM_CONV = 4
SSM_CHUNK = 128
SSM_XBC = GROUP_W + 2 * SSM_GROUPS * SSM_STATE

MLSTM_HEADS = 4
MLSTM_HD = GROUP_W // MLSTM_HEADS
MLSTM_CONV = 4
MLSTM_CHUNK = 128

MLA_HEADS = 4
MLA_Q_LORA = 256
MLA_KV_LORA = 128
MLA_NOPE = 64
MLA_ROPE = 32
MLA_V = GROUP_W // MLA_HEADS
ROPE_THETA = 10000.0

N_EXPERT_GROUPS = 4
EXPERTS_PER_GROUP = 4
N_EXPERTS = N_EXPERT_GROUPS * EXPERTS_PER_GROUP
TOP_K_IN_GROUP = 2
D_EXPERT = 256

IN_SIZES = (3 * GROUP_W,
            GROUP_W,
            SSM_XBC,
            SSM_HEADS,
            2 * GROUP_W,
            GROUP_W,
            MLSTM_HEADS,
            MLSTM_HEADS,
            GROUP_W,
            MLA_Q_LORA,
            MLA_KV_LORA,
            MLA_ROPE)
N_IN = sum(IN_SIZES)

kernel_name = 'hybrid_moba_ssd_mlstm_mla_hmoe'

F32 = jnp.float32


def rms_norm(x, g):
    xf = x.astype(F32)
    y = xf * lax.rsqrt(jnp.mean(xf * xf, axis=-1, keepdims=True) + EPS)
    return (y * g.astype(F32)).astype(x.dtype)


def causal_conv(x, w, b):
    k = w.shape[0]
    y = lax.conv_general_dilated(x, w[:, None, :].astype(x.dtype), window_strides=(1,),
                                 padding=[(k - 1, 0)], dimension_numbers=('NWC', 'WIO', 'NWC'),
                                 feature_group_count=x.shape[-1])
    return y + b.astype(x.dtype)


def rope_tables(positions):
    inv = ROPE_THETA ** (-jnp.arange(0, MLA_ROPE, 2, dtype=F32) / MLA_ROPE)
    ang = positions.astype(F32)[..., None] * inv
    return jnp.cos(ang), jnp.sin(ang)


def apply_rope(x, cos, sin):
    half = x.shape[-1] // 2
    x1 = x[..., :half].astype(F32)
    x2 = x[..., half:].astype(F32)
    return jnp.concatenate([x1 * cos - x2 * sin, x2 * cos + x1 * sin], axis=-1).astype(x.dtype)


def moba_attention(q, k, v):
    bsz, s, h, dh = q.shape
    nb = -(-s // MOBA_BLOCK)
    pad = nb * MOBA_BLOCK - s
    topk = min(MOBA_TOPK, nb)
    nq = s // Q_BLOCK
    scale = dh ** -0.5
    kb = jnp.pad(k, ((0, 0), (0, pad), (0, 0), (0, 0))).reshape(bsz, nb, MOBA_BLOCK, h, dh).transpose(0, 3, 1, 2, 4)
    vb = jnp.pad(v, ((0, 0), (0, pad), (0, 0), (0, 0))).reshape(bsz, nb, MOBA_BLOCK, h, dh).transpose(0, 3, 1, 2, 4)
    k_mean = jnp.mean(kb.astype(F32), axis=3)
    q_blocks = q.reshape(bsz, nq, Q_BLOCK, h, dh).transpose(1, 0, 3, 2, 4)
    take_blocks = jax.vmap(jax.vmap(lambda blocks, idx: blocks[idx]))

    def one_block(args):
        ci, qi = args
        q_pos = ci * Q_BLOCK + jnp.arange(Q_BLOCK)
        cur = (ci * Q_BLOCK) // MOBA_BLOCK
        gate = jnp.einsum('bhqd,bhnd->bhqn', qi.astype(F32), k_mean)
        gate = jnp.where(jnp.arange(nb) < cur, gate, -jnp.inf)
        _, sel = lax.top_k(gate, topk)
        valid = sel < cur
        k_sel = take_blocks(kb, sel)
        v_sel = take_blocks(vb, sel)
        s_sel = jnp.einsum('bhqd,bhqnjd->bhqnj', qi, k_sel).astype(F32) * scale
        s_sel = jnp.where(valid[..., None], s_sel, -jnp.inf).reshape(bsz, h, Q_BLOCK, topk * MOBA_BLOCK)
        k_own = lax.dynamic_index_in_dim(kb, cur, axis=2, keepdims=False)
        v_own = lax.dynamic_index_in_dim(vb, cur, axis=2, keepdims=False)
        k_pos = cur * MOBA_BLOCK + jnp.arange(MOBA_BLOCK)
        s_own = jnp.einsum('bhqd,bhjd->bhqj', qi, k_own).astype(F32) * scale
        s_own = jnp.where(k_pos[None, :] <= q_pos[:, None], s_own, -jnp.inf)
        p = jax.nn.softmax(jnp.concatenate([s_sel, s_own], axis=-1), axis=-1).astype(v.dtype)
        p_sel = p[..., :topk * MOBA_BLOCK].reshape(bsz, h, Q_BLOCK, topk, MOBA_BLOCK)
        p_own = p[..., topk * MOBA_BLOCK:]
        return (jnp.einsum('bhqnj,bhqnjd->bhqd', p_sel, v_sel)
                + jnp.einsum('bhqj,bhjd->bhqd', p_own, v_own))

    out = lax.map(one_block, (jnp.arange(nq), q_blocks))
    return out.transpose(1, 0, 3, 2, 4).reshape(bsz, s, h * dh)


def mamba2_ssd(z, xbc, dt_raw, conv_w, conv_b, dt_bias, a_log, d_skip, norm_g):
    bsz, s, _ = xbc.shape
    hh, pp, nn, ll = SSM_HEADS, SSM_HD, SSM_STATE, SSM_CHUNK
    nc = s // ll
    xbc = jax.nn.silu(causal_conv(xbc, conv_w, conv_b)).astype(F32)
    x = xbc[..., :GROUP_W].reshape(bsz, s, hh, pp)
    rep = hh // SSM_GROUPS
    bm = jnp.repeat(xbc[..., GROUP_W:GROUP_W + SSM_GROUPS * nn].reshape(bsz, s, SSM_GROUPS, nn), rep, axis=2)
    cm = jnp.repeat(xbc[..., GROUP_W + SSM_GROUPS * nn:].reshape(bsz, s, SSM_GROUPS, nn), rep, axis=2)
    dt = jax.nn.softplus(dt_raw.astype(F32) + dt_bias.astype(F32))
    a = -jnp.exp(a_log.astype(F32))
    xc = x.reshape(bsz, nc, ll, hh, pp)
    bc = bm.reshape(bsz, nc, ll, hh, nn)
    cc = cm.reshape(bsz, nc, ll, hh, nn)
    dtc = dt.reshape(bsz, nc, ll, hh)
    a_cum = jnp.cumsum(dtc * a, axis=2)
    causal = jnp.tril(jnp.ones((ll, ll), dtype=bool))
    seg = a_cum[:, :, :, None, :] - a_cum[:, :, None, :, :]
    decay_in = jnp.exp(jnp.where(causal[None, None, :, :, None], seg, -jnp.inf))
    xdt = xc * dtc[..., None]
    scores = jnp.einsum('bclhn,bcshn->bclsh', cc, bc) * decay_in
    y_diag = jnp.einsum('bclsh,bcshp->bclhp', scores, xdt)
    decay_out = jnp.exp(a_cum[:, :, -1:, :] - a_cum)
    chunk_states = jnp.einsum('bclhn,bclh,bclhp->bchpn', bc, decay_out, xdt)
    chunk_decay = jnp.exp(a_cum[:, :, -1, :])

    def carry_state(state, inp):
        st, dec = inp
        return state * dec[:, :, None, None] + st, state

    _, prev = lax.scan(carry_state, jnp.zeros((bsz, hh, pp, nn), F32),
                       (jnp.moveaxis(chunk_states, 1, 0), jnp.moveaxis(chunk_decay, 1, 0)))
    prev = jnp.moveaxis(prev, 0, 1)
    y_off = jnp.einsum('bclhn,bchpn,bclh->bclhp', cc, prev, jnp.exp(a_cum))
    y = (y_diag + y_off).reshape(bsz, s, hh, pp) + x * d_skip.astype(F32)[:, None]
    y = y.reshape(bsz, s, GROUP_W) * jax.nn.silu(z.astype(F32))
    gsz = GROUP_W // SSM_GROUPS
    y = rms_norm(y.reshape(bsz, s, SSM_GROUPS, gsz), norm_g.reshape(SSM_GROUPS, gsz))
    return y.reshape(bsz, s, GROUP_W).astype(z.dtype)


def mlstm_mixer(qk, v, i_pre, f_pre, o_pre, conv_w, conv_b, ig_bias, fg_bias, norm_g):
    bsz, s, _ = v.shape
    hh, dd, ll = MLSTM_HEADS, MLSTM_HD, MLSTM_CHUNK
    nc = s // ll
    qk = jax.nn.silu(causal_conv(qk, conv_w, conv_b)).astype(F32)
    q = qk[..., :GROUP_W]
    k = qk[..., GROUP_W:] * (dd ** -0.5)

    def heads(t):
        return t.reshape(bsz, nc, ll, hh, dd).transpose(1, 0, 3, 2, 4)

    def gates(t):
        return t.reshape(bsz, nc, ll, hh).transpose(1, 0, 3, 2)

    qc, kc, vc = heads(q), heads(k), heads(v.astype(F32))
    igc = gates(i_pre.astype(F32) + ig_bias.astype(F32))
    lfc = gates(jax.nn.log_sigmoid(f_pre.astype(F32) + fg_bias.astype(F32)))
    causal = jnp.tril(jnp.ones((ll, ll), dtype=bool))

    def chunk_step(carry, inp):
        c_st, n_st, m_st = carry
        qb, kb, vb, ig, lf = inp
        b = jnp.cumsum(lf, axis=-1)
        dmat = jnp.where(causal, b[..., :, None] - b[..., None, :] + ig[..., None, :], -jnp.inf)
        inter = b + m_st[..., None]
        m_t = jnp.maximum(inter, jnp.max(dmat, axis=-1))
        sc = jnp.einsum('bhld,bhsd->bhls', qb, kb) * jnp.exp(dmat - m_t[..., None])
        w_inter = jnp.exp(inter - m_t)
        num = jnp.einsum('bhls,bhse->bhle', sc, vb) + w_inter[..., None] * jnp.einsum('bhld,bhde->bhle', qb, c_st)
        den = jnp.sum(sc, axis=-1) + w_inter * jnp.einsum('bhld,bhd->bhl', qb, n_st)
        h = num / jnp.maximum(jnp.abs(den), jnp.exp(-m_t))[..., None]
        g = b[..., -1:] - b + ig
        m_new = jnp.maximum(b[..., -1] + m_st, jnp.max(g, axis=-1))
        w_state = jnp.exp(g - m_new[..., None])
        keep = jnp.exp(b[..., -1] + m_st - m_new)
        c_new = keep[..., None, None] * c_st + jnp.einsum('bhs,bhsd,bhse->bhde', w_state, kb, vb)
        n_new = keep[..., None] * n_st + jnp.einsum('bhs,bhsd->bhd', w_state, kb)
        return (c_new, n_new, m_new), h

    init = (jnp.zeros((bsz, hh, dd, dd), F32), jnp.zeros((bsz, hh, dd), F32), jnp.zeros((bsz, hh), F32))
    _, hs = lax.scan(chunk_step, init, (qc, kc, vc, igc, lfc))
    h = hs.transpose(1, 0, 3, 2, 4).reshape(bsz, s, hh, dd)
    h = jax.nn.sigmoid(o_pre.astype(F32)).reshape(bsz, s, hh, dd) * h
    h = rms_norm(h, norm_g.reshape(hh, dd))
    return h.reshape(bsz, s, GROUP_W).astype(v.dtype)


def mla_attention(c_q, c_kv, k_rope, cos, sin, q_norm_g, w_uq, kv_norm_g, w_ukv):
    bsz, s, _ = c_q.shape
    nq = s // Q_BLOCK
    hh = MLA_HEADS
    q = (rms_norm(c_q, q_norm_g) @ w_uq).reshape(bsz, s, hh, MLA_NOPE + MLA_ROPE)
    kv = (rms_norm(c_kv, kv_norm_g) @ w_ukv).reshape(bsz, s, hh, MLA_NOPE + MLA_V)
    q_nope = q[..., :MLA_NOPE]
    q_pe = apply_rope(q[..., MLA_NOPE:], cos[:, :, None, :], sin[:, :, None, :])
    k_nope = kv[..., :MLA_NOPE].transpose(0, 2, 1, 3)
    v = kv[..., MLA_NOPE:].transpose(0, 2, 1, 3)
    k_pe = apply_rope(k_rope, cos, sin)
    qn_b = q_nope.reshape(bsz, nq, Q_BLOCK, hh, MLA_NOPE).transpose(1, 0, 3, 2, 4)
    qp_b = q_pe.reshape(bsz, nq, Q_BLOCK, hh, MLA_ROPE).transpose(1, 0, 3, 2, 4)
    scale = (MLA_NOPE + MLA_ROPE) ** -0.5
    k_pos = jnp.arange(s)

    def one_block(args):
        ci, qn, qp = args
        q_pos = ci * Q_BLOCK + jnp.arange(Q_BLOCK)
        sc = (jnp.einsum('bhqd,bhkd->bhqk', qn, k_nope)
              + jnp.einsum('bhqr,bkr->bhqk', qp, k_pe)).astype(F32) * scale
        sc = jnp.where(k_pos[None, :] <= q_pos[:, None], sc, -jnp.inf)
        p = jax.nn.softmax(sc, axis=-1).astype(v.dtype)
        return jnp.einsum('bhqk,bhkd->bhqd', p, v)

    out = lax.map(one_block, (jnp.arange(nq), qn_b, qp_b))
    return out.transpose(1, 0, 3, 2, 4).reshape(bsz, s, hh * MLA_V)


def hier_moe(x, w_group, b_group, w_router, b_router, w_gate, w_up, w_down):
    bsz, s, d = x.shape
    t = x.reshape(bsz * s, d)
    n_tok = t.shape[0]
    g_prob = jax.nn.softmax((t @ w_group).astype(F32) + b_group.astype(F32), axis=-1)
    g_w, g_idx = lax.top_k(g_prob, 1)
    e_logits = ((t @ w_router).astype(F32) + b_router.astype(F32)).reshape(n_tok, N_EXPERT_GROUPS, EXPERTS_PER_GROUP)
    idx = jnp.broadcast_to(g_idx[:, :, None], (n_tok, 1, EXPERTS_PER_GROUP))
    e_logits = jnp.take_along_axis(e_logits, idx, axis=1)[:, 0]
    e_w, e_idx = lax.top_k(jax.nn.softmax(e_logits, axis=-1), TOP_K_IN_GROUP)
    e_w = e_w / jnp.sum(e_w, axis=-1, keepdims=True)
    expert_id = g_idx * EXPERTS_PER_GROUP + e_idx
    combine = jnp.sum(jax.nn.one_hot(expert_id, N_EXPERTS, dtype=F32) * (g_w * e_w)[..., None], axis=1)
    hid = jax.nn.silu(jnp.einsum('td,edf->tef', t, w_gate)) * jnp.einsum('td,edf->tef', t, w_up)
    hid = hid * combine[:, :, None].astype(hid.dtype)
    return jnp.einsum('tef,efd->td', hid, w_down).reshape(bsz, s, d)


def setup_inputs(seed: int = 0) -> dict:
    key = jax.random.key(seed)
    ks = jax.random.split(key, 32)
    L = DEPTH

    def normal(k, shape, scale):
        return jax.random.normal(k, shape, F32) * scale

    def gain(k, shape):
        return 1.0 + 0.01 * jax.random.normal(k, shape, F32)

    x = normal(ks[0], (BATCH, SEQ, D_MODEL), 1.0)
    start = jax.random.randint(ks[1], (BATCH, 1), 0, 1024, dtype=jnp.int32)
    positions = (start + jnp.arange(SEQ, dtype=jnp.int32)[None, :]).astype(jnp.int32)
    dt0 = jnp.exp(jax.random.uniform(ks[6], (L, SSM_HEADS), F32, math.log(1e-3), math.log(1e-1)))
    return {
        'x': x,
        'positions': positions,
        'norm_mix_g': gain(ks[2], (L, D_MODEL)),
        'w_in': normal(ks[3], (L, D_MODEL, N_IN), D_MODEL ** -0.5),
        'ssm_conv_w': normal(ks[4], (L, SSM_CONV, SSM_XBC), SSM_CONV ** -0.5),
        'ssm_conv_b': normal(ks[5], (L, SSM_XBC), 0.01),
        'ssm_dt_bias': dt0 + jnp.log(-jnp.expm1(-dt0)),
        'ssm_a_log': jnp.log(jax.random.uniform(ks[7], (L, SSM_HEADS), F32, 1.0, 16.0)),
        'ssm_d': gain(ks[8], (L, SSM_HEADS)),
        'ssm_norm_g': gain(ks[9], (L, GROUP_W)),
        'ml_conv_w': normal(ks[10], (L, MLSTM_CONV, 2 * GROUP_W), MLSTM_CONV ** -0.5),
        'ml_conv_b': normal(ks[11], (L, 2 * GROUP_W), 0.01),
        'ml_ig_bias': normal(ks[12], (L, MLSTM_HEADS), 0.1),
        'ml_fg_bias': 3.0 + 3.0 * jax.random.uniform(ks[13], (L, MLSTM_HEADS), F32),
        'ml_norm_g': gain(ks[14], (L, GROUP_W)),
        'mla_q_norm_g': gain(ks[15], (L, MLA_Q_LORA)),
        'mla_w_uq': normal(ks[16], (L, MLA_Q_LORA, MLA_HEADS * (MLA_NOPE + MLA_ROPE)), MLA_Q_LORA ** -0.5),
        'mla_kv_norm_g': gain(ks[17], (L, MLA_KV_LORA)),
        'mla_w_ukv': normal(ks[18], (L, MLA_KV_LORA, MLA_HEADS * (MLA_NOPE + MLA_V)), MLA_KV_LORA ** -0.5),
        'w_out': normal(ks[19], (L, D_MIX, D_MODEL), D_MIX ** -0.5),
        'norm_ffn_g': gain(ks[20], (L, D_MODEL)),
        'moe_w_group': normal(ks[21], (L, D_MODEL, N_EXPERT_GROUPS), D_MODEL ** -0.5),
        'moe_b_group': normal(ks[22], (L, N_EXPERT_GROUPS), 0.01),
        'moe_w_router': normal(ks[23], (L, D_MODEL, N_EXPERTS), D_MODEL ** -0.5),
        'moe_b_router': normal(ks[24], (L, N_EXPERTS), 0.01),
        'moe_w_gate': normal(ks[25], (L, N_EXPERTS, D_MODEL, D_EXPERT), D_MODEL ** -0.5),
        'moe_w_up': normal(ks[26], (L, N_EXPERTS, D_MODEL, D_EXPERT), D_MODEL ** -0.5),
        'moe_w_down': normal(ks[27], (L, N_EXPERTS, D_EXPERT, D_MODEL), D_EXPERT ** -0.5),
        'final_norm_g': gain(ks[28], (D_MODEL,)),
    }


def reference(x, positions, norm_mix_g, w_in, ssm_conv_w, ssm_conv_b, ssm_dt_bias, ssm_a_log, ssm_d,
              ssm_norm_g, ml_conv_w, ml_conv_b, ml_ig_bias, ml_fg_bias, ml_norm_g, mla_q_norm_g, mla_w_uq,
              mla_kv_norm_g, mla_w_ukv, w_out, norm_ffn_g, moe_w_group, moe_b_group, moe_w_router,
              moe_b_router, moe_w_gate, moe_w_up, moe_w_down, final_norm_g):
    bsz, s, _ = x.shape
    cos, sin = rope_tables(positions)
    split_at = [int(i) for i in np.cumsum(IN_SIZES)[:-1]]
    for l in range(DEPTH):
        h = rms_norm(x, norm_mix_g[l])
        proj = h @ w_in[l]
        (a_qkv, s_z, s_xbc, s_dt, m_qk, m_v, m_i, m_f, m_o,
         d_cq, d_ckv, d_kr) = jnp.split(proj, split_at, axis=-1)
        aq, ak, av = jnp.split(a_qkv.reshape(bsz, s, 3, MOBA_HEADS, MOBA_HD), 3, axis=2)
        y_a = moba_attention(aq[:, :, 0], ak[:, :, 0], av[:, :, 0]).astype(x.dtype)
        y_b = mamba2_ssd(s_z, s_xbc, s_dt, ssm_conv_w[l], ssm_conv_b[l], ssm_dt_bias[l],
                         ssm_a_log[l], ssm_d[l], ssm_norm_g[l]).astype(x.dtype)
        y_c = mlstm_mixer(m_qk, m_v, m_i, m_f, m_o, ml_conv_w[l], ml_conv_b[l], ml_ig_bias[l],
                          ml_fg_bias[l], ml_norm_g[l]).astype(x.dtype)
        y_d = mla_attention(d_cq, d_ckv, d_kr, cos, sin, mla_q_norm_g[l], mla_w_uq[l],
                            mla_kv_norm_g[l], mla_w_ukv[l]).astype(x.dtype)
        x = x + jnp.concatenate([y_a, y_b, y_c, y_d], axis=-1) @ w_out[l]
        h2 = rms_norm(x, norm_ffn_g[l])
        x = x + hier_moe(h2, moe_w_group[l], moe_b_group[l], moe_w_router[l], moe_b_router[l],
                         moe_w_gate[l], moe_w_up[l], moe_w_down[l]).astype(x.dtype)
    return rms_norm(x, final_norm_g)
```

```cpp
#include <hip/hip_runtime.h>
#include <stdint.h>
#include <math.h>

typedef unsigned short bf16_t;
typedef unsigned short us8 __attribute__((ext_vector_type(8)));
typedef unsigned short us4 __attribute__((ext_vector_type(4)));

constexpr int BATCH = 2, SEQ = 8192, DM = 1024, M = BATCH * SEQ, DEPTH = 2;
constexpr int NIN = 3244;
constexpr float EPS = 1e-6f;
constexpr float LOG2E = 1.4426950408889634f;
constexpr float C2A = 0.125f * LOG2E;
constexpr float C2M = 0.10206207261596575f * LOG2E;
constexpr int PC_AQ = 0, PC_AK = 256, PC_AV = 512, PC_Z = 768, PC_XBC = 1024, PC_MQK = 1792, PC_MV = 2304, PC_MO = 2560, PC_CQ = 2816, PROJ_W = 3072;
constexpr int PF_CKV = 0, PF_KR = 128, PF_DT = 160, PF_MI = 164, PF_MF = 168, PROJF_W = 256;

__host__ __device__ inline int dst_col(int n) {
    if (n < 1792) return n;
    if (n < 1796) return PROJ_W + PF_DT + (n - 1792);
    if (n < 2308) return PC_MQK + (n - 1796);
    if (n < 2564) return PC_MV + (n - 2308);
    if (n < 2568) return PROJ_W + PF_MI + (n - 2564);
    if (n < 2572) return PROJ_W + PF_MF + (n - 2568);
    if (n < 2828) return PC_MO + (n - 2572);
    if (n < 3084) return PC_CQ + (n - 2828);
    if (n < 3212) return PROJ_W + PF_CKV + (n - 3084);
    return PROJ_W + PF_KR + (n - 3212);
}

__device__ __forceinline__ float bf2f(bf16_t v) { return __uint_as_float(((unsigned)v) << 16); }
__device__ __forceinline__ bf16_t f2bf(float f) { unsigned u = __float_as_uint(f); return (bf16_t)((u + 0x7fffu + ((u >> 16) & 1u)) >> 16); }
__device__ __forceinline__ float silu_f(float x) { return x / (1.f + __expf(-x)); }
__device__ __forceinline__ float sigmoid_f(float x) { return 1.f / (1.f + __expf(-x)); }
__device__ __forceinline__ float softplus_f(float x) { return x > 20.f ? x : log1pf(__expf(x)); }

#ifdef WAVE_SUM_SHFL
__device__ __forceinline__ float wave_sum(float v) {
#pragma unroll
    for (int o = 1; o < 64; o <<= 1) v += __shfl_xor(v, o);
    return v;
}
#else
#define WS_DPP(v, ctrl) ((v) + __int_as_float(__builtin_amdgcn_update_dpp(0, __float_as_int(v), (ctrl), 0xf, 0xf, true)))
__device__ __forceinline__ float wave_sum(float v) {
    v = WS_DPP(v, 0xB1);
    v = WS_DPP(v, 0x4E);
    v = WS_DPP(v, 0x141);
    v = WS_DPP(v, 0x140);
    { auto rr = __builtin_amdgcn_permlane16_swap(__float_as_uint(v), __float_as_uint(v), false, false); v = __uint_as_float(rr[0]) + __uint_as_float(rr[1]); }
    { auto rr = __builtin_amdgcn_permlane32_swap(__float_as_uint(v), __float_as_uint(v), false, false); v = __uint_as_float(rr[0]) + __uint_as_float(rr[1]); }
    return v;
}
#endif
__device__ __forceinline__ float block_sum256(float v, float* sh) {
    v = wave_sum(v);
    __syncthreads();
    if ((threadIdx.x & 63) == 0) sh[threadIdx.x >> 6] = v;
    __syncthreads();
    return sh[0] + sh[1] + sh[2] + sh[3];
}

__global__ __launch_bounds__(256) void k_rmsnorm_bf16(const float* __restrict__ x, const float* __restrict__ g, bf16_t* __restrict__ out) {
    __shared__ float sh[4];
    const int m = blockIdx.x, t = threadIdx.x;
    const float4 v = ((const float4*)(x + (size_t)m * DM))[t];
    const float ss = block_sum256(v.x * v.x + v.y * v.y + v.z * v.z + v.w * v.w, sh);
    const float r = rsqrtf(ss * (1.f / DM) + EPS);
    const float4 gg = ((const float4*)g)[t];
    us4 o; o.x = f2bf(v.x * r * gg.x); o.y = f2bf(v.y * r * gg.y); o.z = f2bf(v.z * r * gg.z); o.w = f2bf(v.w * r * gg.w);
    ((us4*)(out + (size_t)m * DM))[t] = o;
}
__global__ __launch_bounds__(256) void k_rmsnorm_f32(const float* x, const float* __restrict__ g, float* out) {
    __shared__ float sh[4];
    const int m = blockIdx.x, t = threadIdx.x;
    const float4 v = ((const float4*)(x + (size_t)m * DM))[t];
    const float ss = block_sum256(v.x * v.x + v.y * v.y + v.z * v.z + v.w * v.w, sh);
    const float r = rsqrtf(ss * (1.f / DM) + EPS);
    const float4 gg = ((const float4*)g)[t];
    float4 o; o.x = v.x * r * gg.x; o.y = v.y * r * gg.y; o.z = v.z * r * gg.z; o.w = v.w * r * gg.w;
    ((float4*)(out + (size_t)m * DM))[t] = o;
}

template <class Epi>
__global__ __launch_bounds__(256) void k_gemm(const bf16_t* __restrict__ A, int lda, const float* __restrict__ W, int ldw, int N, int K, Epi epi) {
    __shared__ float As[16][68];
    __shared__ float Bs[16][68];
    const int tid = threadIdx.x, tx = tid & 15, ty = tid >> 4;
    const int m0 = blockIdx.y * 64, n0 = blockIdx.x * 64;
    float acc[4][4];
#pragma unroll
    for (int i = 0; i < 4; ++i)
#pragma unroll
        for (int j = 0; j < 4; ++j) acc[i][j] = 0.f;
    for (int k0 = 0; k0 < K; k0 += 16) {
        {
            const int r = tid >> 2, kq = (tid & 3) * 4;
            const us4 v = *(const us4*)(A + (size_t)(m0 + r) * lda + k0 + kq);
            As[kq + 0][r] = bf2f(v.x); As[kq + 1][r] = bf2f(v.y); As[kq + 2][r] = bf2f(v.z); As[kq + 3][r] = bf2f(v.w);
        }
        {
            const int kk = tid >> 4, nq = (tid & 15) * 4, n = n0 + nq;
            float4 v = make_float4(0.f, 0.f, 0.f, 0.f);
            if (n < N) v = *(const float4*)(W + (size_t)(k0 + kk) * ldw + n);
            Bs[kk][nq + 0] = v.x; Bs[kk][nq + 1] = v.y; Bs[kk][nq + 2] = v.z; Bs[kk][nq + 3] = v.w;
        }
        __syncthreads();
#pragma unroll
        for (int kk = 0; kk < 16; ++kk) {
            float a[4], b[4];
#pragma unroll
            for (int i = 0; i < 4; ++i) { a[i] = As[kk][ty * 4 + i]; b[i] = Bs[kk][tx * 4 + i]; }
#pragma unroll
            for (int i = 0; i < 4; ++i)
#pragma unroll
                for (int j = 0; j < 4; ++j) acc[i][j] += a[i] * b[j];
        }
        __syncthreads();
    }
#pragma unroll
    for (int i = 0; i < 4; ++i)
#pragma unroll
        for (int j = 0; j < 4; ++j) { const int n = n0 + tx * 4 + j; if (n < N) epi(m0 + ty * 4 + i, n, acc[i][j]); }
}

struct EpiInProjNaive {
    bf16_t* proj; float* projf;
    __device__ void operator()(int m, int n, float v) const {
        const int c = dst_col(n);
        if (c < PROJ_W) { if (c < 256) v *= C2A; proj[(size_t)m * PROJ_W + c] = f2bf(v); }
        else projf[(size_t)m * PROJF_W + (c - PROJ_W)] = v;
    }
};
struct EpiResidual {
    float* x;
    __device__ void operator()(int m, int n, float v) const { x[(size_t)m * DM + n] += v; }
};
struct EpiF32 {
    float* out; int ld; int pad;
    __device__ void operator()(int m, int n, float v) const { out[(size_t)m * ld + n] = v; }
};
struct EpiMlaKV {
    bf16_t* km; bf16_t* vm;
    __device__ void operator()(int m, int n, float v) const {
        const int h = n >> 7, d = n & 127;
        if (d < 64) km[(size_t)m * 384 + h * 96 + d] = f2bf(v); else vm[(size_t)m * 256 + h * 64 + (d - 64)] = f2bf(v);
    }
};

__global__ __launch_bounds__(256) void k_conv_silu(const bf16_t* __restrict__ src, int ld, int c0, int C, const float* __restrict__ w, const float* __restrict__ b, bf16_t* __restrict__ dst) {
    const size_t idx = (size_t)blockIdx.x * 256 + threadIdx.x;
    if (idx >= (size_t)M * C) return;
    const int m = (int)(idx / C), c = (int)(idx % C), t = m % SEQ;
    float acc = b[c];
#pragma unroll
    for (int i = 0; i < 4; ++i) { const int tt = t - 3 + i; if (tt >= 0) acc += w[i * C + c] * bf2f(src[(size_t)(m - 3 + i) * ld + c0 + c]); }
    dst[(size_t)m * C + c] = f2bf(silu_f(acc));
}

__global__ __launch_bounds__(256) void k_ssd_scan(const bf16_t* __restrict__ xbca, const bf16_t* __restrict__ proj, const float* __restrict__ projf,
                                                  const float* __restrict__ dt_bias, const float* __restrict__ a_log, const float* __restrict__ d_skip, float* __restrict__ yg) {
    const int blk = blockIdx.x, ps = blk & 3, h = (blk >> 2) & 3, b = blk >> 4;
    const int tid = threadIdx.x, pl = tid >> 4, ns = tid & 15, p = ps * 16 + pl, g = h >> 1;
    const float a = -__expf(a_log[h]), dtb = dt_bias[h], dsk = d_skip[h];
    float st[8];
#pragma unroll
    for (int i = 0; i < 8; ++i) st[i] = 0.f;
    const size_t m0 = (size_t)b * SEQ;
    for (int t = 0; t < SEQ; ++t) {
        const size_t m = m0 + t;
        const float dtv = softplus_f(projf[m * PROJF_W + PF_DT + h] + dtb);
        const float dA = __expf(dtv * a);
        const float xv = bf2f(xbca[m * 768 + h * 64 + p]);
        const us8 Bv = *(const us8*)(xbca + m * 768 + 256 + g * 128 + ns * 8);
        const us8 Cv = *(const us8*)(xbca + m * 768 + 512 + g * 128 + ns * 8);
        const float dx = dtv * xv;
        float y = 0.f;
#pragma unroll
        for (int i = 0; i < 8; ++i) { st[i] = dA * st[i] + dx * bf2f(Bv[i]); y += bf2f(Cv[i]) * st[i]; }
        y += __shfl_xor(y, 1); y += __shfl_xor(y, 2); y += __shfl_xor(y, 4); y += __shfl_xor(y, 8);
        if (ns == 0) {
            const float z = bf2f(proj[m * PROJ_W + PC_Z + h * 64 + p]);
            yg[m * 256 + h * 64 + p] = (y + dsk * xv) * silu_f(z);
        }
    }
}
__global__ __launch_bounds__(256) void k_group_norm(const float* __restrict__ yg, const float* __restrict__ g, int gsz_log2, bf16_t* __restrict__ ycat, int col0) {
    const int wave = (blockIdx.x * 256 + threadIdx.x) >> 6, lane = threadIdx.x & 63;
    const int m = wave >> 1, half = wave & 1;
    if (m >= M) return;
    const float v0 = yg[(size_t)m * 256 + half * 128 + lane * 2], v1 = yg[(size_t)m * 256 + half * 128 + lane * 2 + 1];
    float ss = v0 * v0 + v1 * v1;
    const int nl = (1 << gsz_log2) >> 1;
    for (int o = 1; o < nl; o <<= 1) ss += __shfl_xor(ss, o);
    const float r = rsqrtf(ss / (float)(1 << gsz_log2) + EPS);
    const int c = half * 128 + lane * 2;
    ycat[(size_t)m * DM + col0 + c] = f2bf(v0 * r * g[c]);
    ycat[(size_t)m * DM + col0 + c + 1] = f2bf(v1 * r * g[c + 1]);
}

__global__ __launch_bounds__(256) void k_mlstm_scan(const bf16_t* __restrict__ qka, const bf16_t* __restrict__ proj, const float* __restrict__ projf,
                                                    const float* __restrict__ ig_bias, const float* __restrict__ fg_bias, float* __restrict__ hg) {
    const int blk = blockIdx.x, es = blk & 3, h = (blk >> 2) & 3, b = blk >> 4;
    const int tid = threadIdx.x, el = tid >> 4, ds = tid & 15, e = es * 16 + el;
    const float igb = ig_bias[h], fgb = fg_bias[h];
    float C[4] = {0.f, 0.f, 0.f, 0.f}, nn[4] = {0.f, 0.f, 0.f, 0.f};
    const size_t m0 = (size_t)b * SEQ;
    for (int t = 0; t < SEQ; ++t) {
        const size_t m = m0 + t;
        const float f = sigmoid_f(projf[m * PROJF_W + PF_MF + h] + fgb);
        const float ig = __expf(projf[m * PROJF_W + PF_MI + h] + igb);
        const us4 qv = *(const us4*)(qka + m * 512 + h * 64 + ds * 4);
        const us4 kv = *(const us4*)(qka + m * 512 + 256 + h * 64 + ds * 4);
        const float v = bf2f(proj[m * PROJ_W + PC_MV + h * 64 + e]);
        float num = 0.f, den = 0.f;
#pragma unroll
        for (int i = 0; i < 4; ++i) {
            const float k = bf2f(kv[i]) * 0.125f, q = bf2f(qv[i]);
            C[i] = f * C[i] + ig * k * v; nn[i] = f * nn[i] + ig * k;
            num += q * C[i]; den += q * nn[i];
        }
        num += __shfl_xor(num, 1); num += __shfl_xor(num, 2); num += __shfl_xor(num, 4); num += __shfl_xor(num, 8);
        den += __shfl_xor(den, 1); den += __shfl_xor(den, 2); den += __shfl_xor(den, 4); den += __shfl_xor(den, 8);
        if (ds == 0) {
            const float o = sigmoid_f(bf2f(proj[m * PROJ_W + PC_MO + h * 64 + e]));
            hg[m * 256 + h * 64 + e] = o * num / fmaxf(fabsf(den), 1.f);
        }
    }
}

__global__ __launch_bounds__(256) void k_moba_kmean(const bf16_t* __restrict__ proj, float* __restrict__ kmean) {
    const int jg = blockIdx.x, c = threadIdx.x;
    float s = 0.f;
    for (int r = 0; r < 256; ++r) s += bf2f(proj[(size_t)(jg * 256 + r) * PROJ_W + PC_AK + c]);
    kmean[jg * 256 + c] = s * (1.f / 256.f);
}
__global__ __launch_bounds__(256) void k_moba_attn(const bf16_t* __restrict__ proj, const float* __restrict__ kmean, bf16_t* __restrict__ ycat) {
    __shared__ float km[32][64];
    __shared__ float Ks[32][64];
    __shared__ float Vs[32][64];
    const int blk = blockIdx.x, cur = blk & 31, h = (blk >> 5) & 3, b = blk >> 7;
    const int tid = threadIdx.x, t = cur * 256 + tid;
    const size_t mq = (size_t)b * SEQ + t;
    float q[64];
#pragma unroll
    for (int d8 = 0; d8 < 8; ++d8) { const us8 v = *(const us8*)(proj + mq * PROJ_W + PC_AQ + h * 64 + d8 * 8);
#pragma unroll
        for (int i = 0; i < 8; ++i) q[d8 * 8 + i] = bf2f(v[i]); }
    for (int i = tid; i < 32 * 64; i += 256) { const int j = i >> 6, d = i & 63; km[j][d] = kmean[(b * 32 + j) * 256 + h * 64 + d]; }
    __syncthreads();
    float v0 = -INFINITY, v1 = -INFINITY, v2 = -INFINITY; int i0 = -1, i1 = -1, i2 = -1;
    for (int j = 0; j < cur; ++j) {
        float gq = 0.f;
#pragma unroll
        for (int d = 0; d < 64; ++d) gq += q[d] * km[j][d];
        if (gq > v0) { v2 = v1; i2 = i1; v1 = v0; i1 = i0; v0 = gq; i0 = j; }
        else if (gq > v1) { v2 = v1; i2 = i1; v1 = gq; i1 = j; }
        else if (gq > v2) { v2 = gq; i2 = j; }
    }
    unsigned sel = 0u;
    if (i0 >= 0) sel |= 1u << i0;
    if (i1 >= 0) sel |= 1u << i1;
    if (i2 >= 0) sel |= 1u << i2;
    float o[64];
#pragma unroll
    for (int d = 0; d < 64; ++d) o[d] = 0.f;
    float mx = -INFINITY, l = 0.f;
    for (int jb = 0; jb <= cur; ++jb) {
        for (int kt = 0; kt < 8; ++kt) {
            __syncthreads();
            for (int i = tid; i < 32 * 64; i += 256) { const int r = i >> 6, d = i & 63; const size_t mk = (size_t)b * SEQ + jb * 256 + kt * 32 + r;
                Ks[r][d] = bf2f(proj[mk * PROJ_W + PC_AK + h * 64 + d]); Vs[r][d] = bf2f(proj[mk * PROJ_W + PC_AV + h * 64 + d]); }
            __syncthreads();
            const bool use = (jb == cur) || ((sel >> jb) & 1u);
            if (use) {
                for (int kk = 0; kk < 32; ++kk) {
                    const int key = jb * 256 + kt * 32 + kk;
                    if (key > t) break;
                    float s = 0.f;
#pragma unroll
                    for (int d = 0; d < 64; ++d) s += q[d] * Ks[kk][d];
                    if (s > mx) { const float f = exp2f(mx - s); l *= f;
#pragma unroll
                        for (int d = 0; d < 64; ++d) o[d] *= f;
                        mx = s; }
                    const float p = exp2f(s - mx); l += p;
#pragma unroll
                    for (int d = 0; d < 64; ++d) o[d] += p * Vs[kk][d];
                }
            }
        }
    }
    const float rl = 1.f / l;
#pragma unroll
    for (int d = 0; d < 64; ++d) ycat[mq * DM + 0 + h * 64 + d] = f2bf(o[d] * rl);
}

__global__ __launch_bounds__(256) void k_mla_prep(const bf16_t* __restrict__ proj, const float* __restrict__ projf, const int* __restrict__ positions,
                                                  const float* __restrict__ gq, const float* __restrict__ gkv, bf16_t* __restrict__ cqn, bf16_t* __restrict__ ckvn, bf16_t* __restrict__ km) {
    __shared__ float sh[4];
    const int m = blockIdx.x, tid = threadIdx.x;
    const float cq = bf2f(proj[(size_t)m * PROJ_W + PC_CQ + tid]);
    const float s1 = block_sum256(cq * cq, sh);
    cqn[(size_t)m * 256 + tid] = f2bf(cq * rsqrtf(s1 * (1.f / 256.f) + EPS) * gq[tid]);
    const float ck = tid < 128 ? projf[(size_t)m * PROJF_W + PF_CKV + tid] : 0.f;
    const float s2 = block_sum256(ck * ck, sh);
    if (tid < 128) ckvn[(size_t)m * 128 + tid] = f2bf(ck * rsqrtf(s2 * (1.f / 128.f) + EPS) * gkv[tid]);
    if (tid < 16) {
        const float pos = (float)positions[m];
        const float inv = powf(10000.f, -(float)(2 * tid) / 32.f);
        const float ang = pos * inv; float sn, cs; sincosf(ang, &sn, &cs);
        const float x1 = projf[(size_t)m * PROJF_W + PF_KR + tid], x2 = projf[(size_t)m * PROJF_W + PF_KR + 16 + tid];
        const bf16_t o1 = f2bf(x1 * cs - x2 * sn), o2 = f2bf(x2 * cs + x1 * sn);
#pragma unroll
        for (int h = 0; h < 4; ++h) { km[(size_t)m * 384 + h * 96 + 64 + tid] = o1; km[(size_t)m * 384 + h * 96 + 80 + tid] = o2; }
    }
}
__global__ __launch_bounds__(256) void k_mla_qfinish(const float* __restrict__ qraw, const int* __restrict__ positions, bf16_t* __restrict__ qm) {
    const size_t idx = (size_t)blockIdx.x * 256 + threadIdx.x;
    if (idx >= (size_t)M * 384) return;
    const int m = (int)(idx / 384), c = (int)(idx % 384), h = c / 96, d = c % 96;
    float v;
    if (d < 64) v = qraw[idx];
    else {
        const int i = (d - 64) & 15; const bool second = (d - 64) >= 16;
        const float pos = (float)positions[m];
        const float inv = powf(10000.f, -(float)(2 * i) / 32.f);
        float sn, cs; sincosf(pos * inv, &sn, &cs);
        const float x1 = qraw[(size_t)m * 384 + h * 96 + 64 + i], x2 = qraw[(size_t)m * 384 + h * 96 + 80 + i];
        v = second ? (x2 * cs + x1 * sn) : (x1 * cs - x2 * sn);
    }
    qm[idx] = f2bf(v * C2M);
}
__global__ __launch_bounds__(256) void k_mla_attn(const bf16_t* __restrict__ qm, const bf16_t* __restrict__ km, const bf16_t* __restrict__ vm, bf16_t* __restrict__ ycat) {
    __shared__ float Ks[32][96];
    __shared__ float Vs[32][64];
    const int blk = blockIdx.x, qb = 31 - (blk & 31), h = (blk >> 5) & 3, b = blk >> 7;
    const int tid = threadIdx.x, t = qb * 256 + tid;
    const size_t mq = (size_t)b * SEQ + t;
    float q[96];
#pragma unroll
    for (int d8 = 0; d8 < 12; ++d8) { const us8 v = *(const us8*)(qm + mq * 384 + h * 96 + d8 * 8);
#pragma unroll
        for (int i = 0; i < 8; ++i) q[d8 * 8 + i] = bf2f(v[i]); }
    float o[64];
#pragma unroll
    for (int d = 0; d < 64; ++d) o[d] = 0.f;
    float mx = -INFINITY, l = 0.f;
    const int ntiles = (qb + 1) * 8;
    for (int kt = 0; kt < ntiles; ++kt) {
        __syncthreads();
        for (int i = tid; i < 32 * 96; i += 256) { const int r = i / 96, d = i % 96; Ks[r][d] = bf2f(km[((size_t)b * SEQ + kt * 32 + r) * 384 + h * 96 + d]); }
        for (int i = tid; i < 32 * 64; i += 256) { const int r = i >> 6, d = i & 63; Vs[r][d] = bf2f(vm[((size_t)b * SEQ + kt * 32 + r) * 256 + h * 64 + d]); }
        __syncthreads();
        for (int kk = 0; kk < 32; ++kk) {
            const int key = kt * 32 + kk;
            if (key > t) break;
            float s = 0.f;
#pragma unroll
            for (int d = 0; d < 96; ++d) s += q[d] * Ks[kk][d];
            if (s > mx) { const float f = exp2f(mx - s); l *= f;
#pragma unroll
                for (int d = 0; d < 64; ++d) o[d] *= f;
                mx = s; }
            const float p = exp2f(s - mx); l += p;
#pragma unroll
            for (int d = 0; d < 64; ++d) o[d] += p * Vs[kk][d];
        }
    }
    const float rl = 1.f / l;
#pragma unroll
    for (int d = 0; d < 64; ++d) ycat[mq * DM + 768 + h * 64 + d] = f2bf(o[d] * rl);
}

__global__ __launch_bounds__(256) void k_moe_naive(float* x, const float* __restrict__ gn, const float* __restrict__ wg, const float* __restrict__ bg,
                                                   const float* __restrict__ wr, const float* __restrict__ br, const float* __restrict__ wgate, const float* __restrict__ wup, const float* __restrict__ wdown) {
    __shared__ float h2[1024];
    __shared__ float red[4][20];
    __shared__ float sh[4];
    __shared__ float hid[2][256];
    __shared__ int sE[2]; __shared__ float sW[2];
    __shared__ float slg[20]; __shared__ float spe[4];
    const int m = blockIdx.x, tid = threadIdx.x, lane = tid & 63, wv = tid >> 6;
    const float4 v = ((const float4*)(x + (size_t)m * DM))[tid];
    const float ss = block_sum256(v.x * v.x + v.y * v.y + v.z * v.z + v.w * v.w, sh);
    const float r = rsqrtf(ss * (1.f / DM) + EPS);
    const float4 gg = ((const float4*)gn)[tid];
    const float hv[4] = {v.x * r * gg.x, v.y * r * gg.y, v.z * r * gg.z, v.w * r * gg.w};
#pragma unroll
    for (int i = 0; i < 4; ++i) h2[tid * 4 + i] = hv[i];
    float part[20];
#pragma unroll
    for (int j = 0; j < 20; ++j) part[j] = 0.f;
#pragma unroll
    for (int i = 0; i < 4; ++i) { const int d = tid * 4 + i;
#pragma unroll
        for (int j = 0; j < 4; ++j) part[j] += hv[i] * wg[d * 4 + j];
#pragma unroll
        for (int j = 0; j < 16; ++j) part[4 + j] += hv[i] * wr[d * 16 + j]; }
#pragma unroll
    for (int j = 0; j < 20; ++j) { const float s = wave_sum(part[j]); if (lane == 0) red[wv][j] = s; }
    __syncthreads();
    if (tid < 20) slg[tid] = red[0][tid] + red[1][tid] + red[2][tid] + red[3][tid] + (tid < 4 ? bg[tid] : br[tid - 4]);
    __syncthreads();
    if (tid == 0) {
        int gi = 0; float gm = slg[0];
        for (int j = 1; j < 4; ++j) if (slg[j] > gm) { gm = slg[j]; gi = j; }
        float gs = 0.f; for (int j = 0; j < 4; ++j) gs += __expf(slg[j] - gm);
        const float g_w = 1.f / gs;
        float em = -INFINITY;
        for (int j = 0; j < 4; ++j) em = fmaxf(em, slg[4 + gi * 4 + j]);
        float es = 0.f;
        for (int j = 0; j < 4; ++j) { const float p = __expf(slg[4 + gi * 4 + j] - em); spe[j] = p; es += p; }
        int e0 = 0; float p0 = spe[0];
        for (int j = 1; j < 4; ++j) if (spe[j] > p0) { p0 = spe[j]; e0 = j; }
        int e1 = -1; float p1 = -1.f;
        for (int j = 0; j < 4; ++j) if (j != e0 && spe[j] > p1) { p1 = spe[j]; e1 = j; }
        p0 /= es; p1 /= es;
        const float sw = p0 + p1;
        sE[0] = gi * 4 + e0; sE[1] = gi * 4 + e1; sW[0] = g_w * p0 / sw; sW[1] = g_w * p1 / sw;
    }
    __syncthreads();
#pragma unroll
    for (int j = 0; j < 2; ++j) {
        const int E = sE[j];
        const float* G = wgate + (size_t)E * 1024 * 256 + tid; const float* U = wup + (size_t)E * 1024 * 256 + tid;
        float ga = 0.f, ua = 0.f;
        for (int d = 0; d < 1024; ++d) { const float hd = h2[d]; ga += hd * G[(size_t)d * 256]; ua += hd * U[(size_t)d * 256]; }
        hid[j][tid] = silu_f(ga) * ua * sW[j];
    }
    __syncthreads();
    float out[4] = {0.f, 0.f, 0.f, 0.f};
#pragma unroll
    for (int j = 0; j < 2; ++j) {
        const float* Dn = wdown + (size_t)sE[j] * 256 * 1024;
        for (int f = 0; f < 256; ++f) { const float hf = hid[j][f];
#pragma unroll
            for (int i = 0; i < 4; ++i) out[i] += hf * Dn[(size_t)f * 1024 + tid + 256 * i]; }
    }
#pragma unroll
    for (int i = 0; i < 4; ++i) x[(size_t)m * DM + tid + 256 * i] += out[i];
}

#define ATOMIC_ROUTE 1
#define ST_WT_OFF 1
#define LOADS_OFF 1
#define PADZERO_OFF 1
#define NO_ENTRY_BARRIER 1
#define NO_EXIT_BARRIER 1
namespace pg8 {
#define PG8_LAS __attribute__((address_space(3)))
typedef short bf16x8 __attribute__((ext_vector_type(8)));
typedef float f32x4 __attribute__((ext_vector_type(4)));
typedef unsigned u32x4 __attribute__((ext_vector_type(4)));
constexpr int BM = 256, BK = 64, HALF = 128, HTB = HALF * BK * 2  , STAGE_BYTES = 8 * HTB, NXCD = 8, WGM = 8;

__host__ __device__ __forceinline__ int lds_byte(int r, int c) { const int st = (r >> 4) * 2 + (c >> 5), rr = r & 15, cc = c & 31, ob = rr * 64 + cc * 2; return st * 1024 + (ob ^ (((ob >> 9) & 1) << 5)); }
__host__ __device__ __forceinline__ void stage_rc(int b, int& R, int& C) { const int st = b / 1024, sb = b % 1024, swz = sb ^ (((sb >> 9) & 1) << 5); R = (st >> 1) * 16 + swz / 64; C = (st & 1) * 32 + (swz % 64) / 2; }
__host__ __device__ __forceinline__ int perm32(int rho) { const int n = rho >> 4, i = rho & 15; return 8 * (i >> 2) + 4 * n + (i & 3); }

struct Unit { int pm, pn; };
struct Dims { int K, lda, ldb; };

struct StaticOrder {
    const bf16_t* A; const bf16_t* Bt; int lda, ldb, K;
    int nM, nN, nwg, G, c;
    __device__ void init(const bf16_t* A_, const bf16_t* Bt_, int lda_, int ldb_, int K_, int Mrows, int N, int G_, int c_) { A = A_; Bt = Bt_; lda = lda_; ldb = ldb_; K = K_; nM = Mrows / BM; nN = N / BM; nwg = nM * nN; G = G_; c = c_; }
    __device__ bool next(int i, Unit& u) const {
        const long L = (long)i * G + c; if (L >= nwg) return false;
        int wgid = (int)L; { const int q = nwg / NXCD, r = nwg % NXCD, xcd = wgid % NXCD, off = wgid / NXCD; wgid = (xcd < r ? xcd * (q + 1) : r * (q + 1) + (xcd - r) * q) + off; }
        const int nig = WGM * nN, gid = wgid / nig, fm = gid * WGM, gsz = (nM - fm) < WGM ? (nM - fm) : WGM;
        u.pm = fm + ((wgid % nig) % gsz); u.pn = (wgid % nig) / gsz; return true;
    }
    __device__ __forceinline__ const char* a_ptr(const Unit& u) const { return (const char*)A + (size_t)u.pm * BM * lda * 2; }
    __device__ __forceinline__ const char* b_ptr(const Unit& u, int half) const { return (const char*)Bt + (size_t)u.pn * BM * ldb * 2 + (half ? (size_t)(K / 2) * 2 : 0); }
};

__device__ __forceinline__ unsigned cvt_pk_bf16(float lo, float hi) { unsigned r; asm volatile("v_cvt_pk_bf16_f32 %0, %1, %2" : "=v"(r) : "v"(lo), "v"(hi)); return r; }

template <class Epi, class Sched>
__device__ __forceinline__ void gemm_phase(PG8_LAS unsigned char* lds, const int wid, const Dims g, const Sched& S, const Epi& E) {
    int lane = (int)__builtin_amdgcn_mbcnt_hi(~0u, __builtin_amdgcn_mbcnt_lo(~0u, 0u)); asm volatile("" : "+v"(lane));
    const int tid = wid * 64 + lane, wr = wid >> 2, wc = wid & 3, fr = lane & 15, fq = lane >> 4;
    int K = g.K, lda = g.lda, ldb = g.ldb; asm volatile("" : "+s"(K), "+s"(lda), "+s"(ldb));
    const int nt = K / BK, nth = nt / 2;
    unsigned voffA[2], voffB[2];
#pragma unroll
    for (int i = 0; i < 2; ++i) { int R, C; stage_rc(tid * 16 + i * 8192, R, C); const int Rb = (R & ~31) + perm32(R & 31);
        voffA[i] = (unsigned)(R * lda + C) * 2u; voffB[i] = (unsigned)(Rb * ldb + C) * 2u; }
    const size_t kstep = (size_t)(BK * 2);
    const size_t hstepA = (size_t)HALF * lda * 2, hstepB = (size_t)HALF * ldb * 2;
    const unsigned ldsw = (unsigned)wid * 1024u;
    const int aoff = lds_byte(wr * 64 + fr, fq * 8), boff = lds_byte(wc * 32 + fr, fq * 8);
#define PG8_SA(b, h) (((b) * 2 + (h)) * HTB)
#define PG8_SB(b, h) ((4 + (b) * 2 + (h)) * HTB)
#define PG8_STAGE(bufoff, gbase, voff) do { _Pragma("unroll") for (int _i = 0; _i < 2; ++_i) \
        __builtin_amdgcn_global_load_lds((const unsigned*)((const char*)(gbase) + (voff)[_i]), (PG8_LAS unsigned*)(lds + (bufoff) + ldsw + _i * 8192), 16, 0, 0); } while (0)
#define PG8_LDA(dst, b, h) do { _Pragma("unroll") for (int m = 0; m < 4; ++m) _Pragma("unroll") for (int k = 0; k < 2; ++k) dst[m][k] = *(const PG8_LAS bf16x8*)(lds + PG8_SA(b, h) + aoff + m * 2048 + k * 1024); } while (0)
#define PG8_LDB(dst, b, h) do { _Pragma("unroll") for (int n = 0; n < 2; ++n) _Pragma("unroll") for (int k = 0; k < 2; ++k) dst[n][k] = *(const PG8_LAS bf16x8*)(lds + PG8_SB(b, h) + boff + n * 2048 + k * 1024); } while (0)
#define PG8_MMA(ai, bj, At, Bt) do { __builtin_amdgcn_s_setprio(1); _Pragma("unroll") for (int m = 0; m < 4; ++m) _Pragma("unroll") for (int n = 0; n < 2; ++n) _Pragma("unroll") for (int k = 0; k < 2; ++k) \
        acc[ai][bj][m][n] = __builtin_amdgcn_mfma_f32_16x16x32_bf16(Bt[n][k], At[m][k], acc[ai][bj][m][n], 0, 0, 0); __builtin_amdgcn_s_setprio(0); } while (0)
#define PG8_WAIT_V(n) asm volatile("s_waitcnt vmcnt(" #n ")" ::: "memory")
#define PG8_WAIT_L(n) asm volatile("s_waitcnt lgkmcnt(" #n ")" ::: "memory")
#define PG8_BAR __builtin_amdgcn_s_barrier()
#define PG8_SCHED __builtin_amdgcn_sched_barrier(0)
#define PG8_BP(b0, b1, t) (((t) < nth) ? ((b0) + (size_t)(t) * kstep) : ((b1) + (size_t)((t) - nth) * kstep))
    Unit cur, nxt; int ui = 0;
    if (!S.next(0, cur)) return;
    f32x4 acc[2][2][4][2];
#pragma unroll
    for (int a = 0; a < 2; ++a)
#pragma unroll
        for (int b = 0; b < 2; ++b)
#pragma unroll
            for (int m = 0; m < 4; ++m)
#pragma unroll
                for (int n = 0; n < 2; ++n) acc[a][b][m][n] = (f32x4){0.f, 0.f, 0.f, 0.f};
    bf16x8 At[4][2], B0[2][2], B1[2][2];
    const char* cA = S.a_ptr(cur); const char* cB0 = S.b_ptr(cur, 0); const char* cB1 = S.b_ptr(cur, 1);
    {
        const char* b0 = PG8_BP(cB0, cB1, 0); const char* b1 = PG8_BP(cB0, cB1, 1);
        PG8_STAGE(PG8_SB(0, 0), b0, voffB); PG8_STAGE(PG8_SB(0, 1), b0 + hstepB, voffB); PG8_STAGE(PG8_SA(0, 0), cA, voffA); PG8_STAGE(PG8_SA(0, 1), cA + hstepA, voffA);
        if (wr == 1) PG8_BAR;
        PG8_WAIT_V(2); PG8_BAR;
        PG8_STAGE(PG8_SB(1, 0), b1, voffB); PG8_STAGE(PG8_SA(1, 0), cA + kstep, voffA); PG8_STAGE(PG8_SB(1, 1), b1 + hstepB, voffB);
        PG8_WAIT_V(6); PG8_BAR;
    }
    for (;;) {
        const bool has_next = S.next(ui + 1, nxt);
        const char* nA = has_next ? S.a_ptr(nxt) : cA; const char* nB0 = has_next ? S.b_ptr(nxt, 0) : cB0; const char* nB1 = has_next ? S.b_ptr(nxt, 1) : cB1;
        for (int t = 0; t < nt; t += 2) {
            const bool last = (t == nt - 2);
            const char* a1 = cA + (size_t)(t + 1) * kstep;
            const char* a2 = last ? nA : cA + (size_t)(t + 2) * kstep;
            const char* a3 = a2 + kstep;
            const char* b2 = last ? PG8_BP(nB0, nB1, 0) : PG8_BP(cB0, cB1, t + 2);
            const char* b3 = last ? PG8_BP(nB0, nB1, 1) : PG8_BP(cB0, cB1, t + 3);
            PG8_LDB(B0, 0, 0); PG8_LDB(B1, 0, 1); PG8_SCHED; PG8_LDA(At, 0, 0); PG8_STAGE(PG8_SA(1, 1), a1 + hstepA, voffA);
            PG8_WAIT_V(8); PG8_WAIT_L(0); PG8_BAR; PG8_MMA(0, 0, At, B0); PG8_MMA(0, 1, At, B1); PG8_BAR; PG8_SCHED;
            PG8_LDA(At, 0, 1); PG8_STAGE(PG8_SB(0, 0), b2, voffB); PG8_STAGE(PG8_SB(0, 1), b2 + hstepB, voffB); PG8_STAGE(PG8_SA(0, 0), a2, voffA);
            PG8_WAIT_V(8); PG8_WAIT_L(0); PG8_BAR; PG8_MMA(1, 0, At, B0); PG8_MMA(1, 1, At, B1); PG8_BAR; PG8_SCHED;
            PG8_LDB(B0, 1, 0); PG8_LDB(B1, 1, 1); PG8_SCHED; PG8_LDA(At, 1, 0); PG8_STAGE(PG8_SA(0, 1), a2 + hstepA, voffA);
            PG8_WAIT_V(8); PG8_WAIT_L(0); PG8_BAR; PG8_MMA(0, 0, At, B0); PG8_MMA(0, 1, At, B1); PG8_BAR; PG8_SCHED;
            PG8_LDA(At, 1, 1); PG8_STAGE(PG8_SB(1, 0), b3, voffB); PG8_STAGE(PG8_SB(1, 1), b3 + hstepB, voffB); PG8_STAGE(PG8_SA(1, 0), a3, voffA);
            PG8_WAIT_V(8); PG8_WAIT_L(0); PG8_BAR; PG8_MMA(1, 0, At, B0); PG8_MMA(1, 1, At, B1); PG8_BAR; PG8_SCHED;
        }
        if (wr == 0) PG8_BAR;
        E(acc, cur, wr, wc, fr, fq);
        if (!has_next) break;
#pragma unroll
        for (int a = 0; a < 2; ++a)
#pragma unroll
            for (int b = 0; b < 2; ++b)
#pragma unroll
                for (int m = 0; m < 4; ++m)
#pragma unroll
                    for (int n = 0; n < 2; ++n) acc[a][b][m][n] = (f32x4){0.f, 0.f, 0.f, 0.f};
        cur = nxt; cA = nA; cB0 = nB0; cB1 = nB1; ++ui;
        if (wr == 1) PG8_BAR;
    }
    PG8_WAIT_V(0);
    PG8_BAR;
#undef PG8_SA
#undef PG8_SB
#undef PG8_STAGE
#undef PG8_LDA
#undef PG8_LDB
#undef PG8_MMA
#undef PG8_WAIT_V
#undef PG8_WAIT_L
#undef PG8_BAR
#undef PG8_SCHED
#undef PG8_BP
}
}
#define GAS __attribute__((address_space(1)))
#define LAS __attribute__((address_space(3)))
typedef GAS unsigned gu32;
#define RLX_AGENT __ATOMIC_RELAXED, __HIP_MEMORY_SCOPE_AGENT
#define XB_TMO      128
#define XB_XCNT(j)  (256  + 64 * (j))
#define XB_XSUB(j)  (1280 + 64 * (j))
#define XB_XGEN(j)  (2304 + 64 * (j))
#define XB_TOP      3328
#define XB_TOPGEN   3392
#define XCD_BAR_WORDS 3456
#define XB_SPIN_CAP (1u << 18)

__device__ __forceinline__ unsigned xb_ld(unsigned* p)              { return __hip_atomic_load(p, __ATOMIC_RELAXED, __HIP_MEMORY_SCOPE_AGENT); }
__device__ __forceinline__ unsigned xb_add(unsigned* p, unsigned v) { return __hip_atomic_fetch_add(p, v, __ATOMIC_RELAXED, __HIP_MEMORY_SCOPE_AGENT); }
__device__ __forceinline__ unsigned xb_xcc_id() { return (unsigned)__builtin_amdgcn_s_getreg((3 << 11) | 20) & 0xFu; }
#define XB_SPIN(cond, bar) do { unsigned _sp = 0; while (cond) { __builtin_amdgcn_s_sleep(1); \
    if ((++_sp & 255u) == 0u) { if (xb_ld(&(bar)[XB_TMO])) break; if (_sp > XB_SPIN_CAP) { atomicAdd(&(bar)[XB_TMO], 1u); break; } } } } while (0)

struct XcdBarrier {
    unsigned* bar; unsigned x;
    unsigned w0;
    volatile LAS unsigned* st;
};

__device__ __forceinline__ XcdBarrier xcd_barrier_post(unsigned* bar, volatile LAS unsigned* st) {
    XcdBarrier b; b.bar = bar; b.x = xb_xcc_id(); b.st = st; b.w0 = (__builtin_amdgcn_readfirstlane(threadIdx.x >> 6) == 0) ? 1u : 0u;
    if (threadIdx.x == 0) (void)xb_add(&bar[XB_XCNT(b.x)], 1u);
    return b;
}
__device__ __forceinline__ void xcd_barrier_complete(unsigned* bar, unsigned x, unsigned& nloc, unsigned& nx) {
    const unsigned G = gridDim.x * gridDim.y * gridDim.z;
    unsigned sum, cnt, mine, sp = 0u;
    for (;;) {
        sum = 0u; cnt = 0u; mine = 0u;
#pragma unroll
        for (unsigned j = 0; j < 16; ++j) { const unsigned c = xb_ld(&bar[XB_XCNT(j)]); sum += c; cnt += (c > 0u) ? 1u : 0u; mine = (j == x) ? c : mine; }
        if (sum == G) break;
        __builtin_amdgcn_s_sleep(1);
        if ((++sp & 255u) == 0u) { if (xb_ld(&bar[XB_TMO])) break; if (sp > XB_SPIN_CAP) { atomicAdd(&bar[XB_TMO], 1u); break; } }
    }
    nloc = mine > 0u ? mine : 1u; nx = cnt > 0u ? cnt : 1u;
}

__device__ __forceinline__ void xcd_barrier(const XcdBarrier& b) {
    asm volatile("s_waitcnt vmcnt(0)" ::: "memory");
    __syncthreads();
    if (b.w0 && __builtin_amdgcn_mbcnt_hi(~0u, __builtin_amdgcn_mbcnt_lo(~0u, 0u)) == 0u) {
        unsigned* bar = b.bar;
        __builtin_amdgcn_s_waitcnt(0);
        unsigned nloc = b.st[0], nx = b.st[1];
        if (nloc == 0u) { xcd_barrier_complete(bar, b.x, nloc, nx); b.st[0] = nloc; b.st[1] = nx; }
        const unsigned old = xb_add(&bar[XB_XSUB(b.x)], 1u);
        const unsigned gen = old / nloc;
        if (old + 1u == (gen + 1u) * nloc) {
            __builtin_amdgcn_fence(__ATOMIC_RELEASE, "agent");
            asm volatile("s_waitcnt vmcnt(0)" ::: "memory");
            const unsigned og = xb_add(&bar[XB_TOP], 1u);
            const unsigned tg = og / nx;
            if (og + 1u == (tg + 1u) * nx) xb_add(&bar[XB_TOPGEN], 1u);
            else XB_SPIN(xb_ld(&bar[XB_TOPGEN]) == tg, bar);
            __builtin_amdgcn_fence(__ATOMIC_ACQUIRE, "agent");
            xb_add(&bar[XB_XGEN(b.x)], 1u);
            asm volatile("s_waitcnt vmcnt(0)" ::: "memory");
        } else {
            XB_SPIN(xb_ld(&bar[XB_XGEN(b.x)]) == gen, bar);
            __builtin_amdgcn_fence(__ATOMIC_ACQUIRE, "agent");
            asm volatile("s_waitcnt vmcnt(0)" ::: "memory");
        }
    }
    __syncthreads();
}
constexpr int NWAVES = 8;
constexpr size_t MiB = 1u << 20;
constexpr size_t WS_CTL = 0, CTL_ZERO_BYTES = 1 * MiB;
constexpr size_t WS_KMEAN = 1 * MiB;
constexpr size_t WS_WIN = 2 * MiB, WS_WOUT = 9 * MiB, WS_WUQ = 11 * MiB, WS_WUKV = 11 * MiB + 512 * 1024;
constexpr size_t WS_ACT = 12 * MiB, WS_PROJ = 44 * MiB, WS_PROJF = 140 * MiB, WS_XBCA = 156 * MiB, WS_QKA = 180 * MiB, WS_QM = 196 * MiB, WS_KM = 208 * MiB, WS_VM = 220 * MiB;
constexpr size_t WS_PREVT = 242 * MiB, WS_CST = 250 * MiB, WS_NST = 254 * MiB;
constexpr size_t WS_ROPE = 228 * MiB, WS_CQN = 230 * MiB, WS_CKVN = 238 * MiB, WS_ST = 230 * MiB  , WS_END = 256 * MiB;
constexpr int CW_BAR = 4096;
constexpr int MAX_BAR_REGIONS = 24;
static_assert((CW_BAR + MAX_BAR_REGIONS * 3456) * 4 <= (int)CTL_ZERO_BYTES, "CTL words inside the memset region");
constexpr int PROJ_N = 3328;
constexpr int RING_OFF = 0, RING_BYTES = 131072, LDSCTL_OFF = RING_BYTES, MISC_OFF = LDSCTL_OFF + 320, PTR_OFF = MISC_OFF + 128, LDS_BYTES = 147456;

__host__ __device__ inline int src_col(int c) {
    if (c < 1792) return c;
    if (c < 2304) return 1796 + (c - 1792);
    if (c < 2560) return 2308 + (c - 2304);
    if (c < 2816) return 2572 + (c - 2560);
    if (c < 3072) return 2828 + (c - 2816);
    const int f = c - 3072;
    if (f < 128) return 3084 + f;
    if (f < 160) return 3212 + (f - 128);
    if (f < 164) return 1792 + (f - 160);
    if (f < 168) return 2564 + (f - 164);
    if (f < 172) return 2568 + (f - 168);
    return -1;
}

typedef unsigned v4u __attribute__((ext_vector_type(4)));
typedef float f32x4 __attribute__((ext_vector_type(4)));
#define LDS_WAIT() asm volatile("s_waitcnt lgkmcnt(0)" ::: "memory")
#define VM_WAIT() asm volatile("s_waitcnt vmcnt(0)" ::: "memory")
__device__ __forceinline__ unsigned pk2(float lo, float hi) { return (unsigned)f2bf(lo) | ((unsigned)f2bf(hi) << 16); }

__device__ __forceinline__ const float* in_ptr(LAS unsigned char* lds, int i) {
    const unsigned long long v = ((const LAS unsigned long long*)(lds + PTR_OFF))[i];
    const unsigned lo = __builtin_amdgcn_readfirstlane((unsigned)v), hi = __builtin_amdgcn_readfirstlane((unsigned)(v >> 32));
    return (const float*)(((unsigned long long)hi << 32) | lo);
}
#ifdef ST_WT_OFF
__device__ __forceinline__ void st_wt(float* p, float v) { *p = v; }
__device__ __forceinline__ void st_wt(int* p, int v) { *p = v; }
#else
__device__ __forceinline__ void st_wt(float* p, float v) { __hip_atomic_store(p, v, __ATOMIC_RELAXED, __HIP_MEMORY_SCOPE_AGENT); }
__device__ __forceinline__ void st_wt(int* p, int v) { __hip_atomic_store(p, v, __ATOMIC_RELAXED, __HIP_MEMORY_SCOPE_AGENT); }
#endif
struct Args {
    const float* in[29]; float* out; unsigned char* ws; int ph_lo, ph_hi, bli, pad;
};

struct MapInProj { const float* W; __device__ const float* ptr(int) const { return W; } __device__ int col(int n) const { return src_col(n); } __device__ float scale(int n) const { return n < 256 ? C2A : 1.f; } };
struct MapPlain { const float* W; int ncols; float sc; __device__ const float* ptr(int) const { return W; } __device__ int col(int n) const { return n < ncols ? n : -1; } __device__ float scale(int) const { return sc; } };
template <class Map>
__device__ __forceinline__ void conv_item(const Map& mp, int ldw, int K, bf16_t* WT, int nblk, LAS float* scr, int item, int lane) {
    const int kb = item / nblk, nb = item % nblk, k0 = 64 * kb, n0 = 32 * nb;
    const int c4 = lane & 7, kr = lane >> 3;
    const int nd = n0 + 4 * c4; const int sc = mp.col(nd); const float scl = mp.scale(nd); const float* base = mp.ptr(nd);
    f32x4 v[8];
#pragma unroll
    for (int i = 0; i < 8; ++i) v[i] = sc >= 0 ? *(const GAS f32x4*)(base + (size_t)(k0 + 8 * i + kr) * ldw + sc) : (f32x4){0.f, 0.f, 0.f, 0.f};
#pragma unroll
    for (int i = 0; i < 8; ++i) { LAS float* d = scr + (8 * i + kr) * 33 + 4 * c4; d[0] = v[i].x * scl; d[1] = v[i].y * scl; d[2] = v[i].z * scl; d[3] = v[i].w * scl; }
    LDS_WAIT(); asm volatile("" ::: "memory");
    const int c = lane & 7;
#pragma unroll
    for (int j = 0; j < 4; ++j) { const int n = (lane >> 3) + 8 * j; const LAS float* s = scr + (8 * c) * 33 + n;
        v4u o; o.x = pk2(s[0 * 33], s[1 * 33]); o.y = pk2(s[2 * 33], s[3 * 33]); o.z = pk2(s[4 * 33], s[5 * 33]); o.w = pk2(s[6 * 33], s[7 * 33]);
        *(GAS v4u*)(WT + (size_t)(n0 + n) * K + k0 + 8 * c) = o; }
    LDS_WAIT(); asm volatile("" ::: "memory");
}
__device__ __forceinline__ void rms_row_to_bf16(const float* xrow, const float* g, bf16_t* orow, float* xcopy, int lane) {
    const GAS f32x4* xr = (const GAS f32x4*)xrow + lane; const GAS f32x4* gr = (const GAS f32x4*)g + lane;
    f32x4 v[4]; float s = 0.f;
#pragma unroll
    for (int j = 0; j < 4; ++j) { v[j] = xr[64 * j]; s += (v[j].x * v[j].x + v[j].y * v[j].y) + (v[j].z * v[j].z + v[j].w * v[j].w); }
    const float rstd = rsqrtf(wave_sum(s) * (1.f / DM) + EPS);
    if (xcopy) { GAS f32x4* xc = (GAS f32x4*)xcopy + lane;
#pragma unroll
        for (int j = 0; j < 4; ++j) xc[64 * j] = v[j]; }
    GAS unsigned long long* o8 = (GAS unsigned long long*)orow + lane;
#pragma unroll
    for (int j = 0; j < 4; ++j) { const f32x4 gg = gr[64 * j];
        o8[64 * j] = (unsigned long long)pk2(v[j].x * rstd * gg.x, v[j].y * rstd * gg.y) | ((unsigned long long)pk2(v[j].z * rstd * gg.z, v[j].w * rstd * gg.w) << 32); }
}
__device__ __forceinline__ void rms_row_to_f32(const float* xrow, const float* g, float* orow, int lane) {
    const GAS f32x4* xr = (const GAS f32x4*)xrow + lane; const GAS f32x4* gr = (const GAS f32x4*)g + lane;
    f32x4 v[4]; float s = 0.f;
#pragma unroll
    for (int j = 0; j < 4; ++j) { v[j] = xr[64 * j]; s += (v[j].x * v[j].x + v[j].y * v[j].y) + (v[j].z * v[j].z + v[j].w * v[j].w); }
    const float rstd = rsqrtf(wave_sum(s) * (1.f / DM) + EPS);
    GAS f32x4* o = (GAS f32x4*)orow + lane;
#pragma unroll
    for (int j = 0; j < 4; ++j) { const f32x4 gg = gr[64 * j]; o[64 * j] = (f32x4){v[j].x * rstd * gg.x, v[j].y * rstd * gg.y, v[j].z * rstd * gg.z, v[j].w * rstd * gg.w}; }
}

struct EpiInProj {
    bf16_t* proj; float* projf;
    __device__ __forceinline__ void operator()(const pg8::f32x4 (&acc)[2][2][4][2], const pg8::Unit& u, int wr, int wc, int fr, int fq) const {
        const int row0 = u.pm * 256 + wr * 64 + fr, col0 = wc * 32 + 8 * fq;
        if (u.pn < 12) {
#pragma unroll
            for (int ai = 0; ai < 2; ++ai)
#pragma unroll
                for (int m = 0; m < 4; ++m) { bf16_t* rowp = proj + (size_t)(row0 + ai * 128 + m * 16) * PROJ_W + u.pn * 256 + col0;
#pragma unroll
                    for (int bj = 0; bj < 2; ++bj) { const pg8::f32x4 v0 = acc[ai][bj][m][0], v1 = acc[ai][bj][m][1]; pg8::u32x4 w;
                        w.x = pg8::cvt_pk_bf16(v0[0], v0[1]); w.y = pg8::cvt_pk_bf16(v0[2], v0[3]); w.z = pg8::cvt_pk_bf16(v1[0], v1[1]); w.w = pg8::cvt_pk_bf16(v1[2], v1[3]);
                        *(pg8::u32x4*)(rowp + bj * 128) = w; } }
        } else {
#pragma unroll
            for (int ai = 0; ai < 2; ++ai)
#pragma unroll
                for (int m = 0; m < 4; ++m) { float* rowp = projf + (size_t)(row0 + ai * 128 + m * 16) * PROJF_W + col0;
#pragma unroll
                    for (int bj = 0; bj < 2; ++bj) { *(pg8::f32x4*)(rowp + bj * 128) = acc[ai][bj][m][0]; *(pg8::f32x4*)(rowp + bj * 128 + 4) = acc[ai][bj][m][1]; } }
        }
    }
};
struct EpiResidualF32 {
    float* x; const float* src;
    __device__ __forceinline__ void operator()(const pg8::f32x4 (&acc)[2][2][4][2], const pg8::Unit& u, int wr, int wc, int fr, int fq) const {
        const int row0 = u.pm * 256 + wr * 64 + fr, col0 = u.pn * 256 + wc * 32 + 8 * fq;
#pragma unroll
        for (int ai = 0; ai < 2; ++ai)
#pragma unroll
            for (int m = 0; m < 4; ++m) { float* rowp = x + (size_t)(row0 + ai * 128 + m * 16) * DM + col0; const float* srcp = src + (size_t)(row0 + ai * 128 + m * 16) * DM + col0;
#pragma unroll
                for (int bj = 0; bj < 2; ++bj) { pg8::f32x4* p = (pg8::f32x4*)(rowp + bj * 128); const GAS pg8::f32x4* q = (const GAS pg8::f32x4*)(srcp + bj * 128); const pg8::f32x4 a = q[0] + acc[ai][bj][m][0], b = q[1] + acc[ai][bj][m][1]; p[0] = a; p[1] = b; }
                asm volatile("" ::: "memory"); }
    }
};


struct EpiMlaQ {
    bf16_t* qm; const float* rope;
    __device__ __forceinline__ void operator()(const pg8::f32x4 (&acc)[2][2][4][2], const pg8::Unit& u, int wr, int wc, int fr, int fq) const {
        const int row0 = u.pm * 256 + wr * 64 + fr;
#pragma unroll
        for (int bj = 0; bj < 2; ++bj) {
            const int colg = u.pn * 256 + bj * 128 + wc * 32;
            if (colg >= 384) continue;
            const bool is_rope = ((colg >> 5) % 3) == 2;
#pragma unroll
            for (int ai = 0; ai < 2; ++ai)
#pragma unroll
                for (int m = 0; m < 4; ++m) {
                    const int row = row0 + ai * 128 + m * 16;
                    pg8::f32x4 v0 = acc[ai][bj][m][0], v1 = acc[ai][bj][m][1];
                    if (is_rope) {
                        pg8::f32x4 w0, w1;
#pragma unroll
                        for (int j = 0; j < 4; ++j) { w0[j] = __shfl_xor(v0[j], 32); w1[j] = __shfl_xor(v1[j], 32); }
                        const int i0 = (8 * fq) & 15;
                        const float* rp = rope + (size_t)row * 32 + i0;
                        const pg8::f32x4 c0 = *(const pg8::f32x4*)rp, c1 = *(const pg8::f32x4*)(rp + 4), s0 = *(const pg8::f32x4*)(rp + 16), s1 = *(const pg8::f32x4*)(rp + 20);
                        if (fq < 2) { v0 = v0 * c0 - w0 * s0; v1 = v1 * c1 - w1 * s1; } else { v0 = v0 * c0 + w0 * s0; v1 = v1 * c1 + w1 * s1; }
                    }
                    pg8::u32x4 w; w.x = pg8::cvt_pk_bf16(v0[0], v0[1]); w.y = pg8::cvt_pk_bf16(v0[2], v0[3]); w.z = pg8::cvt_pk_bf16(v1[0], v1[1]); w.w = pg8::cvt_pk_bf16(v1[2], v1[3]);
                    *(pg8::u32x4*)(qm + (size_t)row * 384 + colg + 8 * fq) = w;
                }
        }
    }
};
struct EpiMlaKVf {
    bf16_t* km; bf16_t* vm;
    __device__ __forceinline__ void operator()(const pg8::f32x4 (&acc)[2][2][4][2], const pg8::Unit& u, int wr, int wc, int fr, int fq) const {
        const int row0 = u.pm * 256 + wr * 64 + fr;
#pragma unroll
        for (int bj = 0; bj < 2; ++bj) {
            const int col = u.pn * 256 + bj * 128 + wc * 32 + 8 * fq, hh = col >> 7, d = col & 127;
#pragma unroll
            for (int ai = 0; ai < 2; ++ai)
#pragma unroll
                for (int m = 0; m < 4; ++m) {
                    const int row = row0 + ai * 128 + m * 16;
                    const pg8::f32x4 v0 = acc[ai][bj][m][0], v1 = acc[ai][bj][m][1];
                    pg8::u32x4 w; w.x = pg8::cvt_pk_bf16(v0[0], v0[1]); w.y = pg8::cvt_pk_bf16(v0[2], v0[3]); w.z = pg8::cvt_pk_bf16(v1[0], v1[1]); w.w = pg8::cvt_pk_bf16(v1[2], v1[3]);
                    bf16_t* dst = (d < 64) ? km + (size_t)row * 384 + hh * 96 + d : vm + (size_t)row * 256 + hh * 64 + (d - 64);
                    *(pg8::u32x4*)dst = w;
                }
        }
    }
};

__device__ __forceinline__ void conv_chunk(const bf16_t* proj, int m, int c0, int ch, int C, const float* w, const float* bias, bf16_t* dst, float osc) {
    const int t = m & (SEQ - 1);
    float acc[8];
    { const f32x4 b0 = *(const f32x4*)(bias + ch * 8), b1 = *(const f32x4*)(bias + ch * 8 + 4);
      acc[0] = b0.x; acc[1] = b0.y; acc[2] = b0.z; acc[3] = b0.w; acc[4] = b1.x; acc[5] = b1.y; acc[6] = b1.z; acc[7] = b1.w; }
#pragma unroll
    for (int i = 0; i < 4; ++i) {
        if (t - 3 + i >= 0) {
            const us8 x = *(const us8*)(proj + (size_t)(m - 3 + i) * PROJ_W + c0 + ch * 8);
            const f32x4 w0 = *(const f32x4*)(w + i * C + ch * 8), w1 = *(const f32x4*)(w + i * C + ch * 8 + 4);
            acc[0] += w0.x * bf2f(x[0]); acc[1] += w0.y * bf2f(x[1]); acc[2] += w0.z * bf2f(x[2]); acc[3] += w0.w * bf2f(x[3]);
            acc[4] += w1.x * bf2f(x[4]); acc[5] += w1.y * bf2f(x[5]); acc[6] += w1.z * bf2f(x[6]); acc[7] += w1.w * bf2f(x[7]);
        }
    }
    v4u o; o.x = pk2(silu_f(acc[0]) * osc, silu_f(acc[1]) * osc); o.y = pk2(silu_f(acc[2]) * osc, silu_f(acc[3]) * osc); o.z = pk2(silu_f(acc[4]) * osc, silu_f(acc[5]) * osc); o.w = pk2(silu_f(acc[6]) * osc, silu_f(acc[7]) * osc);
    *(v4u*)(dst + (size_t)m * C + ch * 8) = o;
}
__device__ __forceinline__ void conv_seg(const bf16_t* proj, int m0, int c0, int ch, int C, const float* w, const float* bias, bf16_t* dst, float osc) {
    const int t0 = m0 & (SEQ - 1);
    f32x4 wa[4], wb[4];
#pragma unroll
    for (int i = 0; i < 4; ++i) { wa[i] = *(const f32x4*)(w + i * C + ch * 8); wb[i] = *(const f32x4*)(w + i * C + ch * 8 + 4); }
    const f32x4 b0 = *(const f32x4*)(bias + ch * 8), b1 = *(const f32x4*)(bias + ch * 8 + 4);
    const bf16_t* src = proj + (size_t)m0 * PROJ_W + c0 + ch * 8;
    us8 x0 = us8{}, x1 = us8{}, x2 = us8{};
    if (t0 > 0) { x0 = *(const us8*)(src - 3 * (ptrdiff_t)PROJ_W); x1 = *(const us8*)(src - 2 * (ptrdiff_t)PROJ_W); x2 = *(const us8*)(src - (ptrdiff_t)PROJ_W); }
    for (int j = 0; j < 32; j += 8) {
        us8 xn[8];
#pragma unroll
        for (int k = 0; k < 8; ++k) xn[k] = *(const us8*)(src + (size_t)(j + k) * PROJ_W);
#pragma unroll
        for (int k = 0; k < 8; ++k) {
            float acc[8] = {b0.x, b0.y, b0.z, b0.w, b1.x, b1.y, b1.z, b1.w};
#define CS_TAP(i, xv) do { acc[0] += wa[i].x * bf2f(xv[0]); acc[1] += wa[i].y * bf2f(xv[1]); acc[2] += wa[i].z * bf2f(xv[2]); acc[3] += wa[i].w * bf2f(xv[3]); \
                           acc[4] += wb[i].x * bf2f(xv[4]); acc[5] += wb[i].y * bf2f(xv[5]); acc[6] += wb[i].z * bf2f(xv[6]); acc[7] += wb[i].w * bf2f(xv[7]); } while (0)
            const bool h3 = (t0 + j + k) >= 3, h2 = (t0 + j + k) >= 2, h1 = (t0 + j + k) >= 1;
            if (h3) CS_TAP(0, x0);
            if (h2) CS_TAP(1, x1);
            if (h1) CS_TAP(2, x2);
            CS_TAP(3, xn[k]);
#undef CS_TAP
            v4u o; o.x = pk2(silu_f(acc[0]) * osc, silu_f(acc[1]) * osc); o.y = pk2(silu_f(acc[2]) * osc, silu_f(acc[3]) * osc); o.z = pk2(silu_f(acc[4]) * osc, silu_f(acc[5]) * osc); o.w = pk2(silu_f(acc[6]) * osc, silu_f(acc[7]) * osc);
            *(v4u*)(dst + (size_t)(m0 + j + k) * C + ch * 8) = o;
            x0 = x1; x1 = x2; x2 = xn[k];
        }
    }
}
__device__ __forceinline__ void mla_prep_token(int m, int lane, const bf16_t* proj, const float* projf, const int* positions, const float* gq, const float* gkv,
                                               bf16_t* cqn, bf16_t* ckvn, bf16_t* km, float* rope) {
    { const us4 v = *(const us4*)(proj + (size_t)m * PROJ_W + PC_CQ + lane * 4);
      const float a = bf2f(v.x), b = bf2f(v.y), c = bf2f(v.z), d = bf2f(v.w);
      const float r = rsqrtf(wave_sum(a * a + b * b + c * c + d * d) * (1.f / 256.f) + EPS);
      const f32x4 g = *(const f32x4*)(gq + lane * 4);
      *(unsigned long long*)(cqn + (size_t)m * 256 + lane * 4) = (unsigned long long)pk2(a * r * g.x, b * r * g.y) | ((unsigned long long)pk2(c * r * g.z, d * r * g.w) << 32); }
    { const float a = projf[(size_t)m * PROJF_W + PF_CKV + lane * 2], b = projf[(size_t)m * PROJF_W + PF_CKV + lane * 2 + 1];
      const float r = rsqrtf(wave_sum(a * a + b * b) * (1.f / 128.f) + EPS);
      *(unsigned*)(ckvn + (size_t)m * 128 + lane * 2) = pk2(a * r * gkv[lane * 2], b * r * gkv[lane * 2 + 1]); }
    if (lane < 16) {
        const float pos = (float)positions[m];
        const float inv = exp2f(-(float)(2 * lane) * (13.287712379549449f / 32.f));
        float rev = pos * inv * 0.15915494309189535f; rev -= floorf(rev);
        const float sn = __builtin_amdgcn_sinf(rev), cs = __builtin_amdgcn_cosf(rev);
        rope[(size_t)m * 32 + lane] = cs; rope[(size_t)m * 32 + 16 + lane] = sn;
        const float x1 = projf[(size_t)m * PROJF_W + PF_KR + lane], x2 = projf[(size_t)m * PROJF_W + PF_KR + 16 + lane];
        const bf16_t o1 = f2bf(x1 * cs - x2 * sn), o2 = f2bf(x2 * cs + x1 * sn);
#pragma unroll
        for (int hh = 0; hh < 4; ++hh) { km[(size_t)m * 384 + hh * 96 + 64 + lane] = o1; km[(size_t)m * 384 + hh * 96 + 80 + lane] = o2; }
    }
}
__device__ __forceinline__ void kmean_item(int item, int lane, const bf16_t* proj, float* kmean) {
    const int jg = item >> 2, hh = item & 3, cc = lane & 7, rg = lane >> 3;
    float acc[8];
#pragma unroll
    for (int i = 0; i < 8; ++i) acc[i] = 0.f;
#pragma unroll 8
    for (int r = 0; r < 32; ++r) { const us8 x = *(const us8*)(proj + (size_t)(jg * 256 + rg * 32 + r) * PROJ_W + PC_AK + hh * 64 + cc * 8);
#pragma unroll
        for (int i = 0; i < 8; ++i) acc[i] += bf2f(x[i]); }
#pragma unroll
    for (int i = 0; i < 8; ++i) { float v = acc[i]; v += __shfl_xor(v, 8); v += __shfl_xor(v, 16); v += __shfl_xor(v, 32); acc[i] = v * (1.f / 256.f); }
    if (rg == 0) { *(f32x4*)(kmean + jg * 256 + hh * 64 + cc * 8) = (f32x4){acc[0], acc[1], acc[2], acc[3]}; *(f32x4*)(kmean + jg * 256 + hh * 64 + cc * 8 + 4) = (f32x4){acc[4], acc[5], acc[6], acc[7]}; }
}

constexpr size_t WS_WUP = 44 * MiB, WS_WDN = 60 * MiB, WS_XS = 68 * MiB, WS_HID = 112 * MiB, WS_STOK = 134 * MiB, WS_SW1 = WS_STOK + 128 * 1024, WS_SW2 = WS_STOK + 256 * 1024,
                 WS_TCLS = 135 * MiB, WS_TPOS = WS_TCLS + 64 * 1024, WS_TW1 = WS_TCLS + 128 * 1024, WS_TW2 = WS_TCLS + 192 * 1024;
constexpr int MOE_MAXTILES = 88, CW_MOECNT = 200000;
constexpr int TCLS_OFF = LDSCTL_OFF, OFFS_OFF = LDSCTL_OFF + 128;
__device__ __forceinline__ void pair_decode(int pr, int& a, int& b) { a = (pr < 3) ? 0 : ((pr < 5) ? 1 : 2); b = (pr < 3) ? pr + 1 : ((pr < 5) ? pr - 1 : 3); }
__device__ __forceinline__ int moe_tiles(const unsigned* cnt, LAS unsigned char* lds, bool t0) {
    LAS unsigned char* tcls = lds + TCLS_OFF; LAS int* offs = (LAS int*)(lds + OFFS_OFF);
    __syncthreads();
    if (t0) { int off = 0;
        _Pragma("unroll 1") for (int c = 0; c < 24; ++c) { const int n = (int)cnt[32 * c]; offs[c] = off; const int nt = (n + 255) >> 8; _Pragma("unroll 1") for (int t = 0; t < nt; ++t) tcls[(off >> 8) + t] = (unsigned char)c; off += nt << 8; }
        offs[24] = off; }
    __syncthreads();
    return offs[24] >> 8;
}
struct MoeOrder {
    const bf16_t* A; const bf16_t* W; int lda, ldb; size_t estride; int K; int ntile, G, c; const LAS unsigned char* tcls; bool down;
    __device__ bool next(int i, pg8::Unit& u) const { const int L = i * G + c; if (L >= ntile * 4) return false; u.pm = L >> 2; u.pn = L & 3; return true; }
    __device__ __forceinline__ const char* a_ptr(const pg8::Unit& u) const { return (const char*)A + (size_t)u.pm * 256 * lda * 2; }
    __device__ __forceinline__ const char* b_ptr(const pg8::Unit& u, int half) const {
        const int cls = tcls[u.pm], g = cls / 6; int ea, eb; pair_decode(cls - g * 6, ea, eb);
        if (down) { const int e = g * 4 + (half ? eb : ea); return (const char*)(W + (size_t)e * estride + (size_t)u.pn * 256 * ldb); }
        const int e = g * 4 + ((u.pn < 2) ? ea : eb); return (const char*)(W + (size_t)e * estride + (size_t)(u.pn & 1) * 256 * ldb + (half ? K / 2 : 0));
    }
};
struct EpiMoeUp {
    bf16_t* hid; const float* w1; const float* w2;
    __device__ __forceinline__ void operator()(const pg8::f32x4 (&acc)[2][2][4][2], const pg8::Unit& u, int wr, int wc, int fr, int fq) const {
        const int row0 = u.pm * 256 + wr * 64 + fr; const float* ws = (u.pn < 2) ? w1 : w2;
#pragma unroll
        for (int ai = 0; ai < 2; ++ai)
#pragma unroll
            for (int m = 0; m < 4; ++m) { const int row = row0 + ai * 128 + m * 16; const float wt = ws[row];
                const pg8::f32x4 g0 = acc[ai][0][m][0], g1 = acc[ai][0][m][1], u0 = acc[ai][1][m][0], u1 = acc[ai][1][m][1];
                pg8::u32x4 w;
                w.x = pg8::cvt_pk_bf16(silu_f(g0[0]) * u0[0] * wt, silu_f(g0[1]) * u0[1] * wt); w.y = pg8::cvt_pk_bf16(silu_f(g0[2]) * u0[2] * wt, silu_f(g0[3]) * u0[3] * wt);
                w.z = pg8::cvt_pk_bf16(silu_f(g1[0]) * u1[0] * wt, silu_f(g1[1]) * u1[1] * wt); w.w = pg8::cvt_pk_bf16(silu_f(g1[2]) * u1[2] * wt, silu_f(g1[3]) * u1[3] * wt);
                *(pg8::u32x4*)(hid + (size_t)row * 512 + u.pn * 128 + wc * 32 + 8 * fq) = w; }
    }
};
struct EpiMoeDown {
    float* x; const int* stok;
    __device__ __forceinline__ void operator()(const pg8::f32x4 (&acc)[2][2][4][2], const pg8::Unit& u, int wr, int wc, int fr, int fq) const {
        const int row0 = u.pm * 256 + wr * 64 + fr, col0 = u.pn * 256 + wc * 32 + 8 * fq;
#pragma unroll
        for (int ai = 0; ai < 2; ++ai)
#pragma unroll
            for (int m = 0; m < 4; ++m) { const int tok = stok[row0 + ai * 128 + m * 16];
                if (tok >= 0) { float* rowp = x + (size_t)tok * DM + col0;
#pragma unroll
                    for (int bj = 0; bj < 2; ++bj) { pg8::f32x4* p = (pg8::f32x4*)(rowp + bj * 128); const pg8::f32x4 a = p[0] + acc[ai][bj][m][0], b = p[1] + acc[ai][bj][m][1]; p[0] = a; p[1] = b; } }
                asm volatile("" ::: "memory"); }
    }
};
struct MapMoeUp { const float* W; int fbase;
    __device__ const float* ptr(int) const { return W; } __device__ int col(int n) const { return fbase + (n & 127); } __device__ float scale(int) const { return 1.f; } };
constexpr int RW_PITCH = 1028;
__device__ __forceinline__ void route_token(int m, int lane, const float* X, const float* g, const LAS float* rw, const float* bg, const float* br, bf16_t* xn2,
                                            unsigned* cnt, int* tcls, int* tpos, float* tw1, float* tw2) {
    asm volatile("" : "+v"(lane));
    const GAS f32x4* xr = (const GAS f32x4*)(X + (size_t)m * DM) + lane; const GAS f32x4* gr = (const GAS f32x4*)g + lane;
    f32x4 v[4]; float s = 0.f;
#pragma unroll
    for (int j = 0; j < 4; ++j) { v[j] = xr[64 * j]; s += (v[j].x * v[j].x + v[j].y * v[j].y) + (v[j].z * v[j].z + v[j].w * v[j].w); }
    const float rstd = rsqrtf(wave_sum(s) * (1.f / DM) + EPS);
    GAS unsigned long long* o8 = (GAS unsigned long long*)(xn2 + (size_t)m * DM) + lane;
#pragma unroll
    for (int j = 0; j < 4; ++j) { const f32x4 gg = gr[64 * j]; v[j] = (f32x4){v[j].x * rstd * gg.x, v[j].y * rstd * gg.y, v[j].z * rstd * gg.z, v[j].w * rstd * gg.w};
        o8[64 * j] = (unsigned long long)pk2(v[j].x, v[j].y) | ((unsigned long long)pk2(v[j].z, v[j].w) << 32); }
    float lg[20];
#pragma unroll
    for (int q = 0; q < 20; ++q) { float p = 0.f;
#pragma unroll
        for (int j = 0; j < 4; ++j) { const f32x4 w = *(const LAS f32x4*)(rw + q * RW_PITCH + 4 * (64 * j + lane)); p += (v[j].x * w.x + v[j].y * w.y) + (v[j].z * w.z + v[j].w * w.w); }
        lg[q] = wave_sum(p) + (q < 4 ? bg[q] : br[q - 4]); }
    int gi = 0; float gm = lg[0];
#pragma unroll
    for (int j = 1; j < 4; ++j) if (lg[j] > gm) { gm = lg[j]; gi = j; }
    float gs = 0.f;
#pragma unroll
    for (int j = 0; j < 4; ++j) gs += __expf(lg[j] - gm);
    const float g_w = 1.f / gs;
    float el[4];
#pragma unroll
    for (int j = 0; j < 4; ++j) el[j] = (gi == 0) ? lg[4 + j] : (gi == 1) ? lg[8 + j] : (gi == 2) ? lg[12 + j] : lg[16 + j];
    const float em = fmaxf(fmaxf(el[0], el[1]), fmaxf(el[2], el[3]));
    float pe[4]; float es = 0.f;
#pragma unroll
    for (int j = 0; j < 4; ++j) { pe[j] = __expf(el[j] - em); es += pe[j]; }
    int e0 = 0; float p0 = pe[0];
#pragma unroll
    for (int j = 1; j < 4; ++j) if (pe[j] > p0) { p0 = pe[j]; e0 = j; }
    int e1 = -1; float p1 = -1.f;
#pragma unroll
    for (int j = 0; j < 4; ++j) if (j != e0 && pe[j] > p1) { p1 = pe[j]; e1 = j; }
    p0 /= es; p1 /= es;
    const float sw = p0 + p1; const float w0 = g_w * p0 / sw, w1 = g_w * p1 / sw;
    const int ea = e0 < e1 ? e0 : e1, eb = e0 < e1 ? e1 : e0; const float wa = e0 < e1 ? w0 : w1, wb = e0 < e1 ? w1 : w0;
    const int pr = (ea == 0) ? eb - 1 : (ea == 1) ? eb + 1 : 5;
    const int cls = gi * 6 + pr;
    if (lane == 0) { const unsigned pos = __hip_atomic_fetch_add(cnt + 32 * cls, 1u, __ATOMIC_RELAXED, __HIP_MEMORY_SCOPE_AGENT);
        tcls[m] = cls; tpos[m] = (int)pos; tw1[m] = wa; tw2[m] = wb; }
}
namespace att {
using bf16x8 = __attribute__((ext_vector_type(8))) short;
using s16x4 = __attribute__((ext_vector_type(4))) short;
using f32x16 = __attribute__((ext_vector_type(16))) float;
using u32x4 = __attribute__((ext_vector_type(4))) unsigned;
typedef short v4i16_t __attribute__((ext_vector_type(4)));
constexpr int NW = 8, QBLK = 32, QB = 256, KVBLK = 64;
constexpr int NSLOT = 3, KSLOT = 12288, VSLOT = 8192;
constexpr int LDS_K = 0, LDS_V = NSLOT * KSLOT, LDS_WS = LDS_V + NSLOT * VSLOT, LDS_OST = LDS_WS + NW * 256, LDS_BYTES_ATT = LDS_OST + NW * 4096;
__device__ __forceinline__ int crow(int r, int hi) { return (r & 3) + 8 * (r >> 2) + 4 * hi; }
__device__ __forceinline__ void glds16(const void* gsrc, unsigned lds_dst) { unsigned keep;
    asm volatile("s_mov_b32 %0, m0\n\ts_mov_b32 m0, %2\n\ts_nop 0\n\tglobal_load_lds_dwordx4 %1, off\n\ts_mov_b32 m0, %0" : "=&s"(keep) : "v"(gsrc), "s"(lds_dst) : "memory"); }
__device__ __forceinline__ unsigned cvtpk(float lo, float hi) { unsigned r; asm("v_cvt_pk_bf16_f32 %0, %1, %2" : "=v"(r) : "v"(lo), "v"(hi)); return r; }
__device__ __forceinline__ float xhalf_max(float m) { auto rr = __builtin_amdgcn_permlane32_swap(__float_as_uint(m), __float_as_uint(m), false, false); return fmaxf(__uint_as_float(rr[0]), __uint_as_float(rr[1])); }
__device__ __forceinline__ float xhalf_sum(float m) { auto rr = __builtin_amdgcn_permlane32_swap(__float_as_uint(m), __float_as_uint(m), false, false); return __uint_as_float(rr[0]) + __uint_as_float(rr[1]); }
__device__ __forceinline__ void pv(f32x16* o, int vb, bf16x8 pa0, bf16x8 pa1, bf16x8 pa2, bf16x8 pa3) {
#pragma unroll
    for (int d0 = 0; d0 < 2; ++d0) { s16x4 lo[4], hi[4];
#pragma unroll
        for (int ks = 0; ks < 4; ++ks) {
            asm volatile("ds_read_b64_tr_b16 %0,%1 offset:%c2" : "=&v"(lo[ks]) : "v"(vb), "i"(d0 * 4096 + ks * 1024) : "memory");
            asm volatile("ds_read_b64_tr_b16 %0,%1 offset:%c2" : "=&v"(hi[ks]) : "v"(vb), "i"(d0 * 4096 + ks * 1024 + 512) : "memory"); }
        asm volatile("s_waitcnt lgkmcnt(0)" ::: "memory"); __builtin_amdgcn_sched_barrier(0);
#define ATT_PK(k) (bf16x8){lo[k][0], lo[k][1], lo[k][2], lo[k][3], hi[k][0], hi[k][1], hi[k][2], hi[k][3]}
        o[d0] = __builtin_amdgcn_mfma_f32_32x32x16_bf16(pa0, ATT_PK(0), o[d0], 0, 0, 0);
        o[d0] = __builtin_amdgcn_mfma_f32_32x32x16_bf16(pa1, ATT_PK(1), o[d0], 0, 0, 0);
        o[d0] = __builtin_amdgcn_mfma_f32_32x32x16_bf16(pa2, ATT_PK(2), o[d0], 0, 0, 0);
        o[d0] = __builtin_amdgcn_mfma_f32_32x32x16_bf16(pa3, ATT_PK(3), o[d0], 0, 0, 0);
#undef ATT_PK
    }
}
#define ATT_WAIT_BAR(N) asm volatile("s_waitcnt vmcnt(" #N ") lgkmcnt(0)\n\ts_barrier" ::: "memory")

template <int DQK, bool MOBA>
__device__ __forceinline__ void attn_unit(int b, int h, int qb, const bf16_t* Q, int qpitch, int qcol0, const bf16_t* K, int kpitch, int kcol0, const bf16_t* V, int vpitch, int vcol0,
                                          bf16_t* O, int ocol0, const float* kmean, LAS unsigned char* shm, const int wid) {
    constexpr int ND0 = DQK / 16;
    int lane = (int)__builtin_amdgcn_mbcnt_hi(~0u, __builtin_amdgcn_mbcnt_lo(~0u, 0u)); asm volatile("" : "+v"(lane));
    const int r32 = lane & 31, hi = lane >> 5;
    const long rowbase = (long)b * SEQ; const int q0 = qb * QB;
    const bf16_t* Qw = Q + (rowbase + q0 + wid * QBLK) * qpitch + qcol0;
    const bf16_t* Kh = K + rowbase * kpitch + kcol0; const bf16_t* Vh = V + rowbase * vpitch + vcol0;
    const unsigned lds0 = (unsigned)(size_t)shm;
    LAS float* wsf = (LAS float*)(shm + LDS_WS) + wid * 64;
    const bf16_t* ksrc0 = Kh + (long)lane * kpitch + wid * 8;
    const bf16_t* ksrc1 = Kh + (long)lane * kpitch + (8 + (wid & 3)) * 8;
    const bf16_t* vsrc = Vh + (long)(16 * (wid & 3) + (lane >> 2)) * vpitch + (wid >> 2) * 32 + (lane & 3) * 8;
    const unsigned kdst0 = lds0 + LDS_K + wid * 1024, kdst1 = lds0 + LDS_K + (8 + (wid & 3)) * 1024, vdst = lds0 + LDS_V + wid * 1024;
#define ATT_DMA(t, slot) do { glds16(ksrc0 + (long)(t) * KVBLK * kpitch, (unsigned)__builtin_amdgcn_readfirstlane(kdst0 + (slot) * KSLOT)); \
        if (DQK == 96) glds16(ksrc1 + (long)(t) * KVBLK * kpitch, (unsigned)__builtin_amdgcn_readfirstlane(kdst1 + (slot) * KSLOT)); \
        glds16(vsrc + (long)(t) * KVBLK * vpitch, (unsigned)__builtin_amdgcn_readfirstlane(vdst + (slot) * VSLOT)); } while (0)
    const int NT = (q0 + QB) / KVBLK;
    ATT_DMA(0, 0); ATT_DMA(1, 1);
    bf16x8 qr[ND0];
#pragma unroll
    for (int d0 = 0; d0 < ND0; ++d0) qr[d0] = *reinterpret_cast<const bf16x8*>(&Qw[(long)r32 * qpitch + d0 * 16 + hi * 8]);
    unsigned sel = 0xffffffffu;
    if (MOBA) {
        float v0 = -INFINITY, v1 = -INFINITY, v2 = -INFINITY; int i0 = -1, i1 = -1, i2 = -1;
#ifdef ATT_KM_GLOBAL
        const float* kmb = kmean + (size_t)(b * 32) * 256 + h * 64 + hi * 8;
#else
        constexpr int LDS_KM = 98304;
        static_assert(NSLOT == 3, "LDS_KM assumes the 3-slot layout");
        LAS float* kml = (LAS float*)(shm + LDS_KM);
        { const float* kmg = kmean + (size_t)(b * 32) * 256 + h * 64; const int tid_ = wid * 64 + lane;
          for (int i = tid_; i < qb * 16; i += NW * 64) { const int j = i >> 4, c4 = i & 15; *(LAS pg8::f32x4*)(kml + j * 64 + c4 * 4) = *(const pg8::f32x4*)(kmg + (size_t)j * 256 + c4 * 4); }
          asm volatile("s_waitcnt vmcnt(0) lgkmcnt(0)\n\ts_barrier" ::: "memory"); }
        const LAS float* kmb = kml + hi * 8;
#endif
        for (int j = 0; j < qb; ++j) {
            float g = 0.f;
#pragma unroll
            for (int d0 = 0; d0 < 4; ++d0) {
#ifdef ATT_KM_GLOBAL
                const pg8::f32x4 ka = *(const pg8::f32x4*)(kmb + j * 256 + d0 * 16), kb2 = *(const pg8::f32x4*)(kmb + j * 256 + d0 * 16 + 4);
#else
                const pg8::f32x4 ka = *(const LAS pg8::f32x4*)(kmb + j * 64 + d0 * 16), kb2 = *(const LAS pg8::f32x4*)(kmb + j * 64 + d0 * 16 + 4);
#endif
                const bf16x8 qq = qr[d0];
                g += bf2f((bf16_t)qq[0]) * ka.x + bf2f((bf16_t)qq[1]) * ka.y + bf2f((bf16_t)qq[2]) * ka.z + bf2f((bf16_t)qq[3]) * ka.w
                   + bf2f((bf16_t)qq[4]) * kb2.x + bf2f((bf16_t)qq[5]) * kb2.y + bf2f((bf16_t)qq[6]) * kb2.z + bf2f((bf16_t)qq[7]) * kb2.w; }
            g = xhalf_sum(g);
            if (g > v0) { v2 = v1; i2 = i1; v1 = v0; i1 = i0; v0 = g; i0 = j; }
            else if (g > v1) { v2 = v1; i2 = i1; v1 = g; i1 = j; }
            else if (g > v2) { v2 = g; i2 = j; }
        }
        sel = 0u;
        if (i0 >= 0) sel |= 1u << i0;
        if (i1 >= 0) sel |= 1u << i1;
        if (i2 >= 0) sel |= 1u << i2;
    }
    float m_run = -1e30f, l_run = 0.f; f32x16 o[2]; o[0] = f32x16{}; o[1] = f32x16{};
    const int qrel = wid * QBLK + r32;
    const int vb0 = (int)(lds0 + LDS_V) + ((lane >> 4) & 1) * 32 + (lane & 3) * 8 + (4 * hi + ((lane & 15) >> 2)) * 64;
    int slot = 0;
    for (int t = 0; t < NT; ++t) {
        if (t + 1 < NT) { if (DQK == 96) ATT_WAIT_BAR(3); else ATT_WAIT_BAR(2); } else ATT_WAIT_BAR(0);
        if (t + 2 < NT) { const int s2 = (slot == 0) ? 2 : slot - 1; ATT_DMA(t + 2, s2); }
        f32x16 p0, p1;
        { const LAS unsigned char* kb = shm + LDS_K + slot * KSLOT + hi * 1024 + r32 * 16;
#pragma unroll
          for (int d0 = 0; d0 < ND0; ++d0) {
              const bf16x8 b0 = *(const LAS bf16x8*)(kb + d0 * 2048), b1 = *(const LAS bf16x8*)(kb + d0 * 2048 + 512);
              if (d0 == 0) { p0 = __builtin_amdgcn_mfma_f32_32x32x16_bf16(b0, qr[0], f32x16{}, 0, 0, 0); p1 = __builtin_amdgcn_mfma_f32_32x32x16_bf16(b1, qr[0], f32x16{}, 0, 0, 0); }
              else { p0 = __builtin_amdgcn_mfma_f32_32x32x16_bf16(b0, qr[d0], p0, 0, 0, 0); p1 = __builtin_amdgcn_mfma_f32_32x32x16_bf16(b1, qr[d0], p1, 0, 0, 0); } } }
        const int jb = t - (NT - 4);
        if (jb >= 0) { const int kb0 = 64 * jb + 4 * hi;
#pragma unroll
            for (int r = 0; r < 16; ++r) { const int kv = kb0 + (r & 3) + 8 * (r >> 2); if (kv > qrel) p0[r] = -INFINITY; if (kv + 32 > qrel) p1[r] = -INFINITY; } }
        else if (MOBA) { if (!((sel >> (t >> 2)) & 1u)) {
#pragma unroll
            for (int r = 0; r < 16; ++r) { p0[r] = -INFINITY; p1[r] = -INFINITY; } } }
        float rm = fmaxf(p0[0], p1[0]);
#pragma unroll
        for (int r = 1; r < 16; ++r) rm = fmaxf(rm, fmaxf(p0[r], p1[r]));
        rm = xhalf_max(rm);
        const float m_new = fmaxf(m_run, rm); const float alpha = __builtin_amdgcn_exp2f(m_run - m_new); m_run = m_new;
        float ls = 0.f;
#pragma unroll
        for (int r = 0; r < 16; ++r) { p0[r] = __builtin_amdgcn_exp2f(p0[r] - m_new); p1[r] = __builtin_amdgcn_exp2f(p1[r] - m_new); ls += p0[r] + p1[r]; }
        l_run = l_run * alpha + ls;
        if (hi == 0) wsf[r32] = alpha;
        asm volatile("s_waitcnt lgkmcnt(0)" ::: "memory");
#pragma unroll
        for (int r = 0; r < 16; ++r) { const float a = wsf[crow(r, hi)]; o[0][r] *= a; o[1][r] *= a; }
        u32x4 pw0, pw1, pw2, pw3;
        pw0 = (u32x4){cvtpk(p0[0], p0[1]), cvtpk(p0[2], p0[3]), cvtpk(p0[4], p0[5]), cvtpk(p0[6], p0[7])};
        pw1 = (u32x4){cvtpk(p0[8], p0[9]), cvtpk(p0[10], p0[11]), cvtpk(p0[12], p0[13]), cvtpk(p0[14], p0[15])};
        pw2 = (u32x4){cvtpk(p1[0], p1[1]), cvtpk(p1[2], p1[3]), cvtpk(p1[4], p1[5]), cvtpk(p1[6], p1[7])};
        pw3 = (u32x4){cvtpk(p1[8], p1[9]), cvtpk(p1[10], p1[11]), cvtpk(p1[12], p1[13]), cvtpk(p1[14], p1[15])};
        asm volatile("s_waitcnt lgkmcnt(0)" ::: "memory");
        pv(o, vb0 + slot * VSLOT, __builtin_bit_cast(bf16x8, pw0), __builtin_bit_cast(bf16x8, pw1), __builtin_bit_cast(bf16x8, pw2), __builtin_bit_cast(bf16x8, pw3));
        slot = (slot == 2) ? 0 : slot + 1;
    }
    l_run = xhalf_sum(l_run);
    if (hi == 0) wsf[32 + r32] = l_run;
    asm volatile("s_waitcnt lgkmcnt(0)" ::: "memory");
    float rli[16];
#pragma unroll
    for (int r = 0; r < 16; ++r) rli[r] = __builtin_amdgcn_rcpf(wsf[32 + crow(r, hi)]);
    bf16_t* Ow = O + (rowbase + q0 + wid * QBLK) * DM + ocol0;
    { LAS bf16_t* stg = (LAS bf16_t*)(shm + LDS_OST) + wid * 2048;
#pragma unroll
      for (int r = 0; r < 16; ++r) { const int orow = crow(r, hi);
#pragma unroll
          for (int d0 = 0; d0 < 2; ++d0) stg[orow * 64 + d0 * 32 + r32] = f2bf(o[d0][r] * rli[r]); }
      asm volatile("s_waitcnt lgkmcnt(0)" ::: "memory");
#pragma unroll
      for (int i = 0; i < 4; ++i) { const int row = i * 8 + (lane >> 3), ch = lane & 7; const u32x4 v = *(const LAS u32x4*)(stg + row * 64 + ch * 8); *(u32x4*)(Ow + (long)row * DM + ch * 8) = v; } }
    asm volatile("s_waitcnt vmcnt(0) lgkmcnt(0)\n\ts_barrier" ::: "memory");
#undef ATT_DMA
}
#undef ATT_WAIT_BAR
}
namespace ck {
using att::bf16x8; using att::s16x4; using att::f32x16; using att::u32x4; using att::crow; using att::cvtpk; using att::xhalf_sum;
constexpr int CL = 128, NCH = SEQ / CL;
__device__ __forceinline__ int lane_id() { return (int)__builtin_amdgcn_mbcnt_hi(~0u, __builtin_amdgcn_mbcnt_lo(~0u, 0u)); }
#define CK_TRF(dst, vb, OFF) do { s16x4 lo_, hi_; \
    asm volatile("ds_read_b64_tr_b16 %0,%1 offset:%c2" : "=&v"(lo_) : "v"(vb), "i"(OFF) : "memory"); \
    asm volatile("ds_read_b64_tr_b16 %0,%1 offset:%c2" : "=&v"(hi_) : "v"(vb), "i"((OFF) + 512) : "memory"); \
    asm volatile("s_waitcnt lgkmcnt(0)" ::: "memory"); \
    dst = (bf16x8){lo_[0], lo_[1], lo_[2], lo_[3], hi_[0], hi_[1], hi_[2], hi_[3]}; } while (0)
__device__ __forceinline__ int tr_lane_off(int lane) { const int hi = lane >> 5; return ((lane >> 4) & 1) * 32 + (lane & 3) * 8 + (4 * hi + ((lane & 15) >> 2)) * 64; }
__device__ __forceinline__ void stage_v64(LAS unsigned char* dst, const bf16_t* src, int gp, int tid, const LAS float* rowscale) {
    const int row = tid >> 3, j = tid & 7;
    us8 v = *(const us8*)(src + (size_t)row * gp + 8 * j);
    if (rowscale) { const float s = rowscale[row];
#pragma unroll
        for (int i = 0; i < 8; ++i) v[i] = f2bf(bf2f(v[i]) * s); }
    *(LAS us8*)(dst + (j >> 2) * 4096 + row * 64 + (j & 3) * 16) = v;
}
template <int DQ> __device__ __forceinline__ void stage_k64(LAS unsigned char* dst, const bf16_t* src, int gp, int tid) {
#pragma unroll
    for (int pc = tid; pc < 64 * (DQ / 8); pc += 512) { const int row = pc / (DQ / 8), c = pc % (DQ / 8);
        *(LAS us8*)(dst + c * 1024 + row * 16) = *(const us8*)(src + (size_t)row * gp + 8 * c); }
}
__device__ __forceinline__ void scan128(float a0, float a1, int lane, float& s0, float& s1) {
    float t = a0 + a1;
#pragma unroll
    for (int o = 1; o < 64; o <<= 1) { const float u = __shfl_up(t, o); if (lane >= o) t += u; }
    s1 = t; s0 = t - a1;
}

__device__ __forceinline__ void ssd_s1_unit(int unit, const bf16_t* xbca, const float* projf, const float* dt_bias, const float* a_log, float* S, float* dec, LAS unsigned char* shm, int wave) {
    const int g = unit & 1, c = (unit >> 1) & (NCH - 1), b = unit >> 7;
    int lane = lane_id(); asm volatile("" : "+v"(lane));
    const int tid = wave * 64 + lane; const size_t m0 = (size_t)b * SEQ + (size_t)c * CL;
    LAS float* wtab = (LAS float*)(shm + 65536);
    if (wave < 2) { const int h = 2 * g + wave; const float a = -__expf(a_log[h]), dtb = dt_bias[h];
        const float d0 = softplus_f(projf[(m0 + 2 * lane) * PROJF_W + PF_DT + h] + dtb), d1 = softplus_f(projf[(m0 + 2 * lane + 1) * PROJF_W + PF_DT + h] + dtb);
        float s0, s1; scan128(d0 * a, d1 * a, lane, s0, s1);
        const float alast = __shfl(s1, 63);
        wtab[wave * 128 + 2 * lane] = __expf(alast - s0) * d0; wtab[wave * 128 + 2 * lane + 1] = __expf(alast - s1) * d1;
        if (lane == 0) dec[((size_t)b * NCH + c) * 4 + h] = __expf(alast); }
    __syncthreads();
#pragma unroll
    for (int hh = 0; hh < 2; ++hh)
#pragma unroll
        for (int rt = 0; rt < 2; ++rt) stage_v64(shm + (hh * 2 + rt) * 8192, xbca + (m0 + rt * 64) * 768 + (2 * g + hh) * 64, 768, tid, wtab + hh * 128 + rt * 64);
#pragma unroll
    for (int rt = 0; rt < 2; ++rt)
#pragma unroll
        for (int ct = 0; ct < 2; ++ct) stage_v64(shm + 32768 + (rt * 2 + ct) * 8192, xbca + (m0 + rt * 64) * 768 + 256 + g * 128 + ct * 64, 768, tid, nullptr);
    __syncthreads();
    const int hh = wave >> 2, j = wave & 3, r32 = lane & 31, hi = lane >> 5; const int lo = tr_lane_off(lane);
    f32x16 acc0 = f32x16{}, acc1 = f32x16{};
#pragma unroll
    for (int rt = 0; rt < 2; ++rt) {
        const int vx = (int)(unsigned)(size_t)(shm + (hh * 2 + rt) * 8192) + lo, vbm = (int)(unsigned)(size_t)(shm + 32768 + (rt * 2 + (j >> 1)) * 8192) + lo + (j & 1) * 4096;
#define CK_STEP(ks) do { bf16x8 fb, fa0, fa1; CK_TRF(fb, vbm, (ks) * 1024); CK_TRF(fa0, vx, (ks) * 1024); CK_TRF(fa1, vx, 4096 + (ks) * 1024); \
        acc0 = __builtin_amdgcn_mfma_f32_32x32x16_bf16(fa0, fb, acc0, 0, 0, 0); acc1 = __builtin_amdgcn_mfma_f32_32x32x16_bf16(fa1, fb, acc1, 0, 0, 0); } while (0)
        CK_STEP(0); CK_STEP(1); CK_STEP(2); CK_STEP(3);
#undef CK_STEP
    }
    float* Sp = S + (((size_t)b * NCH + c) * 4 + 2 * g + hh) * 8192 + (size_t)(32 * j + r32) * 64;
#pragma unroll
    for (int q = 0; q < 4; ++q) { *(pg8::f32x4*)(Sp + 8 * q + 4 * hi) = (pg8::f32x4){acc0[4 * q], acc0[4 * q + 1], acc0[4 * q + 2], acc0[4 * q + 3]};
                                  *(pg8::f32x4*)(Sp + 32 + 8 * q + 4 * hi) = (pg8::f32x4){acc1[4 * q], acc1[4 * q + 1], acc1[4 * q + 2], acc1[4 * q + 3]}; }
    __syncthreads();
}

__device__ __forceinline__ void ml_s1_unit(int unit, const bf16_t* qka, const bf16_t* proj, const float* projf, const float* ig_bias, const float* fg_bias, float* U, float* nU, float* dec,
                                           LAS unsigned char* shm, int wave) {
    const int hp = unit & 1, c = (unit >> 1) & (NCH - 1), b = unit >> 7;
    int lane = lane_id(); asm volatile("" : "+v"(lane));
    const int tid = wave * 64 + lane; const size_t m0 = (size_t)b * SEQ + (size_t)c * CL;
    LAS float* wtab = (LAS float*)(shm + 65536);
    if (wave < 2) { const int h = 2 * hp + wave; const float igb = ig_bias[h], fgb = fg_bias[h];
        const float f0 = projf[(m0 + 2 * lane) * PROJF_W + PF_MF + h] + fgb, f1 = projf[(m0 + 2 * lane + 1) * PROJF_W + PF_MF + h] + fgb;
        const float l0 = fminf(f0, 0.f) - log1pf(__expf(-fabsf(f0))), l1 = fminf(f1, 0.f) - log1pf(__expf(-fabsf(f1)));
        const float i0 = projf[(m0 + 2 * lane) * PROJF_W + PF_MI + h] + igb, i1 = projf[(m0 + 2 * lane + 1) * PROJF_W + PF_MI + h] + igb;
        float s0, s1; scan128(l0, l1, lane, s0, s1);
        const float blast = __shfl(s1, 63);
        wtab[wave * 128 + 2 * lane] = __expf(blast - s0 + i0); wtab[wave * 128 + 2 * lane + 1] = __expf(blast - s1 + i1);
        if (lane == 0) dec[((size_t)b * NCH + c) * 4 + h] = __expf(blast); }
    __syncthreads();
#pragma unroll
    for (int hh = 0; hh < 2; ++hh)
#pragma unroll
        for (int rt = 0; rt < 2; ++rt) {
            stage_v64(shm + (hh * 2 + rt) * 8192, qka + (m0 + rt * 64) * 512 + 256 + (2 * hp + hh) * 64, 512, tid, wtab + hh * 128 + rt * 64);
            stage_v64(shm + 32768 + (hh * 2 + rt) * 8192, proj + (m0 + rt * 64) * PROJ_W + PC_MV + (2 * hp + hh) * 64, PROJ_W, tid, nullptr); }
    __syncthreads();
    const int hh = wave >> 2, db = (wave >> 1) & 1, eb = wave & 1, r32 = lane & 31, hi = lane >> 5; const int lo = tr_lane_off(lane);
    f32x16 acc = f32x16{};
#pragma unroll
    for (int rt = 0; rt < 2; ++rt) {
        const int vk = (int)(unsigned)(size_t)(shm + (hh * 2 + rt) * 8192) + lo + db * 4096, vv = (int)(unsigned)(size_t)(shm + 32768 + (hh * 2 + rt) * 8192) + lo + eb * 4096;
#define CK_STEP(ks) do { bf16x8 fa, fb; CK_TRF(fa, vv, (ks) * 1024); CK_TRF(fb, vk, (ks) * 1024); acc = __builtin_amdgcn_mfma_f32_32x32x16_bf16(fa, fb, acc, 0, 0, 0); } while (0)
        CK_STEP(0); CK_STEP(1); CK_STEP(2); CK_STEP(3);
#undef CK_STEP
    }
    const size_t ub = ((size_t)b * NCH + c) * 4 + 2 * hp + hh;
    float* Up = U + ub * 4096 + (size_t)(32 * db + r32) * 64 + 32 * eb;
#pragma unroll
    for (int q = 0; q < 4; ++q) *(pg8::f32x4*)(Up + 8 * q + 4 * hi) = (pg8::f32x4){acc[4 * q], acc[4 * q + 1], acc[4 * q + 2], acc[4 * q + 3]};
    if (tid < 128) { const int h2 = tid >> 6, d = tid & 63; float s = 0.f;
        for (int rt = 0; rt < 2; ++rt) { const LAS bf16_t* kp = (const LAS bf16_t*)(shm + (h2 * 2 + rt) * 8192 + (d >> 5) * 4096) + (d & 31);
            for (int r = 0; r < 64; ++r) s += bf2f(kp[r * 32]); }
        nU[(((size_t)b * NCH + c) * 4 + 2 * hp + h2) * 64 + d] = s; }
    __syncthreads();
}

__device__ __forceinline__ void scan_phase(int gtid, int ngt, const float* S, const float* sdec, bf16_t* prevT, const float* U, const float* nU, const float* mdec, bf16_t* Cst, float* nst) {
    constexpr int N1 = 2 * 4 * 8192, N2 = 2 * 4 * 4096, N3 = 2 * 4 * 64;
#define SCAN_RUN(SRC, DEC, STRIDE, STORE) do { float st = 0.f; \
        for (int c0 = 0; c0 < NCH; c0 += 16) { float sv[16], dv[16]; \
            _Pragma("unroll") for (int k = 0; k < 16; ++k) { const size_t u = ((size_t)b * NCH + c0 + k) * 4 + h; sv[k] = SRC[u * STRIDE + e]; dv[k] = DEC[u]; } \
            _Pragma("unroll") for (int k = 0; k < 16; ++k) { const size_t u = ((size_t)b * NCH + c0 + k) * 4 + h; STORE; st = dv[k] * st + sv[k]; } } } while (0)
    for (int idx = gtid; idx < N1 + N2 + N3; idx += ngt) {
        if (idx < N1) { const int e = idx & 8191, h = (idx >> 13) & 3, b = idx >> 15; SCAN_RUN(S, sdec, 8192, prevT[u * 8192 + e] = f2bf(st)); }
        else if (idx < N1 + N2) { const int i2 = idx - N1, e = i2 & 4095, h = (i2 >> 12) & 3, b = i2 >> 14; SCAN_RUN(U, mdec, 4096, Cst[u * 4096 + e] = f2bf(st)); }
        else { const int i3 = idx - N1 - N2, e = i3 & 63, h = (i3 >> 6) & 3, b = i3 >> 8; SCAN_RUN(nU, mdec, 64, nst[u * 64 + e] = st); }
    }
#undef SCAN_RUN
}

#define CK_PACK(p0, p1, pw0, pw1, pw2, pw3) do { \
    pw0 = (u32x4){cvtpk(p0[0], p0[1]), cvtpk(p0[2], p0[3]), cvtpk(p0[4], p0[5]), cvtpk(p0[6], p0[7])}; \
    pw1 = (u32x4){cvtpk(p0[8], p0[9]), cvtpk(p0[10], p0[11]), cvtpk(p0[12], p0[13]), cvtpk(p0[14], p0[15])}; \
    pw2 = (u32x4){cvtpk(p1[0], p1[1]), cvtpk(p1[2], p1[3]), cvtpk(p1[4], p1[5]), cvtpk(p1[6], p1[7])}; \
    pw3 = (u32x4){cvtpk(p1[8], p1[9]), cvtpk(p1[10], p1[11]), cvtpk(p1[12], p1[13]), cvtpk(p1[14], p1[15])}; } while (0)
__device__ __forceinline__ bf16x8 pv_afrag(const bf16_t* rowp, int ks, int hi, float scale) {
    const us4 a = *(const us4*)(rowp + 16 * ks + 4 * hi), b2 = *(const us4*)(rowp + 16 * ks + 8 + 4 * hi);
    u32x4 w; w.x = cvtpk(bf2f(a.x) * scale, bf2f(a.y) * scale); w.y = cvtpk(bf2f(a.z) * scale, bf2f(a.w) * scale);
    w.z = cvtpk(bf2f(b2.x) * scale, bf2f(b2.y) * scale); w.w = cvtpk(bf2f(b2.z) * scale, bf2f(b2.w) * scale);
    return __builtin_bit_cast(bf16x8, w);
}

__device__ __forceinline__ void ssd_s3_unit(int unit, const bf16_t* xbca, const bf16_t* proj, const float* projf, const float* dt_bias, const float* a_log, const float* d_skip, const float* norm_g,
                                            const bf16_t* prevT, bf16_t* ycat, LAS unsigned char* shm, int wave) {
    const int g = unit & 1, c = (unit >> 1) & (NCH - 1), b = unit >> 7;
    int lane = lane_id(); asm volatile("" : "+v"(lane));
    const int tid = wave * 64 + lane; const size_t m0 = (size_t)b * SEQ + (size_t)c * CL;
    LAS float* acum = (LAS float*)(shm + 98304); LAS float* dtt = acum + 256; LAS float* ssq = dtt + 256;
    if (wave < 2) { const int h = 2 * g + wave; const float a = -__expf(a_log[h]), dtb = dt_bias[h];
        const float d0 = softplus_f(projf[(m0 + 2 * lane) * PROJF_W + PF_DT + h] + dtb), d1 = softplus_f(projf[(m0 + 2 * lane + 1) * PROJF_W + PF_DT + h] + dtb);
        float s0, s1; scan128(d0 * a, d1 * a, lane, s0, s1);
        acum[wave * 128 + 2 * lane] = s0; acum[wave * 128 + 2 * lane + 1] = s1; dtt[wave * 128 + 2 * lane] = d0; dtt[wave * 128 + 2 * lane + 1] = d1; }
#pragma unroll
    for (int rt = 0; rt < 2; ++rt) stage_k64<128>(shm + rt * 16384, xbca + (m0 + rt * 64) * 768 + 256 + g * 128, 768, tid);
#pragma unroll
    for (int hh = 0; hh < 2; ++hh)
#pragma unroll
        for (int rt = 0; rt < 2; ++rt) {
            stage_v64(shm + 32768 + (hh * 2 + rt) * 8192, xbca + (m0 + rt * 64) * 768 + (2 * g + hh) * 64, 768, tid, nullptr);
            stage_v64(shm + 65536 + (hh * 2 + rt) * 8192, prevT + (((size_t)b * NCH + c) * 4 + 2 * g + hh) * 8192 + rt * 64 * 64, 64, tid, nullptr); }
    __syncthreads();
    const int hh = wave >> 2, rw = wave & 3, r32 = lane & 31, hi = lane >> 5, h = 2 * g + hh; const int lo = tr_lane_off(lane);
    const int l = 32 * rw + r32;
    const bf16_t* crowp = xbca + (m0 + l) * 768 + 512 + g * 128;
    f32x16 o[2]; o[0] = f32x16{}; o[1] = f32x16{};
    {
        bf16x8 qr[8];
#pragma unroll
        for (int d0 = 0; d0 < 8; ++d0) qr[d0] = *reinterpret_cast<const bf16x8*>(crowp + d0 * 16 + hi * 8);
        const float al = acum[hh * 128 + l];
        const int ntile = (rw >= 2) ? 2 : 1;
        for (int t = 0; t < ntile; ++t) {
            f32x16 p0 = f32x16{}, p1 = f32x16{};
            const LAS unsigned char* kb = shm + t * 16384 + hi * 1024 + r32 * 16;
#pragma unroll
            for (int d0 = 0; d0 < 8; ++d0) { const bf16x8 b0 = *(const LAS bf16x8*)(kb + d0 * 2048), b1 = *(const LAS bf16x8*)(kb + d0 * 2048 + 512);
                p0 = __builtin_amdgcn_mfma_f32_32x32x16_bf16(b0, qr[d0], p0, 0, 0, 0); p1 = __builtin_amdgcn_mfma_f32_32x32x16_bf16(b1, qr[d0], p1, 0, 0, 0); }
#pragma unroll
            for (int r = 0; r < 16; ++r) { const int s = 64 * t + crow(r, hi);
                const float w0 = (s <= l) ? __expf(al - acum[hh * 128 + s]) * dtt[hh * 128 + s] : 0.f, w1 = (s + 32 <= l) ? __expf(al - acum[hh * 128 + s + 32]) * dtt[hh * 128 + s + 32] : 0.f;
                p0[r] *= w0; p1[r] *= w1; }
            u32x4 pw0, pw1, pw2, pw3; CK_PACK(p0, p1, pw0, pw1, pw2, pw3);
            att::pv(o, (int)(unsigned)(size_t)(shm + 32768 + (hh * 2 + t) * 8192) + lo, __builtin_bit_cast(bf16x8, pw0), __builtin_bit_cast(bf16x8, pw1), __builtin_bit_cast(bf16x8, pw2), __builtin_bit_cast(bf16x8, pw3));
        }
        const float ea = __expf(al);
#pragma unroll
        for (int nt = 0; nt < 2; ++nt)
            att::pv(o, (int)(unsigned)(size_t)(shm + 65536 + (hh * 2 + nt) * 8192) + lo, pv_afrag(crowp + 64 * nt, 0, hi, ea), pv_afrag(crowp + 64 * nt, 1, hi, ea), pv_afrag(crowp + 64 * nt, 2, hi, ea), pv_afrag(crowp + 64 * nt, 3, hi, ea));
    }
    __syncthreads();
    LAS float* stg = (LAS float*)(shm + wave * 8704);
#pragma unroll
    for (int r = 0; r < 16; ++r) { const int orow = crow(r, hi); stg[orow * 68 + r32] = o[0][r]; stg[orow * 68 + 32 + r32] = o[1][r]; }
    asm volatile("s_waitcnt lgkmcnt(0)" ::: "memory");
    {
        const int row = lane >> 1, ch = lane & 1, lr = 32 * rw + row; const size_t m = m0 + lr;
        const float dsk = d_skip[h];
        float y[32]; float ss = 0.f;
#pragma unroll
        for (int q = 0; q < 4; ++q) { const us8 xv = *(const us8*)(xbca + m * 768 + h * 64 + ch * 32 + 8 * q), zv = *(const us8*)(proj + m * PROJ_W + PC_Z + h * 64 + ch * 32 + 8 * q);
#pragma unroll
            for (int i = 0; i < 8; ++i) { const float v = (stg[row * 68 + ch * 32 + 8 * q + i] + dsk * bf2f(xv[i])) * silu_f(bf2f(zv[i])); y[8 * q + i] = v; ss += v * v; } }
        ss += __shfl_xor(ss, 1);
        if (ch == 0) ssq[hh * 128 + lr] = ss;
        __syncthreads();
        const float tot = ssq[lr] + ssq[128 + lr];
        const float rstd = rsqrtf(tot * (1.f / 128.f) + EPS);
        const float* gp = norm_g + h * 64 + ch * 32;
        bf16_t* op = ycat + m * DM + 256 + h * 64 + ch * 32;
#pragma unroll
        for (int q = 0; q < 4; ++q) { v4u w; w.x = pk2(y[8 * q] * rstd * gp[8 * q], y[8 * q + 1] * rstd * gp[8 * q + 1]); w.y = pk2(y[8 * q + 2] * rstd * gp[8 * q + 2], y[8 * q + 3] * rstd * gp[8 * q + 3]);
            w.z = pk2(y[8 * q + 4] * rstd * gp[8 * q + 4], y[8 * q + 5] * rstd * gp[8 * q + 5]); w.w = pk2(y[8 * q + 6] * rstd * gp[8 * q + 6], y[8 * q + 7] * rstd * gp[8 * q + 7]);
            *(v4u*)(op + 8 * q) = w; }
    }
    __syncthreads();
}

__device__ __forceinline__ void ml_s3_unit(int unit, const bf16_t* qka, const bf16_t* proj, const float* projf, const float* ig_bias, const float* fg_bias, const float* norm_g,
                                           const bf16_t* Cst, const float* nst, bf16_t* ycat, LAS unsigned char* shm, int wave) {
    const int hp = unit & 1, c = (unit >> 1) & (NCH - 1), b = unit >> 7;
    int lane = lane_id(); asm volatile("" : "+v"(lane));
    const int tid = wave * 64 + lane; const size_t m0 = (size_t)b * SEQ + (size_t)c * CL;
    LAS float* bt = (LAS float*)(shm + 98304); LAS float* igt = bt + 256; LAS float* nt_ = igt + 256;
    LAS float* wsf = (LAS float*)(shm + 98304 + 4096) + wave * 64;
    if (wave < 2) { const int h = 2 * hp + wave; const float igb = ig_bias[h], fgb = fg_bias[h];
        const float f0 = projf[(m0 + 2 * lane) * PROJF_W + PF_MF + h] + fgb, f1 = projf[(m0 + 2 * lane + 1) * PROJF_W + PF_MF + h] + fgb;
        const float l0 = fminf(f0, 0.f) - log1pf(__expf(-fabsf(f0))), l1 = fminf(f1, 0.f) - log1pf(__expf(-fabsf(f1)));
        float s0, s1; scan128(l0, l1, lane, s0, s1);
        bt[wave * 128 + 2 * lane] = s0; bt[wave * 128 + 2 * lane + 1] = s1;
        igt[wave * 128 + 2 * lane] = projf[(m0 + 2 * lane) * PROJF_W + PF_MI + h] + igb; igt[wave * 128 + 2 * lane + 1] = projf[(m0 + 2 * lane + 1) * PROJF_W + PF_MI + h] + igb;
        nt_[wave * 64 + lane] = nst[(((size_t)b * NCH + c) * 4 + h) * 64 + lane]; }
#pragma unroll
    for (int hh = 0; hh < 2; ++hh) {
#pragma unroll
        for (int rt = 0; rt < 2; ++rt) {
            stage_k64<64>(shm + (hh * 2 + rt) * 8192, qka + (m0 + rt * 64) * 512 + 256 + (2 * hp + hh) * 64, 512, tid);
            stage_v64(shm + 32768 + (hh * 2 + rt) * 8192, proj + (m0 + rt * 64) * PROJ_W + PC_MV + (2 * hp + hh) * 64, PROJ_W, tid, nullptr); }
        stage_v64(shm + 65536 + hh * 8192, Cst + (((size_t)b * NCH + c) * 4 + 2 * hp + hh) * 4096, 64, tid, nullptr); }
    __syncthreads();
    const int hh = wave >> 2, rw = wave & 3, r32 = lane & 31, hi = lane >> 5, h = 2 * hp + hh; const int lo = tr_lane_off(lane);
    const int l = 32 * rw + r32;
    const bf16_t* qrowp = qka + (m0 + l) * 512 + h * 64;
    f32x16 o[2]; o[0] = f32x16{}; o[1] = f32x16{};
    float den = 0.f;
    {
        bf16x8 qr[4];
#pragma unroll
        for (int d0 = 0; d0 < 4; ++d0) qr[d0] = *reinterpret_cast<const bf16x8*>(qrowp + d0 * 16 + hi * 8);
        const float bl = bt[hh * 128 + l];
        const int ntile = (rw >= 2) ? 2 : 1;
        for (int t = 0; t < ntile; ++t) {
            f32x16 p0 = f32x16{}, p1 = f32x16{};
            const LAS unsigned char* kb = shm + (hh * 2 + t) * 8192 + hi * 1024 + r32 * 16;
#pragma unroll
            for (int d0 = 0; d0 < 4; ++d0) { const bf16x8 b0 = *(const LAS bf16x8*)(kb + d0 * 2048), b1 = *(const LAS bf16x8*)(kb + d0 * 2048 + 512);
                p0 = __builtin_amdgcn_mfma_f32_32x32x16_bf16(b0, qr[d0], p0, 0, 0, 0); p1 = __builtin_amdgcn_mfma_f32_32x32x16_bf16(b1, qr[d0], p1, 0, 0, 0); }
#pragma unroll
            for (int r = 0; r < 16; ++r) { const int s = 64 * t + crow(r, hi);
                const float w0 = (s <= l) ? __expf(bl - bt[hh * 128 + s] + igt[hh * 128 + s]) : 0.f, w1 = (s + 32 <= l) ? __expf(bl - bt[hh * 128 + s + 32] + igt[hh * 128 + s + 32]) : 0.f;
                p0[r] *= w0; p1[r] *= w1; den += p0[r] + p1[r]; }
            u32x4 pw0, pw1, pw2, pw3; CK_PACK(p0, p1, pw0, pw1, pw2, pw3);
            att::pv(o, (int)(unsigned)(size_t)(shm + 32768 + (hh * 2 + t) * 8192) + lo, __builtin_bit_cast(bf16x8, pw0), __builtin_bit_cast(bf16x8, pw1), __builtin_bit_cast(bf16x8, pw2), __builtin_bit_cast(bf16x8, pw3));
        }
        const float eb = __expf(bl);
        att::pv(o, (int)(unsigned)(size_t)(shm + 65536 + hh * 8192) + lo, pv_afrag(qrowp, 0, hi, eb), pv_afrag(qrowp, 1, hi, eb), pv_afrag(qrowp, 2, hi, eb), pv_afrag(qrowp, 3, hi, eb));
        float qn = 0.f;
#pragma unroll
        for (int d0 = 0; d0 < 4; ++d0)
#pragma unroll
            for (int i = 0; i < 8; ++i) qn += bf2f((bf16_t)qr[d0][i]) * nt_[hh * 64 + 16 * d0 + 8 * hi + i];
        den = xhalf_sum(den + eb * qn);
    }
    if (hi == 0) wsf[r32] = 1.f / fmaxf(fabsf(den), 1.f);
    asm volatile("s_waitcnt lgkmcnt(0)" ::: "memory");
    float rli[16];
#pragma unroll
    for (int r = 0; r < 16; ++r) rli[r] = wsf[crow(r, hi)];
    __syncthreads();
    LAS float* stg = (LAS float*)(shm + wave * 8704);
#pragma unroll
    for (int r = 0; r < 16; ++r) { const int orow = crow(r, hi); stg[orow * 68 + r32] = o[0][r] * rli[r]; stg[orow * 68 + 32 + r32] = o[1][r] * rli[r]; }
    asm volatile("s_waitcnt lgkmcnt(0)" ::: "memory");
    {
        const int row = lane >> 1, ch = lane & 1, lr = 32 * rw + row; const size_t m = m0 + lr;
        float y[32]; float ss = 0.f;
#pragma unroll
        for (int q = 0; q < 4; ++q) { const us8 ov = *(const us8*)(proj + m * PROJ_W + PC_MO + h * 64 + ch * 32 + 8 * q);
#pragma unroll
            for (int i = 0; i < 8; ++i) { const float v = stg[row * 68 + ch * 32 + 8 * q + i] * sigmoid_f(bf2f(ov[i])); y[8 * q + i] = v; ss += v * v; } }
        ss += __shfl_xor(ss, 1);
        const float rstd = rsqrtf(ss * (1.f / 64.f) + EPS);
        const float* gp = norm_g + h * 64 + ch * 32;
        bf16_t* op = ycat + m * DM + 512 + h * 64 + ch * 32;
#pragma unroll
        for (int q = 0; q < 4; ++q) { v4u w; w.x = pk2(y[8 * q] * rstd * gp[8 * q], y[8 * q + 1] * rstd * gp[8 * q + 1]); w.y = pk2(y[8 * q + 2] * rstd * gp[8 * q + 2], y[8 * q + 3] * rstd * gp[8 * q + 3]);
            w.z = pk2(y[8 * q + 4] * rstd * gp[8 * q + 4], y[8 * q + 5] * rstd * gp[8 * q + 5]); w.w = pk2(y[8 * q + 6] * rstd * gp[8 * q + 6], y[8 * q + 7] * rstd * gp[8 * q + 7]);
            *(v4u*)(op + 8 * q) = w; }
    }
    __syncthreads();
}
#undef CK_TRF
#undef CK_PACK
}
#ifndef EN_P_MOE
#define EN_P_MOE 1
#endif
#ifndef EN_P_SCAN
#define EN_P_SCAN 1
#endif
#ifndef EN_P_CONV
#define EN_P_CONV 1
#endif
#ifndef EN_P_INPROJ
#define EN_P_INPROJ 1
#endif
#ifndef EN_P_PREP
#define EN_P_PREP 1
#endif
#ifndef EN_P_MLAUP
#define EN_P_MLAUP 1
#endif
#ifndef EN_P_ATTN
#define EN_P_ATTN 1
#endif
#ifndef EN_P_OUTPROJ
#define EN_P_OUTPROJ 1
#endif
constexpr int NPH = 11, PH_FINAL = 2 * NPH;
enum { P_CONV = 0, P_INPROJ = 1, P_PREP = 2, P_MLAUP = 3, P_SCAN = 4, P_ATTN = 5, P_OUTPROJ = 6, P_ROUTE = 7, P_SORT = 8, P_MOEUP = 9, P_MOEDOWN = 10 };

__global__ void __launch_bounds__(NWAVES * 64, 2) mk_fwd(Args args) {
    extern __shared__ __attribute__((aligned(16))) unsigned char lds_raw[];
    LAS unsigned char* lds0p = (LAS unsigned char*)lds_raw; LAS unsigned char* lds = lds0p;
    volatile LAS unsigned* MISC = (volatile LAS unsigned*)(lds + MISC_OFF);
    const int tid = threadIdx.x, lane0 = tid & 63, wave = __builtin_amdgcn_readfirstlane(tid >> 6);
    const int G = gridDim.x; const int bx = blockIdx.x; const int vcu = (G % 8 == 0) ? (bx % 8) * (G / 8) + bx / 8 : bx;
    unsigned char* ws = args.ws;
    gu32* ctl = (gu32*)(ws + WS_CTL);
    for (int u = tid; u < (LDS_BYTES - LDSCTL_OFF) / 4; u += NWAVES * 64) ((LAS unsigned*)(lds + LDSCTL_OFF))[u] = 0u;
    __syncthreads();
    if (tid == 0) { LAS unsigned long long* tb = (LAS unsigned long long*)(lds + PTR_OFF);
#pragma unroll
        for (int i = 0; i < 29; ++i) tb[i] = (unsigned long long)args.in[i]; }
    __syncthreads();
#define INP(i) in_ptr(lds, (i))
    XcdBarrier bar = xcd_barrier_post((unsigned*)(ctl + CW_BAR) + args.bli * XCD_BAR_WORDS, MISC + 8);
    const int lo = args.ph_lo, hi = args.ph_hi;
#define IN(k) (lo <= (k) && (k) < hi)
#define SEAM(k) do { if (IN(k) && IN((k) + 1)) xcd_barrier(bar); } while (0)
    float* X = args.out;
    bf16_t* ACT = (bf16_t*)(ws + WS_ACT); bf16_t* PROJ = (bf16_t*)(ws + WS_PROJ); float* PROJF = (float*)(ws + WS_PROJF);
    bf16_t* WinT = (bf16_t*)(ws + WS_WIN); bf16_t* WoutT = (bf16_t*)(ws + WS_WOUT); bf16_t* WuqT = (bf16_t*)(ws + WS_WUQ); bf16_t* WukvT = (bf16_t*)(ws + WS_WUKV);
    bf16_t* XBCA = (bf16_t*)(ws + WS_XBCA); bf16_t* QKA = (bf16_t*)(ws + WS_QKA); bf16_t* QM = (bf16_t*)(ws + WS_QM); bf16_t* KM = (bf16_t*)(ws + WS_KM); bf16_t* VM = (bf16_t*)(ws + WS_VM);
    bf16_t* WupT = (bf16_t*)(ws + WS_WUP); bf16_t* WdnT = (bf16_t*)(ws + WS_WDN); bf16_t* XS = (bf16_t*)(ws + WS_XS); bf16_t* HID = (bf16_t*)(ws + WS_HID);
    int* STOK = (int*)(ws + WS_STOK); float* SW1 = (float*)(ws + WS_SW1); float* SW2 = (float*)(ws + WS_SW2);
    int* TCLS = (int*)(ws + WS_TCLS); int* TPOS = (int*)(ws + WS_TPOS); float* TW1 = (float*)(ws + WS_TW1); float* TW2 = (float*)(ws + WS_TW2);
    float* S1S = (float*)(ws + WS_ACT); float* S1U = (float*)(ws + WS_ACT + 16 * MiB); float* S1N = (float*)(ws + WS_ACT + 24 * MiB); float* S1SD = (float*)(ws + WS_ACT + 25 * MiB); float* S1MD = S1SD + 1024;
    bf16_t* PREVT = (bf16_t*)(ws + WS_PREVT); bf16_t* CST = (bf16_t*)(ws + WS_CST); float* NST = (float*)(ws + WS_NST);
    bf16_t* CQN = (bf16_t*)(ws + WS_CQN); bf16_t* CKVN = (bf16_t*)(ws + WS_CKVN); float* ROPE = (float*)(ws + WS_ROPE); float* KMEAN = (float*)(ws + WS_KMEAN);
    const int gw = vcu * NWAVES + wave, NGW = G * NWAVES;

    for (int l = 0; l < DEPTH; ++l) {
        const int pb = l * NPH;
        { unsigned lv = (unsigned)(size_t)lds0p; asm volatile("" : "+s"(lv)); lds = (LAS unsigned char*)(size_t)lv; }
        if (EN_P_CONV && IN(pb + P_CONV)) {
            int lane = (int)__builtin_amdgcn_mbcnt_hi(~0u, __builtin_amdgcn_mbcnt_lo(~0u, 0u)); asm volatile("" : "+v"(lane));
            LAS float* scr = (LAS float*)(lds + RING_OFF + wave * 16384);
            constexpr int I_IN = (DM / 64) * (PROJ_N / 32), I_OUT = (DM / 64) * (DM / 32), I_UQ = (256 / 64) * (512 / 32), I_UKV = (128 / 64) * (512 / 32);
            const MapInProj mi{INP(3) + (size_t)l * DM * NIN};
            const MapPlain mo{INP(19) + (size_t)l * DM * DM, DM, 1.f};
            const MapPlain muq{INP(16) + (size_t)l * 256 * 384, 384, C2M};
            const MapPlain mukv{INP(18) + (size_t)l * 128 * 512, 512, 1.f};
            for (int it = gw; it < I_IN + I_OUT + I_UQ + I_UKV; it += NGW) {
                if (it < I_IN) conv_item(mi, NIN, DM, WinT, PROJ_N / 32, scr, it, lane);
                else if (it < I_IN + I_OUT) conv_item(mo, DM, DM, WoutT, DM / 32, scr, it - I_IN, lane);
                else if (it < I_IN + I_OUT + I_UQ) conv_item(muq, 384, 256, WuqT, 512 / 32, scr, it - I_IN - I_OUT, lane);
                else conv_item(mukv, 512, 128, WukvT, 512 / 32, scr, it - I_IN - I_OUT - I_UQ, lane);
            }
            const float* xsrc = (l == 0) ? INP(0) : X;
            for (int m = gw; m < M; m += NGW) rms_row_to_bf16(xsrc + (size_t)m * DM, INP(2) + l * DM, ACT + (size_t)m * DM, nullptr, lane);
        }
        SEAM(pb + P_CONV);
        if (EN_P_INPROJ && IN(pb + P_INPROJ)) {
            pg8::StaticOrder S; S.init(ACT, WinT, DM, DM, DM, M, PROJ_N, G, bx);
            const EpiInProj E{PROJ, PROJF};
            pg8::gemm_phase(lds + RING_OFF, wave, pg8::Dims{DM, DM, DM}, S, E);
        }
        SEAM(pb + P_INPROJ);
        if (EN_P_PREP && IN(pb + P_PREP)) {
            int lane = (int)__builtin_amdgcn_mbcnt_hi(~0u, __builtin_amdgcn_mbcnt_lo(~0u, 0u)); asm volatile("" : "+v"(lane));
            if (wave == 0) for (int it = vcu; it < 256; it += G) kmean_item(it, lane, PROJ, KMEAN);
            for (int m = gw; m < M; m += NGW) mla_prep_token(m, lane, PROJ, PROJF, (const int*)INP(1), INP(15) + l * 256, INP(17) + l * 128, CQN, CKVN, KM, ROPE);
            for (int wt = gw; wt < (M / 32) * 3; wt += NGW) { const int seg = wt / 3, part = wt - seg * 3;
                if (part == 0) conv_seg(PROJ, seg * 32, PC_XBC, lane, 768, INP(4) + l * 4 * 768, INP(5) + l * 768, XBCA, 1.f);
                else if (part == 1) { if (lane < 32) conv_seg(PROJ, seg * 32, PC_XBC, 64 + lane, 768, INP(4) + l * 4 * 768, INP(5) + l * 768, XBCA, 1.f); }
                else conv_seg(PROJ, seg * 32, PC_MQK, lane, 512, INP(10) + l * 4 * 512, INP(11) + l * 512, QKA, lane >= 32 ? 0.125f : 1.f); }
        }
        SEAM(pb + P_PREP);
        if (EN_P_MLAUP && IN(pb + P_MLAUP)) {
            const int half = G / 2;
            if (bx < half) { pg8::StaticOrder S; S.init(CQN, WuqT, 256, 256, 256, M, 512, half, bx); const EpiMlaQ E{QM, ROPE}; pg8::gemm_phase(lds + RING_OFF, wave, pg8::Dims{256, 256, 256}, S, E); }
            else { pg8::StaticOrder S; S.init(CKVN, WukvT, 128, 128, 128, M, 512, G - half, bx - half); const EpiMlaKVf E{KM, VM}; pg8::gemm_phase(lds + RING_OFF, wave, pg8::Dims{128, 128, 128}, S, E); }
            for (int u = vcu; u < 512; u += G) {
                if (u < 256) ck::ssd_s1_unit(u, XBCA, PROJF, INP(6) + l * 4, INP(7) + l * 4, S1S, S1SD, lds + RING_OFF, wave);
                else ck::ml_s1_unit(u - 256, QKA, PROJ, PROJF, INP(12) + l * 4, INP(13) + l * 4, S1U, S1N, S1MD, lds + RING_OFF, wave);
            }
        }
        SEAM(pb + P_MLAUP);
        if (EN_P_SCAN && IN(pb + P_SCAN)) {
            const int lane = (int)__builtin_amdgcn_mbcnt_hi(~0u, __builtin_amdgcn_mbcnt_lo(~0u, 0u));
            ck::scan_phase(gw * 64 + lane, NGW * 64, S1S, S1SD, PREVT, S1U, S1N, S1MD, CST, NST);
        }
        SEAM(pb + P_SCAN);
        if (EN_P_ATTN && IN(pb + P_ATTN)) {
            for (int u = vcu; u < 512; u += G) {
                const int bh = (u & 255) >> 5, qs = u & 31, b = bh >> 2, hh = bh & 3;
                if (u < 256) att::attn_unit<96, false>(b, hh, qs, QM, 384, hh * 96, KM, 384, hh * 96, VM, 256, hh * 64, ACT, 768 + hh * 64, nullptr, lds + RING_OFF, wave);
                else att::attn_unit<64, true>(b, hh, 31 - qs, PROJ, PROJ_W, PC_AQ + hh * 64, PROJ, PROJ_W, PC_AK + hh * 64, PROJ, PROJ_W, PC_AV + hh * 64, ACT, hh * 64, KMEAN, lds + RING_OFF, wave);
            }
            for (int u = vcu; u < 512; u += G) {
                if (u < 256) ck::ssd_s3_unit(u, XBCA, PROJ, PROJF, INP(6) + l * 4, INP(7) + l * 4, INP(8) + l * 4, INP(9) + l * 256, PREVT, ACT, lds + RING_OFF, wave);
                else ck::ml_s3_unit(u - 256, QKA, PROJ, PROJF, INP(12) + l * 4, INP(13) + l * 4, INP(14) + l * 256, CST, NST, ACT, lds + RING_OFF, wave);
            }
        }
        SEAM(pb + P_ATTN);
        if (EN_P_OUTPROJ && IN(pb + P_OUTPROJ)) {
            pg8::StaticOrder S; S.init(ACT, WoutT, DM, DM, DM, M, DM, G, bx);
            const EpiResidualF32 E{X, (l == 0) ? INP(0) : (const float*)X};
            pg8::gemm_phase(lds + RING_OFF, wave, pg8::Dims{DM, DM, DM}, S, E);
            int lane = (int)__builtin_amdgcn_mbcnt_hi(~0u, __builtin_amdgcn_mbcnt_lo(~0u, 0u)); asm volatile("" : "+v"(lane));
            LAS float* scr = (LAS float*)(lds + RING_OFF + wave * 16384);
            const float* wgate = INP(25) + (size_t)l * 16 * 1024 * 256; const float* wup = INP(26) + (size_t)l * 16 * 1024 * 256; const float* wdn = INP(27) + (size_t)l * 16 * 256 * 1024;
            for (int it = gw; it < 16 * 256 + 16 * 128; it += NGW) {
                if (it < 16 * 256) { const int e = it >> 8, q = ((it & 255) & 15) >> 2;
                    if (q & 1) { const MapMoeUp mu{wup + (size_t)e * 1024 * 256, (q >> 1) * 128}; conv_item(mu, 256, 1024, WupT + (size_t)e * 512 * 1024, 512 / 32, scr, it & 255, lane); }
                    else { const MapMoeUp mu{wgate + (size_t)e * 1024 * 256, (q >> 1) * 128}; conv_item(mu, 256, 1024, WupT + (size_t)e * 512 * 1024, 512 / 32, scr, it & 255, lane); } }
                else { const int r = it - 16 * 256, e = r >> 7; const MapPlain md{wdn + (size_t)e * 256 * 1024, 1024, 1.f};
                    conv_item(md, 1024, 256, WdnT + (size_t)e * 1024 * 256, 1024 / 32, scr, r & 127, lane); }
            }
        }
        SEAM(pb + P_OUTPROJ);
        unsigned* mcnt = (unsigned*)(ctl + CW_MOECNT + l * 1024);
        if (EN_P_MOE && IN(pb + P_ROUTE)) {
            int lane = (int)__builtin_amdgcn_mbcnt_hi(~0u, __builtin_amdgcn_mbcnt_lo(~0u, 0u)); asm volatile("" : "+v"(lane));
            LAS float* rw = (LAS float*)(lds + RING_OFF);
            { const float* wg = INP(21) + (size_t)l * DM * 4; const float* wr = INP(23) + (size_t)l * DM * 16; const int tid2 = wave * 64 + lane;
              for (int i = tid2; i < DM; i += NWAVES * 64) { const f32x4 w = *(const GAS f32x4*)(wg + 4 * i); rw[0 * RW_PITCH + i] = w.x; rw[1 * RW_PITCH + i] = w.y; rw[2 * RW_PITCH + i] = w.z; rw[3 * RW_PITCH + i] = w.w; }
              for (int i = tid2; i < DM * 4; i += NWAVES * 64) { const int k = i >> 2, c = i & 3; const f32x4 w = *(const GAS f32x4*)(wr + 4 * i);
                  rw[(4 + 4 * c) * RW_PITCH + k] = w.x; rw[(5 + 4 * c) * RW_PITCH + k] = w.y; rw[(6 + 4 * c) * RW_PITCH + k] = w.z; rw[(7 + 4 * c) * RW_PITCH + k] = w.w; } }
            __syncthreads();
            for (int m = gw; m < M; m += NGW) route_token(m, lane, X, INP(20) + l * DM, rw, INP(22) + l * 4, INP(24) + l * 16, ACT, mcnt, TCLS, TPOS, TW1, TW2);
            __syncthreads();
        }
        SEAM(pb + P_ROUTE);
        if (EN_P_MOE && IN(pb + P_SORT)) {
            int lane = (int)__builtin_amdgcn_mbcnt_hi(~0u, __builtin_amdgcn_mbcnt_lo(~0u, 0u)); asm volatile("" : "+v"(lane));
            (void)moe_tiles(mcnt, lds, wave == 0 && lane == 0);
            const LAS int* offs = (const LAS int*)(lds + OFFS_OFF);
            if (bx < 24) { const int beg = offs[bx] + (int)mcnt[32 * bx], end = offs[bx + 1];
                for (int r = beg + wave * 64 + lane; r < end; r += NWAVES * 64) { st_wt(STOK + r, -1); st_wt(SW1 + r, 0.f); st_wt(SW2 + r, 0.f); }
#ifndef PADZERO_OFF
                for (int r = beg + wave; r < end; r += NWAVES) { v4u* dst = (v4u*)(XS + (size_t)r * DM); dst[lane] = (v4u){0u, 0u, 0u, 0u}; dst[64 + lane] = (v4u){0u, 0u, 0u, 0u}; }
#endif
            }
            for (int m = gw; m < M; m += NGW) { const int row = offs[TCLS[m]] + TPOS[m];
                if (lane == 0) { st_wt(STOK + row, m); st_wt(SW1 + row, TW1[m]); st_wt(SW2 + row, TW2[m]); }
                const v4u* src = (const v4u*)(ACT + (size_t)m * DM); v4u* dst = (v4u*)(XS + (size_t)row * DM);
                const v4u a = src[lane], b = src[64 + lane]; dst[lane] = a; dst[64 + lane] = b; }
        }
        SEAM(pb + P_SORT);
        if (EN_P_MOE && IN(pb + P_MOEUP)) {
            const int lane = (int)__builtin_amdgcn_mbcnt_hi(~0u, __builtin_amdgcn_mbcnt_lo(~0u, 0u));
            const int ntile = moe_tiles(mcnt, lds, wave == 0 && lane == 0);
            const int nu = ntile * 4;
            unsigned* tdone = (unsigned*)(ctl + 210000 + l * 128);
            const EpiMoeUp E{HID, SW1, SW2};
            for (int L = bx; L < nu; L += G) {
                const MoeOrder S{XS, WupT, DM, DM, (size_t)512 * 1024, DM, ntile, 1 << 20, L, lds + TCLS_OFF, false};
                pg8::gemm_phase(lds + RING_OFF, wave, pg8::Dims{DM, DM, DM}, S, E);
                asm volatile("s_waitcnt vmcnt(0)" ::: "memory");
                __syncthreads();
                if (wave == 0 && lane == 0) { __builtin_amdgcn_fence(__ATOMIC_RELEASE, "agent"); asm volatile("s_waitcnt vmcnt(0)" ::: "memory");
                    (void)__hip_atomic_fetch_add(tdone + (L >> 2), 1u, __ATOMIC_RELAXED, __HIP_MEMORY_SCOPE_AGENT); }
            }
            const int maxu = (nu + G - 1) / G; int two = nu - (maxu - 1) * G; if (two >= G) two = 0;
            const int c2 = (bx >= two) ? bx - two : bx + (G - two);
            const EpiMoeDown E2{X, STOK};
            for (int L = c2; L < nu; L += G) {
                if (wave == 0 && lane == 0) { unsigned sp = 0u;
                    while (__hip_atomic_load(tdone + (L >> 2), __ATOMIC_RELAXED, __HIP_MEMORY_SCOPE_AGENT) < 4u && ++sp < (1u << 22)) __builtin_amdgcn_s_sleep(2);
                    __builtin_amdgcn_fence(__ATOMIC_ACQUIRE, "agent"); asm volatile("s_waitcnt vmcnt(0)" ::: "memory"); }
                __syncthreads();
                const MoeOrder S2{HID, WdnT, 512, 256, (size_t)1024 * 256, 512, ntile, 1 << 20, L, lds + TCLS_OFF, true};
                pg8::gemm_phase(lds + RING_OFF, wave, pg8::Dims{512, 512, 256}, S2, E2);
            }
        }
        SEAM(pb + P_MOEDOWN);
    }
    if (IN(PH_FINAL)) {
        int lane = (int)__builtin_amdgcn_mbcnt_hi(~0u, __builtin_amdgcn_mbcnt_lo(~0u, 0u)); asm volatile("" : "+v"(lane));
        for (int m = gw; m < M; m += NGW) rms_row_to_f32(X + (size_t)m * DM, INP(28), X + (size_t)m * DM, lane);
    }
#undef IN
#undef SEAM
}
static void launch_mk(Args a, int lo, int hi, int bli, int grid, hipStream_t stream) {
    a.ph_lo = lo; a.ph_hi = hi; a.bli = bli; a.pad = 0;
    hipLaunchKernelGGL(mk_fwd, dim3(grid), dim3(NWAVES * 64), LDS_BYTES, stream, a);
}
extern "C" void kernel_launch(void* const* d_in, const int* in_sizes, int n_in, void* d_out, int out_size, void* d_ws, size_t ws_size, hipStream_t stream) {
    static int grid = 0;
    if (grid == 0) {
        int dev = 0, cus = 0;
        if (hipGetDevice(&dev) != hipSuccess || hipDeviceGetAttribute(&cus, hipDeviceAttributeMultiprocessorCount, dev) != hipSuccess) { grid = -1; return; }
        if (hipFuncSetAttribute((const void*)mk_fwd, hipFuncAttributeMaxDynamicSharedMemorySize, LDS_BYTES) != hipSuccess) { grid = -1; return; }
        int per_cu = 0;
        (void)hipOccupancyMaxActiveBlocksPerMultiprocessor(&per_cu, (const void*)mk_fwd, NWAVES * 64, LDS_BYTES);
        (void)hipGetLastError();
        grid = cus;
        if (n_in != 29 || ws_size < WS_END) { grid = -1; return; }
    }
    if (grid < 0) return;
    (void)hipMemsetAsync((char*)d_ws + WS_CTL, 0, CTL_ZERO_BYTES, stream);
    Args a{};
    for (int i = 0; i < 29; ++i) a.in[i] = (const float*)d_in[i];
    a.out = (float*)d_out; a.ws = (unsigned char*)d_ws;
    launch_mk(a, 0, PH_FINAL + 1, 0, grid, stream);
}
```

```cpp
#include <hip/hip_runtime.h>
#include <stdint.h>
#include <math.h>

typedef unsigned short bf16_t;
typedef unsigned short us8 __attribute__((ext_vector_type(8)));
typedef unsigned short us4 __attribute__((ext_vector_type(4)));

constexpr int BATCH = 2, SEQ = 8192, DM = 1024, M = BATCH * SEQ, DEPTH = 2;
constexpr int NIN = 3244;
constexpr float EPS = 1e-6f;
constexpr float LOG2E = 1.4426950408889634f;
constexpr float C2A = 0.125f * LOG2E;
constexpr float C2M = 0.10206207261596575f * LOG2E;
constexpr int PC_AQ = 0, PC_AK = 256, PC_AV = 512, PC_Z = 768, PC_XBC = 1024, PC_MQK = 1792, PC_MV = 2304, PC_MO = 2560, PC_CQ = 2816, PROJ_W = 3072;
constexpr int PF_CKV = 0, PF_KR = 128, PF_DT = 160, PF_MI = 164, PF_MF = 168, PROJF_W = 256;

__host__ __device__ inline int dst_col(int n) {
    if (n < 1792) return n;
    if (n < 1796) return PROJ_W + PF_DT + (n - 1792);
    if (n < 2308) return PC_MQK + (n - 1796);
    if (n < 2564) return PC_MV + (n - 2308);
    if (n < 2568) return PROJ_W + PF_MI + (n - 2564);
    if (n < 2572) return PROJ_W + PF_MF + (n - 2568);
    if (n < 2828) return PC_MO + (n - 2572);
    if (n < 3084) return PC_CQ + (n - 2828);
    if (n < 3212) return PROJ_W + PF_CKV + (n - 3084);
    return PROJ_W + PF_KR + (n - 3212);
}

__device__ __forceinline__ float bf2f(bf16_t v) { return __uint_as_float(((unsigned)v) << 16); }
__device__ __forceinline__ bf16_t f2bf(float f) { unsigned u = __float_as_uint(f); return (bf16_t)((u + 0x7fffu + ((u >> 16) & 1u)) >> 16); }
__device__ __forceinline__ float silu_f(float x) { return x / (1.f + __expf(-x)); }
__device__ __forceinline__ float sigmoid_f(float x) { return 1.f / (1.f + __expf(-x)); }
__device__ __forceinline__ float softplus_f(float x) { return x > 20.f ? x : log1pf(__expf(x)); }

#ifdef WAVE_SUM_SHFL
__device__ __forceinline__ float wave_sum(float v) {
#pragma unroll
    for (int o = 1; o < 64; o <<= 1) v += __shfl_xor(v, o);
    return v;
}
#else
#define WS_DPP(v, ctrl) ((v) + __int_as_float(__builtin_amdgcn_update_dpp(0, __float_as_int(v), (ctrl), 0xf, 0xf, true)))
__device__ __forceinline__ float wave_sum(float v) {
    v = WS_DPP(v, 0xB1);
    v = WS_DPP(v, 0x4E);
    v = WS_DPP(v, 0x141);
    v = WS_DPP(v, 0x140);
    { auto rr = __builtin_amdgcn_permlane16_swap(__float_as_uint(v), __float_as_uint(v), false, false); v = __uint_as_float(rr[0]) + __uint_as_float(rr[1]); }
    { auto rr = __builtin_amdgcn_permlane32_swap(__float_as_uint(v), __float_as_uint(v), false, false); v = __uint_as_float(rr[0]) + __uint_as_float(rr[1]); }
    return v;
}
#endif
__device__ __forceinline__ float block_sum256(float v, float* sh) {
    v = wave_sum(v);
    __syncthreads();
    if ((threadIdx.x & 63) == 0) sh[threadIdx.x >> 6] = v;
    __syncthreads();
    return sh[0] + sh[1] + sh[2] + sh[3];
}

__global__ __launch_bounds__(256) void k_rmsnorm_bf16(const float* __restrict__ x, const float* __restrict__ g, bf16_t* __restrict__ out) {
    __shared__ float sh[4];
    const int m = blockIdx.x, t = threadIdx.x;
    const float4 v = ((const float4*)(x + (size_t)m * DM))[t];
    const float ss = block_sum256(v.x * v.x + v.y * v.y + v.z * v.z + v.w * v.w, sh);
    const float r = rsqrtf(ss * (1.f / DM) + EPS);
    const float4 gg = ((const float4*)g)[t];
    us4 o; o.x = f2bf(v.x * r * gg.x); o.y = f2bf(v.y * r * gg.y); o.z = f2bf(v.z * r * gg.z); o.w = f2bf(v.w * r * gg.w);
    ((us4*)(out + (size_t)m * DM))[t] = o;
}
__global__ __launch_bounds__(256) void k_rmsnorm_f32(const float* x, const float* __restrict__ g, float* out) {
    __shared__ float sh[4];
    const int m = blockIdx.x, t = threadIdx.x;
    const float4 v = ((const float4*)(x + (size_t)m * DM))[t];
    const float ss = block_sum256(v.x * v.x + v.y * v.y + v.z * v.z + v.w * v.w, sh);
    const float r = rsqrtf(ss * (1.f / DM) + EPS);
    const float4 gg = ((const float4*)g)[t];
    float4 o; o.x = v.x * r * gg.x; o.y = v.y * r * gg.y; o.z = v.z * r * gg.z; o.w = v.w * r * gg.w;
    ((float4*)(out + (size_t)m * DM))[t] = o;
}

template <class Epi>
__global__ __launch_bounds__(256) void k_gemm(const bf16_t* __restrict__ A, int lda, const float* __restrict__ W, int ldw, int N, int K, Epi epi) {
    __shared__ float As[16][68];
    __shared__ float Bs[16][68];
    const int tid = threadIdx.x, tx = tid & 15, ty = tid >> 4;
    const int m0 = blockIdx.y * 64, n0 = blockIdx.x * 64;
    float acc[4][4];
#pragma unroll
    for (int i = 0; i < 4; ++i)
#pragma unroll
        for (int j = 0; j < 4; ++j) acc[i][j] = 0.f;
    for (int k0 = 0; k0 < K; k0 += 16) {
        {
            const int r = tid >> 2, kq = (tid & 3) * 4;
            const us4 v = *(const us4*)(A + (size_t)(m0 + r) * lda + k0 + kq);
            As[kq + 0][r] = bf2f(v.x); As[kq + 1][r] = bf2f(v.y); As[kq + 2][r] = bf2f(v.z); As[kq + 3][r] = bf2f(v.w);
        }
        {
            const int kk = tid >> 4, nq = (tid & 15) * 4, n = n0 + nq;
            float4 v = make_float4(0.f, 0.f, 0.f, 0.f);
            if (n < N) v = *(const float4*)(W + (size_t)(k0 + kk) * ldw + n);
            Bs[kk][nq + 0] = v.x; Bs[kk][nq + 1] = v.y; Bs[kk][nq + 2] = v.z; Bs[kk][nq + 3] = v.w;
        }
        __syncthreads();
#pragma unroll
        for (int kk = 0; kk < 16; ++kk) {
            float a[4], b[4];
#pragma unroll
            for (int i = 0; i < 4; ++i) { a[i] = As[kk][ty * 4 + i]; b[i] = Bs[kk][tx * 4 + i]; }
#pragma unroll
            for (int i = 0; i < 4; ++i)
#pragma unroll
                for (int j = 0; j < 4; ++j) acc[i][j] += a[i] * b[j];
        }
        __syncthreads();
    }
#pragma unroll
    for (int i = 0; i < 4; ++i)
#pragma unroll
        for (int j = 0; j < 4; ++j) { const int n = n0 + tx * 4 + j; if (n < N) epi(m0 + ty * 4 + i, n, acc[i][j]); }
}

struct EpiInProjNaive {
    bf16_t* proj; float* projf;
    __device__ void operator()(int m, int n, float v) const {
        const int c = dst_col(n);
        if (c < PROJ_W) { if (c < 256) v *= C2A; proj[(size_t)m * PROJ_W + c] = f2bf(v); }
        else projf[(size_t)m * PROJF_W + (c - PROJ_W)] = v;
    }
};
struct EpiResidual {
    float* x;
    __device__ void operator()(int m, int n, float v) const { x[(size_t)m * DM + n] += v; }
};
struct EpiF32 {
    float* out; int ld; int pad;
    __device__ void operator()(int m, int n, float v) const { out[(size_t)m * ld + n] = v; }
};
struct EpiMlaKV {
    bf16_t* km; bf16_t* vm;
    __device__ void operator()(int m, int n, float v) const {
        const int h = n >> 7, d = n & 127;
        if (d < 64) km[(size_t)m * 384 + h * 96 + d] = f2bf(v); else vm[(size_t)m * 256 + h * 64 + (d - 64)] = f2bf(v);
    }
};

__global__ __launch_bounds__(256) void k_conv_silu(const bf16_t* __restrict__ src, int ld, int c0, int C, const float* __restrict__ w, const float* __restrict__ b, bf16_t* __restrict__ dst) {
    const size_t idx = (size_t)blockIdx.x * 256 + threadIdx.x;
    if (idx >= (size_t)M * C) return;
    const int m = (int)(idx / C), c = (int)(idx % C), t = m % SEQ;
    float acc = b[c];
#pragma unroll
    for (int i = 0; i < 4; ++i) { const int tt = t - 3 + i; if (tt >= 0) acc += w[i * C + c] * bf2f(src[(size_t)(m - 3 + i) * ld + c0 + c]); }
    dst[(size_t)m * C + c] = f2bf(silu_f(acc));
}

__global__ __launch_bounds__(256) void k_ssd_scan(const bf16_t* __restrict__ xbca, const bf16_t* __restrict__ proj, const float* __restrict__ projf,
                                                  const float* __restrict__ dt_bias, const float* __restrict__ a_log, const float* __restrict__ d_skip, float* __restrict__ yg) {
    const int blk = blockIdx.x, ps = blk & 3, h = (blk >> 2) & 3, b = blk >> 4;
    const int tid = threadIdx.x, pl = tid >> 4, ns = tid & 15, p = ps * 16 + pl, g = h >> 1;
    const float a = -__expf(a_log[h]), dtb = dt_bias[h], dsk = d_skip[h];
    float st[8];
#pragma unroll
    for (int i = 0; i < 8; ++i) st[i] = 0.f;
    const size_t m0 = (size_t)b * SEQ;
    for (int t = 0; t < SEQ; ++t) {
        const size_t m = m0 + t;
        const float dtv = softplus_f(projf[m * PROJF_W + PF_DT + h] + dtb);
        const float dA = __expf(dtv * a);
        const float xv = bf2f(xbca[m * 768 + h * 64 + p]);
        const us8 Bv = *(const us8*)(xbca + m * 768 + 256 + g * 128 + ns * 8);
        const us8 Cv = *(const us8*)(xbca + m * 768 + 512 + g * 128 + ns * 8);
        const float dx = dtv * xv;
        float y = 0.f;
#pragma unroll
        for (int i = 0; i < 8; ++i) { st[i] = dA * st[i] + dx * bf2f(Bv[i]); y += bf2f(Cv[i]) * st[i]; }
        y += __shfl_xor(y, 1); y += __shfl_xor(y, 2); y += __shfl_xor(y, 4); y += __shfl_xor(y, 8);
        if (ns == 0) {
            const float z = bf2f(proj[m * PROJ_W + PC_Z + h * 64 + p]);
            yg[m * 256 + h * 64 + p] = (y + dsk * xv) * silu_f(z);
        }
    }
}
__global__ __launch_bounds__(256) void k_group_norm(const float* __restrict__ yg, const float* __restrict__ g, int gsz_log2, bf16_t* __restrict__ ycat, int col0) {
    const int wave = (blockIdx.x * 256 + threadIdx.x) >> 6, lane = threadIdx.x & 63;
    const int m = wave >> 1, half = wave & 1;
    if (m >= M) return;
    const float v0 = yg[(size_t)m * 256 + half * 128 + lane * 2], v1 = yg[(size_t)m * 256 + half * 128 + lane * 2 + 1];
    float ss = v0 * v0 + v1 * v1;
    const int nl = (1 << gsz_log2) >> 1;
    for (int o = 1; o < nl; o <<= 1) ss += __shfl_xor(ss, o);
    const float r = rsqrtf(ss / (float)(1 << gsz_log2) + EPS);
    const int c = half * 128 + lane * 2;
    ycat[(size_t)m * DM + col0 + c] = f2bf(v0 * r * g[c]);
    ycat[(size_t)m * DM + col0 + c + 1] = f2bf(v1 * r * g[c + 1]);
}

__global__ __launch_bounds__(256) void k_mlstm_scan(const bf16_t* __restrict__ qka, const bf16_t* __restrict__ proj, const float* __restrict__ projf,
                                                    const float* __restrict__ ig_bias, const float* __restrict__ fg_bias, float* __restrict__ hg) {
    const int blk = blockIdx.x, es = blk & 3, h = (blk >> 2) & 3, b = blk >> 4;
    const int tid = threadIdx.x, el = tid >> 4, ds = tid & 15, e = es * 16 + el;
    const float igb = ig_bias[h], fgb = fg_bias[h];
    float C[4] = {0.f, 0.f, 0.f, 0.f}, nn[4] = {0.f, 0.f, 0.f, 0.f};
    const size_t m0 = (size_t)b * SEQ;
    for (int t = 0; t < SEQ; ++t) {
        const size_t m = m0 + t;
        const float f = sigmoid_f(projf[m * PROJF_W + PF_MF + h] + fgb);
        const float ig = __expf(projf[m * PROJF_W + PF_MI + h] + igb);
        const us4 qv = *(const us4*)(qka + m * 512 + h * 64 + ds * 4);
        const us4 kv = *(const us4*)(qka + m * 512 + 256 + h * 64 + ds * 4);
        const float v = bf2f(proj[m * PROJ_W + PC_MV + h * 64 + e]);
        float num = 0.f, den = 0.f;
#pragma unroll
        for (int i = 0; i < 4; ++i) {
            const float k = bf2f(kv[i]) * 0.125f, q = bf2f(qv[i]);
            C[i] = f * C[i] + ig * k * v; nn[i] = f * nn[i] + ig * k;
            num += q * C[i]; den += q * nn[i];
        }
        num += __shfl_xor(num, 1); num += __shfl_xor(num, 2); num += __shfl_xor(num, 4); num += __shfl_xor(num, 8);
        den += __shfl_xor(den, 1); den += __shfl_xor(den, 2); den += __shfl_xor(den, 4); den += __shfl_xor(den, 8);
        if (ds == 0) {
            const float o = sigmoid_f(bf2f(proj[m * PROJ_W + PC_MO + h * 64 + e]));
            hg[m * 256 + h * 64 + e] = o * num / fmaxf(fabsf(den), 1.f);
        }
    }
}

__global__ __launch_bounds__(256) void k_moba_kmean(const bf16_t* __restrict__ proj, float* __restrict__ kmean) {
    const int jg = blockIdx.x, c = threadIdx.x;
    float s = 0.f;
    for (int r = 0; r < 256; ++r) s += bf2f(proj[(size_t)(jg * 256 + r) * PROJ_W + PC_AK + c]);
    kmean[jg * 256 + c] = s * (1.f / 256.f);
}
__global__ __launch_bounds__(256) void k_moba_attn(const bf16_t* __restrict__ proj, const float* __restrict__ kmean, bf16_t* __restrict__ ycat) {
    __shared__ float km[32][64];
    __shared__ float Ks[32][64];
    __shared__ float Vs[32][64];
    const int blk = blockIdx.x, cur = blk & 31, h = (blk >> 5) & 3, b = blk >> 7;
    const int tid = threadIdx.x, t = cur * 256 + tid;
    const size_t mq = (size_t)b * SEQ + t;
    float q[64];
#pragma unroll
    for (int d8 = 0; d8 < 8; ++d8) { const us8 v = *(const us8*)(proj + mq * PROJ_W + PC_AQ + h * 64 + d8 * 8);
#pragma unroll
        for (int i = 0; i < 8; ++i) q[d8 * 8 + i] = bf2f(v[i]); }
    for (int i = tid; i < 32 * 64; i += 256) { const int j = i >> 6, d = i & 63; km[j][d] = kmean[(b * 32 + j) * 256 + h * 64 + d]; }
    __syncthreads();
    float v0 = -INFINITY, v1 = -INFINITY, v2 = -INFINITY; int i0 = -1, i1 = -1, i2 = -1;
    for (int j = 0; j < cur; ++j) {
        float gq = 0.f;
#pragma unroll
        for (int d = 0; d < 64; ++d) gq += q[d] * km[j][d];
        if (gq > v0) { v2 = v1; i2 = i1; v1 = v0; i1 = i0; v0 = gq; i0 = j; }
        else if (gq > v1) { v2 = v1; i2 = i1; v1 = gq; i1 = j; }
        else if (gq > v2) { v2 = gq; i2 = j; }
    }
    unsigned sel = 0u;
    if (i0 >= 0) sel |= 1u << i0;
    if (i1 >= 0) sel |= 1u << i1;
    if (i2 >= 0) sel |= 1u << i2;
    float o[64];
#pragma unroll
    for (int d = 0; d < 64; ++d) o[d] = 0.f;
    float mx = -INFINITY, l = 0.f;
    for (int jb = 0; jb <= cur; ++jb) {
        for (int kt = 0; kt < 8; ++kt) {
            __syncthreads();
            for (int i = tid; i < 32 * 64; i += 256) { const int r = i >> 6, d = i & 63; const size_t mk = (size_t)b * SEQ + jb * 256 + kt * 32 + r;
                Ks[r][d] = bf2f(proj[mk * PROJ_W + PC_AK + h * 64 + d]); Vs[r][d] = bf2f(proj[mk * PROJ_W + PC_AV + h * 64 + d]); }
            __syncthreads();
            const bool use = (jb == cur) || ((sel >> jb) & 1u);
            if (use) {
                for (int kk = 0; kk < 32; ++kk) {
                    const int key = jb * 256 + kt * 32 + kk;
                    if (key > t) break;
                    float s = 0.f;
#pragma unroll
                    for (int d = 0; d < 64; ++d) s += q[d] * Ks[kk][d];
                    if (s > mx) { const float f = exp2f(mx - s); l *= f;
#pragma unroll
                        for (int d = 0; d < 64; ++d) o[d] *= f;
                        mx = s; }
                    const float p = exp2f(s - mx); l += p;
#pragma unroll
                    for (int d = 0; d < 64; ++d) o[d] += p * Vs[kk][d];
                }
            }
        }
    }
    const float rl = 1.f / l;
#pragma unroll
    for (int d = 0; d < 64; ++d) ycat[mq * DM + 0 + h * 64 + d] = f2bf(o[d] * rl);
}

__global__ __launch_bounds__(256) void k_mla_prep(const bf16_t* __restrict__ proj, const float* __restrict__ projf, const int* __restrict__ positions,
                                                  const float* __restrict__ gq, const float* __restrict__ gkv, bf16_t* __restrict__ cqn, bf16_t* __restrict__ ckvn, bf16_t* __restrict__ km) {
    __shared__ float sh[4];
    const int m = blockIdx.x, tid = threadIdx.x;
    const float cq = bf2f(proj[(size_t)m * PROJ_W + PC_CQ + tid]);
    const float s1 = block_sum256(cq * cq, sh);
    cqn[(size_t)m * 256 + tid] = f2bf(cq * rsqrtf(s1 * (1.f / 256.f) + EPS) * gq[tid]);
    const float ck = tid < 128 ? projf[(size_t)m * PROJF_W + PF_CKV + tid] : 0.f;
    const float s2 = block_sum256(ck * ck, sh);
    if (tid < 128) ckvn[(size_t)m * 128 + tid] = f2bf(ck * rsqrtf(s2 * (1.f / 128.f) + EPS) * gkv[tid]);
    if (tid < 16) {
        const float pos = (float)positions[m];
        const float inv = powf(10000.f, -(float)(2 * tid) / 32.f);
        const float ang = pos * inv; float sn, cs; sincosf(ang, &sn, &cs);
        const float x1 = projf[(size_t)m * PROJF_W + PF_KR + tid], x2 = projf[(size_t)m * PROJF_W + PF_KR + 16 + tid];
        const bf16_t o1 = f2bf(x1 * cs - x2 * sn), o2 = f2bf(x2 * cs + x1 * sn);
#pragma unroll
        for (int h = 0; h < 4; ++h) { km[(size_t)m * 384 + h * 96 + 64 + tid] = o1; km[(size_t)m * 384 + h * 96 + 80 + tid] = o2; }
    }
}
__global__ __launch_bounds__(256) void k_mla_qfinish(const float* __restrict__ qraw, const int* __restrict__ positions, bf16_t* __restrict__ qm) {
    const size_t idx = (size_t)blockIdx.x * 256 + threadIdx.x;
    if (idx >= (size_t)M * 384) return;
    const int m = (int)(idx / 384), c = (int)(idx % 384), h = c / 96, d = c % 96;
    float v;
    if (d < 64) v = qraw[idx];
    else {
        const int i = (d - 64) & 15; const bool second = (d - 64) >= 16;
        const float pos = (float)positions[m];
        const float inv = powf(10000.f, -(float)(2 * i) / 32.f);
        float sn, cs; sincosf(pos * inv, &sn, &cs);
        const float x1 = qraw[(size_t)m * 384 + h * 96 + 64 + i], x2 = qraw[(size_t)m * 384 + h * 96 + 80 + i];
        v = second ? (x2 * cs + x1 * sn) : (x1 * cs - x2 * sn);
    }
    qm[idx] = f2bf(v * C2M);
}
__global__ __launch_bounds__(256) void k_mla_attn(const bf16_t* __restrict__ qm, const bf16_t* __restrict__ km, const bf16_t* __restrict__ vm, bf16_t* __restrict__ ycat) {
    __shared__ float Ks[32][96];
    __shared__ float Vs[32][64];
    const int blk = blockIdx.x, qb = 31 - (blk & 31), h = (blk >> 5) & 3, b = blk >> 7;
    const int tid = threadIdx.x, t = qb * 256 + tid;
    const size_t mq = (size_t)b * SEQ + t;
    float q[96];
#pragma unroll
    for (int d8 = 0; d8 < 12; ++d8) { const us8 v = *(const us8*)(qm + mq * 384 + h * 96 + d8 * 8);
#pragma unroll
        for (int i = 0; i < 8; ++i) q[d8 * 8 + i] = bf2f(v[i]); }
    float o[64];
#pragma unroll
    for (int d = 0; d < 64; ++d) o[d] = 0.f;
    float mx = -INFINITY, l = 0.f;
    const int ntiles = (qb + 1) * 8;
    for (int kt = 0; kt < ntiles; ++kt) {
        __syncthreads();
        for (int i = tid; i < 32 * 96; i += 256) { const int r = i / 96, d = i % 96; Ks[r][d] = bf2f(km[((size_t)b * SEQ + kt * 32 + r) * 384 + h * 96 + d]); }
        for (int i = tid; i < 32 * 64; i += 256) { const int r = i >> 6, d = i & 63; Vs[r][d] = bf2f(vm[((size_t)b * SEQ + kt * 32 + r) * 256 + h * 64 + d]); }
        __syncthreads();
        for (int kk = 0; kk < 32; ++kk) {
            const int key = kt * 32 + kk;
            if (key > t) break;
            float s = 0.f;
#pragma unroll
            for (int d = 0; d < 96; ++d) s += q[d] * Ks[kk][d];
            if (s > mx) { const float f = exp2f(mx - s); l *= f;
#pragma unroll
                for (int d = 0; d < 64; ++d) o[d] *= f;
                mx = s; }
            const float p = exp2f(s - mx); l += p;
#pragma unroll
            for (int d = 0; d < 64; ++d) o[d] += p * Vs[kk][d];
        }
    }
    const float rl = 1.f / l;
#pragma unroll
    for (int d = 0; d < 64; ++d) ycat[mq * DM + 768 + h * 64 + d] = f2bf(o[d] * rl);
}

__global__ __launch_bounds__(256) void k_moe_naive(float* x, const float* __restrict__ gn, const float* __restrict__ wg, const float* __restrict__ bg,
                                                   const float* __restrict__ wr, const float* __restrict__ br, const float* __restrict__ wgate, const float* __restrict__ wup, const float* __restrict__ wdown) {
    __shared__ float h2[1024];
    __shared__ float red[4][20];
    __shared__ float sh[4];
    __shared__ float hid[2][256];
    __shared__ int sE[2]; __shared__ float sW[2];
    __shared__ float slg[20]; __shared__ float spe[4];
    const int m = blockIdx.x, tid = threadIdx.x, lane = tid & 63, wv = tid >> 6;
    const float4 v = ((const float4*)(x + (size_t)m * DM))[tid];
    const float ss = block_sum256(v.x * v.x + v.y * v.y + v.z * v.z + v.w * v.w, sh);
    const float r = rsqrtf(ss * (1.f / DM) + EPS);
    const float4 gg = ((const float4*)gn)[tid];
    const float hv[4] = {v.x * r * gg.x, v.y * r * gg.y, v.z * r * gg.z, v.w * r * gg.w};
#pragma unroll
    for (int i = 0; i < 4; ++i) h2[tid * 4 + i] = hv[i];
    float part[20];
#pragma unroll
    for (int j = 0; j < 20; ++j) part[j] = 0.f;
#pragma unroll
    for (int i = 0; i < 4; ++i) { const int d = tid * 4 + i;
#pragma unroll
        for (int j = 0; j < 4; ++j) part[j] += hv[i] * wg[d * 4 + j];
#pragma unroll
        for (int j = 0; j < 16; ++j) part[4 + j] += hv[i] * wr[d * 16 + j]; }
#pragma unroll
    for (int j = 0; j < 20; ++j) { const float s = wave_sum(part[j]); if (lane == 0) red[wv][j] = s; }
    __syncthreads();
    if (tid < 20) slg[tid] = red[0][tid] + red[1][tid] + red[2][tid] + red[3][tid] + (tid < 4 ? bg[tid] : br[tid - 4]);
    __syncthreads();
    if (tid == 0) {
        int gi = 0; float gm = slg[0];
        for (int j = 1; j < 4; ++j) if (slg[j] > gm) { gm = slg[j]; gi = j; }
        float gs = 0.f; for (int j = 0; j < 4; ++j) gs += __expf(slg[j] - gm);
        const float g_w = 1.f / gs;
        float em = -INFINITY;
        for (int j = 0; j < 4; ++j) em = fmaxf(em, slg[4 + gi * 4 + j]);
        float es = 0.f;
        for (int j = 0; j < 4; ++j) { const float p = __expf(slg[4 + gi * 4 + j] - em); spe[j] = p; es += p; }
        int e0 = 0; float p0 = spe[0];
        for (int j = 1; j < 4; ++j) if (spe[j] > p0) { p0 = spe[j]; e0 = j; }
        int e1 = -1; float p1 = -1.f;
        for (int j = 0; j < 4; ++j) if (j != e0 && spe[j] > p1) { p1 = spe[j]; e1 = j; }
        p0 /= es; p1 /= es;
        const float sw = p0 + p1;
        sE[0] = gi * 4 + e0; sE[1] = gi * 4 + e1; sW[0] = g_w * p0 / sw; sW[1] = g_w * p1 / sw;
    }
    __syncthreads();
#pragma unroll
    for (int j = 0; j < 2; ++j) {
        const int E = sE[j];
        const float* G = wgate + (size_t)E * 1024 * 256 + tid; const float* U = wup + (size_t)E * 1024 * 256 + tid;
        float ga = 0.f, ua = 0.f;
        for (int d = 0; d < 1024; ++d) { const float hd = h2[d]; ga += hd * G[(size_t)d * 256]; ua += hd * U[(size_t)d * 256]; }
        hid[j][tid] = silu_f(ga) * ua * sW[j];
    }
    __syncthreads();
    float out[4] = {0.f, 0.f, 0.f, 0.f};
#pragma unroll
    for (int j = 0; j < 2; ++j) {
        const float* Dn = wdown + (size_t)sE[j] * 256 * 1024;
        for (int f = 0; f < 256; ++f) { const float hf = hid[j][f];
#pragma unroll
            for (int i = 0; i < 4; ++i) out[i] += hf * Dn[(size_t)f * 1024 + tid + 256 * i]; }
    }
#pragma unroll
    for (int i = 0; i < 4; ++i) x[(size_t)m * DM + tid + 256 * i] += out[i];
}

#define ATOMIC_ROUTE 1
#define ST_WT_OFF 1
#define LOADS_OFF 1
#define PADZERO_OFF 1
#define NO_ENTRY_BARRIER 1
#define NO_EXIT_BARRIER 1
namespace pg8 {
#define PG8_LAS __attribute__((address_space(3)))
typedef short bf16x8 __attribute__((ext_vector_type(8)));
typedef float f32x4 __attribute__((ext_vector_type(4)));
typedef unsigned u32x4 __attribute__((ext_vector_type(4)));
constexpr int BM = 256, BK = 64, HALF = 128, HTB = HALF * BK * 2  , STAGE_BYTES = 8 * HTB, NXCD = 8, WGM = 8;

__host__ __device__ __forceinline__ int lds_byte(int r, int c) { const int st = (r >> 4) * 2 + (c >> 5), rr = r & 15, cc = c & 31, ob = rr * 64 + cc * 2; return st * 1024 + (ob ^ (((ob >> 9) & 1) << 5)); }
__host__ __device__ __forceinline__ void stage_rc(int b, int& R, int& C) { const int st = b / 1024, sb = b % 1024, swz = sb ^ (((sb >> 9) & 1) << 5); R = (st >> 1) * 16 + swz / 64; C = (st & 1) * 32 + (swz % 64) / 2; }
__host__ __device__ __forceinline__ int perm32(int rho) { const int n = rho >> 4, i = rho & 15; return 8 * (i >> 2) + 4 * n + (i & 3); }

struct Unit { int pm, pn; };
struct Dims { int K, lda, ldb; };

struct StaticOrder {
    const bf16_t* A; const bf16_t* Bt; int lda, ldb, K;
    int nM, nN, nwg, G, c;
    __device__ void init(const bf16_t* A_, const bf16_t* Bt_, int lda_, int ldb_, int K_, int Mrows, int N, int G_, int c_) { A = A_; Bt = Bt_; lda = lda_; ldb = ldb_; K = K_; nM = Mrows / BM; nN = N / BM; nwg = nM * nN; G = G_; c = c_; }
    __device__ bool next(int i, Unit& u) const {
        const long L = (long)i * G + c; if (L >= nwg) return false;
        int wgid = (int)L; { const int q = nwg / NXCD, r = nwg % NXCD, xcd = wgid % NXCD, off = wgid / NXCD; wgid = (xcd < r ? xcd * (q + 1) : r * (q + 1) + (xcd - r) * q) + off; }
        const int nig = WGM * nN, gid = wgid / nig, fm = gid * WGM, gsz = (nM - fm) < WGM ? (nM - fm) : WGM;
        u.pm = fm + ((wgid % nig) % gsz); u.pn = (wgid % nig) / gsz; return true;
    }
    __device__ __forceinline__ const char* a_ptr(const Unit& u) const { return (const char*)A + (size_t)u.pm * BM * lda * 2; }
    __device__ __forceinline__ const char* b_ptr(const Unit& u, int half) const { return (const char*)Bt + (size_t)u.pn * BM * ldb * 2 + (half ? (size_t)(K / 2) * 2 : 0); }
};

__device__ __forceinline__ unsigned cvt_pk_bf16(float lo, float hi) { unsigned r; asm volatile("v_cvt_pk_bf16_f32 %0, %1, %2" : "=v"(r) : "v"(lo), "v"(hi)); return r; }

template <class Epi, class Sched>
__device__ __forceinline__ void gemm_phase(PG8_LAS unsigned char* lds, const int wid, const Dims g, const Sched& S, const Epi& E) {
    int lane = (int)__builtin_amdgcn_mbcnt_hi(~0u, __builtin_amdgcn_mbcnt_lo(~0u, 0u)); asm volatile("" : "+v"(lane));
    const int tid = wid * 64 + lane, wr = wid >> 2, wc = wid & 3, fr = lane & 15, fq = lane >> 4;
    int K = g.K, lda = g.lda, ldb = g.ldb; asm volatile("" : "+s"(K), "+s"(lda), "+s"(ldb));
    const int nt = K / BK, nth = nt / 2;
    unsigned voffA[2], voffB[2];
#pragma unroll
    for (int i = 0; i < 2; ++i) { int R, C; stage_rc(tid * 16 + i * 8192, R, C); const int Rb = (R & ~31) + perm32(R & 31);
        voffA[i] = (unsigned)(R * lda + C) * 2u; voffB[i] = (unsigned)(Rb * ldb + C) * 2u; }
    const size_t kstep = (size_t)(BK * 2);
    const size_t hstepA = (size_t)HALF * lda * 2, hstepB = (size_t)HALF * ldb * 2;
    const unsigned ldsw = (unsigned)wid * 1024u;
    const int aoff = lds_byte(wr * 64 + fr, fq * 8), boff = lds_byte(wc * 32 + fr, fq * 8);
#define PG8_SA(b, h) (((b) * 2 + (h)) * HTB)
#define PG8_SB(b, h) ((4 + (b) * 2 + (h)) * HTB)
#define PG8_STAGE(bufoff, gbase, voff) do { _Pragma("unroll") for (int _i = 0; _i < 2; ++_i) \
        __builtin_amdgcn_global_load_lds((const unsigned*)((const char*)(gbase) + (voff)[_i]), (PG8_LAS unsigned*)(lds + (bufoff) + ldsw + _i * 8192), 16, 0, 0); } while (0)
#define PG8_LDA(dst, b, h) do { _Pragma("unroll") for (int m = 0; m < 4; ++m) _Pragma("unroll") for (int k = 0; k < 2; ++k) dst[m][k] = *(const PG8_LAS bf16x8*)(lds + PG8_SA(b, h) + aoff + m * 2048 + k * 1024); } while (0)
#define PG8_LDB(dst, b, h) do { _Pragma("unroll") for (int n = 0; n < 2; ++n) _Pragma("unroll") for (int k = 0; k < 2; ++k) dst[n][k] = *(const PG8_LAS bf16x8*)(lds + PG8_SB(b, h) + boff + n * 2048 + k * 1024); } while (0)
#define PG8_MMA(ai, bj, At, Bt) do { __builtin_amdgcn_s_setprio(1); _Pragma("unroll") for (int m = 0; m < 4; ++m) _Pragma("unroll") for (int n = 0; n < 2; ++n) _Pragma("unroll") for (int k = 0; k < 2; ++k) \
        acc[ai][bj][m][n] = __builtin_amdgcn_mfma_f32_16x16x32_bf16(Bt[n][k], At[m][k], acc[ai][bj][m][n], 0, 0, 0); __builtin_amdgcn_s_setprio(0); } while (0)
#define PG8_WAIT_V(n) asm volatile("s_waitcnt vmcnt(" #n ")" ::: "memory")
#define PG8_WAIT_L(n) asm volatile("s_waitcnt lgkmcnt(" #n ")" ::: "memory")
#define PG8_BAR __builtin_amdgcn_s_barrier()
#define PG8_SCHED __builtin_amdgcn_sched_barrier(0)
#define PG8_BP(b0, b1, t) (((t) < nth) ? ((b0) + (size_t)(t) * kstep) : ((b1) + (size_t)((t) - nth) * kstep))
    Unit cur, nxt; int ui = 0;
    if (!S.next(0, cur)) return;
    f32x4 acc[2][2][4][2];
#pragma unroll
    for (int a = 0; a < 2; ++a)
#pragma unroll
        for (int b = 0; b < 2; ++b)
#pragma unroll
            for (int m = 0; m < 4; ++m)
#pragma unroll
                for (int n = 0; n < 2; ++n) acc[a][b][m][n] = (f32x4){0.f, 0.f, 0.f, 0.f};
    bf16x8 At[4][2], B0[2][2], B1[2][2];
    const char* cA = S.a_ptr(cur); const char* cB0 = S.b_ptr(cur, 0); const char* cB1 = S.b_ptr(cur, 1);
    {
        const char* b0 = PG8_BP(cB0, cB1, 0); const char* b1 = PG8_BP(cB0, cB1, 1);
        PG8_STAGE(PG8_SB(0, 0), b0, voffB); PG8_STAGE(PG8_SB(0, 1), b0 + hstepB, voffB); PG8_STAGE(PG8_SA(0, 0), cA, voffA); PG8_STAGE(PG8_SA(0, 1), cA + hstepA, voffA);
        if (wr == 1) PG8_BAR;
        PG8_WAIT_V(2); PG8_BAR;
        PG8_STAGE(PG8_SB(1, 0), b1, voffB); PG8_STAGE(PG8_SA(1, 0), cA + kstep, voffA); PG8_STAGE(PG8_SB(1, 1), b1 + hstepB, voffB);
        PG8_WAIT_V(6); PG8_BAR;
    }
    for (;;) {
        const bool has_next = S.next(ui + 1, nxt);
        const char* nA = has_next ? S.a_ptr(nxt) : cA; const char* nB0 = has_next ? S.b_ptr(nxt, 0) : cB0; const char* nB1 = has_next ? S.b_ptr(nxt, 1) : cB1;
        for (int t = 0; t < nt; t += 2) {
            const bool last = (t == nt - 2);
            const char* a1 = cA + (size_t)(t + 1) * kstep;
            const char* a2 = last ? nA : cA + (size_t)(t + 2) * kstep;
            const char* a3 = a2 + kstep;
            const char* b2 = last ? PG8_BP(nB0, nB1, 0) : PG8_BP(cB0, cB1, t + 2);
            const char* b3 = last ? PG8_BP(nB0, nB1, 1) : PG8_BP(cB0, cB1, t + 3);
            PG8_LDB(B0, 0, 0); PG8_LDB(B1, 0, 1); PG8_SCHED; PG8_LDA(At, 0, 0); PG8_STAGE(PG8_SA(1, 1), a1 + hstepA, voffA);
            PG8_WAIT_V(8); PG8_WAIT_L(0); PG8_BAR; PG8_MMA(0, 0, At, B0); PG8_MMA(0, 1, At, B1); PG8_BAR; PG8_SCHED;
            PG8_LDA(At, 0, 1); PG8_STAGE(PG8_SB(0, 0), b2, voffB); PG8_STAGE(PG8_SB(0, 1), b2 + hstepB, voffB); PG8_STAGE(PG8_SA(0, 0), a2, voffA);
            PG8_WAIT_V(8); PG8_WAIT_L(0); PG8_BAR; PG8_MMA(1, 0, At, B0); PG8_MMA(1, 1, At, B1); PG8_BAR; PG8_SCHED;
            PG8_LDB(B0, 1, 0); PG8_LDB(B1, 1, 1); PG8_SCHED; PG8_LDA(At, 1, 0); PG8_STAGE(PG8_SA(0, 1), a2 + hstepA, voffA);
            PG8_WAIT_V(8); PG8_WAIT_L(0); PG8_BAR; PG8_MMA(0, 0, At, B0); PG8_MMA(0, 1, At, B1); PG8_BAR; PG8_SCHED;
            PG8_LDA(At, 1, 1); PG8_STAGE(PG8_SB(1, 0), b3, voffB); PG8_STAGE(PG8_SB(1, 1), b3 + hstepB, voffB); PG8_STAGE(PG8_SA(1, 0), a3, voffA);
            PG8_WAIT_V(8); PG8_WAIT_L(0); PG8_BAR; PG8_MMA(1, 0, At, B0); PG8_MMA(1, 1, At, B1); PG8_BAR; PG8_SCHED;
        }
        if (wr == 0) PG8_BAR;
        E(acc, cur, wr, wc, fr, fq);
        if (!has_next) break;
#pragma unroll
        for (int a = 0; a < 2; ++a)
#pragma unroll
            for (int b = 0; b < 2; ++b)
#pragma unroll
                for (int m = 0; m < 4; ++m)
#pragma unroll
                    for (int n = 0; n < 2; ++n) acc[a][b][m][n] = (f32x4){0.f, 0.f, 0.f, 0.f};
        cur = nxt; cA = nA; cB0 = nB0; cB1 = nB1; ++ui;
        if (wr == 1) PG8_BAR;
    }
    PG8_WAIT_V(0);
    PG8_BAR;
#undef PG8_SA
#undef PG8_SB
#undef PG8_STAGE
#undef PG8_LDA
#undef PG8_LDB
#undef PG8_MMA
#undef PG8_WAIT_V
#undef PG8_WAIT_L
#undef PG8_BAR
#undef PG8_SCHED
#undef PG8_BP
}
}
#define GAS __attribute__((address_space(1)))
#define LAS __attribute__((address_space(3)))
typedef GAS unsigned gu32;
#define RLX_AGENT __ATOMIC_RELAXED, __HIP_MEMORY_SCOPE_AGENT
#define XB_TMO      128
#define XB_XCNT(j)  (256  + 64 * (j))
#define XB_XSUB(j)  (1280 + 64 * (j))
#define XB_XGEN(j)  (2304 + 64 * (j))
#define XB_TOP      3328
#define XB_TOPGEN   3392
#define XCD_BAR_WORDS 3456
#define XB_SPIN_CAP (1u << 18)

__device__ __forceinline__ unsigned xb_ld(unsigned* p)              { return __hip_atomic_load(p, __ATOMIC_RELAXED, __HIP_MEMORY_SCOPE_AGENT); }
__device__ __forceinline__ unsigned xb_add(unsigned* p, unsigned v) { return __hip_atomic_fetch_add(p, v, __ATOMIC_RELAXED, __HIP_MEMORY_SCOPE_AGENT); }
__device__ __forceinline__ unsigned xb_xcc_id() { return (unsigned)__builtin_amdgcn_s_getreg((3 << 11) | 20) & 0xFu; }
#define XB_SPIN(cond, bar) do { unsigned _sp = 0; while (cond) { __builtin_amdgcn_s_sleep(1); \
    if ((++_sp & 255u) == 0u) { if (xb_ld(&(bar)[XB_TMO])) break; if (_sp > XB_SPIN_CAP) { atomicAdd(&(bar)[XB_TMO], 1u); break; } } } } while (0)

struct XcdBarrier {
    unsigned* bar; unsigned x;
    unsigned w0;
    volatile LAS unsigned* st;
};

__device__ __forceinline__ XcdBarrier xcd_barrier_post(unsigned* bar, volatile LAS unsigned* st) {
    XcdBarrier b; b.bar = bar; b.x = xb_xcc_id(); b.st = st; b.w0 = (__builtin_amdgcn_readfirstlane(threadIdx.x >> 6) == 0) ? 1u : 0u;
    if (threadIdx.x == 0) (void)xb_add(&bar[XB_XCNT(b.x)], 1u);
    return b;
}
__device__ __forceinline__ void xcd_barrier_complete(unsigned* bar, unsigned x, unsigned& nloc, unsigned& nx) {
    const unsigned G = gridDim.x * gridDim.y * gridDim.z;
    unsigned sum, cnt, mine, sp = 0u;
    for (;;) {
        sum = 0u; cnt = 0u; mine = 0u;
#pragma unroll
        for (unsigned j = 0; j < 16; ++j) { const unsigned c = xb_ld(&bar[XB_XCNT(j)]); sum += c; cnt += (c > 0u) ? 1u : 0u; mine = (j == x) ? c : mine; }
        if (sum == G) break;
        __builtin_amdgcn_s_sleep(1);
        if ((++sp & 255u) == 0u) { if (xb_ld(&bar[XB_TMO])) break; if (sp > XB_SPIN_CAP) { atomicAdd(&bar[XB_TMO], 1u); break; } }
    }
    nloc = mine > 0u ? mine : 1u; nx = cnt > 0u ? cnt : 1u;
}

__device__ __forceinline__ void xcd_barrier(const XcdBarrier& b) {
    asm volatile("s_waitcnt vmcnt(0)" ::: "memory");
    __syncthreads();
    if (b.w0 && __builtin_amdgcn_mbcnt_hi(~0u, __builtin_amdgcn_mbcnt_lo(~0u, 0u)) == 0u) {
        unsigned* bar = b.bar;
        __builtin_amdgcn_s_waitcnt(0);
        unsigned nloc = b.st[0], nx = b.st[1];
        if (nloc == 0u) { xcd_barrier_complete(bar, b.x, nloc, nx); b.st[0] = nloc; b.st[1] = nx; }
        const unsigned old = xb_add(&bar[XB_XSUB(b.x)], 1u);
        const unsigned gen = old / nloc;
        if (old + 1u == (gen + 1u) * nloc) {
            __builtin_amdgcn_fence(__ATOMIC_RELEASE, "agent");
            asm volatile("s_waitcnt vmcnt(0)" ::: "memory");
            const unsigned og = xb_add(&bar[XB_TOP], 1u);
            const unsigned tg = og / nx;
            if (og + 1u == (tg + 1u) * nx) xb_add(&bar[XB_TOPGEN], 1u);
            else XB_SPIN(xb_ld(&bar[XB_TOPGEN]) == tg, bar);
            __builtin_amdgcn_fence(__ATOMIC_ACQUIRE, "agent");
            xb_add(&bar[XB_XGEN(b.x)], 1u);
            asm volatile("s_waitcnt vmcnt(0)" ::: "memory");
        } else {
            XB_SPIN(xb_ld(&bar[XB_XGEN(b.x)]) == gen, bar);
            __builtin_amdgcn_fence(__ATOMIC_ACQUIRE, "agent");
            asm volatile("s_waitcnt vmcnt(0)" ::: "memory");
        }
    }
    __syncthreads();
}
constexpr int NWAVES = 8;
constexpr size_t MiB = 1u << 20;
constexpr size_t WS_CTL = 0, CTL_ZERO_BYTES = 1 * MiB;
constexpr size_t WS_KMEAN = 1 * MiB;
constexpr size_t WS_WIN = 2 * MiB, WS_WOUT = 9 * MiB, WS_WUQ = 11 * MiB, WS_WUKV = 11 * MiB + 512 * 1024;
constexpr size_t WS_ACT = 12 * MiB, WS_PROJ = 44 * MiB, WS_PROJF = 140 * MiB, WS_XBCA = 156 * MiB, WS_QKA = 180 * MiB, WS_QM = 196 * MiB, WS_KM = 208 * MiB, WS_VM = 220 * MiB;
constexpr size_t WS_PREVT = 242 * MiB, WS_CST = 250 * MiB, WS_NST = 254 * MiB;
constexpr size_t WS_ROPE = 228 * MiB, WS_CQN = 230 * MiB, WS_CKVN = 238 * MiB, WS_ST = 230 * MiB  , WS_END = 256 * MiB;
constexpr int CW_BAR = 4096;
constexpr int MAX_BAR_REGIONS = 24;
static_assert((CW_BAR + MAX_BAR_REGIONS * 3456) * 4 <= (int)CTL_ZERO_BYTES, "CTL words inside the memset region");
constexpr int PROJ_N = 3328;
constexpr int RING_OFF = 0, RING_BYTES = 131072, LDSCTL_OFF = RING_BYTES, MISC_OFF = LDSCTL_OFF + 320, PTR_OFF = MISC_OFF + 128, LDS_BYTES = 147456;

__host__ __device__ inline int src_col(int c) {
    if (c < 1792) return c;
    if (c < 2304) return 1796 + (c - 1792);
    if (c < 2560) return 2308 + (c - 2304);
    if (c < 2816) return 2572 + (c - 2560);
    if (c < 3072) return 2828 + (c - 2816);
    const int f = c - 3072;
    if (f < 128) return 3084 + f;
    if (f < 160) return 3212 + (f - 128);
    if (f < 164) return 1792 + (f - 160);
    if (f < 168) return 2564 + (f - 164);
    if (f < 172) return 2568 + (f - 168);
    return -1;
}

typedef unsigned v4u __attribute__((ext_vector_type(4)));
typedef float f32x4 __attribute__((ext_vector_type(4)));
#define LDS_WAIT() asm volatile("s_waitcnt lgkmcnt(0)" ::: "memory")
#define VM_WAIT() asm volatile("s_waitcnt vmcnt(0)" ::: "memory")
__device__ __forceinline__ unsigned pk2(float lo, float hi) { return (unsigned)f2bf(lo) | ((unsigned)f2bf(hi) << 16); }

__device__ __forceinline__ const float* in_ptr(LAS unsigned char* lds, int i) {
    const unsigned long long v = ((const LAS unsigned long long*)(lds + PTR_OFF))[i];
    const unsigned lo = __builtin_amdgcn_readfirstlane((unsigned)v), hi = __builtin_amdgcn_readfirstlane((unsigned)(v >> 32));
    return (const float*)(((unsigned long long)hi << 32) | lo);
}
#ifdef ST_WT_OFF
__device__ __forceinline__ void st_wt(float* p, float v) { *p = v; }
__device__ __forceinline__ void st_wt(int* p, int v) { *p = v; }
#else
__device__ __forceinline__ void st_wt(float* p, float v) { __hip_atomic_store(p, v, __ATOMIC_RELAXED, __HIP_MEMORY_SCOPE_AGENT); }
__device__ __forceinline__ void st_wt(int* p, int v) { __hip_atomic_store(p, v, __ATOMIC_RELAXED, __HIP_MEMORY_SCOPE_AGENT); }
#endif
struct Args {
    const float* in[29]; float* out; unsigned char* ws; int ph_lo, ph_hi, bli, pad;
};

struct MapInProj { const float* W; __device__ const float* ptr(int) const { return W; } __device__ int col(int n) const { return src_col(n); } __device__ float scale(int n) const { return n < 256 ? C2A : 1.f; } };
struct MapPlain { const float* W; int ncols; float sc; __device__ const float* ptr(int) const { return W; } __device__ int col(int n) const { return n < ncols ? n : -1; } __device__ float scale(int) const { return sc; } };
template <class Map>
__device__ __forceinline__ void conv_item(const Map& mp, int ldw, int K, bf16_t* WT, int nblk, LAS float* scr, int item, int lane) {
    const int kb = item / nblk, nb = item % nblk, k0 = 64 * kb, n0 = 32 * nb;
    const int c4 = lane & 7, kr = lane >> 3;
    const int nd = n0 + 4 * c4; const int sc = mp.col(nd); const float scl = mp.scale(nd); const float* base = mp.ptr(nd);
    f32x4 v[8];
#pragma unroll
    for (int i = 0; i < 8; ++i) v[i] = sc >= 0 ? __builtin_nontemporal_load((const GAS f32x4*)(base + (size_t)(k0 + 8 * i + kr) * ldw + sc)) : (f32x4){0.f, 0.f, 0.f, 0.f};
#pragma unroll
    for (int i = 0; i < 8; ++i) { LAS float* d = scr + (8 * i + kr) * 33 + 4 * c4; d[0] = v[i].x * scl; d[1] = v[i].y * scl; d[2] = v[i].z * scl; d[3] = v[i].w * scl; }
    LDS_WAIT(); asm volatile("" ::: "memory");
    const int c = lane & 7;
#pragma unroll
    for (int j = 0; j < 4; ++j) { const int n = (lane >> 3) + 8 * j; const LAS float* s = scr + (8 * c) * 33 + n;
        v4u o; o.x = pk2(s[0 * 33], s[1 * 33]); o.y = pk2(s[2 * 33], s[3 * 33]); o.z = pk2(s[4 * 33], s[5 * 33]); o.w = pk2(s[6 * 33], s[7 * 33]);
        *(GAS v4u*)(WT + (size_t)(n0 + n) * K + k0 + 8 * c) = o; }
    LDS_WAIT(); asm volatile("" ::: "memory");
}
__device__ __forceinline__ void rms_row_to_bf16(const float* xrow, const float* g, bf16_t* orow, float* xcopy, int lane) {
    const GAS f32x4* xr = (const GAS f32x4*)xrow + lane; const GAS f32x4* gr = (const GAS f32x4*)g + lane;
    f32x4 v[4]; float s = 0.f;
#pragma unroll
    for (int j = 0; j < 4; ++j) { v[j] = xr[64 * j]; s += (v[j].x * v[j].x + v[j].y * v[j].y) + (v[j].z * v[j].z + v[j].w * v[j].w); }
    const float rstd = rsqrtf(wave_sum(s) * (1.f / DM) + EPS);
    if (xcopy) { GAS f32x4* xc = (GAS f32x4*)xcopy + lane;
#pragma unroll
        for (int j = 0; j < 4; ++j) xc[64 * j] = v[j]; }
    GAS unsigned long long* o8 = (GAS unsigned long long*)orow + lane;
#pragma unroll
    for (int j = 0; j < 4; ++j) { const f32x4 gg = gr[64 * j];
        o8[64 * j] = (unsigned long long)pk2(v[j].x * rstd * gg.x, v[j].y * rstd * gg.y) | ((unsigned long long)pk2(v[j].z * rstd * gg.z, v[j].w * rstd * gg.w) << 32); }
}
__device__ __forceinline__ void rms_row_to_f32(const float* xrow, const float* g, float* orow, int lane) {
    const GAS f32x4* xr = (const GAS f32x4*)xrow + lane; const GAS f32x4* gr = (const GAS f32x4*)g + lane;
    f32x4 v[4]; float s = 0.f;
#pragma unroll
    for (int j = 0; j < 4; ++j) { v[j] = xr[64 * j]; s += (v[j].x * v[j].x + v[j].y * v[j].y) + (v[j].z * v[j].z + v[j].w * v[j].w); }
    const float rstd = rsqrtf(wave_sum(s) * (1.f / DM) + EPS);
    GAS f32x4* o = (GAS f32x4*)orow + lane;
#pragma unroll
    for (int j = 0; j < 4; ++j) { const f32x4 gg = gr[64 * j]; o[64 * j] = (f32x4){v[j].x * rstd * gg.x, v[j].y * rstd * gg.y, v[j].z * rstd * gg.z, v[j].w * rstd * gg.w}; }
}

struct EpiInProj {
    bf16_t* proj; float* projf;
    __device__ __forceinline__ void operator()(const pg8::f32x4 (&acc)[2][2][4][2], const pg8::Unit& u, int wr, int wc, int fr, int fq) const {
        const int row0 = u.pm * 256 + wr * 64 + fr, col0 = wc * 32 + 8 * fq;
        if (u.pn < 12) {
#pragma unroll
            for (int ai = 0; ai < 2; ++ai)
#pragma unroll
                for (int m = 0; m < 4; ++m) { bf16_t* rowp = proj + (size_t)(row0 + ai * 128 + m * 16) * PROJ_W + u.pn * 256 + col0;
#pragma unroll
                    for (int bj = 0; bj < 2; ++bj) { const pg8::f32x4 v0 = acc[ai][bj][m][0], v1 = acc[ai][bj][m][1]; pg8::u32x4 w;
                        w.x = pg8::cvt_pk_bf16(v0[0], v0[1]); w.y = pg8::cvt_pk_bf16(v0[2], v0[3]); w.z = pg8::cvt_pk_bf16(v1[0], v1[1]); w.w = pg8::cvt_pk_bf16(v1[2], v1[3]);
                        *(pg8::u32x4*)(rowp + bj * 128) = w; } }
        } else {
#pragma unroll
            for (int ai = 0; ai < 2; ++ai)
#pragma unroll
                for (int m = 0; m < 4; ++m) { float* rowp = projf + (size_t)(row0 + ai * 128 + m * 16) * PROJF_W + col0;
#pragma unroll
                    for (int bj = 0; bj < 2; ++bj) { *(pg8::f32x4*)(rowp + bj * 128) = acc[ai][bj][m][0]; *(pg8::f32x4*)(rowp + bj * 128 + 4) = acc[ai][bj][m][1]; } }
        }
    }
};
struct EpiResidualF32 {
    float* x; const float* src;
    __device__ __forceinline__ void operator()(const pg8::f32x4 (&acc)[2][2][4][2], const pg8::Unit& u, int wr, int wc, int fr, int fq) const {
        const int row0 = u.pm * 256 + wr * 64 + fr, col0 = u.pn * 256 + wc * 32 + 8 * fq;
#pragma unroll
        for (int ai = 0; ai < 2; ++ai)
#pragma unroll
            for (int m = 0; m < 4; ++m) { float* rowp = x + (size_t)(row0 + ai * 128 + m * 16) * DM + col0; const float* srcp = src + (size_t)(row0 + ai * 128 + m * 16) * DM + col0;
#pragma unroll
                for (int bj = 0; bj < 2; ++bj) { pg8::f32x4* p = (pg8::f32x4*)(rowp + bj * 128); const GAS pg8::f32x4* q = (const GAS pg8::f32x4*)(srcp + bj * 128); const pg8::f32x4 a = q[0] + acc[ai][bj][m][0], b = q[1] + acc[ai][bj][m][1]; p[0] = a; p[1] = b; }
                asm volatile("" ::: "memory"); }
    }
};


struct EpiMlaQ {
    bf16_t* qm; const float* rope;
    __device__ __forceinline__ void operator()(const pg8::f32x4 (&acc)[2][2][4][2], const pg8::Unit& u, int wr, int wc, int fr, int fq) const {
        const int row0 = u.pm * 256 + wr * 64 + fr;
#pragma unroll
        for (int bj = 0; bj < 2; ++bj) {
            const int colg = u.pn * 256 + bj * 128 + wc * 32;
            if (colg >= 384) continue;
            const bool is_rope = ((colg >> 5) % 3) == 2;
#pragma unroll
            for (int ai = 0; ai < 2; ++ai)
#pragma unroll
                for (int m = 0; m < 4; ++m) {
                    const int row = row0 + ai * 128 + m * 16;
                    pg8::f32x4 v0 = acc[ai][bj][m][0], v1 = acc[ai][bj][m][1];
                    if (is_rope) {
                        pg8::f32x4 w0, w1;
#pragma unroll
                        for (int j = 0; j < 4; ++j) { w0[j] = __shfl_xor(v0[j], 32); w1[j] = __shfl_xor(v1[j], 32); }
                        const int i0 = (8 * fq) & 15;
                        const float* rp = rope + (size_t)row * 32 + i0;
                        const pg8::f32x4 c0 = *(const pg8::f32x4*)rp, c1 = *(const pg8::f32x4*)(rp + 4), s0 = *(const pg8::f32x4*)(rp + 16), s1 = *(const pg8::f32x4*)(rp + 20);
                        if (fq < 2) { v0 = v0 * c0 - w0 * s0; v1 = v1 * c1 - w1 * s1; } else { v0 = v0 * c0 + w0 * s0; v1 = v1 * c1 + w1 * s1; }
                    }
                    pg8::u32x4 w; w.x = pg8::cvt_pk_bf16(v0[0], v0[1]); w.y = pg8::cvt_pk_bf16(v0[2], v0[3]); w.z = pg8::cvt_pk_bf16(v1[0], v1[1]); w.w = pg8::cvt_pk_bf16(v1[2], v1[3]);
                    *(pg8::u32x4*)(qm + (size_t)row * 384 + colg + 8 * fq) = w;
                }
        }
    }
};
struct EpiMlaKVf {
    bf16_t* km; bf16_t* vm;
    __device__ __forceinline__ void operator()(const pg8::f32x4 (&acc)[2][2][4][2], const pg8::Unit& u, int wr, int wc, int fr, int fq) const {
        const int row0 = u.pm * 256 + wr * 64 + fr;
#pragma unroll
        for (int bj = 0; bj < 2; ++bj) {
            const int col = u.pn * 256 + bj * 128 + wc * 32 + 8 * fq, hh = col >> 7, d = col & 127;
#pragma unroll
            for (int ai = 0; ai < 2; ++ai)
#pragma unroll
                for (int m = 0; m < 4; ++m) {
                    const int row = row0 + ai * 128 + m * 16;
                    const pg8::f32x4 v0 = acc[ai][bj][m][0], v1 = acc[ai][bj][m][1];
                    pg8::u32x4 w; w.x = pg8::cvt_pk_bf16(v0[0], v0[1]); w.y = pg8::cvt_pk_bf16(v0[2], v0[3]); w.z = pg8::cvt_pk_bf16(v1[0], v1[1]); w.w = pg8::cvt_pk_bf16(v1[2], v1[3]);
                    bf16_t* dst = (d < 64) ? km + (size_t)row * 384 + hh * 96 + d : vm + (size_t)row * 256 + hh * 64 + (d - 64);
                    *(pg8::u32x4*)dst = w;
                }
        }
    }
};

__device__ __forceinline__ void conv_chunk(const bf16_t* proj, int m, int c0, int ch, int C, const float* w, const float* bias, bf16_t* dst, float osc) {
    const int t = m & (SEQ - 1);
    float acc[8];
    { const f32x4 b0 = *(const f32x4*)(bias + ch * 8), b1 = *(const f32x4*)(bias + ch * 8 + 4);
      acc[0] = b0.x; acc[1] = b0.y; acc[2] = b0.z; acc[3] = b0.w; acc[4] = b1.x; acc[5] = b1.y; acc[6] = b1.z; acc[7] = b1.w; }
#pragma unroll
    for (int i = 0; i < 4; ++i) {
        if (t - 3 + i >= 0) {
            const us8 x = *(const us8*)(proj + (size_t)(m - 3 + i) * PROJ_W + c0 + ch * 8);
            const f32x4 w0 = *(const f32x4*)(w + i * C + ch * 8), w1 = *(const f32x4*)(w + i * C + ch * 8 + 4);
            acc[0] += w0.x * bf2f(x[0]); acc[1] += w0.y * bf2f(x[1]); acc[2] += w0.z * bf2f(x[2]); acc[3] += w0.w * bf2f(x[3]);
            acc[4] += w1.x * bf2f(x[4]); acc[5] += w1.y * bf2f(x[5]); acc[6] += w1.z * bf2f(x[6]); acc[7] += w1.w * bf2f(x[7]);
        }
    }
    v4u o; o.x = pk2(silu_f(acc[0]) * osc, silu_f(acc[1]) * osc); o.y = pk2(silu_f(acc[2]) * osc, silu_f(acc[3]) * osc); o.z = pk2(silu_f(acc[4]) * osc, silu_f(acc[5]) * osc); o.w = pk2(silu_f(acc[6]) * osc, silu_f(acc[7]) * osc);
    *(v4u*)(dst + (size_t)m * C + ch * 8) = o;
}
__device__ __forceinline__ void conv_seg(const bf16_t* proj, int m0, int c0, int ch, int C, const float* w, const float* bias, bf16_t* dst, float osc) {
    const int t0 = m0 & (SEQ - 1);
    f32x4 wa[4], wb[4];
#pragma unroll
    for (int i = 0; i < 4; ++i) { wa[i] = *(const f32x4*)(w + i * C + ch * 8); wb[i] = *(const f32x4*)(w + i * C + ch * 8 + 4); }
    const f32x4 b0 = *(const f32x4*)(bias + ch * 8), b1 = *(const f32x4*)(bias + ch * 8 + 4);
    const bf16_t* src = proj + (size_t)m0 * PROJ_W + c0 + ch * 8;
    us8 x0 = us8{}, x1 = us8{}, x2 = us8{};
    if (t0 > 0) { x0 = *(const us8*)(src - 3 * (ptrdiff_t)PROJ_W); x1 = *(const us8*)(src - 2 * (ptrdiff_t)PROJ_W); x2 = *(const us8*)(src - (ptrdiff_t)PROJ_W); }
    for (int j = 0; j < 32; j += 8) {
        us8 xn[8];
#pragma unroll
        for (int k = 0; k < 8; ++k) xn[k] = *(const us8*)(src + (size_t)(j + k) * PROJ_W);
#pragma unroll
        for (int k = 0; k < 8; ++k) {
            float acc[8] = {b0.x, b0.y, b0.z, b0.w, b1.x, b1.y, b1.z, b1.w};
#define CS_TAP(i, xv) do { acc[0] += wa[i].x * bf2f(xv[0]); acc[1] += wa[i].y * bf2f(xv[1]); acc[2] += wa[i].z * bf2f(xv[2]); acc[3] += wa[i].w * bf2f(xv[3]); \
                           acc[4] += wb[i].x * bf2f(xv[4]); acc[5] += wb[i].y * bf2f(xv[5]); acc[6] += wb[i].z * bf2f(xv[6]); acc[7] += wb[i].w * bf2f(xv[7]); } while (0)
            const bool h3 = (t0 + j + k) >= 3, h2 = (t0 + j + k) >= 2, h1 = (t0 + j + k) >= 1;
            if (h3) CS_TAP(0, x0);
            if (h2) CS_TAP(1, x1);
            if (h1) CS_TAP(2, x2);
            CS_TAP(3, xn[k]);
#undef CS_TAP
            v4u o; o.x = pk2(silu_f(acc[0]) * osc, silu_f(acc[1]) * osc); o.y = pk2(silu_f(acc[2]) * osc, silu_f(acc[3]) * osc); o.z = pk2(silu_f(acc[4]) * osc, silu_f(acc[5]) * osc); o.w = pk2(silu_f(acc[6]) * osc, silu_f(acc[7]) * osc);
            *(v4u*)(dst + (size_t)(m0 + j + k) * C + ch * 8) = o;
            x0 = x1; x1 = x2; x2 = xn[k];
        }
    }
}
__device__ __forceinline__ void mla_prep_token(int m, int lane, const bf16_t* proj, const float* projf, const int* positions, const float* gq, const float* gkv,
                                               bf16_t* cqn, bf16_t* ckvn, bf16_t* km, float* rope) {
    { const us4 v = *(const us4*)(proj + (size_t)m * PROJ_W + PC_CQ + lane * 4);
      const float a = bf2f(v.x), b = bf2f(v.y), c = bf2f(v.z), d = bf2f(v.w);
      const float r = rsqrtf(wave_sum(a * a + b * b + c * c + d * d) * (1.f / 256.f) + EPS);
      const f32x4 g = *(const f32x4*)(gq + lane * 4);
      *(unsigned long long*)(cqn + (size_t)m * 256 + lane * 4) = (unsigned long long)pk2(a * r * g.x, b * r * g.y) | ((unsigned long long)pk2(c * r * g.z, d * r * g.w) << 32); }
    { const float a = projf[(size_t)m * PROJF_W + PF_CKV + lane * 2], b = projf[(size_t)m * PROJF_W + PF_CKV + lane * 2 + 1];
      const float r = rsqrtf(wave_sum(a * a + b * b) * (1.f / 128.f) + EPS);
      *(unsigned*)(ckvn + (size_t)m * 128 + lane * 2) = pk2(a * r * gkv[lane * 2], b * r * gkv[lane * 2 + 1]); }
    if (lane < 16) {
        const float pos = (float)positions[m];
        const float inv = powf(10000.f, -(float)(2 * lane) / 32.f);
        float sn, cs; sincosf(pos * inv, &sn, &cs);
        rope[(size_t)m * 32 + lane] = cs; rope[(size_t)m * 32 + 16 + lane] = sn;
        const float x1 = projf[(size_t)m * PROJF_W + PF_KR + lane], x2 = projf[(size_t)m * PROJF_W + PF_KR + 16 + lane];
        const bf16_t o1 = f2bf(x1 * cs - x2 * sn), o2 = f2bf(x2 * cs + x1 * sn);
#pragma unroll
        for (int hh = 0; hh < 4; ++hh) { km[(size_t)m * 384 + hh * 96 + 64 + lane] = o1; km[(size_t)m * 384 + hh * 96 + 80 + lane] = o2; }
    }
}
__device__ __forceinline__ void kmean_item(int item, int lane, const bf16_t* proj, float* kmean) {
    const int jg = item >> 2, hh = item & 3, cc = lane & 7, rg = lane >> 3;
    float acc[8];
#pragma unroll
    for (int i = 0; i < 8; ++i) acc[i] = 0.f;
#pragma unroll 8
    for (int r = 0; r < 32; ++r) { const us8 x = *(const us8*)(proj + (size_t)(jg * 256 + rg * 32 + r) * PROJ_W + PC_AK + hh * 64 + cc * 8);
#pragma unroll
        for (int i = 0; i < 8; ++i) acc[i] += bf2f(x[i]); }
#pragma unroll
    for (int i = 0; i < 8; ++i) { float v = acc[i]; v += __shfl_xor(v, 8); v += __shfl_xor(v, 16); v += __shfl_xor(v, 32); acc[i] = v * (1.f / 256.f); }
    if (rg == 0) { *(f32x4*)(kmean + jg * 256 + hh * 64 + cc * 8) = (f32x4){acc[0], acc[1], acc[2], acc[3]}; *(f32x4*)(kmean + jg * 256 + hh * 64 + cc * 8 + 4) = (f32x4){acc[4], acc[5], acc[6], acc[7]}; }
}

constexpr size_t WS_WUP = 44 * MiB, WS_WDN = 60 * MiB, WS_XS = 68 * MiB, WS_HID = 112 * MiB, WS_STOK = 134 * MiB, WS_SW1 = WS_STOK + 128 * 1024, WS_SW2 = WS_STOK + 256 * 1024,
                 WS_TCLS = 135 * MiB, WS_TPOS = WS_TCLS + 64 * 1024, WS_TW1 = WS_TCLS + 128 * 1024, WS_TW2 = WS_TCLS + 192 * 1024;
constexpr int MOE_MAXTILES = 88, CW_MOECNT = 200000;
constexpr int TCLS_OFF = LDSCTL_OFF, OFFS_OFF = LDSCTL_OFF + 128;
__device__ __forceinline__ void pair_decode(int pr, int& a, int& b) { a = (pr < 3) ? 0 : ((pr < 5) ? 1 : 2); b = (pr < 3) ? pr + 1 : ((pr < 5) ? pr - 1 : 3); }
__device__ __forceinline__ int moe_tiles(const unsigned* cnt, LAS unsigned char* lds, bool t0) {
    LAS unsigned char* tcls = lds + TCLS_OFF; LAS int* offs = (LAS int*)(lds + OFFS_OFF);
    __syncthreads();
    if (t0) { int off = 0;
        _Pragma("unroll 1") for (int c = 0; c < 24; ++c) { const int n = (int)cnt[32 * c]; offs[c] = off; const int nt = (n + 255) >> 8; _Pragma("unroll 1") for (int t = 0; t < nt; ++t) tcls[(off >> 8) + t] = (unsigned char)c; off += nt << 8; }
        offs[24] = off; }
    __syncthreads();
    return offs[24] >> 8;
}
struct MoeOrder {
    const bf16_t* A; const bf16_t* W; int lda, ldb; size_t estride; int K; int ntile, G, c; const LAS unsigned char* tcls; bool down;
    __device__ bool next(int i, pg8::Unit& u) const { const int L = i * G + c; if (L >= ntile * 4) return false; u.pm = L >> 2; u.pn = L & 3; return true; }
    __device__ __forceinline__ const char* a_ptr(const pg8::Unit& u) const { return (const char*)A + (size_t)u.pm * 256 * lda * 2; }
    __device__ __forceinline__ const char* b_ptr(const pg8::Unit& u, int half) const {
        const int cls = tcls[u.pm], g = cls / 6; int ea, eb; pair_decode(cls - g * 6, ea, eb);
        if (down) { const int e = g * 4 + (half ? eb : ea); return (const char*)(W + (size_t)e * estride + (size_t)u.pn * 256 * ldb); }
        const int e = g * 4 + ((u.pn < 2) ? ea : eb); return (const char*)(W + (size_t)e * estride + (size_t)(u.pn & 1) * 256 * ldb + (half ? K / 2 : 0));
    }
};
struct EpiMoeUp {
    bf16_t* hid; const float* w1; const float* w2;
    __device__ __forceinline__ void operator()(const pg8::f32x4 (&acc)[2][2][4][2], const pg8::Unit& u, int wr, int wc, int fr, int fq) const {
        const int row0 = u.pm * 256 + wr * 64 + fr; const float* ws = (u.pn < 2) ? w1 : w2;
#pragma unroll
        for (int ai = 0; ai < 2; ++ai)
#pragma unroll
            for (int m = 0; m < 4; ++m) { const int row = row0 + ai * 128 + m * 16; const float wt = ws[row];
                const pg8::f32x4 g0 = acc[ai][0][m][0], g1 = acc[ai][0][m][1], u0 = acc[ai][1][m][0], u1 = acc[ai][1][m][1];
                pg8::u32x4 w;
                w.x = pg8::cvt_pk_bf16(silu_f(g0[0]) * u0[0] * wt, silu_f(g0[1]) * u0[1] * wt); w.y = pg8::cvt_pk_bf16(silu_f(g0[2]) * u0[2] * wt, silu_f(g0[3]) * u0[3] * wt);
                w.z = pg8::cvt_pk_bf16(silu_f(g1[0]) * u1[0] * wt, silu_f(g1[1]) * u1[1] * wt); w.w = pg8::cvt_pk_bf16(silu_f(g1[2]) * u1[2] * wt, silu_f(g1[3]) * u1[3] * wt);
                *(pg8::u32x4*)(hid + (size_t)row * 512 + u.pn * 128 + wc * 32 + 8 * fq) = w; }
    }
};
struct EpiMoeDown {
    float* x; const int* stok;
    __device__ __forceinline__ void operator()(const pg8::f32x4 (&acc)[2][2][4][2], const pg8::Unit& u, int wr, int wc, int fr, int fq) const {
        const int row0 = u.pm * 256 + wr * 64 + fr, col0 = u.pn * 256 + wc * 32 + 8 * fq;
#pragma unroll
        for (int ai = 0; ai < 2; ++ai)
#pragma unroll
            for (int m = 0; m < 4; ++m) { const int tok = stok[row0 + ai * 128 + m * 16];
                if (tok >= 0) { float* rowp = x + (size_t)tok * DM + col0;
#pragma unroll
                    for (int bj = 0; bj < 2; ++bj) { pg8::f32x4* p = (pg8::f32x4*)(rowp + bj * 128); const pg8::f32x4 a = p[0] + acc[ai][bj][m][0], b = p[1] + acc[ai][bj][m][1]; p[0] = a; p[1] = b; } }
                asm volatile("" ::: "memory"); }
    }
};
struct MapMoeUp { const float* W; int fbase;
    __device__ const float* ptr(int) const { return W; } __device__ int col(int n) const { return fbase + (n & 127); } __device__ float scale(int) const { return 1.f; } };
constexpr int RW_PITCH = 1028;
__device__ __forceinline__ void route_token(int m, int lane, const float* X, const float* g, const LAS float* rw, const float* bg, const float* br, bf16_t* xn2,
                                            unsigned* cnt, int* tcls, int* tpos, float* tw1, float* tw2) {
    asm volatile("" : "+v"(lane));
    const GAS f32x4* xr = (const GAS f32x4*)(X + (size_t)m * DM) + lane; const GAS f32x4* gr = (const GAS f32x4*)g + lane;
    f32x4 v[4]; float s = 0.f;
#pragma unroll
    for (int j = 0; j < 4; ++j) { v[j] = xr[64 * j]; s += (v[j].x * v[j].x + v[j].y * v[j].y) + (v[j].z * v[j].z + v[j].w * v[j].w); }
    const float rstd = rsqrtf(wave_sum(s) * (1.f / DM) + EPS);
    GAS unsigned long long* o8 = (GAS unsigned long long*)(xn2 + (size_t)m * DM) + lane;
#pragma unroll
    for (int j = 0; j < 4; ++j) { const f32x4 gg = gr[64 * j]; v[j] = (f32x4){v[j].x * rstd * gg.x, v[j].y * rstd * gg.y, v[j].z * rstd * gg.z, v[j].w * rstd * gg.w};
        o8[64 * j] = (unsigned long long)pk2(v[j].x, v[j].y) | ((unsigned long long)pk2(v[j].z, v[j].w) << 32); }
    float lg[20];
#pragma unroll
    for (int q = 0; q < 20; ++q) { float p = 0.f;
#pragma unroll
        for (int j = 0; j < 4; ++j) { const f32x4 w = *(const LAS f32x4*)(rw + q * RW_PITCH + 4 * (64 * j + lane)); p += (v[j].x * w.x + v[j].y * w.y) + (v[j].z * w.z + v[j].w * w.w); }
        lg[q] = wave_sum(p) + (q < 4 ? bg[q] : br[q - 4]); }
    int gi = 0; float gm = lg[0];
#pragma unroll
    for (int j = 1; j < 4; ++j) if (lg[j] > gm) { gm = lg[j]; gi = j; }
    float gs = 0.f;
#pragma unroll
    for (int j = 0; j < 4; ++j) gs += __expf(lg[j] - gm);
    const float g_w = 1.f / gs;
    float el[4];
#pragma unroll
    for (int j = 0; j < 4; ++j) el[j] = (gi == 0) ? lg[4 + j] : (gi == 1) ? lg[8 + j] : (gi == 2) ? lg[12 + j] : lg[16 + j];
    const float em = fmaxf(fmaxf(el[0], el[1]), fmaxf(el[2], el[3]));
    float pe[4]; float es = 0.f;
#pragma unroll
    for (int j = 0; j < 4; ++j) { pe[j] = __expf(el[j] - em); es += pe[j]; }
    int e0 = 0; float p0 = pe[0];
#pragma unroll
    for (int j = 1; j < 4; ++j) if (pe[j] > p0) { p0 = pe[j]; e0 = j; }
    int e1 = -1; float p1 = -1.f;
#pragma unroll
    for (int j = 0; j < 4; ++j) if (j != e0 && pe[j] > p1) { p1 = pe[j]; e1 = j; }
    p0 /= es; p1 /= es;
    const float sw = p0 + p1; const float w0 = g_w * p0 / sw, w1 = g_w * p1 / sw;
    const int ea = e0 < e1 ? e0 : e1, eb = e0 < e1 ? e1 : e0; const float wa = e0 < e1 ? w0 : w1, wb = e0 < e1 ? w1 : w0;
    const int pr = (ea == 0) ? eb - 1 : (ea == 1) ? eb + 1 : 5;
    const int cls = gi * 6 + pr;
    if (lane == 0) { const unsigned pos = __hip_atomic_fetch_add(cnt + 32 * cls, 1u, __ATOMIC_RELAXED, __HIP_MEMORY_SCOPE_AGENT);
        tcls[m] = cls; tpos[m] = (int)pos; tw1[m] = wa; tw2[m] = wb; }
}
namespace att {
using bf16x8 = __attribute__((ext_vector_type(8))) short;
using s16x4 = __attribute__((ext_vector_type(4))) short;
using f32x16 = __attribute__((ext_vector_type(16))) float;
using u32x4 = __attribute__((ext_vector_type(4))) unsigned;
typedef short v4i16_t __attribute__((ext_vector_type(4)));
constexpr int NW = 8, QBLK = 32, QB = 256, KVBLK = 64;
constexpr int NSLOT = 3, KSLOT = 12288, VSLOT = 8192;
constexpr int LDS_K = 0, LDS_V = NSLOT * KSLOT, LDS_WS = LDS_V + NSLOT * VSLOT, LDS_OST = LDS_WS + NW * 256, LDS_BYTES_ATT = LDS_OST + NW * 4096;
__device__ __forceinline__ int crow(int r, int hi) { return (r & 3) + 8 * (r >> 2) + 4 * hi; }
__device__ __forceinline__ void glds16(const void* gsrc, unsigned lds_dst) { unsigned keep;
    asm volatile("s_mov_b32 %0, m0\n\ts_mov_b32 m0, %2\n\ts_nop 0\n\tglobal_load_lds_dwordx4 %1, off\n\ts_mov_b32 m0, %0" : "=&s"(keep) : "v"(gsrc), "s"(lds_dst) : "memory"); }
__device__ __forceinline__ unsigned cvtpk(float lo, float hi) { unsigned r; asm("v_cvt_pk_bf16_f32 %0, %1, %2" : "=v"(r) : "v"(lo), "v"(hi)); return r; }
__device__ __forceinline__ float xhalf_max(float m) { auto rr = __builtin_amdgcn_permlane32_swap(__float_as_uint(m), __float_as_uint(m), false, false); return fmaxf(__uint_as_float(rr[0]), __uint_as_float(rr[1])); }
__device__ __forceinline__ float xhalf_sum(float m) { auto rr = __builtin_amdgcn_permlane32_swap(__float_as_uint(m), __float_as_uint(m), false, false); return __uint_as_float(rr[0]) + __uint_as_float(rr[1]); }
__device__ __forceinline__ void pv(f32x16* o, int vb, bf16x8 pa0, bf16x8 pa1, bf16x8 pa2, bf16x8 pa3) {
#pragma unroll
    for (int d0 = 0; d0 < 2; ++d0) { s16x4 lo[4], hi[4];
#pragma unroll
        for (int ks = 0; ks < 4; ++ks) {
            asm volatile("ds_read_b64_tr_b16 %0,%1 offset:%c2" : "=&v"(lo[ks]) : "v"(vb), "i"(d0 * 4096 + ks * 1024) : "memory");
            asm volatile("ds_read_b64_tr_b16 %0,%1 offset:%c2" : "=&v"(hi[ks]) : "v"(vb), "i"(d0 * 4096 + ks * 1024 + 512) : "memory"); }
        asm volatile("s_waitcnt lgkmcnt(0)" ::: "memory"); __builtin_amdgcn_sched_barrier(0);
#define ATT_PK(k) (bf16x8){lo[k][0], lo[k][1], lo[k][2], lo[k][3], hi[k][0], hi[k][1], hi[k][2], hi[k][3]}
        o[d0] = __builtin_amdgcn_mfma_f32_32x32x16_bf16(pa0, ATT_PK(0), o[d0], 0, 0, 0);
        o[d0] = __builtin_amdgcn_mfma_f32_32x32x16_bf16(pa1, ATT_PK(1), o[d0], 0, 0, 0);
        o[d0] = __builtin_amdgcn_mfma_f32_32x32x16_bf16(pa2, ATT_PK(2), o[d0], 0, 0, 0);
        o[d0] = __builtin_amdgcn_mfma_f32_32x32x16_bf16(pa3, ATT_PK(3), o[d0], 0, 0, 0);
#undef ATT_PK
    }
}
#define ATT_WAIT_BAR(N) asm volatile("s_waitcnt vmcnt(" #N ") lgkmcnt(0)\n\ts_barrier" ::: "memory")

template <int DQK, bool MOBA>
__device__ __forceinline__ void attn_unit(int b, int h, int qb, const bf16_t* Q, int qpitch, int qcol0, const bf16_t* K, int kpitch, int kcol0, const bf16_t* V, int vpitch, int vcol0,
                                          bf16_t* O, int ocol0, const float* kmean, LAS unsigned char* shm, const int wid) {
    constexpr int ND0 = DQK / 16;
    int lane = (int)__builtin_amdgcn_mbcnt_hi(~0u, __builtin_amdgcn_mbcnt_lo(~0u, 0u)); asm volatile("" : "+v"(lane));
    const int r32 = lane & 31, hi = lane >> 5;
    const long rowbase = (long)b * SEQ; const int q0 = qb * QB;
    const bf16_t* Qw = Q + (rowbase + q0 + wid * QBLK) * qpitch + qcol0;
    const bf16_t* Kh = K + rowbase * kpitch + kcol0; const bf16_t* Vh = V + rowbase * vpitch + vcol0;
    const unsigned lds0 = (unsigned)(size_t)shm;
    LAS float* wsf = (LAS float*)(shm + LDS_WS) + wid * 64;
    const bf16_t* ksrc0 = Kh + (long)lane * kpitch + wid * 8;
    const bf16_t* ksrc1 = Kh + (long)lane * kpitch + (8 + (wid & 3)) * 8;
    const bf16_t* vsrc = Vh + (long)(16 * (wid & 3) + (lane >> 2)) * vpitch + (wid >> 2) * 32 + (lane & 3) * 8;
    const unsigned kdst0 = lds0 + LDS_K + wid * 1024, kdst1 = lds0 + LDS_K + (8 + (wid & 3)) * 1024, vdst = lds0 + LDS_V + wid * 1024;
#define ATT_DMA(t, slot) do { glds16(ksrc0 + (long)(t) * KVBLK * kpitch, (unsigned)__builtin_amdgcn_readfirstlane(kdst0 + (slot) * KSLOT)); \
        if (DQK == 96) glds16(ksrc1 + (long)(t) * KVBLK * kpitch, (unsigned)__builtin_amdgcn_readfirstlane(kdst1 + (slot) * KSLOT)); \
        glds16(vsrc + (long)(t) * KVBLK * vpitch, (unsigned)__builtin_amdgcn_readfirstlane(vdst + (slot) * VSLOT)); } while (0)
    const int NT = (q0 + QB) / KVBLK;
    ATT_DMA(0, 0); ATT_DMA(1, 1);
    bf16x8 qr[ND0];
#pragma unroll
    for (int d0 = 0; d0 < ND0; ++d0) qr[d0] = *reinterpret_cast<const bf16x8*>(&Qw[(long)r32 * qpitch + d0 * 16 + hi * 8]);
    unsigned sel = 0xffffffffu;
    if (MOBA) {
        float v0 = -INFINITY, v1 = -INFINITY, v2 = -INFINITY; int i0 = -1, i1 = -1, i2 = -1;
#ifdef ATT_KM_GLOBAL
        const float* kmb = kmean + (size_t)(b * 32) * 256 + h * 64 + hi * 8;
#else
        constexpr int LDS_KM = 98304;
        static_assert(NSLOT == 3, "LDS_KM assumes the 3-slot layout");
        LAS float* kml = (LAS float*)(shm + LDS_KM);
        { const float* kmg = kmean + (size_t)(b * 32) * 256 + h * 64; const int tid_ = wid * 64 + lane;
          for (int i = tid_; i < qb * 16; i += NW * 64) { const int j = i >> 4, c4 = i & 15; *(LAS pg8::f32x4*)(kml + j * 64 + c4 * 4) = *(const pg8::f32x4*)(kmg + (size_t)j * 256 + c4 * 4); }
          asm volatile("s_waitcnt vmcnt(0) lgkmcnt(0)\n\ts_barrier" ::: "memory"); }
        const LAS float* kmb = kml + hi * 8;
#endif
        for (int j = 0; j < qb; ++j) {
            float g = 0.f;
#pragma unroll
            for (int d0 = 0; d0 < 4; ++d0) {
#ifdef ATT_KM_GLOBAL
                const pg8::f32x4 ka = *(const pg8::f32x4*)(kmb + j * 256 + d0 * 16), kb2 = *(const pg8::f32x4*)(kmb + j * 256 + d0 * 16 + 4);
#else
                const pg8::f32x4 ka = *(const LAS pg8::f32x4*)(kmb + j * 64 + d0 * 16), kb2 = *(const LAS pg8::f32x4*)(kmb + j * 64 + d0 * 16 + 4);
#endif
                const bf16x8 qq = qr[d0];
                g += bf2f((bf16_t)qq[0]) * ka.x + bf2f((bf16_t)qq[1]) * ka.y + bf2f((bf16_t)qq[2]) * ka.z + bf2f((bf16_t)qq[3]) * ka.w
                   + bf2f((bf16_t)qq[4]) * kb2.x + bf2f((bf16_t)qq[5]) * kb2.y + bf2f((bf16_t)qq[6]) * kb2.z + bf2f((bf16_t)qq[7]) * kb2.w; }
            g = xhalf_sum(g);
            if (g > v0) { v2 = v1; i2 = i1; v1 = v0; i1 = i0; v0 = g; i0 = j; }
            else if (g > v1) { v2 = v1; i2 = i1; v1 = g; i1 = j; }
            else if (g > v2) { v2 = g; i2 = j; }
        }
        sel = 0u;
        if (i0 >= 0) sel |= 1u << i0;
        if (i1 >= 0) sel |= 1u << i1;
        if (i2 >= 0) sel |= 1u << i2;
    }
    float m_run = -1e30f, l_run = 0.f; f32x16 o[2]; o[0] = f32x16{}; o[1] = f32x16{};
    const int qrel = wid * QBLK + r32;
    const int vb0 = (int)(lds0 + LDS_V) + ((lane >> 4) & 1) * 32 + (lane & 3) * 8 + (4 * hi + ((lane & 15) >> 2)) * 64;
    int slot = 0;
    for (int t = 0; t < NT; ++t) {
        if (t + 1 < NT) { if (DQK == 96) ATT_WAIT_BAR(3); else ATT_WAIT_BAR(2); } else ATT_WAIT_BAR(0);
        if (t + 2 < NT) { const int s2 = (slot == 0) ? 2 : slot - 1; ATT_DMA(t + 2, s2); }
        f32x16 p0, p1;
        { const LAS unsigned char* kb = shm + LDS_K + slot * KSLOT + hi * 1024 + r32 * 16;
#pragma unroll
          for (int d0 = 0; d0 < ND0; ++d0) {
              const bf16x8 b0 = *(const LAS bf16x8*)(kb + d0 * 2048), b1 = *(const LAS bf16x8*)(kb + d0 * 2048 + 512);
              if (d0 == 0) { p0 = __builtin_amdgcn_mfma_f32_32x32x16_bf16(b0, qr[0], f32x16{}, 0, 0, 0); p1 = __builtin_amdgcn_mfma_f32_32x32x16_bf16(b1, qr[0], f32x16{}, 0, 0, 0); }
              else { p0 = __builtin_amdgcn_mfma_f32_32x32x16_bf16(b0, qr[d0], p0, 0, 0, 0); p1 = __builtin_amdgcn_mfma_f32_32x32x16_bf16(b1, qr[d0], p1, 0, 0, 0); } } }
        const int jb = t - (NT - 4);
        if (jb >= 0) { const int kb0 = 64 * jb + 4 * hi;
#pragma unroll
            for (int r = 0; r < 16; ++r) { const int kv = kb0 + (r & 3) + 8 * (r >> 2); if (kv > qrel) p0[r] = -INFINITY; if (kv + 32 > qrel) p1[r] = -INFINITY; } }
        else if (MOBA) { if (!((sel >> (t >> 2)) & 1u)) {
#pragma unroll
            for (int r = 0; r < 16; ++r) { p0[r] = -INFINITY; p1[r] = -INFINITY; } } }
        float rm = fmaxf(p0[0], p1[0]);
#pragma unroll
        for (int r = 1; r < 16; ++r) rm = fmaxf(rm, fmaxf(p0[r], p1[r]));
        rm = xhalf_max(rm);
        const float m_new = fmaxf(m_run, rm); const float alpha = __builtin_amdgcn_exp2f(m_run - m_new); m_run = m_new;
        float ls = 0.f;
#pragma unroll
        for (int r = 0; r < 16; ++r) { p0[r] = __builtin_amdgcn_exp2f(p0[r] - m_new); p1[r] = __builtin_amdgcn_exp2f(p1[r] - m_new); ls += p0[r] + p1[r]; }
        l_run = l_run * alpha + ls;
        if (hi == 0) wsf[r32] = alpha;
        asm volatile("s_waitcnt lgkmcnt(0)" ::: "memory");
#pragma unroll
        for (int r = 0; r < 16; ++r) { const float a = wsf[crow(r, hi)]; o[0][r] *= a; o[1][r] *= a; }
        u32x4 pw0, pw1, pw2, pw3;
        pw0 = (u32x4){cvtpk(p0[0], p0[1]), cvtpk(p0[2], p0[3]), cvtpk(p0[4], p0[5]), cvtpk(p0[6], p0[7])};
        pw1 = (u32x4){cvtpk(p0[8], p0[9]), cvtpk(p0[10], p0[11]), cvtpk(p0[12], p0[13]), cvtpk(p0[14], p0[15])};
        pw2 = (u32x4){cvtpk(p1[0], p1[1]), cvtpk(p1[2], p1[3]), cvtpk(p1[4], p1[5]), cvtpk(p1[6], p1[7])};
        pw3 = (u32x4){cvtpk(p1[8], p1[9]), cvtpk(p1[10], p1[11]), cvtpk(p1[12], p1[13]), cvtpk(p1[14], p1[15])};
        asm volatile("s_waitcnt lgkmcnt(0)" ::: "memory");
        pv(o, vb0 + slot * VSLOT, __builtin_bit_cast(bf16x8, pw0), __builtin_bit_cast(bf16x8, pw1), __builtin_bit_cast(bf16x8, pw2), __builtin_bit_cast(bf16x8, pw3));
        slot = (slot == 2) ? 0 : slot + 1;
    }
    l_run = xhalf_sum(l_run);
    if (hi == 0) wsf[32 + r32] = l_run;
    asm volatile("s_waitcnt lgkmcnt(0)" ::: "memory");
    float rli[16];
#pragma unroll
    for (int r = 0; r < 16; ++r) rli[r] = __builtin_amdgcn_rcpf(wsf[32 + crow(r, hi)]);
    bf16_t* Ow = O + (rowbase + q0 + wid * QBLK) * DM + ocol0;
    { LAS bf16_t* stg = (LAS bf16_t*)(shm + LDS_OST) + wid * 2048;
#pragma unroll
      for (int r = 0; r < 16; ++r) { const int orow = crow(r, hi);
#pragma unroll
          for (int d0 = 0; d0 < 2; ++d0) stg[orow * 64 + d0 * 32 + r32] = f2bf(o[d0][r] * rli[r]); }
      asm volatile("s_waitcnt lgkmcnt(0)" ::: "memory");
#pragma unroll
      for (int i = 0; i < 4; ++i) { const int row = i * 8 + (lane >> 3), ch = lane & 7; const u32x4 v = *(const LAS u32x4*)(stg + row * 64 + ch * 8); *(u32x4*)(Ow + (long)row * DM + ch * 8) = v; } }
    asm volatile("s_waitcnt vmcnt(0) lgkmcnt(0)\n\ts_barrier" ::: "memory");
#undef ATT_DMA
}
#undef ATT_WAIT_BAR
}
namespace ck {
using att::bf16x8; using att::s16x4; using att::f32x16; using att::u32x4; using att::crow; using att::cvtpk; using att::xhalf_sum;
constexpr int CL = 128, NCH = SEQ / CL;
__device__ __forceinline__ int lane_id() { return (int)__builtin_amdgcn_mbcnt_hi(~0u, __builtin_amdgcn_mbcnt_lo(~0u, 0u)); }
#define CK_TRF(dst, vb, OFF) do { s16x4 lo_, hi_; \
    asm volatile("ds_read_b64_tr_b16 %0,%1 offset:%c2" : "=&v"(lo_) : "v"(vb), "i"(OFF) : "memory"); \
    asm volatile("ds_read_b64_tr_b16 %0,%1 offset:%c2" : "=&v"(hi_) : "v"(vb), "i"((OFF) + 512) : "memory"); \
    asm volatile("s_waitcnt lgkmcnt(0)" ::: "memory"); \
    dst = (bf16x8){lo_[0], lo_[1], lo_[2], lo_[3], hi_[0], hi_[1], hi_[2], hi_[3]}; } while (0)
__device__ __forceinline__ int tr_lane_off(int lane) { const int hi = lane >> 5; return ((lane >> 4) & 1) * 32 + (lane & 3) * 8 + (4 * hi + ((lane & 15) >> 2)) * 64; }
__device__ __forceinline__ void stage_v64(LAS unsigned char* dst, const bf16_t* src, int gp, int tid, const LAS float* rowscale) {
    const int row = tid >> 3, j = tid & 7;
    us8 v = *(const us8*)(src + (size_t)row * gp + 8 * j);
    if (rowscale) { const float s = rowscale[row];
#pragma unroll
        for (int i = 0; i < 8; ++i) v[i] = f2bf(bf2f(v[i]) * s); }
    *(LAS us8*)(dst + (j >> 2) * 4096 + row * 64 + (j & 3) * 16) = v;
}
template <int DQ> __device__ __forceinline__ void stage_k64(LAS unsigned char* dst, const bf16_t* src, int gp, int tid) {
#pragma unroll
    for (int pc = tid; pc < 64 * (DQ / 8); pc += 512) { const int row = pc / (DQ / 8), c = pc % (DQ / 8);
        *(LAS us8*)(dst + c * 1024 + row * 16) = *(const us8*)(src + (size_t)row * gp + 8 * c); }
}
__device__ __forceinline__ void scan128(float a0, float a1, int lane, float& s0, float& s1) {
    float t = a0 + a1;
#pragma unroll
    for (int o = 1; o < 64; o <<= 1) { const float u = __shfl_up(t, o); if (lane >= o) t += u; }
    s1 = t; s0 = t - a1;
}

__device__ __forceinline__ void ssd_s1_unit(int unit, const bf16_t* xbca, const float* projf, const float* dt_bias, const float* a_log, float* S, float* dec, LAS unsigned char* shm, int wave) {
    const int g = unit & 1, c = (unit >> 1) & (NCH - 1), b = unit >> 7;
    int lane = lane_id(); asm volatile("" : "+v"(lane));
    const int tid = wave * 64 + lane; const size_t m0 = (size_t)b * SEQ + (size_t)c * CL;
    LAS float* wtab = (LAS float*)(shm + 65536);
    if (wave < 2) { const int h = 2 * g + wave; const float a = -__expf(a_log[h]), dtb = dt_bias[h];
        const float d0 = softplus_f(projf[(m0 + 2 * lane) * PROJF_W + PF_DT + h] + dtb), d1 = softplus_f(projf[(m0 + 2 * lane + 1) * PROJF_W + PF_DT + h] + dtb);
        float s0, s1; scan128(d0 * a, d1 * a, lane, s0, s1);
        const float alast = __shfl(s1, 63);
        wtab[wave * 128 + 2 * lane] = __expf(alast - s0) * d0; wtab[wave * 128 + 2 * lane + 1] = __expf(alast - s1) * d1;
        if (lane == 0) dec[((size_t)b * NCH + c) * 4 + h] = __expf(alast); }
    __syncthreads();
#pragma unroll
    for (int hh = 0; hh < 2; ++hh)
#pragma unroll
        for (int rt = 0; rt < 2; ++rt) stage_v64(shm + (hh * 2 + rt) * 8192, xbca + (m0 + rt * 64) * 768 + (2 * g + hh) * 64, 768, tid, wtab + hh * 128 + rt * 64);
#pragma unroll
    for (int rt = 0; rt < 2; ++rt)
#pragma unroll
        for (int ct = 0; ct < 2; ++ct) stage_v64(shm + 32768 + (rt * 2 + ct) * 8192, xbca + (m0 + rt * 64) * 768 + 256 + g * 128 + ct * 64, 768, tid, nullptr);
    __syncthreads();
    const int hh = wave >> 2, j = wave & 3, r32 = lane & 31, hi = lane >> 5; const int lo = tr_lane_off(lane);
    f32x16 acc0 = f32x16{}, acc1 = f32x16{};
#pragma unroll
    for (int rt = 0; rt < 2; ++rt) {
        const int vx = (int)(unsigned)(size_t)(shm + (hh * 2 + rt) * 8192) + lo, vbm = (int)(unsigned)(size_t)(shm + 32768 + (rt * 2 + (j >> 1)) * 8192) + lo + (j & 1) * 4096;
#define CK_STEP(ks) do { bf16x8 fb, fa0, fa1; CK_TRF(fb, vbm, (ks) * 1024); CK_TRF(fa0, vx, (ks) * 1024); CK_TRF(fa1, vx, 4096 + (ks) * 1024); \
        acc0 = __builtin_amdgcn_mfma_f32_32x32x16_bf16(fa0, fb, acc0, 0, 0, 0); acc1 = __builtin_amdgcn_mfma_f32_32x32x16_bf16(fa1, fb, acc1, 0, 0, 0); } while (0)
        CK_STEP(0); CK_STEP(1); CK_STEP(2); CK_STEP(3);
#undef CK_STEP
    }
    float* Sp = S + (((size_t)b * NCH + c) * 4 + 2 * g + hh) * 8192 + (size_t)(32 * j + r32) * 64;
#pragma unroll
    for (int q = 0; q < 4; ++q) { *(pg8::f32x4*)(Sp + 8 * q + 4 * hi) = (pg8::f32x4){acc0[4 * q], acc0[4 * q + 1], acc0[4 * q + 2], acc0[4 * q + 3]};
                                  *(pg8::f32x4*)(Sp + 32 + 8 * q + 4 * hi) = (pg8::f32x4){acc1[4 * q], acc1[4 * q + 1], acc1[4 * q + 2], acc1[4 * q + 3]}; }
    __syncthreads();
}

__device__ __forceinline__ void ml_s1_unit(int unit, const bf16_t* qka, const bf16_t* proj, const float* projf, const float* ig_bias, const float* fg_bias, float* U, float* nU, float* dec,
                                           LAS unsigned char* shm, int wave) {
    const int hp = unit & 1, c = (unit >> 1) & (NCH - 1), b = unit >> 7;
    int lane = lane_id(); asm volatile("" : "+v"(lane));
    const int tid = wave * 64 + lane; const size_t m0 = (size_t)b * SEQ + (size_t)c * CL;
    LAS float* wtab = (LAS float*)(shm + 65536);
    if (wave < 2) { const int h = 2 * hp + wave; const float igb = ig_bias[h], fgb = fg_bias[h];
        const float f0 = projf[(m0 + 2 * lane) * PROJF_W + PF_MF + h] + fgb, f1 = projf[(m0 + 2 * lane + 1) * PROJF_W + PF_MF + h] + fgb;
        const float l0 = fminf(f0, 0.f) - log1pf(__expf(-fabsf(f0))), l1 = fminf(f1, 0.f) - log1pf(__expf(-fabsf(f1)));
        const float i0 = projf[(m0 + 2 * lane) * PROJF_W + PF_MI + h] + igb, i1 = projf[(m0 + 2 * lane + 1) * PROJF_W + PF_MI + h] + igb;
        float s0, s1; scan128(l0, l1, lane, s0, s1);
        const float blast = __shfl(s1, 63);
        wtab[wave * 128 + 2 * lane] = __expf(blast - s0 + i0); wtab[wave * 128 + 2 * lane + 1] = __expf(blast - s1 + i1);
        if (lane == 0) dec[((size_t)b * NCH + c) * 4 + h] = __expf(blast); }
    __syncthreads();
#pragma unroll
    for (int hh = 0; hh < 2; ++hh)
#pragma unroll
        for (int rt = 0; rt < 2; ++rt) {
            stage_v64(shm + (hh * 2 + rt) * 8192, qka + (m0 + rt * 64) * 512 + 256 + (2 * hp + hh) * 64, 512, tid, wtab + hh * 128 + rt * 64);
            stage_v64(shm + 32768 + (hh * 2 + rt) * 8192, proj + (m0 + rt * 64) * PROJ_W + PC_MV + (2 * hp + hh) * 64, PROJ_W, tid, nullptr); }
    __syncthreads();
    const int hh = wave >> 2, db = (wave >> 1) & 1, eb = wave & 1, r32 = lane & 31, hi = lane >> 5; const int lo = tr_lane_off(lane);
    f32x16 acc = f32x16{};
#pragma unroll
    for (int rt = 0; rt < 2; ++rt) {
        const int vk = (int)(unsigned)(size_t)(shm + (hh * 2 + rt) * 8192) + lo + db * 4096, vv = (int)(unsigned)(size_t)(shm + 32768 + (hh * 2 + rt) * 8192) + lo + eb * 4096;
#define CK_STEP(ks) do { bf16x8 fa, fb; CK_TRF(fa, vv, (ks) * 1024); CK_TRF(fb, vk, (ks) * 1024); acc = __builtin_amdgcn_mfma_f32_32x32x16_bf16(fa, fb, acc, 0, 0, 0); } while (0)
        CK_STEP(0); CK_STEP(1); CK_STEP(2); CK_STEP(3);
#undef CK_STEP
    }
    const size_t ub = ((size_t)b * NCH + c) * 4 + 2 * hp + hh;
    float* Up = U + ub * 4096 + (size_t)(32 * db + r32) * 64 + 32 * eb;
#pragma unroll
    for (int q = 0; q < 4; ++q) *(pg8::f32x4*)(Up + 8 * q + 4 * hi) = (pg8::f32x4){acc[4 * q], acc[4 * q + 1], acc[4 * q + 2], acc[4 * q + 3]};
    if (tid < 128) { const int h2 = tid >> 6, d = tid & 63; float s = 0.f;
        for (int rt = 0; rt < 2; ++rt) { const LAS bf16_t* kp = (const LAS bf16_t*)(shm + (h2 * 2 + rt) * 8192 + (d >> 5) * 4096) + (d & 31);
            for (int r = 0; r < 64; ++r) s += bf2f(kp[r * 32]); }
        nU[(((size_t)b * NCH + c) * 4 + 2 * hp + h2) * 64 + d] = s; }
    __syncthreads();
}

__device__ __forceinline__ void scan_phase(int gtid, int ngt, const float* S, const float* sdec, bf16_t* prevT, const float* U, const float* nU, const float* mdec, bf16_t* Cst, float* nst) {
    constexpr int N1 = 2 * 4 * 8192, N2 = 2 * 4 * 4096, N3 = 2 * 4 * 64;
#define SCAN_RUN(SRC, DEC, STRIDE, STORE) do { float st = 0.f; \
        for (int c0 = 0; c0 < NCH; c0 += 16) { float sv[16], dv[16]; \
            _Pragma("unroll") for (int k = 0; k < 16; ++k) { const size_t u = ((size_t)b * NCH + c0 + k) * 4 + h; sv[k] = SRC[u * STRIDE + e]; dv[k] = DEC[u]; } \
            _Pragma("unroll") for (int k = 0; k < 16; ++k) { const size_t u = ((size_t)b * NCH + c0 + k) * 4 + h; STORE; st = dv[k] * st + sv[k]; } } } while (0)
    for (int idx = gtid; idx < N1 + N2 + N3; idx += ngt) {
        if (idx < N1) { const int e = idx & 8191, h = (idx >> 13) & 3, b = idx >> 15; SCAN_RUN(S, sdec, 8192, prevT[u * 8192 + e] = f2bf(st)); }
        else if (idx < N1 + N2) { const int i2 = idx - N1, e = i2 & 4095, h = (i2 >> 12) & 3, b = i2 >> 14; SCAN_RUN(U, mdec, 4096, Cst[u * 4096 + e] = f2bf(st)); }
        else { const int i3 = idx - N1 - N2, e = i3 & 63, h = (i3 >> 6) & 3, b = i3 >> 8; SCAN_RUN(nU, mdec, 64, nst[u * 64 + e] = st); }
    }
#undef SCAN_RUN
}

#define CK_PACK(p0, p1, pw0, pw1, pw2, pw3) do { \
    pw0 = (u32x4){cvtpk(p0[0], p0[1]), cvtpk(p0[2], p0[3]), cvtpk(p0[4], p0[5]), cvtpk(p0[6], p0[7])}; \
    pw1 = (u32x4){cvtpk(p0[8], p0[9]), cvtpk(p0[10], p0[11]), cvtpk(p0[12], p0[13]), cvtpk(p0[14], p0[15])}; \
    pw2 = (u32x4){cvtpk(p1[0], p1[1]), cvtpk(p1[2], p1[3]), cvtpk(p1[4], p1[5]), cvtpk(p1[6], p1[7])}; \
    pw3 = (u32x4){cvtpk(p1[8], p1[9]), cvtpk(p1[10], p1[11]), cvtpk(p1[12], p1[13]), cvtpk(p1[14], p1[15])}; } while (0)
__device__ __forceinline__ bf16x8 pv_afrag(const bf16_t* rowp, int ks, int hi, float scale) {
    const us4 a = *(const us4*)(rowp + 16 * ks + 4 * hi), b2 = *(const us4*)(rowp + 16 * ks + 8 + 4 * hi);
    u32x4 w; w.x = cvtpk(bf2f(a.x) * scale, bf2f(a.y) * scale); w.y = cvtpk(bf2f(a.z) * scale, bf2f(a.w) * scale);
    w.z = cvtpk(bf2f(b2.x) * scale, bf2f(b2.y) * scale); w.w = cvtpk(bf2f(b2.z) * scale, bf2f(b2.w) * scale);
    return __builtin_bit_cast(bf16x8, w);
}

__device__ __forceinline__ void ssd_s3_unit(int unit, const bf16_t* xbca, const bf16_t* proj, const float* projf, const float* dt_bias, const float* a_log, const float* d_skip, const float* norm_g,
                                            const bf16_t* prevT, bf16_t* ycat, LAS unsigned char* shm, int wave) {
    const int g = unit & 1, c = (unit >> 1) & (NCH - 1), b = unit >> 7;
    int lane = lane_id(); asm volatile("" : "+v"(lane));
    const int tid = wave * 64 + lane; const size_t m0 = (size_t)b * SEQ + (size_t)c * CL;
    LAS float* acum = (LAS float*)(shm + 98304); LAS float* dtt = acum + 256; LAS float* ssq = dtt + 256;
    if (wave < 2) { const int h = 2 * g + wave; const float a = -__expf(a_log[h]), dtb = dt_bias[h];
        const float d0 = softplus_f(projf[(m0 + 2 * lane) * PROJF_W + PF_DT + h] + dtb), d1 = softplus_f(projf[(m0 + 2 * lane + 1) * PROJF_W + PF_DT + h] + dtb);
        float s0, s1; scan128(d0 * a, d1 * a, lane, s0, s1);
        acum[wave * 128 + 2 * lane] = s0; acum[wave * 128 + 2 * lane + 1] = s1; dtt[wave * 128 + 2 * lane] = d0; dtt[wave * 128 + 2 * lane + 1] = d1; }
#pragma unroll
    for (int rt = 0; rt < 2; ++rt) stage_k64<128>(shm + rt * 16384, xbca + (m0 + rt * 64) * 768 + 256 + g * 128, 768, tid);
#pragma unroll
    for (int hh = 0; hh < 2; ++hh)
#pragma unroll
        for (int rt = 0; rt < 2; ++rt) {
            stage_v64(shm + 32768 + (hh * 2 + rt) * 8192, xbca + (m0 + rt * 64) * 768 + (2 * g + hh) * 64, 768, tid, nullptr);
            stage_v64(shm + 65536 + (hh * 2 + rt) * 8192, prevT + (((size_t)b * NCH + c) * 4 + 2 * g + hh) * 8192 + rt * 64 * 64, 64, tid, nullptr); }
    __syncthreads();
    const int hh = wave >> 2, rw = wave & 3, r32 = lane & 31, hi = lane >> 5, h = 2 * g + hh; const int lo = tr_lane_off(lane);
    const int l = 32 * rw + r32;
    const bf16_t* crowp = xbca + (m0 + l) * 768 + 512 + g * 128;
    f32x16 o[2]; o[0] = f32x16{}; o[1] = f32x16{};
    {
        bf16x8 qr[8];
#pragma unroll
        for (int d0 = 0; d0 < 8; ++d0) qr[d0] = *reinterpret_cast<const bf16x8*>(crowp + d0 * 16 + hi * 8);
        const float al = acum[hh * 128 + l];
        const int ntile = (rw >= 2) ? 2 : 1;
        for (int t = 0; t < ntile; ++t) {
            f32x16 p0 = f32x16{}, p1 = f32x16{};
            const LAS unsigned char* kb = shm + t * 16384 + hi * 1024 + r32 * 16;
#pragma unroll
            for (int d0 = 0; d0 < 8; ++d0) { const bf16x8 b0 = *(const LAS bf16x8*)(kb + d0 * 2048), b1 = *(const LAS bf16x8*)(kb + d0 * 2048 + 512);
                p0 = __builtin_amdgcn_mfma_f32_32x32x16_bf16(b0, qr[d0], p0, 0, 0, 0); p1 = __builtin_amdgcn_mfma_f32_32x32x16_bf16(b1, qr[d0], p1, 0, 0, 0); }
#pragma unroll
            for (int r = 0; r < 16; ++r) { const int s = 64 * t + crow(r, hi);
                const float w0 = (s <= l) ? __expf(al - acum[hh * 128 + s]) * dtt[hh * 128 + s] : 0.f, w1 = (s + 32 <= l) ? __expf(al - acum[hh * 128 + s + 32]) * dtt[hh * 128 + s + 32] : 0.f;
                p0[r] *= w0; p1[r] *= w1; }
            u32x4 pw0, pw1, pw2, pw3; CK_PACK(p0, p1, pw0, pw1, pw2, pw3);
            att::pv(o, (int)(unsigned)(size_t)(shm + 32768 + (hh * 2 + t) * 8192) + lo, __builtin_bit_cast(bf16x8, pw0), __builtin_bit_cast(bf16x8, pw1), __builtin_bit_cast(bf16x8, pw2), __builtin_bit_cast(bf16x8, pw3));
        }
        const float ea = __expf(al);
#pragma unroll
        for (int nt = 0; nt < 2; ++nt)
            att::pv(o, (int)(unsigned)(size_t)(shm + 65536 + (hh * 2 + nt) * 8192) + lo, pv_afrag(crowp + 64 * nt, 0, hi, ea), pv_afrag(crowp + 64 * nt, 1, hi, ea), pv_afrag(crowp + 64 * nt, 2, hi, ea), pv_afrag(crowp + 64 * nt, 3, hi, ea));
    }
    __syncthreads();
    LAS float* stg = (LAS float*)(shm + wave * 8704);
#pragma unroll
    for (int r = 0; r < 16; ++r) { const int orow = crow(r, hi); stg[orow * 68 + r32] = o[0][r]; stg[orow * 68 + 32 + r32] = o[1][r]; }
    asm volatile("s_waitcnt lgkmcnt(0)" ::: "memory");
    {
        const int row = lane >> 1, ch = lane & 1, lr = 32 * rw + row; const size_t m = m0 + lr;
        const float dsk = d_skip[h];
        float y[32]; float ss = 0.f;
#pragma unroll
        for (int q = 0; q < 4; ++q) { const us8 xv = *(const us8*)(xbca + m * 768 + h * 64 + ch * 32 + 8 * q), zv = *(const us8*)(proj + m * PROJ_W + PC_Z + h * 64 + ch * 32 + 8 * q);
#pragma unroll
            for (int i = 0; i < 8; ++i) { const float v = (stg[row * 68 + ch * 32 + 8 * q + i] + dsk * bf2f(xv[i])) * silu_f(bf2f(zv[i])); y[8 * q + i] = v; ss += v * v; } }
        ss += __shfl_xor(ss, 1);
        if (ch == 0) ssq[hh * 128 + lr] = ss;
        __syncthreads();
        const float tot = ssq[lr] + ssq[128 + lr];
        const float rstd = rsqrtf(tot * (1.f / 128.f) + EPS);
        const float* gp = norm_g + h * 64 + ch * 32;
        bf16_t* op = ycat + m * DM + 256 + h * 64 + ch * 32;
#pragma unroll
        for (int q = 0; q < 4; ++q) { v4u w; w.x = pk2(y[8 * q] * rstd * gp[8 * q], y[8 * q + 1] * rstd * gp[8 * q + 1]); w.y = pk2(y[8 * q + 2] * rstd * gp[8 * q + 2], y[8 * q + 3] * rstd * gp[8 * q + 3]);
            w.z = pk2(y[8 * q + 4] * rstd * gp[8 * q + 4], y[8 * q + 5] * rstd * gp[8 * q + 5]); w.w = pk2(y[8 * q + 6] * rstd * gp[8 * q + 6], y[8 * q + 7] * rstd * gp[8 * q + 7]);
            *(v4u*)(op + 8 * q) = w; }
    }
    __syncthreads();
}

__device__ __forceinline__ void ml_s3_unit(int unit, const bf16_t* qka, const bf16_t* proj, const float* projf, const float* ig_bias, const float* fg_bias, const float* norm_g,
                                           const bf16_t* Cst, const float* nst, bf16_t* ycat, LAS unsigned char* shm, int wave) {
    const int hp = unit & 1, c = (unit >> 1) & (NCH - 1), b = unit >> 7;
    int lane = lane_id(); asm volatile("" : "+v"(lane));
    const int tid = wave * 64 + lane; const size_t m0 = (size_t)b * SEQ + (size_t)c * CL;
    LAS float* bt = (LAS float*)(shm + 98304); LAS float* igt = bt + 256; LAS float* nt_ = igt + 256;
    LAS float* wsf = (LAS float*)(shm + 98304 + 4096) + wave * 64;
    if (wave < 2) { const int h = 2 * hp + wave; const float igb = ig_bias[h], fgb = fg_bias[h];
        const float f0 = projf[(m0 + 2 * lane) * PROJF_W + PF_MF + h] + fgb, f1 = projf[(m0 + 2 * lane + 1) * PROJF_W + PF_MF + h] + fgb;
        const float l0 = fminf(f0, 0.f) - log1pf(__expf(-fabsf(f0))), l1 = fminf(f1, 0.f) - log1pf(__expf(-fabsf(f1)));
        float s0, s1; scan128(l0, l1, lane, s0, s1);
        bt[wave * 128 + 2 * lane] = s0; bt[wave * 128 + 2 * lane + 1] = s1;
        igt[wave * 128 + 2 * lane] = projf[(m0 + 2 * lane) * PROJF_W + PF_MI + h] + igb; igt[wave * 128 + 2 * lane + 1] = projf[(m0 + 2 * lane + 1) * PROJF_W + PF_MI + h] + igb;
        nt_[wave * 64 + lane] = nst[(((size_t)b * NCH + c) * 4 + h) * 64 + lane]; }
#pragma unroll
    for (int hh = 0; hh < 2; ++hh) {
#pragma unroll
        for (int rt = 0; rt < 2; ++rt) {
            stage_k64<64>(shm + (hh * 2 + rt) * 8192, qka + (m0 + rt * 64) * 512 + 256 + (2 * hp + hh) * 64, 512, tid);
            stage_v64(shm + 32768 + (hh * 2 + rt) * 8192, proj + (m0 + rt * 64) * PROJ_W + PC_MV + (2 * hp + hh) * 64, PROJ_W, tid, nullptr); }
        stage_v64(shm + 65536 + hh * 8192, Cst + (((size_t)b * NCH + c) * 4 + 2 * hp + hh) * 4096, 64, tid, nullptr); }
    __syncthreads();
    const int hh = wave >> 2, rw = wave & 3, r32 = lane & 31, hi = lane >> 5, h = 2 * hp + hh; const int lo = tr_lane_off(lane);
    const int l = 32 * rw + r32;
    const bf16_t* qrowp = qka + (m0 + l) * 512 + h * 64;
    f32x16 o[2]; o[0] = f32x16{}; o[1] = f32x16{};
    float den = 0.f;
    {
        bf16x8 qr[4];
#pragma unroll
        for (int d0 = 0; d0 < 4; ++d0) qr[d0] = *reinterpret_cast<const bf16x8*>(qrowp + d0 * 16 + hi * 8);
        const float bl = bt[hh * 128 + l];
        const int ntile = (rw >= 2) ? 2 : 1;
        for (int t = 0; t < ntile; ++t) {
            f32x16 p0 = f32x16{}, p1 = f32x16{};
            const LAS unsigned char* kb = shm + (hh * 2 + t) * 8192 + hi * 1024 + r32 * 16;
#pragma unroll
            for (int d0 = 0; d0 < 4; ++d0) { const bf16x8 b0 = *(const LAS bf16x8*)(kb + d0 * 2048), b1 = *(const LAS bf16x8*)(kb + d0 * 2048 + 512);
                p0 = __builtin_amdgcn_mfma_f32_32x32x16_bf16(b0, qr[d0], p0, 0, 0, 0); p1 = __builtin_amdgcn_mfma_f32_32x32x16_bf16(b1, qr[d0], p1, 0, 0, 0); }
#pragma unroll
            for (int r = 0; r < 16; ++r) { const int s = 64 * t + crow(r, hi);
                const float w0 = (s <= l) ? __expf(bl - bt[hh * 128 + s] + igt[hh * 128 + s]) : 0.f, w1 = (s + 32 <= l) ? __expf(bl - bt[hh * 128 + s + 32] + igt[hh * 128 + s + 32]) : 0.f;
                p0[r] *= w0; p1[r] *= w1; den += p0[r] + p1[r]; }
            u32x4 pw0, pw1, pw2, pw3; CK_PACK(p0, p1, pw0, pw1, pw2, pw3);
            att::pv(o, (int)(unsigned)(size_t)(shm + 32768 + (hh * 2 + t) * 8192) + lo, __builtin_bit_cast(bf16x8, pw0), __builtin_bit_cast(bf16x8, pw1), __builtin_bit_cast(bf16x8, pw2), __builtin_bit_cast(bf16x8, pw3));
        }
        const float eb = __expf(bl);
        att::pv(o, (int)(unsigned)(size_t)(shm + 65536 + hh * 8192) + lo, pv_afrag(qrowp, 0, hi, eb), pv_afrag(qrowp, 1, hi, eb), pv_afrag(qrowp, 2, hi, eb), pv_afrag(qrowp, 3, hi, eb));
        float qn = 0.f;
#pragma unroll
        for (int d0 = 0; d0 < 4; ++d0)
#pragma unroll
            for (int i = 0; i < 8; ++i) qn += bf2f((bf16_t)qr[d0][i]) * nt_[hh * 64 + 16 * d0 + 8 * hi + i];
        den = xhalf_sum(den + eb * qn);
    }
    if (hi == 0) wsf[r32] = 1.f / fmaxf(fabsf(den), 1.f);
    asm volatile("s_waitcnt lgkmcnt(0)" ::: "memory");
    float rli[16];
#pragma unroll
    for (int r = 0; r < 16; ++r) rli[r] = wsf[crow(r, hi)];
    __syncthreads();
    LAS float* stg = (LAS float*)(shm + wave * 8704);
#pragma unroll
    for (int r = 0; r < 16; ++r) { const int orow = crow(r, hi); stg[orow * 68 + r32] = o[0][r] * rli[r]; stg[orow * 68 + 32 + r32] = o[1][r] * rli[r]; }
    asm volatile("s_waitcnt lgkmcnt(0)" ::: "memory");
    {
        const int row = lane >> 1, ch = lane & 1, lr = 32 * rw + row; const size_t m = m0 + lr;
        float y[32]; float ss = 0.f;
#pragma unroll
        for (int q = 0; q < 4; ++q) { const us8 ov = *(const us8*)(proj + m * PROJ_W + PC_MO + h * 64 + ch * 32 + 8 * q);
#pragma unroll
            for (int i = 0; i < 8; ++i) { const float v = stg[row * 68 + ch * 32 + 8 * q + i] * sigmoid_f(bf2f(ov[i])); y[8 * q + i] = v; ss += v * v; } }
        ss += __shfl_xor(ss, 1);
        const float rstd = rsqrtf(ss * (1.f / 64.f) + EPS);
        const float* gp = norm_g + h * 64 + ch * 32;
        bf16_t* op = ycat + m * DM + 512 + h * 64 + ch * 32;
#pragma unroll
        for (int q = 0; q < 4; ++q) { v4u w; w.x = pk2(y[8 * q] * rstd * gp[8 * q], y[8 * q + 1] * rstd * gp[8 * q + 1]); w.y = pk2(y[8 * q + 2] * rstd * gp[8 * q + 2], y[8 * q + 3] * rstd * gp[8 * q + 3]);
            w.z = pk2(y[8 * q + 4] * rstd * gp[8 * q + 4], y[8 * q + 5] * rstd * gp[8 * q + 5]); w.w = pk2(y[8 * q + 6] * rstd * gp[8 * q + 6], y[8 * q + 7] * rstd * gp[8 * q + 7]);
            *(v4u*)(op + 8 * q) = w; }
    }
    __syncthreads();
}
#undef CK_TRF
#undef CK_PACK
}
#ifndef EN_P_MOE
#define EN_P_MOE 1
#endif
#ifndef EN_P_SCAN
#define EN_P_SCAN 1
#endif
#ifndef EN_P_CONV
#define EN_P_CONV 1
#endif
#ifndef EN_P_INPROJ
#define EN_P_INPROJ 1
#endif
#ifndef EN_P_PREP
#define EN_P_PREP 1
#endif
#ifndef EN_P_MLAUP
#define EN_P_MLAUP 1
#endif
#ifndef EN_P_ATTN
#define EN_P_ATTN 1
#endif
#ifndef EN_P_OUTPROJ
#define EN_P_OUTPROJ 1
#endif
constexpr int NPH = 11, PH_FINAL = 2 * NPH;
enum { P_CONV = 0, P_INPROJ = 1, P_PREP = 2, P_MLAUP = 3, P_SCAN = 4, P_ATTN = 5, P_OUTPROJ = 6, P_ROUTE = 7, P_SORT = 8, P_MOEUP = 9, P_MOEDOWN = 10 };

__global__ void __launch_bounds__(NWAVES * 64, 2) mk_fwd(Args args) {
    extern __shared__ __attribute__((aligned(16))) unsigned char lds_raw[];
    LAS unsigned char* lds0p = (LAS unsigned char*)lds_raw; LAS unsigned char* lds = lds0p;
    volatile LAS unsigned* MISC = (volatile LAS unsigned*)(lds + MISC_OFF);
    const int tid = threadIdx.x, lane0 = tid & 63, wave = __builtin_amdgcn_readfirstlane(tid >> 6);
    const int G = gridDim.x; const int bx = blockIdx.x; const int vcu = (G % 8 == 0) ? (bx % 8) * (G / 8) + bx / 8 : bx;
    unsigned char* ws = args.ws;
    gu32* ctl = (gu32*)(ws + WS_CTL);
    for (int u = tid; u < (LDS_BYTES - LDSCTL_OFF) / 4; u += NWAVES * 64) ((LAS unsigned*)(lds + LDSCTL_OFF))[u] = 0u;
    __syncthreads();
    if (tid == 0) { LAS unsigned long long* tb = (LAS unsigned long long*)(lds + PTR_OFF);
#pragma unroll
        for (int i = 0; i < 29; ++i) tb[i] = (unsigned long long)args.in[i]; }
    __syncthreads();
#define INP(i) in_ptr(lds, (i))
    XcdBarrier bar = xcd_barrier_post((unsigned*)(ctl + CW_BAR) + args.bli * XCD_BAR_WORDS, MISC + 8);
    const int lo = args.ph_lo, hi = args.ph_hi;
#define IN(k) (lo <= (k) && (k) < hi)
#define SEAM(k) do { if (IN(k) && IN((k) + 1)) xcd_barrier(bar); } while (0)
    float* X = args.out;
    bf16_t* ACT = (bf16_t*)(ws + WS_ACT); bf16_t* PROJ = (bf16_t*)(ws + WS_PROJ); float* PROJF = (float*)(ws + WS_PROJF);
    bf16_t* WinT = (bf16_t*)(ws + WS_WIN); bf16_t* WoutT = (bf16_t*)(ws + WS_WOUT); bf16_t* WuqT = (bf16_t*)(ws + WS_WUQ); bf16_t* WukvT = (bf16_t*)(ws + WS_WUKV);
    bf16_t* XBCA = (bf16_t*)(ws + WS_XBCA); bf16_t* QKA = (bf16_t*)(ws + WS_QKA); bf16_t* QM = (bf16_t*)(ws + WS_QM); bf16_t* KM = (bf16_t*)(ws + WS_KM); bf16_t* VM = (bf16_t*)(ws + WS_VM);
    bf16_t* WupT = (bf16_t*)(ws + WS_WUP); bf16_t* WdnT = (bf16_t*)(ws + WS_WDN); bf16_t* XS = (bf16_t*)(ws + WS_XS); bf16_t* HID = (bf16_t*)(ws + WS_HID);
    int* STOK = (int*)(ws + WS_STOK); float* SW1 = (float*)(ws + WS_SW1); float* SW2 = (float*)(ws + WS_SW2);
    int* TCLS = (int*)(ws + WS_TCLS); int* TPOS = (int*)(ws + WS_TPOS); float* TW1 = (float*)(ws + WS_TW1); float* TW2 = (float*)(ws + WS_TW2);
    float* S1S = (float*)(ws + WS_ACT); float* S1U = (float*)(ws + WS_ACT + 16 * MiB); float* S1N = (float*)(ws + WS_ACT + 24 * MiB); float* S1SD = (float*)(ws + WS_ACT + 25 * MiB); float* S1MD = S1SD + 1024;
    bf16_t* PREVT = (bf16_t*)(ws + WS_PREVT); bf16_t* CST = (bf16_t*)(ws + WS_CST); float* NST = (float*)(ws + WS_NST);
    bf16_t* CQN = (bf16_t*)(ws + WS_CQN); bf16_t* CKVN = (bf16_t*)(ws + WS_CKVN); float* ROPE = (float*)(ws + WS_ROPE); float* KMEAN = (float*)(ws + WS_KMEAN);
    const int gw = vcu * NWAVES + wave, NGW = G * NWAVES;

    for (int l = 0; l < DEPTH; ++l) {
        const int pb = l * NPH;
        { unsigned lv = (unsigned)(size_t)lds0p; asm volatile("" : "+s"(lv)); lds = (LAS unsigned char*)(size_t)lv; }
        if (EN_P_CONV && IN(pb + P_CONV)) {
            int lane = (int)__builtin_amdgcn_mbcnt_hi(~0u, __builtin_amdgcn_mbcnt_lo(~0u, 0u)); asm volatile("" : "+v"(lane));
            LAS float* scr = (LAS float*)(lds + RING_OFF + wave * 16384);
            constexpr int I_IN = (DM / 64) * (PROJ_N / 32), I_OUT = (DM / 64) * (DM / 32), I_UQ = (256 / 64) * (512 / 32), I_UKV = (128 / 64) * (512 / 32);
            const MapInProj mi{INP(3) + (size_t)l * DM * NIN};
            const MapPlain mo{INP(19) + (size_t)l * DM * DM, DM, 1.f};
            const MapPlain muq{INP(16) + (size_t)l * 256 * 384, 384, C2M};
            const MapPlain mukv{INP(18) + (size_t)l * 128 * 512, 512, 1.f};
            for (int it = gw; it < I_IN + I_OUT + I_UQ + I_UKV; it += NGW) {
                if (it < I_IN) conv_item(mi, NIN, DM, WinT, PROJ_N / 32, scr, it, lane);
                else if (it < I_IN + I_OUT) conv_item(mo, DM, DM, WoutT, DM / 32, scr, it - I_IN, lane);
                else if (it < I_IN + I_OUT + I_UQ) conv_item(muq, 384, 256, WuqT, 512 / 32, scr, it - I_IN - I_OUT, lane);
                else conv_item(mukv, 512, 128, WukvT, 512 / 32, scr, it - I_IN - I_OUT - I_UQ, lane);
            }
            const float* xsrc = (l == 0) ? INP(0) : X;
            for (int m = gw; m < M; m += NGW) rms_row_to_bf16(xsrc + (size_t)m * DM, INP(2) + l * DM, ACT + (size_t)m * DM, nullptr, lane);
        }
        SEAM(pb + P_CONV);
        if (EN_P_INPROJ && IN(pb + P_INPROJ)) {
            pg8::StaticOrder S; S.init(ACT, WinT, DM, DM, DM, M, PROJ_N, G, bx);
            const EpiInProj E{PROJ, PROJF};
            pg8::gemm_phase(lds + RING_OFF, wave, pg8::Dims{DM, DM, DM}, S, E);
        }
        SEAM(pb + P_INPROJ);
        if (EN_P_PREP && IN(pb + P_PREP)) {
            int lane = (int)__builtin_amdgcn_mbcnt_hi(~0u, __builtin_amdgcn_mbcnt_lo(~0u, 0u)); asm volatile("" : "+v"(lane));
            if (wave == 0) for (int it = vcu; it < 256; it += G) kmean_item(it, lane, PROJ, KMEAN);
            for (int m = gw; m < M; m += NGW) mla_prep_token(m, lane, PROJ, PROJF, (const int*)INP(1), INP(15) + l * 256, INP(17) + l * 128, CQN, CKVN, KM, ROPE);
            for (int wt = gw; wt < (M / 32) * 3; wt += NGW) { const int seg = wt / 3, part = wt - seg * 3;
                if (part == 0) conv_seg(PROJ, seg * 32, PC_XBC, lane, 768, INP(4) + l * 4 * 768, INP(5) + l * 768, XBCA, 1.f);
                else if (part == 1) { if (lane < 32) conv_seg(PROJ, seg * 32, PC_XBC, 64 + lane, 768, INP(4) + l * 4 * 768, INP(5) + l * 768, XBCA, 1.f); }
                else conv_seg(PROJ, seg * 32, PC_MQK, lane, 512, INP(10) + l * 4 * 512, INP(11) + l * 512, QKA, lane >= 32 ? 0.125f : 1.f); }
        }
        SEAM(pb + P_PREP);
        if (EN_P_MLAUP && IN(pb + P_MLAUP)) {
            const int half = G / 2;
            if (bx < half) { pg8::StaticOrder S; S.init(CQN, WuqT, 256, 256, 256, M, 512, half, bx); const EpiMlaQ E{QM, ROPE}; pg8::gemm_phase(lds + RING_OFF, wave, pg8::Dims{256, 256, 256}, S, E); }
            else { pg8::StaticOrder S; S.init(CKVN, WukvT, 128, 128, 128, M, 512, G - half, bx - half); const EpiMlaKVf E{KM, VM}; pg8::gemm_phase(lds + RING_OFF, wave, pg8::Dims{128, 128, 128}, S, E); }
            for (int u = vcu; u < 512; u += G) {
                if (u < 256) ck::ssd_s1_unit(u, XBCA, PROJF, INP(6) + l * 4, INP(7) + l * 4, S1S, S1SD, lds + RING_OFF, wave);
                else ck::ml_s1_unit(u - 256, QKA, PROJ, PROJF, INP(12) + l * 4, INP(13) + l * 4, S1U, S1N, S1MD, lds + RING_OFF, wave);
            }
        }
        SEAM(pb + P_MLAUP);
        if (EN_P_SCAN && IN(pb + P_SCAN)) {
            const int lane = (int)__builtin_amdgcn_mbcnt_hi(~0u, __builtin_amdgcn_mbcnt_lo(~0u, 0u));
            ck::scan_phase(gw * 64 + lane, NGW * 64, S1S, S1SD, PREVT, S1U, S1N, S1MD, CST, NST);
        }
        SEAM(pb + P_SCAN);
        if (EN_P_ATTN && IN(pb + P_ATTN)) {
            for (int u = vcu; u < 512; u += G) {
                const int bh = (u & 255) >> 5, qs = u & 31, b = bh >> 2, hh = bh & 3;
                if (u < 256) att::attn_unit<96, false>(b, hh, qs, QM, 384, hh * 96, KM, 384, hh * 96, VM, 256, hh * 64, ACT, 768 + hh * 64, nullptr, lds + RING_OFF, wave);
                else att::attn_unit<64, true>(b, hh, 31 - qs, PROJ, PROJ_W, PC_AQ + hh * 64, PROJ, PROJ_W, PC_AK + hh * 64, PROJ, PROJ_W, PC_AV + hh * 64, ACT, hh * 64, KMEAN, lds + RING_OFF, wave);
            }
            for (int u = vcu; u < 512; u += G) {
                if (u < 256) ck::ssd_s3_unit(u, XBCA, PROJ, PROJF, INP(6) + l * 4, INP(7) + l * 4, INP(8) + l * 4, INP(9) + l * 256, PREVT, ACT, lds + RING_OFF, wave);
                else ck::ml_s3_unit(u - 256, QKA, PROJ, PROJF, INP(12) + l * 4, INP(13) + l * 4, INP(14) + l * 256, CST, NST, ACT, lds + RING_OFF, wave);
            }
        }
        SEAM(pb + P_ATTN);
        if (EN_P_OUTPROJ && IN(pb + P_OUTPROJ)) {
            pg8::StaticOrder S; S.init(ACT, WoutT, DM, DM, DM, M, DM, G, bx);
            const EpiResidualF32 E{X, (l == 0) ? INP(0) : (const float*)X};
            pg8::gemm_phase(lds + RING_OFF, wave, pg8::Dims{DM, DM, DM}, S, E);
            int lane = (int)__builtin_amdgcn_mbcnt_hi(~0u, __builtin_amdgcn_mbcnt_lo(~0u, 0u)); asm volatile("" : "+v"(lane));
            LAS float* scr = (LAS float*)(lds + RING_OFF + wave * 16384);
            const float* wgate = INP(25) + (size_t)l * 16 * 1024 * 256; const float* wup = INP(26) + (size_t)l * 16 * 1024 * 256; const float* wdn = INP(27) + (size_t)l * 16 * 256 * 1024;
            for (int it = gw; it < 16 * 256 + 16 * 128; it += NGW) {
                if (it < 16 * 256) { const int e = it >> 8, q = ((it & 255) & 15) >> 2;
                    if (q & 1) { const MapMoeUp mu{wup + (size_t)e * 1024 * 256, (q >> 1) * 128}; conv_item(mu, 256, 1024, WupT + (size_t)e * 512 * 1024, 512 / 32, scr, it & 255, lane); }
                    else { const MapMoeUp mu{wgate + (size_t)e * 1024 * 256, (q >> 1) * 128}; conv_item(mu, 256, 1024, WupT + (size_t)e * 512 * 1024, 512 / 32, scr, it & 255, lane); } }
                else { const int r = it - 16 * 256, e = r >> 7; const MapPlain md{wdn + (size_t)e * 256 * 1024, 1024, 1.f};
                    conv_item(md, 1024, 256, WdnT + (size_t)e * 1024 * 256, 1024 / 32, scr, r & 127, lane); }
            }
        }
        SEAM(pb + P_OUTPROJ);
        unsigned* mcnt = (unsigned*)(ctl + CW_MOECNT + l * 1024);
        if (EN_P_MOE && IN(pb + P_ROUTE)) {
            int lane = (int)__builtin_amdgcn_mbcnt_hi(~0u, __builtin_amdgcn_mbcnt_lo(~0u, 0u)); asm volatile("" : "+v"(lane));
            LAS float* rw = (LAS float*)(lds + RING_OFF);
            { const float* wg = INP(21) + (size_t)l * DM * 4; const float* wr = INP(23) + (size_t)l * DM * 16; const int tid2 = wave * 64 + lane;
              for (int i = tid2; i < DM; i += NWAVES * 64) { const f32x4 w = *(const GAS f32x4*)(wg + 4 * i); rw[0 * RW_PITCH + i] = w.x; rw[1 * RW_PITCH + i] = w.y; rw[2 * RW_PITCH + i] = w.z; rw[3 * RW_PITCH + i] = w.w; }
              for (int i = tid2; i < DM * 4; i += NWAVES * 64) { const int k = i >> 2, c = i & 3; const f32x4 w = *(const GAS f32x4*)(wr + 4 * i);
                  rw[(4 + 4 * c) * RW_PITCH + k] = w.x; rw[(5 + 4 * c) * RW_PITCH + k] = w.y; rw[(6 + 4 * c) * RW_PITCH + k] = w.z; rw[(7 + 4 * c) * RW_PITCH + k] = w.w; } }
            __syncthreads();
            for (int m = gw; m < M; m += NGW) route_token(m, lane, X, INP(20) + l * DM, rw, INP(22) + l * 4, INP(24) + l * 16, ACT, mcnt, TCLS, TPOS, TW1, TW2);
            __syncthreads();
        }
        SEAM(pb + P_ROUTE);
        if (EN_P_MOE && IN(pb + P_SORT)) {
            int lane = (int)__builtin_amdgcn_mbcnt_hi(~0u, __builtin_amdgcn_mbcnt_lo(~0u, 0u)); asm volatile("" : "+v"(lane));
            (void)moe_tiles(mcnt, lds, wave == 0 && lane == 0);
            const LAS int* offs = (const LAS int*)(lds + OFFS_OFF);
            if (bx < 24) { const int beg = offs[bx] + (int)mcnt[32 * bx], end = offs[bx + 1];
                for (int r = beg + wave * 64 + lane; r < end; r += NWAVES * 64) { st_wt(STOK + r, -1); st_wt(SW1 + r, 0.f); st_wt(SW2 + r, 0.f); }
#ifndef PADZERO_OFF
                for (int r = beg + wave; r < end; r += NWAVES) { v4u* dst = (v4u*)(XS + (size_t)r * DM); dst[lane] = (v4u){0u, 0u, 0u, 0u}; dst[64 + lane] = (v4u){0u, 0u, 0u, 0u}; }
#endif
            }
            for (int m = gw; m < M; m += NGW) { const int row = offs[TCLS[m]] + TPOS[m];
                if (lane == 0) { st_wt(STOK + row, m); st_wt(SW1 + row, TW1[m]); st_wt(SW2 + row, TW2[m]); }
                const v4u* src = (const v4u*)(ACT + (size_t)m * DM); v4u* dst = (v4u*)(XS + (size_t)row * DM);
                const v4u a = src[lane], b = src[64 + lane]; dst[lane] = a; dst[64 + lane] = b; }
        }
        SEAM(pb + P_SORT);
        if (EN_P_MOE && IN(pb + P_MOEUP)) {
            const int lane = (int)__builtin_amdgcn_mbcnt_hi(~0u, __builtin_amdgcn_mbcnt_lo(~0u, 0u));
            const int ntile = moe_tiles(mcnt, lds, wave == 0 && lane == 0);
            const int nu = ntile * 4;
            unsigned* tdone = (unsigned*)(ctl + 210000 + l * 128);
            const EpiMoeUp E{HID, SW1, SW2};
            for (int L = bx; L < nu; L += G) {
                const MoeOrder S{XS, WupT, DM, DM, (size_t)512 * 1024, DM, ntile, 1 << 20, L, lds + TCLS_OFF, false};
                pg8::gemm_phase(lds + RING_OFF, wave, pg8::Dims{DM, DM, DM}, S, E);
                asm volatile("s_waitcnt vmcnt(0)" ::: "memory");
                __syncthreads();
                if (wave == 0 && lane == 0) { __builtin_amdgcn_fence(__ATOMIC_RELEASE, "agent"); asm volatile("s_waitcnt vmcnt(0)" ::: "memory");
                    (void)__hip_atomic_fetch_add(tdone + (L >> 2), 1u, __ATOMIC_RELAXED, __HIP_MEMORY_SCOPE_AGENT); }
            }
            const int maxu = (nu + G - 1) / G; int two = nu - (maxu - 1) * G; if (two >= G) two = 0;
            const int c2 = (bx >= two) ? bx - two : bx + (G - two);
            const EpiMoeDown E2{X, STOK};
            for (int L = c2; L < nu; L += G) {
                if (wave == 0 && lane == 0) { unsigned sp = 0u;
                    while (__hip_atomic_load(tdone + (L >> 2), __ATOMIC_RELAXED, __HIP_MEMORY_SCOPE_AGENT) < 4u && ++sp < (1u << 22)) __builtin_amdgcn_s_sleep(2);
                    __builtin_amdgcn_fence(__ATOMIC_ACQUIRE, "agent"); asm volatile("s_waitcnt vmcnt(0)" ::: "memory"); }
                __syncthreads();
                const MoeOrder S2{HID, WdnT, 512, 256, (size_t)1024 * 256, 512, ntile, 1 << 20, L, lds + TCLS_OFF, true};
                pg8::gemm_phase(lds + RING_OFF, wave, pg8::Dims{512, 512, 256}, S2, E2);
            }
        }
        SEAM(pb + P_MOEDOWN);
    }
    if (IN(PH_FINAL)) {
        int lane = (int)__builtin_amdgcn_mbcnt_hi(~0u, __builtin_amdgcn_mbcnt_lo(~0u, 0u)); asm volatile("" : "+v"(lane));
        for (int m = gw; m < M; m += NGW) rms_row_to_f32(X + (size_t)m * DM, INP(28), X + (size_t)m * DM, lane);
    }
#undef IN
#undef SEAM
}
static void launch_mk(Args a, int lo, int hi, int bli, int grid, hipStream_t stream) {
    a.ph_lo = lo; a.ph_hi = hi; a.bli = bli; a.pad = 0;
    hipLaunchKernelGGL(mk_fwd, dim3(grid), dim3(NWAVES * 64), LDS_BYTES, stream, a);
}
extern "C" void kernel_launch(void* const* d_in, const int* in_sizes, int n_in, void* d_out, int out_size, void* d_ws, size_t ws_size, hipStream_t stream) {
    static int grid = 0;
    if (grid == 0) {
        int dev = 0, cus = 0;
        if (hipGetDevice(&dev) != hipSuccess || hipDeviceGetAttribute(&cus, hipDeviceAttributeMultiprocessorCount, dev) != hipSuccess) { grid = -1; return; }
        if (hipFuncSetAttribute((const void*)mk_fwd, hipFuncAttributeMaxDynamicSharedMemorySize, LDS_BYTES) != hipSuccess) { grid = -1; return; }
        int per_cu = 0;
        (void)hipOccupancyMaxActiveBlocksPerMultiprocessor(&per_cu, (const void*)mk_fwd, NWAVES * 64, LDS_BYTES);
        (void)hipGetLastError();
        grid = cus;
        if (n_in != 29 || ws_size < WS_END) { grid = -1; return; }
    }
    if (grid < 0) return;
    (void)hipMemsetAsync((char*)d_ws + WS_CTL, 0, CTL_ZERO_BYTES, stream);
    Args a{};
    for (int i = 0; i < 29; ++i) a.in[i] = (const float*)d_in[i];
    a.out = (float*)d_out; a.ws = (unsigned char*)d_ws;
    launch_mk(a, 0, PH_FINAL + 1, 0, grid, stream);
}
```

```cpp
#include <hip/hip_runtime.h>
#include <stdint.h>
#include <math.h>

typedef unsigned short bf16_t;
typedef unsigned short us8 __attribute__((ext_vector_type(8)));
typedef unsigned short us4 __attribute__((ext_vector_type(4)));

constexpr int BATCH = 2, SEQ = 8192, DM = 1024, M = BATCH * SEQ, DEPTH = 2;
constexpr int NIN = 3244;
constexpr float EPS = 1e-6f;
constexpr float LOG2E = 1.4426950408889634f;
constexpr float C2A = 0.125f * LOG2E;
constexpr float C2M = 0.10206207261596575f * LOG2E;
constexpr int PC_AQ = 0, PC_AK = 256, PC_AV = 512, PC_Z = 768, PC_XBC = 1024, PC_MQK = 1792, PC_MV = 2304, PC_MO = 2560, PC_CQ = 2816, PROJ_W = 3072;
constexpr int PF_CKV = 0, PF_KR = 128, PF_DT = 160, PF_MI = 164, PF_MF = 168, PROJF_W = 256;

__host__ __device__ inline int dst_col(int n) {
    if (n < 1792) return n;
    if (n < 1796) return PROJ_W + PF_DT + (n - 1792);
    if (n < 2308) return PC_MQK + (n - 1796);
    if (n < 2564) return PC_MV + (n - 2308);
    if (n < 2568) return PROJ_W + PF_MI + (n - 2564);
    if (n < 2572) return PROJ_W + PF_MF + (n - 2568);
    if (n < 2828) return PC_MO + (n - 2572);
    if (n < 3084) return PC_CQ + (n - 2828);
    if (n < 3212) return PROJ_W + PF_CKV + (n - 3084);
    return PROJ_W + PF_KR + (n - 3212);
}

__device__ __forceinline__ float bf2f(bf16_t v) { return __uint_as_float(((unsigned)v) << 16); }
__device__ __forceinline__ bf16_t f2bf(float f) { unsigned u = __float_as_uint(f); return (bf16_t)((u + 0x7fffu + ((u >> 16) & 1u)) >> 16); }
__device__ __forceinline__ float silu_f(float x) { return x / (1.f + __expf(-x)); }
__device__ __forceinline__ float sigmoid_f(float x) { return 1.f / (1.f + __expf(-x)); }
__device__ __forceinline__ float softplus_f(float x) { return x > 20.f ? x : log1pf(__expf(x)); }

#ifdef WAVE_SUM_SHFL
__device__ __forceinline__ float wave_sum(float v) {
#pragma unroll
    for (int o = 1; o < 64; o <<= 1) v += __shfl_xor(v, o);
    return v;
}
#else
#define WS_DPP(v, ctrl) ((v) + __int_as_float(__builtin_amdgcn_update_dpp(0, __float_as_int(v), (ctrl), 0xf, 0xf, true)))
__device__ __forceinline__ float wave_sum(float v) {
    v = WS_DPP(v, 0xB1);
    v = WS_DPP(v, 0x4E);
    v = WS_DPP(v, 0x141);
    v = WS_DPP(v, 0x140);
    { auto rr = __builtin_amdgcn_permlane16_swap(__float_as_uint(v), __float_as_uint(v), false, false); v = __uint_as_float(rr[0]) + __uint_as_float(rr[1]); }
    { auto rr = __builtin_amdgcn_permlane32_swap(__float_as_uint(v), __float_as_uint(v), false, false); v = __uint_as_float(rr[0]) + __uint_as_float(rr[1]); }
    return v;
}
#endif
__device__ __forceinline__ float block_sum256(float v, float* sh) {
    v = wave_sum(v);
    __syncthreads();
    if ((threadIdx.x & 63) == 0) sh[threadIdx.x >> 6] = v;
    __syncthreads();
    return sh[0] + sh[1] + sh[2] + sh[3];
}

__global__ __launch_bounds__(256) void k_rmsnorm_bf16(const float* __restrict__ x, const float* __restrict__ g, bf16_t* __restrict__ out) {
    __shared__ float sh[4];
    const int m = blockIdx.x, t = threadIdx.x;
    const float4 v = ((const float4*)(x + (size_t)m * DM))[t];
    const float ss = block_sum256(v.x * v.x + v.y * v.y + v.z * v.z + v.w * v.w, sh);
    const float r = rsqrtf(ss * (1.f / DM) + EPS);
    const float4 gg = ((const float4*)g)[t];
    us4 o; o.x = f2bf(v.x * r * gg.x); o.y = f2bf(v.y * r * gg.y); o.z = f2bf(v.z * r * gg.z); o.w = f2bf(v.w * r * gg.w);
    ((us4*)(out + (size_t)m * DM))[t] = o;
}
__global__ __launch_bounds__(256) void k_rmsnorm_f32(const float* x, const float* __restrict__ g, float* out) {
    __shared__ float sh[4];
    const int m = blockIdx.x, t = threadIdx.x;
    const float4 v = ((const float4*)(x + (size_t)m * DM))[t];
    const float ss = block_sum256(v.x * v.x + v.y * v.y + v.z * v.z + v.w * v.w, sh);
    const float r = rsqrtf(ss * (1.f / DM) + EPS);
    const float4 gg = ((const float4*)g)[t];
    float4 o; o.x = v.x * r * gg.x; o.y = v.y * r * gg.y; o.z = v.z * r * gg.z; o.w = v.w * r * gg.w;
    ((float4*)(out + (size_t)m * DM))[t] = o;
}

template <class Epi>
__global__ __launch_bounds__(256) void k_gemm(const bf16_t* __restrict__ A, int lda, const float* __restrict__ W, int ldw, int N, int K, Epi epi) {
    __shared__ float As[16][68];
    __shared__ float Bs[16][68];
    const int tid = threadIdx.x, tx = tid & 15, ty = tid >> 4;
    const int m0 = blockIdx.y * 64, n0 = blockIdx.x * 64;
    float acc[4][4];
#pragma unroll
    for (int i = 0; i < 4; ++i)
#pragma unroll
        for (int j = 0; j < 4; ++j) acc[i][j] = 0.f;
    for (int k0 = 0; k0 < K; k0 += 16) {
        {
            const int r = tid >> 2, kq = (tid & 3) * 4;
            const us4 v = *(const us4*)(A + (size_t)(m0 + r) * lda + k0 + kq);
            As[kq + 0][r] = bf2f(v.x); As[kq + 1][r] = bf2f(v.y); As[kq + 2][r] = bf2f(v.z); As[kq + 3][r] = bf2f(v.w);
        }
        {
            const int kk = tid >> 4, nq = (tid & 15) * 4, n = n0 + nq;
            float4 v = make_float4(0.f, 0.f, 0.f, 0.f);
            if (n < N) v = *(const float4*)(W + (size_t)(k0 + kk) * ldw + n);
            Bs[kk][nq + 0] = v.x; Bs[kk][nq + 1] = v.y; Bs[kk][nq + 2] = v.z; Bs[kk][nq + 3] = v.w;
        }
        __syncthreads();
#pragma unroll
        for (int kk = 0; kk < 16; ++kk) {
            float a[4], b[4];
#pragma unroll
            for (int i = 0; i < 4; ++i) { a[i] = As[kk][ty * 4 + i]; b[i] = Bs[kk][tx * 4 + i]; }
#pragma unroll
            for (int i = 0; i < 4; ++i)
#pragma unroll
                for (int j = 0; j < 4; ++j) acc[i][j] += a[i] * b[j];
        }
        __syncthreads();
    }
#pragma unroll
    for (int i = 0; i < 4; ++i)
#pragma unroll
        for (int j = 0; j < 4; ++j) { const int n = n0 + tx * 4 + j; if (n < N) epi(m0 + ty * 4 + i, n, acc[i][j]); }
}

struct EpiInProjNaive {
    bf16_t* proj; float* projf;
    __device__ void operator()(int m, int n, float v) const {
        const int c = dst_col(n);
        if (c < PROJ_W) { if (c < 256) v *= C2A; proj[(size_t)m * PROJ_W + c] = f2bf(v); }
        else projf[(size_t)m * PROJF_W + (c - PROJ_W)] = v;
    }
};
struct EpiResidual {
    float* x;
    __device__ void operator()(int m, int n, float v) const { x[(size_t)m * DM + n] += v; }
};
struct EpiF32 {
    float* out; int ld; int pad;
    __device__ void operator()(int m, int n, float v) const { out[(size_t)m * ld + n] = v; }
};
struct EpiMlaKV {
    bf16_t* km; bf16_t* vm;
    __device__ void operator()(int m, int n, float v) const {
        const int h = n >> 7, d = n & 127;
        if (d < 64) km[(size_t)m * 384 + h * 96 + d] = f2bf(v); else vm[(size_t)m * 256 + h * 64 + (d - 64)] = f2bf(v);
    }
};

__global__ __launch_bounds__(256) void k_conv_silu(const bf16_t* __restrict__ src, int ld, int c0, int C, const float* __restrict__ w, const float* __restrict__ b, bf16_t* __restrict__ dst) {
    const size_t idx = (size_t)blockIdx.x * 256 + threadIdx.x;
    if (idx >= (size_t)M * C) return;
    const int m = (int)(idx / C), c = (int)(idx % C), t = m % SEQ;
    float acc = b[c];
#pragma unroll
    for (int i = 0; i < 4; ++i) { const int tt = t - 3 + i; if (tt >= 0) acc += w[i * C + c] * bf2f(src[(size_t)(m - 3 + i) * ld + c0 + c]); }
    dst[(size_t)m * C + c] = f2bf(silu_f(acc));
}

__global__ __launch_bounds__(256) void k_ssd_scan(const bf16_t* __restrict__ xbca, const bf16_t* __restrict__ proj, const float* __restrict__ projf,
                                                  const float* __restrict__ dt_bias, const float* __restrict__ a_log, const float* __restrict__ d_skip, float* __restrict__ yg) {
    const int blk = blockIdx.x, ps = blk & 3, h = (blk >> 2) & 3, b = blk >> 4;
    const int tid = threadIdx.x, pl = tid >> 4, ns = tid & 15, p = ps * 16 + pl, g = h >> 1;
    const float a = -__expf(a_log[h]), dtb = dt_bias[h], dsk = d_skip[h];
    float st[8];
#pragma unroll
    for (int i = 0; i < 8; ++i) st[i] = 0.f;
    const size_t m0 = (size_t)b * SEQ;
    for (int t = 0; t < SEQ; ++t) {
        const size_t m = m0 + t;
        const float dtv = softplus_f(projf[m * PROJF_W + PF_DT + h] + dtb);
        const float dA = __expf(dtv * a);
        const float xv = bf2f(xbca[m * 768 + h * 64 + p]);
        const us8 Bv = *(const us8*)(xbca + m * 768 + 256 + g * 128 + ns * 8);
        const us8 Cv = *(const us8*)(xbca + m * 768 + 512 + g * 128 + ns * 8);
        const float dx = dtv * xv;
        float y = 0.f;
#pragma unroll
        for (int i = 0; i < 8; ++i) { st[i] = dA * st[i] + dx * bf2f(Bv[i]); y += bf2f(Cv[i]) * st[i]; }
        y += __shfl_xor(y, 1); y += __shfl_xor(y, 2); y += __shfl_xor(y, 4); y += __shfl_xor(y, 8);
        if (ns == 0) {
            const float z = bf2f(proj[m * PROJ_W + PC_Z + h * 64 + p]);
            yg[m * 256 + h * 64 + p] = (y + dsk * xv) * silu_f(z);
        }
    }
}
__global__ __launch_bounds__(256) void k_group_norm(const float* __restrict__ yg, const float* __restrict__ g, int gsz_log2, bf16_t* __restrict__ ycat, int col0) {
    const int wave = (blockIdx.x * 256 + threadIdx.x) >> 6, lane = threadIdx.x & 63;
    const int m = wave >> 1, half = wave & 1;
    if (m >= M) return;
    const float v0 = yg[(size_t)m * 256 + half * 128 + lane * 2], v1 = yg[(size_t)m * 256 + half * 128 + lane * 2 + 1];
    float ss = v0 * v0 + v1 * v1;
    const int nl = (1 << gsz_log2) >> 1;
    for (int o = 1; o < nl; o <<= 1) ss += __shfl_xor(ss, o);
    const float r = rsqrtf(ss / (float)(1 << gsz_log2) + EPS);
    const int c = half * 128 + lane * 2;
    ycat[(size_t)m * DM + col0 + c] = f2bf(v0 * r * g[c]);
    ycat[(size_t)m * DM + col0 + c + 1] = f2bf(v1 * r * g[c + 1]);
}

__global__ __launch_bounds__(256) void k_mlstm_scan(const bf16_t* __restrict__ qka, const bf16_t* __restrict__ proj, const float* __restrict__ projf,
                                                    const float* __restrict__ ig_bias, const float* __restrict__ fg_bias, float* __restrict__ hg) {
    const int blk = blockIdx.x, es = blk & 3, h = (blk >> 2) & 3, b = blk >> 4;
    const int tid = threadIdx.x, el = tid >> 4, ds = tid & 15, e = es * 16 + el;
    const float igb = ig_bias[h], fgb = fg_bias[h];
    float C[4] = {0.f, 0.f, 0.f, 0.f}, nn[4] = {0.f, 0.f, 0.f, 0.f};
    const size_t m0 = (size_t)b * SEQ;
    for (int t = 0; t < SEQ; ++t) {
        const size_t m = m0 + t;
        const float f = sigmoid_f(projf[m * PROJF_W + PF_MF + h] + fgb);
        const float ig = __expf(projf[m * PROJF_W + PF_MI + h] + igb);
        const us4 qv = *(const us4*)(qka + m * 512 + h * 64 + ds * 4);
        const us4 kv = *(const us4*)(qka + m * 512 + 256 + h * 64 + ds * 4);
        const float v = bf2f(proj[m * PROJ_W + PC_MV + h * 64 + e]);
        float num = 0.f, den = 0.f;
#pragma unroll
        for (int i = 0; i < 4; ++i) {
            const float k = bf2f(kv[i]) * 0.125f, q = bf2f(qv[i]);
            C[i] = f * C[i] + ig * k * v; nn[i] = f * nn[i] + ig * k;
            num += q * C[i]; den += q * nn[i];
        }
        num += __shfl_xor(num, 1); num += __shfl_xor(num, 2); num += __shfl_xor(num, 4); num += __shfl_xor(num, 8);
        den += __shfl_xor(den, 1); den += __shfl_xor(den, 2); den += __shfl_xor(den, 4); den += __shfl_xor(den, 8);
        if (ds == 0) {
            const float o = sigmoid_f(bf2f(proj[m * PROJ_W + PC_MO + h * 64 + e]));
            hg[m * 256 + h * 64 + e] = o * num / fmaxf(fabsf(den), 1.f);
        }
    }
}

__global__ __launch_bounds__(256) void k_moba_kmean(const bf16_t* __restrict__ proj, float* __restrict__ kmean) {
    const int jg = blockIdx.x, c = threadIdx.x;
    float s = 0.f;
    for (int r = 0; r < 256; ++r) s += bf2f(proj[(size_t)(jg * 256 + r) * PROJ_W + PC_AK + c]);
    kmean[jg * 256 + c] = s * (1.f / 256.f);
}
__global__ __launch_bounds__(256) void k_moba_attn(const bf16_t* __restrict__ proj, const float* __restrict__ kmean, bf16_t* __restrict__ ycat) {
    __shared__ float km[32][64];
    __shared__ float Ks[32][64];
    __shared__ float Vs[32][64];
    const int blk = blockIdx.x, cur = blk & 31, h = (blk >> 5) & 3, b = blk >> 7;
    const int tid = threadIdx.x, t = cur * 256 + tid;
    const size_t mq = (size_t)b * SEQ + t;
    float q[64];
#pragma unroll
    for (int d8 = 0; d8 < 8; ++d8) { const us8 v = *(const us8*)(proj + mq * PROJ_W + PC_AQ + h * 64 + d8 * 8);
#pragma unroll
        for (int i = 0; i < 8; ++i) q[d8 * 8 + i] = bf2f(v[i]); }
    for (int i = tid; i < 32 * 64; i += 256) { const int j = i >> 6, d = i & 63; km[j][d] = kmean[(b * 32 + j) * 256 + h * 64 + d]; }
    __syncthreads();
    float v0 = -INFINITY, v1 = -INFINITY, v2 = -INFINITY; int i0 = -1, i1 = -1, i2 = -1;
    for (int j = 0; j < cur; ++j) {
        float gq = 0.f;
#pragma unroll
        for (int d = 0; d < 64; ++d) gq += q[d] * km[j][d];
        if (gq > v0) { v2 = v1; i2 = i1; v1 = v0; i1 = i0; v0 = gq; i0 = j; }
        else if (gq > v1) { v2 = v1; i2 = i1; v1 = gq; i1 = j; }
        else if (gq > v2) { v2 = gq; i2 = j; }
    }
    unsigned sel = 0u;
    if (i0 >= 0) sel |= 1u << i0;
    if (i1 >= 0) sel |= 1u << i1;
    if (i2 >= 0) sel |= 1u << i2;
    float o[64];
#pragma unroll
    for (int d = 0; d < 64; ++d) o[d] = 0.f;
    float mx = -INFINITY, l = 0.f;
    for (int jb = 0; jb <= cur; ++jb) {
        for (int kt = 0; kt < 8; ++kt) {
            __syncthreads();
            for (int i = tid; i < 32 * 64; i += 256) { const int r = i >> 6, d = i & 63; const size_t mk = (size_t)b * SEQ + jb * 256 + kt * 32 + r;
                Ks[r][d] = bf2f(proj[mk * PROJ_W + PC_AK + h * 64 + d]); Vs[r][d] = bf2f(proj[mk * PROJ_W + PC_AV + h * 64 + d]); }
            __syncthreads();
            const bool use = (jb == cur) || ((sel >> jb) & 1u);
            if (use) {
                for (int kk = 0; kk < 32; ++kk) {
                    const int key = jb * 256 + kt * 32 + kk;
                    if (key > t) break;
                    float s = 0.f;
#pragma unroll
                    for (int d = 0; d < 64; ++d) s += q[d] * Ks[kk][d];
                    if (s > mx) { const float f = exp2f(mx - s); l *= f;
#pragma unroll
                        for (int d = 0; d < 64; ++d) o[d] *= f;
                        mx = s; }
                    const float p = exp2f(s - mx); l += p;
#pragma unroll
                    for (int d = 0; d < 64; ++d) o[d] += p * Vs[kk][d];
                }
            }
        }
    }
    const float rl = 1.f / l;
#pragma unroll
    for (int d = 0; d < 64; ++d) ycat[mq * DM + 0 + h * 64 + d] = f2bf(o[d] * rl);
}

__global__ __launch_bounds__(256) void k_mla_prep(const bf16_t* __restrict__ proj, const float* __restrict__ projf, const int* __restrict__ positions,
                                                  const float* __restrict__ gq, const float* __restrict__ gkv, bf16_t* __restrict__ cqn, bf16_t* __restrict__ ckvn, bf16_t* __restrict__ km) {
    __shared__ float sh[4];
    const int m = blockIdx.x, tid = threadIdx.x;
    const float cq = bf2f(proj[(size_t)m * PROJ_W + PC_CQ + tid]);
    const float s1 = block_sum256(cq * cq, sh);
    cqn[(size_t)m * 256 + tid] = f2bf(cq * rsqrtf(s1 * (1.f / 256.f) + EPS) * gq[tid]);
    const float ck = tid < 128 ? projf[(size_t)m * PROJF_W + PF_CKV + tid] : 0.f;
    const float s2 = block_sum256(ck * ck, sh);
    if (tid < 128) ckvn[(size_t)m * 128 + tid] = f2bf(ck * rsqrtf(s2 * (1.f / 128.f) + EPS) * gkv[tid]);
    if (tid < 16) {
        const float pos = (float)positions[m];
        const float inv = powf(10000.f, -(float)(2 * tid) / 32.f);
        const float ang = pos * inv; float sn, cs; sincosf(ang, &sn, &cs);
        const float x1 = projf[(size_t)m * PROJF_W + PF_KR + tid], x2 = projf[(size_t)m * PROJF_W + PF_KR + 16 + tid];
        const bf16_t o1 = f2bf(x1 * cs - x2 * sn), o2 = f2bf(x2 * cs + x1 * sn);
#pragma unroll
        for (int h = 0; h < 4; ++h) { km[(size_t)m * 384 + h * 96 + 64 + tid] = o1; km[(size_t)m * 384 + h * 96 + 80 + tid] = o2; }
    }
}
__global__ __launch_bounds__(256) void k_mla_qfinish(const float* __restrict__ qraw, const int* __restrict__ positions, bf16_t* __restrict__ qm) {
    const size_t idx = (size_t)blockIdx.x * 256 + threadIdx.x;
    if (idx >= (size_t)M * 384) return;
    const int m = (int)(idx / 384), c = (int)(idx % 384), h = c / 96, d = c % 96;
    float v;
    if (d < 64) v = qraw[idx];
    else {
        const int i = (d - 64) & 15; const bool second = (d - 64) >= 16;
        const float pos = (float)positions[m];
        const float inv = powf(10000.f, -(float)(2 * i) / 32.f);
        float sn, cs; sincosf(pos * inv, &sn, &cs);
        const float x1 = qraw[(size_t)m * 384 + h * 96 + 64 + i], x2 = qraw[(size_t)m * 384 + h * 96 + 80 + i];
        v = second ? (x2 * cs + x1 * sn) : (x1 * cs - x2 * sn);
    }
    qm[idx] = f2bf(v * C2M);
}
__global__ __launch_bounds__(256) void k_mla_attn(const bf16_t* __restrict__ qm, const bf16_t* __restrict__ km, const bf16_t* __restrict__ vm, bf16_t* __restrict__ ycat) {
    __shared__ float Ks[32][96];
    __shared__ float Vs[32][64];
    const int blk = blockIdx.x, qb = 31 - (blk & 31), h = (blk >> 5) & 3, b = blk >> 7;
    const int tid = threadIdx.x, t = qb * 256 + tid;
    const size_t mq = (size_t)b * SEQ + t;
    float q[96];
#pragma unroll
    for (int d8 = 0; d8 < 12; ++d8) { const us8 v = *(const us8*)(qm + mq * 384 + h * 96 + d8 * 8);
#pragma unroll
        for (int i = 0; i < 8; ++i) q[d8 * 8 + i] = bf2f(v[i]); }
    float o[64];
#pragma unroll
    for (int d = 0; d < 64; ++d) o[d] = 0.f;
    float mx = -INFINITY, l = 0.f;
    const int ntiles = (qb + 1) * 8;
    for (int kt = 0; kt < ntiles; ++kt) {
        __syncthreads();
        for (int i = tid; i < 32 * 96; i += 256) { const int r = i / 96, d = i % 96; Ks[r][d] = bf2f(km[((size_t)b * SEQ + kt * 32 + r) * 384 + h * 96 + d]); }
        for (int i = tid; i < 32 * 64; i += 256) { const int r = i >> 6, d = i & 63; Vs[r][d] = bf2f(vm[((size_t)b * SEQ + kt * 32 + r) * 256 + h * 64 + d]); }
        __syncthreads();
        for (int kk = 0; kk < 32; ++kk) {
            const int key = kt * 32 + kk;
            if (key > t) break;
            float s = 0.f;
#pragma unroll
            for (int d = 0; d < 96; ++d) s += q[d] * Ks[kk][d];
            if (s > mx) { const float f = exp2f(mx - s); l *= f;
#pragma unroll
                for (int d = 0; d < 64; ++d) o[d] *= f;
                mx = s; }
            const float p = exp2f(s - mx); l += p;
#pragma unroll
            for (int d = 0; d < 64; ++d) o[d] += p * Vs[kk][d];
        }
    }
    const float rl = 1.f / l;
#pragma unroll
    for (int d = 0; d < 64; ++d) ycat[mq * DM + 768 + h * 64 + d] = f2bf(o[d] * rl);
}

__global__ __launch_bounds__(256) void k_moe_naive(float* x, const float* __restrict__ gn, const float* __restrict__ wg, const float* __restrict__ bg,
                                                   const float* __restrict__ wr, const float* __restrict__ br, const float* __restrict__ wgate, const float* __restrict__ wup, const float* __restrict__ wdown) {
    __shared__ float h2[1024];
    __shared__ float red[4][20];
    __shared__ float sh[4];
    __shared__ float hid[2][256];
    __shared__ int sE[2]; __shared__ float sW[2];
    __shared__ float slg[20]; __shared__ float spe[4];
    const int m = blockIdx.x, tid = threadIdx.x, lane = tid & 63, wv = tid >> 6;
    const float4 v = ((const float4*)(x + (size_t)m * DM))[tid];
    const float ss = block_sum256(v.x * v.x + v.y * v.y + v.z * v.z + v.w * v.w, sh);
    const float r = rsqrtf(ss * (1.f / DM) + EPS);
    const float4 gg = ((const float4*)gn)[tid];
    const float hv[4] = {v.x * r * gg.x, v.y * r * gg.y, v.z * r * gg.z, v.w * r * gg.w};
#pragma unroll
    for (int i = 0; i < 4; ++i) h2[tid * 4 + i] = hv[i];
    float part[20];
#pragma unroll
    for (int j = 0; j < 20; ++j) part[j] = 0.f;
#pragma unroll
    for (int i = 0; i < 4; ++i) { const int d = tid * 4 + i;
#pragma unroll
        for (int j = 0; j < 4; ++j) part[j] += hv[i] * wg[d * 4 + j];
#pragma unroll
        for (int j = 0; j < 16; ++j) part[4 + j] += hv[i] * wr[d * 16 + j]; }
#pragma unroll
    for (int j = 0; j < 20; ++j) { const float s = wave_sum(part[j]); if (lane == 0) red[wv][j] = s; }
    __syncthreads();
    if (tid < 20) slg[tid] = red[0][tid] + red[1][tid] + red[2][tid] + red[3][tid] + (tid < 4 ? bg[tid] : br[tid - 4]);
    __syncthreads();
    if (tid == 0) {
        int gi = 0; float gm = slg[0];
        for (int j = 1; j < 4; ++j) if (slg[j] > gm) { gm = slg[j]; gi = j; }
        float gs = 0.f; for (int j = 0; j < 4; ++j) gs += __expf(slg[j] - gm);
        const float g_w = 1.f / gs;
        float em = -INFINITY;
        for (int j = 0; j < 4; ++j) em = fmaxf(em, slg[4 + gi * 4 + j]);
        float es = 0.f;
        for (int j = 0; j < 4; ++j) { const float p = __expf(slg[4 + gi * 4 + j] - em); spe[j] = p; es += p; }
        int e0 = 0; float p0 = spe[0];
        for (int j = 1; j < 4; ++j) if (spe[j] > p0) { p0 = spe[j]; e0 = j; }
        int e1 = -1; float p1 = -1.f;
        for (int j = 0; j < 4; ++j) if (j != e0 && spe[j] > p1) { p1 = spe[j]; e1 = j; }
        p0 /= es; p1 /= es;
        const float sw = p0 + p1;
        sE[0] = gi * 4 + e0; sE[1] = gi * 4 + e1; sW[0] = g_w * p0 / sw; sW[1] = g_w * p1 / sw;
    }
    __syncthreads();
#pragma unroll
    for (int j = 0; j < 2; ++j) {
        const int E = sE[j];
        const float* G = wgate + (size_t)E * 1024 * 256 + tid; const float* U = wup + (size_t)E * 1024 * 256 + tid;
        float ga = 0.f, ua = 0.f;
        for (int d = 0; d < 1024; ++d) { const float hd = h2[d]; ga += hd * G[(size_t)d * 256]; ua += hd * U[(size_t)d * 256]; }
        hid[j][tid] = silu_f(ga) * ua * sW[j];
    }
    __syncthreads();
    float out[4] = {0.f, 0.f, 0.f, 0.f};
#pragma unroll
    for (int j = 0; j < 2; ++j) {
        const float* Dn = wdown + (size_t)sE[j] * 256 * 1024;
        for (int f = 0; f < 256; ++f) { const float hf = hid[j][f];
#pragma unroll
            for (int i = 0; i < 4; ++i) out[i] += hf * Dn[(size_t)f * 1024 + tid + 256 * i]; }
    }
#pragma unroll
    for (int i = 0; i < 4; ++i) x[(size_t)m * DM + tid + 256 * i] += out[i];
}

#define ATOMIC_ROUTE 1
#define ST_WT_OFF 1
#define LOADS_OFF 1
#define PADZERO_OFF 1
#define NO_ENTRY_BARRIER 1
#define NO_EXIT_BARRIER 1
namespace pg8 {
#define PG8_LAS __attribute__((address_space(3)))
typedef short bf16x8 __attribute__((ext_vector_type(8)));
typedef float f32x4 __attribute__((ext_vector_type(4)));
typedef unsigned u32x4 __attribute__((ext_vector_type(4)));
constexpr int BM = 256, BK = 64, HALF = 128, HTB = HALF * BK * 2  , STAGE_BYTES = 8 * HTB, NXCD = 8, WGM = 8;

__host__ __device__ __forceinline__ int lds_byte(int r, int c) { const int st = (r >> 4) * 2 + (c >> 5), rr = r & 15, cc = c & 31, ob = rr * 64 + cc * 2; return st * 1024 + (ob ^ (((ob >> 9) & 1) << 5)); }
__host__ __device__ __forceinline__ void stage_rc(int b, int& R, int& C) { const int st = b / 1024, sb = b % 1024, swz = sb ^ (((sb >> 9) & 1) << 5); R = (st >> 1) * 16 + swz / 64; C = (st & 1) * 32 + (swz % 64) / 2; }
__host__ __device__ __forceinline__ int perm32(int rho) { const int n = rho >> 4, i = rho & 15; return 8 * (i >> 2) + 4 * n + (i & 3); }

struct Unit { int pm, pn; };
struct Dims { int K, lda, ldb; };

struct StaticOrder {
    const bf16_t* A; const bf16_t* Bt; int lda, ldb, K;
    int nM, nN, nwg, G, c;
    __device__ void init(const bf16_t* A_, const bf16_t* Bt_, int lda_, int ldb_, int K_, int Mrows, int N, int G_, int c_) { A = A_; Bt = Bt_; lda = lda_; ldb = ldb_; K = K_; nM = Mrows / BM; nN = N / BM; nwg = nM * nN; G = G_; c = c_; }
    __device__ bool next(int i, Unit& u) const {
        const long L = (long)i * G + c; if (L >= nwg) return false;
        int wgid = (int)L; { const int q = nwg / NXCD, r = nwg % NXCD, xcd = wgid % NXCD, off = wgid / NXCD; wgid = (xcd < r ? xcd * (q + 1) : r * (q + 1) + (xcd - r) * q) + off; }
        const int nig = WGM * nN, gid = wgid / nig, fm = gid * WGM, gsz = (nM - fm) < WGM ? (nM - fm) : WGM;
        u.pm = fm + ((wgid % nig) % gsz); u.pn = (wgid % nig) / gsz; return true;
    }
    __device__ __forceinline__ const char* a_ptr(const Unit& u) const { return (const char*)A + (size_t)u.pm * BM * lda * 2; }
    __device__ __forceinline__ const char* b_ptr(const Unit& u, int half) const { return (const char*)Bt + (size_t)u.pn * BM * ldb * 2 + (half ? (size_t)(K / 2) * 2 : 0); }
};

__device__ __forceinline__ unsigned cvt_pk_bf16(float lo, float hi) { unsigned r; asm volatile("v_cvt_pk_bf16_f32 %0, %1, %2" : "=v"(r) : "v"(lo), "v"(hi)); return r; }

template <class Epi, class Sched>
__device__ __forceinline__ void gemm_phase(PG8_LAS unsigned char* lds, const int wid, const Dims g, const Sched& S, const Epi& E) {
    int lane = (int)__builtin_amdgcn_mbcnt_hi(~0u, __builtin_amdgcn_mbcnt_lo(~0u, 0u)); asm volatile("" : "+v"(lane));
    const int tid = wid * 64 + lane, wr = wid >> 2, wc = wid & 3, fr = lane & 15, fq = lane >> 4;
    int K = g.K, lda = g.lda, ldb = g.ldb; asm volatile("" : "+s"(K), "+s"(lda), "+s"(ldb));
    const int nt = K / BK, nth = nt / 2;
    unsigned voffA[2], voffB[2];
#pragma unroll
    for (int i = 0; i < 2; ++i) { int R, C; stage_rc(tid * 16 + i * 8192, R, C); const int Rb = (R & ~31) + perm32(R & 31);
        voffA[i] = (unsigned)(R * lda + C) * 2u; voffB[i] = (unsigned)(Rb * ldb + C) * 2u; }
    const size_t kstep = (size_t)(BK * 2);
    const size_t hstepA = (size_t)HALF * lda * 2, hstepB = (size_t)HALF * ldb * 2;
    const unsigned ldsw = (unsigned)wid * 1024u;
    const int aoff = lds_byte(wr * 64 + fr, fq * 8), boff = lds_byte(wc * 32 + fr, fq * 8);
#define PG8_SA(b, h) (((b) * 2 + (h)) * HTB)
#define PG8_SB(b, h) ((4 + (b) * 2 + (h)) * HTB)
#define PG8_STAGE(bufoff, gbase, voff) do { _Pragma("unroll") for (int _i = 0; _i < 2; ++_i) \
        __builtin_amdgcn_global_load_lds((const unsigned*)((const char*)(gbase) + (voff)[_i]), (PG8_LAS unsigned*)(lds + (bufoff) + ldsw + _i * 8192), 16, 0, 0); } while (0)
#define PG8_LDA(dst, b, h) do { _Pragma("unroll") for (int m = 0; m < 4; ++m) _Pragma("unroll") for (int k = 0; k < 2; ++k) dst[m][k] = *(const PG8_LAS bf16x8*)(lds + PG8_SA(b, h) + aoff + m * 2048 + k * 1024); } while (0)
#define PG8_LDB(dst, b, h) do { _Pragma("unroll") for (int n = 0; n < 2; ++n) _Pragma("unroll") for (int k = 0; k < 2; ++k) dst[n][k] = *(const PG8_LAS bf16x8*)(lds + PG8_SB(b, h) + boff + n * 2048 + k * 1024); } while (0)
#define PG8_MMA(ai, bj, At, Bt) do { __builtin_amdgcn_s_setprio(1); _Pragma("unroll") for (int m = 0; m < 4; ++m) _Pragma("unroll") for (int n = 0; n < 2; ++n) _Pragma("unroll") for (int k = 0; k < 2; ++k) \
        acc[ai][bj][m][n] = __builtin_amdgcn_mfma_f32_16x16x32_bf16(Bt[n][k], At[m][k], acc[ai][bj][m][n], 0, 0, 0); __builtin_amdgcn_s_setprio(0); } while (0)
#define PG8_WAIT_V(n) asm volatile("s_waitcnt vmcnt(" #n ")" ::: "memory")
#define PG8_WAIT_L(n) asm volatile("s_waitcnt lgkmcnt(" #n ")" ::: "memory")
#define PG8_BAR __builtin_amdgcn_s_barrier()
#define PG8_SCHED __builtin_amdgcn_sched_barrier(0)
#define PG8_BP(b0, b1, t) (((t) < nth) ? ((b0) + (size_t)(t) * kstep) : ((b1) + (size_t)((t) - nth) * kstep))
    Unit cur, nxt; int ui = 0;
    if (!S.next(0, cur)) return;
    f32x4 acc[2][2][4][2];
#pragma unroll
    for (int a = 0; a < 2; ++a)
#pragma unroll
        for (int b = 0; b < 2; ++b)
#pragma unroll
            for (int m = 0; m < 4; ++m)
#pragma unroll
                for (int n = 0; n < 2; ++n) acc[a][b][m][n] = (f32x4){0.f, 0.f, 0.f, 0.f};
    bf16x8 At[4][2], B0[2][2], B1[2][2];
    const char* cA = S.a_ptr(cur); const char* cB0 = S.b_ptr(cur, 0); const char* cB1 = S.b_ptr(cur, 1);
    {
        const char* b0 = PG8_BP(cB0, cB1, 0); const char* b1 = PG8_BP(cB0, cB1, 1);
        PG8_STAGE(PG8_SB(0, 0), b0, voffB); PG8_STAGE(PG8_SB(0, 1), b0 + hstepB, voffB); PG8_STAGE(PG8_SA(0, 0), cA, voffA); PG8_STAGE(PG8_SA(0, 1), cA + hstepA, voffA);
        if (wr == 1) PG8_BAR;
        PG8_WAIT_V(2); PG8_BAR;
        PG8_STAGE(PG8_SB(1, 0), b1, voffB); PG8_STAGE(PG8_SA(1, 0), cA + kstep, voffA); PG8_STAGE(PG8_SB(1, 1), b1 + hstepB, voffB);
        PG8_WAIT_V(6); PG8_BAR;
    }
    for (;;) {
        const bool has_next = S.next(ui + 1, nxt);
        const char* nA = has_next ? S.a_ptr(nxt) : cA; const char* nB0 = has_next ? S.b_ptr(nxt, 0) : cB0; const char* nB1 = has_next ? S.b_ptr(nxt, 1) : cB1;
        for (int t = 0; t < nt; t += 2) {
            const bool last = (t == nt - 2);
            const char* a1 = cA + (size_t)(t + 1) * kstep;
            const char* a2 = last ? nA : cA + (size_t)(t + 2) * kstep;
            const char* a3 = a2 + kstep;
            const char* b2 = last ? PG8_BP(nB0, nB1, 0) : PG8_BP(cB0, cB1, t + 2);
            const char* b3 = last ? PG8_BP(nB0, nB1, 1) : PG8_BP(cB0, cB1, t + 3);
            PG8_LDB(B0, 0, 0); PG8_LDB(B1, 0, 1); PG8_SCHED; PG8_LDA(At, 0, 0); PG8_STAGE(PG8_SA(1, 1), a1 + hstepA, voffA);
            PG8_WAIT_V(8); PG8_WAIT_L(0); PG8_BAR; PG8_MMA(0, 0, At, B0); PG8_MMA(0, 1, At, B1); PG8_BAR; PG8_SCHED;
            PG8_LDA(At, 0, 1); PG8_STAGE(PG8_SB(0, 0), b2, voffB); PG8_STAGE(PG8_SB(0, 1), b2 + hstepB, voffB); PG8_STAGE(PG8_SA(0, 0), a2, voffA);
            PG8_WAIT_V(8); PG8_WAIT_L(0); PG8_BAR; PG8_MMA(1, 0, At, B0); PG8_MMA(1, 1, At, B1); PG8_BAR; PG8_SCHED;
            PG8_LDB(B0, 1, 0); PG8_LDB(B1, 1, 1); PG8_SCHED; PG8_LDA(At, 1, 0); PG8_STAGE(PG8_SA(0, 1), a2 + hstepA, voffA);
            PG8_WAIT_V(8); PG8_WAIT_L(0); PG8_BAR; PG8_MMA(0, 0, At, B0); PG8_MMA(0, 1, At, B1); PG8_BAR; PG8_SCHED;
            PG8_LDA(At, 1, 1); PG8_STAGE(PG8_SB(1, 0), b3, voffB); PG8_STAGE(PG8_SB(1, 1), b3 + hstepB, voffB); PG8_STAGE(PG8_SA(1, 0), a3, voffA);
            PG8_WAIT_V(8); PG8_WAIT_L(0); PG8_BAR; PG8_MMA(1, 0, At, B0); PG8_MMA(1, 1, At, B1); PG8_BAR; PG8_SCHED;
        }
        if (wr == 0) PG8_BAR;
        E(acc, cur, wr, wc, fr, fq);
        if (!has_next) break;
#pragma unroll
        for (int a = 0; a < 2; ++a)
#pragma unroll
            for (int b = 0; b < 2; ++b)
#pragma unroll
                for (int m = 0; m < 4; ++m)
#pragma unroll
                    for (int n = 0; n < 2; ++n) acc[a][b][m][n] = (f32x4){0.f, 0.f, 0.f, 0.f};
        cur = nxt; cA = nA; cB0 = nB0; cB1 = nB1; ++ui;
        if (wr == 1) PG8_BAR;
    }
    PG8_WAIT_V(0);
    PG8_BAR;
#undef PG8_SA
#undef PG8_SB
#undef PG8_STAGE
#undef PG8_LDA
#undef PG8_LDB
#undef PG8_MMA
#undef PG8_WAIT_V
#undef PG8_WAIT_L
#undef PG8_BAR
#undef PG8_SCHED
#undef PG8_BP
}
}
#define GAS __attribute__((address_space(1)))
#define LAS __attribute__((address_space(3)))
typedef GAS unsigned gu32;
#define RLX_AGENT __ATOMIC_RELAXED, __HIP_MEMORY_SCOPE_AGENT
#define XB_TMO      128
#define XB_XCNT(j)  (256  + 64 * (j))
#define XB_XSUB(j)  (1280 + 64 * (j))
#define XB_XGEN(j)  (2304 + 64 * (j))
#define XB_TOP      3328
#define XB_TOPGEN   3392
#define XCD_BAR_WORDS 3456
#define XB_SPIN_CAP (1u << 18)

__device__ __forceinline__ unsigned xb_ld(unsigned* p)              { return __hip_atomic_load(p, __ATOMIC_RELAXED, __HIP_MEMORY_SCOPE_AGENT); }
__device__ __forceinline__ unsigned xb_add(unsigned* p, unsigned v) { return __hip_atomic_fetch_add(p, v, __ATOMIC_RELAXED, __HIP_MEMORY_SCOPE_AGENT); }
__device__ __forceinline__ unsigned xb_xcc_id() { return (unsigned)__builtin_amdgcn_s_getreg((3 << 11) | 20) & 0xFu; }
#define XB_SPIN(cond, bar) do { unsigned _sp = 0; while (cond) { __builtin_amdgcn_s_sleep(1); \
    if ((++_sp & 255u) == 0u) { if (xb_ld(&(bar)[XB_TMO])) break; if (_sp > XB_SPIN_CAP) { atomicAdd(&(bar)[XB_TMO], 1u); break; } } } } while (0)

struct XcdBarrier {
    unsigned* bar; unsigned x;
    unsigned w0;
    volatile LAS unsigned* st;
};

__device__ __forceinline__ XcdBarrier xcd_barrier_post(unsigned* bar, volatile LAS unsigned* st) {
    XcdBarrier b; b.bar = bar; b.x = xb_xcc_id(); b.st = st; b.w0 = (__builtin_amdgcn_readfirstlane(threadIdx.x >> 6) == 0) ? 1u : 0u;
    if (threadIdx.x == 0) (void)xb_add(&bar[XB_XCNT(b.x)], 1u);
    return b;
}
__device__ __forceinline__ void xcd_barrier_complete(unsigned* bar, unsigned x, unsigned& nloc, unsigned& nx) {
    const unsigned G = gridDim.x * gridDim.y * gridDim.z;
    unsigned sum, cnt, mine, sp = 0u;
    for (;;) {
        sum = 0u; cnt = 0u; mine = 0u;
#pragma unroll
        for (unsigned j = 0; j < 16; ++j) { const unsigned c = xb_ld(&bar[XB_XCNT(j)]); sum += c; cnt += (c > 0u) ? 1u : 0u; mine = (j == x) ? c : mine; }
        if (sum == G) break;
        __builtin_amdgcn_s_sleep(1);
        if ((++sp & 255u) == 0u) { if (xb_ld(&bar[XB_TMO])) break; if (sp > XB_SPIN_CAP) { atomicAdd(&bar[XB_TMO], 1u); break; } }
    }
    nloc = mine > 0u ? mine : 1u; nx = cnt > 0u ? cnt : 1u;
}

__device__ __forceinline__ void xcd_barrier(const XcdBarrier& b) {
    asm volatile("s_waitcnt vmcnt(0)" ::: "memory");
    __syncthreads();
    if (b.w0 && __builtin_amdgcn_mbcnt_hi(~0u, __builtin_amdgcn_mbcnt_lo(~0u, 0u)) == 0u) {
        unsigned* bar = b.bar;
        __builtin_amdgcn_s_waitcnt(0);
        unsigned nloc = b.st[0], nx = b.st[1];
        if (nloc == 0u) { xcd_barrier_complete(bar, b.x, nloc, nx); b.st[0] = nloc; b.st[1] = nx; }
        const unsigned old = xb_add(&bar[XB_XSUB(b.x)], 1u);
        const unsigned gen = old / nloc;
        if (old + 1u == (gen + 1u) * nloc) {
            __builtin_amdgcn_fence(__ATOMIC_RELEASE, "agent");
            asm volatile("s_waitcnt vmcnt(0)" ::: "memory");
            const unsigned og = xb_add(&bar[XB_TOP], 1u);
            const unsigned tg = og / nx;
            if (og + 1u == (tg + 1u) * nx) xb_add(&bar[XB_TOPGEN], 1u);
            else XB_SPIN(xb_ld(&bar[XB_TOPGEN]) == tg, bar);
            __builtin_amdgcn_fence(__ATOMIC_ACQUIRE, "agent");
            xb_add(&bar[XB_XGEN(b.x)], 1u);
            asm volatile("s_waitcnt vmcnt(0)" ::: "memory");
        } else {
            XB_SPIN(xb_ld(&bar[XB_XGEN(b.x)]) == gen, bar);
            __builtin_amdgcn_fence(__ATOMIC_ACQUIRE, "agent");
            asm volatile("s_waitcnt vmcnt(0)" ::: "memory");
        }
    }
    __syncthreads();
}
constexpr int NWAVES = 8;
constexpr size_t MiB = 1u << 20;
constexpr size_t WS_CTL = 0, CTL_ZERO_BYTES = 1 * MiB;
constexpr size_t WS_KMEAN = 1 * MiB;
constexpr size_t WS_WIN = 2 * MiB, WS_WOUT = 9 * MiB, WS_WUQ = 11 * MiB, WS_WUKV = 11 * MiB + 512 * 1024;
constexpr size_t WS_ACT = 12 * MiB, WS_PROJ = 44 * MiB, WS_PROJF = 140 * MiB, WS_XBCA = 156 * MiB, WS_QKA = 180 * MiB, WS_QM = 196 * MiB, WS_KM = 208 * MiB, WS_VM = 220 * MiB;
constexpr size_t WS_PREVT = 242 * MiB, WS_CST = 250 * MiB, WS_NST = 254 * MiB;
constexpr size_t WS_ROPE = 228 * MiB, WS_CQN = 230 * MiB, WS_CKVN = 238 * MiB, WS_ST = 230 * MiB  , WS_END = 256 * MiB;
constexpr int CW_BAR = 4096;
constexpr int MAX_BAR_REGIONS = 24;
static_assert((CW_BAR + MAX_BAR_REGIONS * 3456) * 4 <= (int)CTL_ZERO_BYTES, "CTL words inside the memset region");
constexpr int PROJ_N = 3328;
constexpr int RING_OFF = 0, RING_BYTES = 131072, LDSCTL_OFF = RING_BYTES, MISC_OFF = LDSCTL_OFF + 320, PTR_OFF = MISC_OFF + 128, LDS_BYTES = 147456;

__host__ __device__ inline int src_col(int c) {
    if (c < 1792) return c;
    if (c < 2304) return 1796 + (c - 1792);
    if (c < 2560) return 2308 + (c - 2304);
    if (c < 2816) return 2572 + (c - 2560);
    if (c < 3072) return 2828 + (c - 2816);
    const int f = c - 3072;
    if (f < 128) return 3084 + f;
    if (f < 160) return 3212 + (f - 128);
    if (f < 164) return 1792 + (f - 160);
    if (f < 168) return 2564 + (f - 164);
    if (f < 172) return 2568 + (f - 168);
    return -1;
}

typedef unsigned v4u __attribute__((ext_vector_type(4)));
typedef float f32x4 __attribute__((ext_vector_type(4)));
#define LDS_WAIT() asm volatile("s_waitcnt lgkmcnt(0)" ::: "memory")
#define VM_WAIT() asm volatile("s_waitcnt vmcnt(0)" ::: "memory")
__device__ __forceinline__ unsigned pk2(float lo, float hi) { return (unsigned)f2bf(lo) | ((unsigned)f2bf(hi) << 16); }

__device__ __forceinline__ const float* in_ptr(LAS unsigned char* lds, int i) {
    const unsigned long long v = ((const LAS unsigned long long*)(lds + PTR_OFF))[i];
    const unsigned lo = __builtin_amdgcn_readfirstlane((unsigned)v), hi = __builtin_amdgcn_readfirstlane((unsigned)(v >> 32));
    return (const float*)(((unsigned long long)hi << 32) | lo);
}
#ifdef ST_WT_OFF
__device__ __forceinline__ void st_wt(float* p, float v) { *p = v; }
__device__ __forceinline__ void st_wt(int* p, int v) { *p = v; }
#else
__device__ __forceinline__ void st_wt(float* p, float v) { __hip_atomic_store(p, v, __ATOMIC_RELAXED, __HIP_MEMORY_SCOPE_AGENT); }
__device__ __forceinline__ void st_wt(int* p, int v) { __hip_atomic_store(p, v, __ATOMIC_RELAXED, __HIP_MEMORY_SCOPE_AGENT); }
#endif
struct Args {
    const float* in[29]; float* out; unsigned char* ws; int ph_lo, ph_hi, bli, pad;
};

struct MapInProj { const float* W; __device__ const float* ptr(int) const { return W; } __device__ int col(int n) const { return src_col(n); } __device__ float scale(int n) const { return n < 256 ? C2A : 1.f; } };
struct MapPlain { const float* W; int ncols; float sc; __device__ const float* ptr(int) const { return W; } __device__ int col(int n) const { return n < ncols ? n : -1; } __device__ float scale(int) const { return sc; } };
template <class Map>
__device__ __forceinline__ void conv_item(const Map& mp, int ldw, int K, bf16_t* WT, int nblk, LAS float* scr, int item, int lane) {
    const int kb = item / nblk, nb = item % nblk, k0 = 64 * kb, n0 = 32 * nb;
    const int c4 = lane & 7, kr = lane >> 3;
    const int nd = n0 + 4 * c4; const int sc = mp.col(nd); const float scl = mp.scale(nd); const float* base = mp.ptr(nd);
    f32x4 v[8];
#pragma unroll
    for (int i = 0; i < 8; ++i) v[i] = sc >= 0 ? __builtin_nontemporal_load((const GAS f32x4*)(base + (size_t)(k0 + 8 * i + kr) * ldw + sc)) : (f32x4){0.f, 0.f, 0.f, 0.f};
#pragma unroll
    for (int i = 0; i < 8; ++i) { LAS float* d = scr + (8 * i + kr) * 33 + 4 * c4; d[0] = v[i].x * scl; d[1] = v[i].y * scl; d[2] = v[i].z * scl; d[3] = v[i].w * scl; }
    LDS_WAIT(); asm volatile("" ::: "memory");
    const int c = lane & 7;
#pragma unroll
    for (int j = 0; j < 4; ++j) { const int n = (lane >> 3) + 8 * j; const LAS float* s = scr + (8 * c) * 33 + n;
        v4u o; o.x = pk2(s[0 * 33], s[1 * 33]); o.y = pk2(s[2 * 33], s[3 * 33]); o.z = pk2(s[4 * 33], s[5 * 33]); o.w = pk2(s[6 * 33], s[7 * 33]);
        *(GAS v4u*)(WT + (size_t)(n0 + n) * K + k0 + 8 * c) = o; }
    LDS_WAIT(); asm volatile("" ::: "memory");
}
__device__ __forceinline__ void rms_row_to_bf16(const float* xrow, const float* g, bf16_t* orow, float* xcopy, int lane) {
    const GAS f32x4* xr = (const GAS f32x4*)xrow + lane; const GAS f32x4* gr = (const GAS f32x4*)g + lane;
    f32x4 v[4]; float s = 0.f;
#pragma unroll
    for (int j = 0; j < 4; ++j) { v[j] = __builtin_nontemporal_load(xr + 64 * j); s += (v[j].x * v[j].x + v[j].y * v[j].y) + (v[j].z * v[j].z + v[j].w * v[j].w); }
    const float rstd = rsqrtf(wave_sum(s) * (1.f / DM) + EPS);
    if (xcopy) { GAS f32x4* xc = (GAS f32x4*)xcopy + lane;
#pragma unroll
        for (int j = 0; j < 4; ++j) xc[64 * j] = v[j]; }
    GAS unsigned long long* o8 = (GAS unsigned long long*)orow + lane;
#pragma unroll
    for (int j = 0; j < 4; ++j) { const f32x4 gg = gr[64 * j];
        o8[64 * j] = (unsigned long long)pk2(v[j].x * rstd * gg.x, v[j].y * rstd * gg.y) | ((unsigned long long)pk2(v[j].z * rstd * gg.z, v[j].w * rstd * gg.w) << 32); }
}
__device__ __forceinline__ void rms_row_to_f32(const float* xrow, const float* g, float* orow, int lane) {
    const GAS f32x4* xr = (const GAS f32x4*)xrow + lane; const GAS f32x4* gr = (const GAS f32x4*)g + lane;
    f32x4 v[4]; float s = 0.f;
#pragma unroll
    for (int j = 0; j < 4; ++j) { v[j] = __builtin_nontemporal_load(xr + 64 * j); s += (v[j].x * v[j].x + v[j].y * v[j].y) + (v[j].z * v[j].z + v[j].w * v[j].w); }
    const float rstd = rsqrtf(wave_sum(s) * (1.f / DM) + EPS);
    GAS f32x4* o = (GAS f32x4*)orow + lane;
#pragma unroll
    for (int j = 0; j < 4; ++j) { const f32x4 gg = gr[64 * j]; __builtin_nontemporal_store((f32x4){v[j].x * rstd * gg.x, v[j].y * rstd * gg.y, v[j].z * rstd * gg.z, v[j].w * rstd * gg.w}, o + 64 * j); }
}

struct EpiInProj {
    bf16_t* proj; float* projf;
    __device__ __forceinline__ void operator()(const pg8::f32x4 (&acc)[2][2][4][2], const pg8::Unit& u, int wr, int wc, int fr, int fq) const {
        const int row0 = u.pm * 256 + wr * 64 + fr, col0 = wc * 32 + 8 * fq;
        if (u.pn < 12) {
#pragma unroll
            for (int ai = 0; ai < 2; ++ai)
#pragma unroll
                for (int m = 0; m < 4; ++m) { bf16_t* rowp = proj + (size_t)(row0 + ai * 128 + m * 16) * PROJ_W + u.pn * 256 + col0;
#pragma unroll
                    for (int bj = 0; bj < 2; ++bj) { const pg8::f32x4 v0 = acc[ai][bj][m][0], v1 = acc[ai][bj][m][1]; pg8::u32x4 w;
                        w.x = pg8::cvt_pk_bf16(v0[0], v0[1]); w.y = pg8::cvt_pk_bf16(v0[2], v0[3]); w.z = pg8::cvt_pk_bf16(v1[0], v1[1]); w.w = pg8::cvt_pk_bf16(v1[2], v1[3]);
                        *(pg8::u32x4*)(rowp + bj * 128) = w; } }
        } else {
#pragma unroll
            for (int ai = 0; ai < 2; ++ai)
#pragma unroll
                for (int m = 0; m < 4; ++m) { float* rowp = projf + (size_t)(row0 + ai * 128 + m * 16) * PROJF_W + col0;
#pragma unroll
                    for (int bj = 0; bj < 2; ++bj) { *(pg8::f32x4*)(rowp + bj * 128) = acc[ai][bj][m][0]; *(pg8::f32x4*)(rowp + bj * 128 + 4) = acc[ai][bj][m][1]; } }
        }
    }
};
struct EpiResidualF32 {
    float* x; const float* src;
    __device__ __forceinline__ void operator()(const pg8::f32x4 (&acc)[2][2][4][2], const pg8::Unit& u, int wr, int wc, int fr, int fq) const {
        const int row0 = u.pm * 256 + wr * 64 + fr, col0 = u.pn * 256 + wc * 32 + 8 * fq;
#pragma unroll
        for (int ai = 0; ai < 2; ++ai)
#pragma unroll
            for (int m = 0; m < 4; ++m) { float* rowp = x + (size_t)(row0 + ai * 128 + m * 16) * DM + col0; const float* srcp = src + (size_t)(row0 + ai * 128 + m * 16) * DM + col0;
#pragma unroll
                for (int bj = 0; bj < 2; ++bj) { pg8::f32x4* p = (pg8::f32x4*)(rowp + bj * 128); const GAS pg8::f32x4* q = (const GAS pg8::f32x4*)(srcp + bj * 128); const pg8::f32x4 a = q[0] + acc[ai][bj][m][0], b = q[1] + acc[ai][bj][m][1]; p[0] = a; p[1] = b; }
                asm volatile("" ::: "memory"); }
    }
};


struct EpiMlaQ {
    bf16_t* qm; const float* rope;
    __device__ __forceinline__ void operator()(const pg8::f32x4 (&acc)[2][2][4][2], const pg8::Unit& u, int wr, int wc, int fr, int fq) const {
        const int row0 = u.pm * 256 + wr * 64 + fr;
#pragma unroll
        for (int bj = 0; bj < 2; ++bj) {
            const int colg = u.pn * 256 + bj * 128 + wc * 32;
            if (colg >= 384) continue;
            const bool is_rope = ((colg >> 5) % 3) == 2;
#pragma unroll
            for (int ai = 0; ai < 2; ++ai)
#pragma unroll
                for (int m = 0; m < 4; ++m) {
                    const int row = row0 + ai * 128 + m * 16;
                    pg8::f32x4 v0 = acc[ai][bj][m][0], v1 = acc[ai][bj][m][1];
                    if (is_rope) {
                        pg8::f32x4 w0, w1;
#pragma unroll
                        for (int j = 0; j < 4; ++j) { w0[j] = __shfl_xor(v0[j], 32); w1[j] = __shfl_xor(v1[j], 32); }
                        const int i0 = (8 * fq) & 15;
                        const float* rp = rope + (size_t)row * 32 + i0;
                        const pg8::f32x4 c0 = *(const pg8::f32x4*)rp, c1 = *(const pg8::f32x4*)(rp + 4), s0 = *(const pg8::f32x4*)(rp + 16), s1 = *(const pg8::f32x4*)(rp + 20);
                        if (fq < 2) { v0 = v0 * c0 - w0 * s0; v1 = v1 * c1 - w1 * s1; } else { v0 = v0 * c0 + w0 * s0; v1 = v1 * c1 + w1 * s1; }
                    }
                    pg8::u32x4 w; w.x = pg8::cvt_pk_bf16(v0[0], v0[1]); w.y = pg8::cvt_pk_bf16(v0[2], v0[3]); w.z = pg8::cvt_pk_bf16(v1[0], v1[1]); w.w = pg8::cvt_pk_bf16(v1[2], v1[3]);
                    *(pg8::u32x4*)(qm + (size_t)row * 384 + colg + 8 * fq) = w;
                }
        }
    }
};
struct EpiMlaKVf {
    bf16_t* km; bf16_t* vm;
    __device__ __forceinline__ void operator()(const pg8::f32x4 (&acc)[2][2][4][2], const pg8::Unit& u, int wr, int wc, int fr, int fq) const {
        const int row0 = u.pm * 256 + wr * 64 + fr;
#pragma unroll
        for (int bj = 0; bj < 2; ++bj) {
            const int col = u.pn * 256 + bj * 128 + wc * 32 + 8 * fq, hh = col >> 7, d = col & 127;
#pragma unroll
            for (int ai = 0; ai < 2; ++ai)
#pragma unroll
                for (int m = 0; m < 4; ++m) {
                    const int row = row0 + ai * 128 + m * 16;
                    const pg8::f32x4 v0 = acc[ai][bj][m][0], v1 = acc[ai][bj][m][1];
                    pg8::u32x4 w; w.x = pg8::cvt_pk_bf16(v0[0], v0[1]); w.y = pg8::cvt_pk_bf16(v0[2], v0[3]); w.z = pg8::cvt_pk_bf16(v1[0], v1[1]); w.w = pg8::cvt_pk_bf16(v1[2], v1[3]);
                    bf16_t* dst = (d < 64) ? km + (size_t)row * 384 + hh * 96 + d : vm + (size_t)row * 256 + hh * 64 + (d - 64);
                    *(pg8::u32x4*)dst = w;
                }
        }
    }
};

__device__ __forceinline__ void conv_chunk(const bf16_t* proj, int m, int c0, int ch, int C, const float* w, const float* bias, bf16_t* dst, float osc) {
    const int t = m & (SEQ - 1);
    float acc[8];
    { const f32x4 b0 = *(const f32x4*)(bias + ch * 8), b1 = *(const f32x4*)(bias + ch * 8 + 4);
      acc[0] = b0.x; acc[1] = b0.y; acc[2] = b0.z; acc[3] = b0.w; acc[4] = b1.x; acc[5] = b1.y; acc[6] = b1.z; acc[7] = b1.w; }
#pragma unroll
    for (int i = 0; i < 4; ++i) {
        if (t - 3 + i >= 0) {
            const us8 x = *(const us8*)(proj + (size_t)(m - 3 + i) * PROJ_W + c0 + ch * 8);
            const f32x4 w0 = *(const f32x4*)(w + i * C + ch * 8), w1 = *(const f32x4*)(w + i * C + ch * 8 + 4);
            acc[0] += w0.x * bf2f(x[0]); acc[1] += w0.y * bf2f(x[1]); acc[2] += w0.z * bf2f(x[2]); acc[3] += w0.w * bf2f(x[3]);
            acc[4] += w1.x * bf2f(x[4]); acc[5] += w1.y * bf2f(x[5]); acc[6] += w1.z * bf2f(x[6]); acc[7] += w1.w * bf2f(x[7]);
        }
    }
    v4u o; o.x = pk2(silu_f(acc[0]) * osc, silu_f(acc[1]) * osc); o.y = pk2(silu_f(acc[2]) * osc, silu_f(acc[3]) * osc); o.z = pk2(silu_f(acc[4]) * osc, silu_f(acc[5]) * osc); o.w = pk2(silu_f(acc[6]) * osc, silu_f(acc[7]) * osc);
    *(v4u*)(dst + (size_t)m * C + ch * 8) = o;
}
__device__ __forceinline__ void conv_seg(const bf16_t* proj, int m0, int c0, int ch, int C, const float* w, const float* bias, bf16_t* dst, float osc) {
    const int t0 = m0 & (SEQ - 1);
    f32x4 wa[4], wb[4];
#pragma unroll
    for (int i = 0; i < 4; ++i) { wa[i] = *(const f32x4*)(w + i * C + ch * 8); wb[i] = *(const f32x4*)(w + i * C + ch * 8 + 4); }
    const f32x4 b0 = *(const f32x4*)(bias + ch * 8), b1 = *(const f32x4*)(bias + ch * 8 + 4);
    const bf16_t* src = proj + (size_t)m0 * PROJ_W + c0 + ch * 8;
    us8 x0 = us8{}, x1 = us8{}, x2 = us8{};
    if (t0 > 0) { x0 = *(const us8*)(src - 3 * (ptrdiff_t)PROJ_W); x1 = *(const us8*)(src - 2 * (ptrdiff_t)PROJ_W); x2 = *(const us8*)(src - (ptrdiff_t)PROJ_W); }
    for (int j = 0; j < 32; j += 8) {
        us8 xn[8];
#pragma unroll
        for (int k = 0; k < 8; ++k) xn[k] = __builtin_nontemporal_load((const us8*)(src + (size_t)(j + k) * PROJ_W));
#pragma unroll
        for (int k = 0; k < 8; ++k) {
            float acc[8] = {b0.x, b0.y, b0.z, b0.w, b1.x, b1.y, b1.z, b1.w};
#define CS_TAP(i, xv) do { acc[0] += wa[i].x * bf2f(xv[0]); acc[1] += wa[i].y * bf2f(xv[1]); acc[2] += wa[i].z * bf2f(xv[2]); acc[3] += wa[i].w * bf2f(xv[3]); \
                           acc[4] += wb[i].x * bf2f(xv[4]); acc[5] += wb[i].y * bf2f(xv[5]); acc[6] += wb[i].z * bf2f(xv[6]); acc[7] += wb[i].w * bf2f(xv[7]); } while (0)
            const bool h3 = (t0 + j + k) >= 3, h2 = (t0 + j + k) >= 2, h1 = (t0 + j + k) >= 1;
            if (h3) CS_TAP(0, x0);
            if (h2) CS_TAP(1, x1);
            if (h1) CS_TAP(2, x2);
            CS_TAP(3, xn[k]);
#undef CS_TAP
            v4u o; o.x = pk2(silu_f(acc[0]) * osc, silu_f(acc[1]) * osc); o.y = pk2(silu_f(acc[2]) * osc, silu_f(acc[3]) * osc); o.z = pk2(silu_f(acc[4]) * osc, silu_f(acc[5]) * osc); o.w = pk2(silu_f(acc[6]) * osc, silu_f(acc[7]) * osc);
            *(v4u*)(dst + (size_t)(m0 + j + k) * C + ch * 8) = o;
            x0 = x1; x1 = x2; x2 = xn[k];
        }
    }
}
__device__ __forceinline__ void mla_prep_token(int m, int lane, const bf16_t* proj, const float* projf, const int* positions, const float* gq, const float* gkv,
                                               bf16_t* cqn, bf16_t* ckvn, bf16_t* km, float* rope) {
    { const us4 v = *(const us4*)(proj + (size_t)m * PROJ_W + PC_CQ + lane * 4);
      const float a = bf2f(v.x), b = bf2f(v.y), c = bf2f(v.z), d = bf2f(v.w);
      const float r = rsqrtf(wave_sum(a * a + b * b + c * c + d * d) * (1.f / 256.f) + EPS);
      const f32x4 g = *(const f32x4*)(gq + lane * 4);
      *(unsigned long long*)(cqn + (size_t)m * 256 + lane * 4) = (unsigned long long)pk2(a * r * g.x, b * r * g.y) | ((unsigned long long)pk2(c * r * g.z, d * r * g.w) << 32); }
    { const float a = projf[(size_t)m * PROJF_W + PF_CKV + lane * 2], b = projf[(size_t)m * PROJF_W + PF_CKV + lane * 2 + 1];
      const float r = rsqrtf(wave_sum(a * a + b * b) * (1.f / 128.f) + EPS);
      *(unsigned*)(ckvn + (size_t)m * 128 + lane * 2) = pk2(a * r * gkv[lane * 2], b * r * gkv[lane * 2 + 1]); }
    if (lane < 16) {
        const float pos = (float)positions[m];
        const float inv = powf(10000.f, -(float)(2 * lane) / 32.f);
        float sn, cs; sincosf(pos * inv, &sn, &cs);
        rope[(size_t)m * 32 + lane] = cs; rope[(size_t)m * 32 + 16 + lane] = sn;
        const float x1 = projf[(size_t)m * PROJF_W + PF_KR + lane], x2 = projf[(size_t)m * PROJF_W + PF_KR + 16 + lane];
        const bf16_t o1 = f2bf(x1 * cs - x2 * sn), o2 = f2bf(x2 * cs + x1 * sn);
#pragma unroll
        for (int hh = 0; hh < 4; ++hh) { km[(size_t)m * 384 + hh * 96 + 64 + lane] = o1; km[(size_t)m * 384 + hh * 96 + 80 + lane] = o2; }
    }
}
__device__ __forceinline__ void kmean_item(int item, int lane, const bf16_t* proj, float* kmean) {
    const int jg = item >> 2, hh = item & 3, cc = lane & 7, rg = lane >> 3;
    float acc[8];
#pragma unroll
    for (int i = 0; i < 8; ++i) acc[i] = 0.f;
#pragma unroll 8
    for (int r = 0; r < 32; ++r) { const us8 x = *(const us8*)(proj + (size_t)(jg * 256 + rg * 32 + r) * PROJ_W + PC_AK + hh * 64 + cc * 8);
#pragma unroll
        for (int i = 0; i < 8; ++i) acc[i] += bf2f(x[i]); }
#pragma unroll
    for (int i = 0; i < 8; ++i) { float v = acc[i]; v += __shfl_xor(v, 8); v += __shfl_xor(v, 16); v += __shfl_xor(v, 32); acc[i] = v * (1.f / 256.f); }
    if (rg == 0) { *(f32x4*)(kmean + jg * 256 + hh * 64 + cc * 8) = (f32x4){acc[0], acc[1], acc[2], acc[3]}; *(f32x4*)(kmean + jg * 256 + hh * 64 + cc * 8 + 4) = (f32x4){acc[4], acc[5], acc[6], acc[7]}; }
}

constexpr size_t WS_WUP = 44 * MiB, WS_WDN = 60 * MiB, WS_XS = 68 * MiB, WS_HID = 112 * MiB, WS_STOK = 134 * MiB, WS_SW1 = WS_STOK + 128 * 1024, WS_SW2 = WS_STOK + 256 * 1024,
                 WS_TCLS = 135 * MiB, WS_TPOS = WS_TCLS + 64 * 1024, WS_TW1 = WS_TCLS + 128 * 1024, WS_TW2 = WS_TCLS + 192 * 1024;
constexpr int MOE_MAXTILES = 88, CW_MOECNT = 200000;
constexpr int TCLS_OFF = LDSCTL_OFF, OFFS_OFF = LDSCTL_OFF + 128;
__device__ __forceinline__ void pair_decode(int pr, int& a, int& b) { a = (pr < 3) ? 0 : ((pr < 5) ? 1 : 2); b = (pr < 3) ? pr + 1 : ((pr < 5) ? pr - 1 : 3); }
__device__ __forceinline__ int moe_tiles(const unsigned* cnt, LAS unsigned char* lds, bool t0) {
    LAS unsigned char* tcls = lds + TCLS_OFF; LAS int* offs = (LAS int*)(lds + OFFS_OFF);
    __syncthreads();
    if (t0) { int off = 0;
        _Pragma("unroll 1") for (int c = 0; c < 24; ++c) { const int n = (int)cnt[32 * c]; offs[c] = off; const int nt = (n + 255) >> 8; _Pragma("unroll 1") for (int t = 0; t < nt; ++t) tcls[(off >> 8) + t] = (unsigned char)c; off += nt << 8; }
        offs[24] = off; }
    __syncthreads();
    return offs[24] >> 8;
}
struct MoeOrder {
    const bf16_t* A; const bf16_t* W; int lda, ldb; size_t estride; int K; int ntile, G, c; const LAS unsigned char* tcls; bool down;
    __device__ bool next(int i, pg8::Unit& u) const { const int L = i * G + c; if (L >= ntile * 4) return false; u.pm = L >> 2; u.pn = L & 3; return true; }
    __device__ __forceinline__ const char* a_ptr(const pg8::Unit& u) const { return (const char*)A + (size_t)u.pm * 256 * lda * 2; }
    __device__ __forceinline__ const char* b_ptr(const pg8::Unit& u, int half) const {
        const int cls = tcls[u.pm], g = cls / 6; int ea, eb; pair_decode(cls - g * 6, ea, eb);
        if (down) { const int e = g * 4 + (half ? eb : ea); return (const char*)(W + (size_t)e * estride + (size_t)u.pn * 256 * ldb); }
        const int e = g * 4 + ((u.pn < 2) ? ea : eb); return (const char*)(W + (size_t)e * estride + (size_t)(u.pn & 1) * 256 * ldb + (half ? K / 2 : 0));
    }
};
struct EpiMoeUp {
    bf16_t* hid; const float* w1; const float* w2;
    __device__ __forceinline__ void operator()(const pg8::f32x4 (&acc)[2][2][4][2], const pg8::Unit& u, int wr, int wc, int fr, int fq) const {
        const int row0 = u.pm * 256 + wr * 64 + fr; const float* ws = (u.pn < 2) ? w1 : w2;
#pragma unroll
        for (int ai = 0; ai < 2; ++ai)
#pragma unroll
            for (int m = 0; m < 4; ++m) { const int row = row0 + ai * 128 + m * 16; const float wt = ws[row];
                const pg8::f32x4 g0 = acc[ai][0][m][0], g1 = acc[ai][0][m][1], u0 = acc[ai][1][m][0], u1 = acc[ai][1][m][1];
                pg8::u32x4 w;
                w.x = pg8::cvt_pk_bf16(silu_f(g0[0]) * u0[0] * wt, silu_f(g0[1]) * u0[1] * wt); w.y = pg8::cvt_pk_bf16(silu_f(g0[2]) * u0[2] * wt, silu_f(g0[3]) * u0[3] * wt);
                w.z = pg8::cvt_pk_bf16(silu_f(g1[0]) * u1[0] * wt, silu_f(g1[1]) * u1[1] * wt); w.w = pg8::cvt_pk_bf16(silu_f(g1[2]) * u1[2] * wt, silu_f(g1[3]) * u1[3] * wt);
                *(pg8::u32x4*)(hid + (size_t)row * 512 + u.pn * 128 + wc * 32 + 8 * fq) = w; }
    }
};
struct EpiMoeDown {
    float* x; const int* stok;
    __device__ __forceinline__ void operator()(const pg8::f32x4 (&acc)[2][2][4][2], const pg8::Unit& u, int wr, int wc, int fr, int fq) const {
        const int row0 = u.pm * 256 + wr * 64 + fr, col0 = u.pn * 256 + wc * 32 + 8 * fq;
#pragma unroll
        for (int ai = 0; ai < 2; ++ai)
#pragma unroll
            for (int m = 0; m < 4; ++m) { const int tok = stok[row0 + ai * 128 + m * 16];
                if (tok >= 0) { float* rowp = x + (size_t)tok * DM + col0;
#pragma unroll
                    for (int bj = 0; bj < 2; ++bj) { pg8::f32x4* p = (pg8::f32x4*)(rowp + bj * 128); const pg8::f32x4 a = p[0] + acc[ai][bj][m][0], b = p[1] + acc[ai][bj][m][1]; p[0] = a; p[1] = b; } }
                asm volatile("" ::: "memory"); }
    }
};
struct MapMoeUp { const float* W; int fbase;
    __device__ const float* ptr(int) const { return W; } __device__ int col(int n) const { return fbase + (n & 127); } __device__ float scale(int) const { return 1.f; } };
constexpr int RW_PITCH = 1028;
__device__ __forceinline__ void route_token(int m, int lane, const float* X, const float* g, const LAS float* rw, const float* bg, const float* br, bf16_t* xn2,
                                            unsigned* cnt, int* tcls, int* tpos, float* tw1, float* tw2) {
    asm volatile("" : "+v"(lane));
    const GAS f32x4* xr = (const GAS f32x4*)(X + (size_t)m * DM) + lane; const GAS f32x4* gr = (const GAS f32x4*)g + lane;
    f32x4 v[4]; float s = 0.f;
#pragma unroll
    for (int j = 0; j < 4; ++j) { v[j] = __builtin_nontemporal_load(xr + 64 * j); s += (v[j].x * v[j].x + v[j].y * v[j].y) + (v[j].z * v[j].z + v[j].w * v[j].w); }
    const float rstd = rsqrtf(wave_sum(s) * (1.f / DM) + EPS);
    GAS unsigned long long* o8 = (GAS unsigned long long*)(xn2 + (size_t)m * DM) + lane;
#pragma unroll
    for (int j = 0; j < 4; ++j) { const f32x4 gg = gr[64 * j]; v[j] = (f32x4){v[j].x * rstd * gg.x, v[j].y * rstd * gg.y, v[j].z * rstd * gg.z, v[j].w * rstd * gg.w};
        o8[64 * j] = (unsigned long long)pk2(v[j].x, v[j].y) | ((unsigned long long)pk2(v[j].z, v[j].w) << 32); }
    float lg[20];
#pragma unroll
    for (int q = 0; q < 20; ++q) { float p = 0.f;
#pragma unroll
        for (int j = 0; j < 4; ++j) { const f32x4 w = *(const LAS f32x4*)(rw + q * RW_PITCH + 4 * (64 * j + lane)); p += (v[j].x * w.x + v[j].y * w.y) + (v[j].z * w.z + v[j].w * w.w); }
        lg[q] = wave_sum(p) + (q < 4 ? bg[q] : br[q - 4]); }
    int gi = 0; float gm = lg[0];
#pragma unroll
    for (int j = 1; j < 4; ++j) if (lg[j] > gm) { gm = lg[j]; gi = j; }
    float gs = 0.f;
#pragma unroll
    for (int j = 0; j < 4; ++j) gs += __expf(lg[j] - gm);
    const float g_w = 1.f / gs;
    float el[4];
#pragma unroll
    for (int j = 0; j < 4; ++j) el[j] = (gi == 0) ? lg[4 + j] : (gi == 1) ? lg[8 + j] : (gi == 2) ? lg[12 + j] : lg[16 + j];
    const float em = fmaxf(fmaxf(el[0], el[1]), fmaxf(el[2], el[3]));
    float pe[4]; float es = 0.f;
#pragma unroll
    for (int j = 0; j < 4; ++j) { pe[j] = __expf(el[j] - em); es += pe[j]; }
    int e0 = 0; float p0 = pe[0];
#pragma unroll
    for (int j = 1; j < 4; ++j) if (pe[j] > p0) { p0 = pe[j]; e0 = j; }
    int e1 = -1; float p1 = -1.f;
#pragma unroll
    for (int j = 0; j < 4; ++j) if (j != e0 && pe[j] > p1) { p1 = pe[j]; e1 = j; }
    p0 /= es; p1 /= es;
    const float sw = p0 + p1; const float w0 = g_w * p0 / sw, w1 = g_w * p1 / sw;
    const int ea = e0 < e1 ? e0 : e1, eb = e0 < e1 ? e1 : e0; const float wa = e0 < e1 ? w0 : w1, wb = e0 < e1 ? w1 : w0;
    const int pr = (ea == 0) ? eb - 1 : (ea == 1) ? eb + 1 : 5;
    const int cls = gi * 6 + pr;
    if (lane == 0) { const unsigned pos = __hip_atomic_fetch_add(cnt + 32 * cls, 1u, __ATOMIC_RELAXED, __HIP_MEMORY_SCOPE_AGENT);
        tcls[m] = cls; tpos[m] = (int)pos; tw1[m] = wa; tw2[m] = wb; }
}
namespace att {
using bf16x8 = __attribute__((ext_vector_type(8))) short;
using s16x4 = __attribute__((ext_vector_type(4))) short;
using f32x16 = __attribute__((ext_vector_type(16))) float;
using u32x4 = __attribute__((ext_vector_type(4))) unsigned;
typedef short v4i16_t __attribute__((ext_vector_type(4)));
constexpr int NW = 8, QBLK = 32, QB = 256, KVBLK = 64;
constexpr int NSLOT = 3, KSLOT = 12288, VSLOT = 8192;
constexpr int LDS_K = 0, LDS_V = NSLOT * KSLOT, LDS_WS = LDS_V + NSLOT * VSLOT, LDS_OST = LDS_WS + NW * 256, LDS_BYTES_ATT = LDS_OST + NW * 4096;
__device__ __forceinline__ int crow(int r, int hi) { return (r & 3) + 8 * (r >> 2) + 4 * hi; }
__device__ __forceinline__ void glds16(const void* gsrc, unsigned lds_dst) { unsigned keep;
    asm volatile("s_mov_b32 %0, m0\n\ts_mov_b32 m0, %2\n\ts_nop 0\n\tglobal_load_lds_dwordx4 %1, off\n\ts_mov_b32 m0, %0" : "=&s"(keep) : "v"(gsrc), "s"(lds_dst) : "memory"); }
__device__ __forceinline__ unsigned cvtpk(float lo, float hi) { unsigned r; asm("v_cvt_pk_bf16_f32 %0, %1, %2" : "=v"(r) : "v"(lo), "v"(hi)); return r; }
__device__ __forceinline__ float xhalf_max(float m) { auto rr = __builtin_amdgcn_permlane32_swap(__float_as_uint(m), __float_as_uint(m), false, false); return fmaxf(__uint_as_float(rr[0]), __uint_as_float(rr[1])); }
__device__ __forceinline__ float xhalf_sum(float m) { auto rr = __builtin_amdgcn_permlane32_swap(__float_as_uint(m), __float_as_uint(m), false, false); return __uint_as_float(rr[0]) + __uint_as_float(rr[1]); }
__device__ __forceinline__ void pv(f32x16* o, int vb, bf16x8 pa0, bf16x8 pa1, bf16x8 pa2, bf16x8 pa3) {
#pragma unroll
    for (int d0 = 0; d0 < 2; ++d0) { s16x4 lo[4], hi[4];
#pragma unroll
        for (int ks = 0; ks < 4; ++ks) {
            asm volatile("ds_read_b64_tr_b16 %0,%1 offset:%c2" : "=&v"(lo[ks]) : "v"(vb), "i"(d0 * 4096 + ks * 1024) : "memory");
            asm volatile("ds_read_b64_tr_b16 %0,%1 offset:%c2" : "=&v"(hi[ks]) : "v"(vb), "i"(d0 * 4096 + ks * 1024 + 512) : "memory"); }
        asm volatile("s_waitcnt lgkmcnt(0)" ::: "memory"); __builtin_amdgcn_sched_barrier(0);
#define ATT_PK(k) (bf16x8){lo[k][0], lo[k][1], lo[k][2], lo[k][3], hi[k][0], hi[k][1], hi[k][2], hi[k][3]}
        o[d0] = __builtin_amdgcn_mfma_f32_32x32x16_bf16(pa0, ATT_PK(0), o[d0], 0, 0, 0);
        o[d0] = __builtin_amdgcn_mfma_f32_32x32x16_bf16(pa1, ATT_PK(1), o[d0], 0, 0, 0);
        o[d0] = __builtin_amdgcn_mfma_f32_32x32x16_bf16(pa2, ATT_PK(2), o[d0], 0, 0, 0);
        o[d0] = __builtin_amdgcn_mfma_f32_32x32x16_bf16(pa3, ATT_PK(3), o[d0], 0, 0, 0);
#undef ATT_PK
    }
}
#define ATT_WAIT_BAR(N) asm volatile("s_waitcnt vmcnt(" #N ") lgkmcnt(0)\n\ts_barrier" ::: "memory")

template <int DQK, bool MOBA>
__device__ __forceinline__ void attn_unit(int b, int h, int qb, const bf16_t* Q, int qpitch, int qcol0, const bf16_t* K, int kpitch, int kcol0, const bf16_t* V, int vpitch, int vcol0,
                                          bf16_t* O, int ocol0, const float* kmean, LAS unsigned char* shm, const int wid) {
    constexpr int ND0 = DQK / 16;
    int lane = (int)__builtin_amdgcn_mbcnt_hi(~0u, __builtin_amdgcn_mbcnt_lo(~0u, 0u)); asm volatile("" : "+v"(lane));
    const int r32 = lane & 31, hi = lane >> 5;
    const long rowbase = (long)b * SEQ; const int q0 = qb * QB;
    const bf16_t* Qw = Q + (rowbase + q0 + wid * QBLK) * qpitch + qcol0;
    const bf16_t* Kh = K + rowbase * kpitch + kcol0; const bf16_t* Vh = V + rowbase * vpitch + vcol0;
    const unsigned lds0 = (unsigned)(size_t)shm;
    LAS float* wsf = (LAS float*)(shm + LDS_WS) + wid * 64;
    const bf16_t* ksrc0 = Kh + (long)lane * kpitch + wid * 8;
    const bf16_t* ksrc1 = Kh + (long)lane * kpitch + (8 + (wid & 3)) * 8;
    const bf16_t* vsrc = Vh + (long)(16 * (wid & 3) + (lane >> 2)) * vpitch + (wid >> 2) * 32 + (lane & 3) * 8;
    const unsigned kdst0 = lds0 + LDS_K + wid * 1024, kdst1 = lds0 + LDS_K + (8 + (wid & 3)) * 1024, vdst = lds0 + LDS_V + wid * 1024;
#define ATT_DMA(t, slot) do { glds16(ksrc0 + (long)(t) * KVBLK * kpitch, (unsigned)__builtin_amdgcn_readfirstlane(kdst0 + (slot) * KSLOT)); \
        if (DQK == 96) glds16(ksrc1 + (long)(t) * KVBLK * kpitch, (unsigned)__builtin_amdgcn_readfirstlane(kdst1 + (slot) * KSLOT)); \
        glds16(vsrc + (long)(t) * KVBLK * vpitch, (unsigned)__builtin_amdgcn_readfirstlane(vdst + (slot) * VSLOT)); } while (0)
    const int NT = (q0 + QB) / KVBLK;
    ATT_DMA(0, 0); ATT_DMA(1, 1);
    bf16x8 qr[ND0];
#pragma unroll
    for (int d0 = 0; d0 < ND0; ++d0) qr[d0] = *reinterpret_cast<const bf16x8*>(&Qw[(long)r32 * qpitch + d0 * 16 + hi * 8]);
    unsigned sel = 0xffffffffu;
    if (MOBA) {
        float v0 = -INFINITY, v1 = -INFINITY, v2 = -INFINITY; int i0 = -1, i1 = -1, i2 = -1;
#ifdef ATT_KM_GLOBAL
        const float* kmb = kmean + (size_t)(b * 32) * 256 + h * 64 + hi * 8;
#else
        constexpr int LDS_KM = 98304;
        static_assert(NSLOT == 3, "LDS_KM assumes the 3-slot layout");
        LAS float* kml = (LAS float*)(shm + LDS_KM);
        { const float* kmg = kmean + (size_t)(b * 32) * 256 + h * 64; const int tid_ = wid * 64 + lane;
          for (int i = tid_; i < qb * 16; i += NW * 64) { const int j = i >> 4, c4 = i & 15; *(LAS pg8::f32x4*)(kml + j * 64 + c4 * 4) = *(const pg8::f32x4*)(kmg + (size_t)j * 256 + c4 * 4); }
          asm volatile("s_waitcnt vmcnt(0) lgkmcnt(0)\n\ts_barrier" ::: "memory"); }
        const LAS float* kmb = kml + hi * 8;
#endif
        for (int j = 0; j < qb; ++j) {
            float g = 0.f;
#pragma unroll
            for (int d0 = 0; d0 < 4; ++d0) {
#ifdef ATT_KM_GLOBAL
                const pg8::f32x4 ka = *(const pg8::f32x4*)(kmb + j * 256 + d0 * 16), kb2 = *(const pg8::f32x4*)(kmb + j * 256 + d0 * 16 + 4);
#else
                const pg8::f32x4 ka = *(const LAS pg8::f32x4*)(kmb + j * 64 + d0 * 16), kb2 = *(const LAS pg8::f32x4*)(kmb + j * 64 + d0 * 16 + 4);
#endif
                const bf16x8 qq = qr[d0];
                g += bf2f((bf16_t)qq[0]) * ka.x + bf2f((bf16_t)qq[1]) * ka.y + bf2f((bf16_t)qq[2]) * ka.z + bf2f((bf16_t)qq[3]) * ka.w
                   + bf2f((bf16_t)qq[4]) * kb2.x + bf2f((bf16_t)qq[5]) * kb2.y + bf2f((bf16_t)qq[6]) * kb2.z + bf2f((bf16_t)qq[7]) * kb2.w; }
            g = xhalf_sum(g);
            if (g > v0) { v2 = v1; i2 = i1; v1 = v0; i1 = i0; v0 = g; i0 = j; }
            else if (g > v1) { v2 = v1; i2 = i1; v1 = g; i1 = j; }
            else if (g > v2) { v2 = g; i2 = j; }
        }
        sel = 0u;
        if (i0 >= 0) sel |= 1u << i0;
        if (i1 >= 0) sel |= 1u << i1;
        if (i2 >= 0) sel |= 1u << i2;
    }
    float m_run = -1e30f, l_run = 0.f; f32x16 o[2]; o[0] = f32x16{}; o[1] = f32x16{};
    const int qrel = wid * QBLK + r32;
    const int vb0 = (int)(lds0 + LDS_V) + ((lane >> 4) & 1) * 32 + (lane & 3) * 8 + (4 * hi + ((lane & 15) >> 2)) * 64;
    int slot = 0;
    for (int t = 0; t < NT; ++t) {
        if (t + 1 < NT) { if (DQK == 96) ATT_WAIT_BAR(3); else ATT_WAIT_BAR(2); } else ATT_WAIT_BAR(0);
        if (t + 2 < NT) { const int s2 = (slot == 0) ? 2 : slot - 1; ATT_DMA(t + 2, s2); }
        f32x16 p0, p1;
        { const LAS unsigned char* kb = shm + LDS_K + slot * KSLOT + hi * 1024 + r32 * 16;
#pragma unroll
          for (int d0 = 0; d0 < ND0; ++d0) {
              const bf16x8 b0 = *(const LAS bf16x8*)(kb + d0 * 2048), b1 = *(const LAS bf16x8*)(kb + d0 * 2048 + 512);
              if (d0 == 0) { p0 = __builtin_amdgcn_mfma_f32_32x32x16_bf16(b0, qr[0], f32x16{}, 0, 0, 0); p1 = __builtin_amdgcn_mfma_f32_32x32x16_bf16(b1, qr[0], f32x16{}, 0, 0, 0); }
              else { p0 = __builtin_amdgcn_mfma_f32_32x32x16_bf16(b0, qr[d0], p0, 0, 0, 0); p1 = __builtin_amdgcn_mfma_f32_32x32x16_bf16(b1, qr[d0], p1, 0, 0, 0); } } }
        const int jb = t - (NT - 4);
        if (jb >= 0) { const int kb0 = 64 * jb + 4 * hi;
#pragma unroll
            for (int r = 0; r < 16; ++r) { const int kv = kb0 + (r & 3) + 8 * (r >> 2); if (kv > qrel) p0[r] = -INFINITY; if (kv + 32 > qrel) p1[r] = -INFINITY; } }
        else if (MOBA) { if (!((sel >> (t >> 2)) & 1u)) {
#pragma unroll
            for (int r = 0; r < 16; ++r) { p0[r] = -INFINITY; p1[r] = -INFINITY; } } }
        float rm = fmaxf(p0[0], p1[0]);
#pragma unroll
        for (int r = 1; r < 16; ++r) rm = fmaxf(rm, fmaxf(p0[r], p1[r]));
        rm = xhalf_max(rm);
        const float m_new = fmaxf(m_run, rm); const float alpha = __builtin_amdgcn_exp2f(m_run - m_new); m_run = m_new;
        float ls = 0.f;
#pragma unroll
        for (int r = 0; r < 16; ++r) { p0[r] = __builtin_amdgcn_exp2f(p0[r] - m_new); p1[r] = __builtin_amdgcn_exp2f(p1[r] - m_new); ls += p0[r] + p1[r]; }
        l_run = l_run * alpha + ls;
        if (hi == 0) wsf[r32] = alpha;
        asm volatile("s_waitcnt lgkmcnt(0)" ::: "memory");
#pragma unroll
        for (int r = 0; r < 16; ++r) { const float a = wsf[crow(r, hi)]; o[0][r] *= a; o[1][r] *= a; }
        u32x4 pw0, pw1, pw2, pw3;
        pw0 = (u32x4){cvtpk(p0[0], p0[1]), cvtpk(p0[2], p0[3]), cvtpk(p0[4], p0[5]), cvtpk(p0[6], p0[7])};
        pw1 = (u32x4){cvtpk(p0[8], p0[9]), cvtpk(p0[10], p0[11]), cvtpk(p0[12], p0[13]), cvtpk(p0[14], p0[15])};
        pw2 = (u32x4){cvtpk(p1[0], p1[1]), cvtpk(p1[2], p1[3]), cvtpk(p1[4], p1[5]), cvtpk(p1[6], p1[7])};
        pw3 = (u32x4){cvtpk(p1[8], p1[9]), cvtpk(p1[10], p1[11]), cvtpk(p1[12], p1[13]), cvtpk(p1[14], p1[15])};
        asm volatile("s_waitcnt lgkmcnt(0)" ::: "memory");
        pv(o, vb0 + slot * VSLOT, __builtin_bit_cast(bf16x8, pw0), __builtin_bit_cast(bf16x8, pw1), __builtin_bit_cast(bf16x8, pw2), __builtin_bit_cast(bf16x8, pw3));
        slot = (slot == 2) ? 0 : slot + 1;
    }
    l_run = xhalf_sum(l_run);
    if (hi == 0) wsf[32 + r32] = l_run;
    asm volatile("s_waitcnt lgkmcnt(0)" ::: "memory");
    float rli[16];
#pragma unroll
    for (int r = 0; r < 16; ++r) rli[r] = __builtin_amdgcn_rcpf(wsf[32 + crow(r, hi)]);
    bf16_t* Ow = O + (rowbase + q0 + wid * QBLK) * DM + ocol0;
    { LAS bf16_t* stg = (LAS bf16_t*)(shm + LDS_OST) + wid * 2048;
#pragma unroll
      for (int r = 0; r < 16; ++r) { const int orow = crow(r, hi);
#pragma unroll
          for (int d0 = 0; d0 < 2; ++d0) stg[orow * 64 + d0 * 32 + r32] = f2bf(o[d0][r] * rli[r]); }
      asm volatile("s_waitcnt lgkmcnt(0)" ::: "memory");
#pragma unroll
      for (int i = 0; i < 4; ++i) { const int row = i * 8 + (lane >> 3), ch = lane & 7; const u32x4 v = *(const LAS u32x4*)(stg + row * 64 + ch * 8); *(u32x4*)(Ow + (long)row * DM + ch * 8) = v; } }
    asm volatile("s_waitcnt vmcnt(0) lgkmcnt(0)\n\ts_barrier" ::: "memory");
#undef ATT_DMA
}
#undef ATT_WAIT_BAR
}
namespace ck {
using att::bf16x8; using att::s16x4; using att::f32x16; using att::u32x4; using att::crow; using att::cvtpk; using att::xhalf_sum;
constexpr int CL = 128, NCH = SEQ / CL;
__device__ __forceinline__ int lane_id() { return (int)__builtin_amdgcn_mbcnt_hi(~0u, __builtin_amdgcn_mbcnt_lo(~0u, 0u)); }
#define CK_TRF(dst, vb, OFF) do { s16x4 lo_, hi_; \
    asm volatile("ds_read_b64_tr_b16 %0,%1 offset:%c2" : "=&v"(lo_) : "v"(vb), "i"(OFF) : "memory"); \
    asm volatile("ds_read_b64_tr_b16 %0,%1 offset:%c2" : "=&v"(hi_) : "v"(vb), "i"((OFF) + 512) : "memory"); \
    asm volatile("s_waitcnt lgkmcnt(0)" ::: "memory"); \
    dst = (bf16x8){lo_[0], lo_[1], lo_[2], lo_[3], hi_[0], hi_[1], hi_[2], hi_[3]}; } while (0)
__device__ __forceinline__ int tr_lane_off(int lane) { const int hi = lane >> 5; return ((lane >> 4) & 1) * 32 + (lane & 3) * 8 + (4 * hi + ((lane & 15) >> 2)) * 64; }
__device__ __forceinline__ void stage_v64(LAS unsigned char* dst, const bf16_t* src, int gp, int tid, const LAS float* rowscale) {
    const int row = tid >> 3, j = tid & 7;
    us8 v = *(const us8*)(src + (size_t)row * gp + 8 * j);
    if (rowscale) { const float s = rowscale[row];
#pragma unroll
        for (int i = 0; i < 8; ++i) v[i] = f2bf(bf2f(v[i]) * s); }
    *(LAS us8*)(dst + (j >> 2) * 4096 + row * 64 + (j & 3) * 16) = v;
}
template <int DQ> __device__ __forceinline__ void stage_k64(LAS unsigned char* dst, const bf16_t* src, int gp, int tid) {
#pragma unroll
    for (int pc = tid; pc < 64 * (DQ / 8); pc += 512) { const int row = pc / (DQ / 8), c = pc % (DQ / 8);
        *(LAS us8*)(dst + c * 1024 + row * 16) = *(const us8*)(src + (size_t)row * gp + 8 * c); }
}
__device__ __forceinline__ void scan128(float a0, float a1, int lane, float& s0, float& s1) {
    float t = a0 + a1;
#pragma unroll
    for (int o = 1; o < 64; o <<= 1) { const float u = __shfl_up(t, o); if (lane >= o) t += u; }
    s1 = t; s0 = t - a1;
}

__device__ __forceinline__ void ssd_s1_unit(int unit, const bf16_t* xbca, const float* projf, const float* dt_bias, const float* a_log, float* S, float* dec, LAS unsigned char* shm, int wave) {
    const int g = unit & 1, c = (unit >> 1) & (NCH - 1), b = unit >> 7;
    int lane = lane_id(); asm volatile("" : "+v"(lane));
    const int tid = wave * 64 + lane; const size_t m0 = (size_t)b * SEQ + (size_t)c * CL;
    LAS float* wtab = (LAS float*)(shm + 65536);
    if (wave < 2) { const int h = 2 * g + wave; const float a = -__expf(a_log[h]), dtb = dt_bias[h];
        const float d0 = softplus_f(projf[(m0 + 2 * lane) * PROJF_W + PF_DT + h] + dtb), d1 = softplus_f(projf[(m0 + 2 * lane + 1) * PROJF_W + PF_DT + h] + dtb);
        float s0, s1; scan128(d0 * a, d1 * a, lane, s0, s1);
        const float alast = __shfl(s1, 63);
        wtab[wave * 128 + 2 * lane] = __expf(alast - s0) * d0; wtab[wave * 128 + 2 * lane + 1] = __expf(alast - s1) * d1;
        if (lane == 0) dec[((size_t)b * NCH + c) * 4 + h] = __expf(alast); }
    __syncthreads();
#pragma unroll
    for (int hh = 0; hh < 2; ++hh)
#pragma unroll
        for (int rt = 0; rt < 2; ++rt) stage_v64(shm + (hh * 2 + rt) * 8192, xbca + (m0 + rt * 64) * 768 + (2 * g + hh) * 64, 768, tid, wtab + hh * 128 + rt * 64);
#pragma unroll
    for (int rt = 0; rt < 2; ++rt)
#pragma unroll
        for (int ct = 0; ct < 2; ++ct) stage_v64(shm + 32768 + (rt * 2 + ct) * 8192, xbca + (m0 + rt * 64) * 768 + 256 + g * 128 + ct * 64, 768, tid, nullptr);
    __syncthreads();
    const int hh = wave >> 2, j = wave & 3, r32 = lane & 31, hi = lane >> 5; const int lo = tr_lane_off(lane);
    f32x16 acc0 = f32x16{}, acc1 = f32x16{};
#pragma unroll
    for (int rt = 0; rt < 2; ++rt) {
        const int vx = (int)(unsigned)(size_t)(shm + (hh * 2 + rt) * 8192) + lo, vbm = (int)(unsigned)(size_t)(shm + 32768 + (rt * 2 + (j >> 1)) * 8192) + lo + (j & 1) * 4096;
#define CK_STEP(ks) do { bf16x8 fb, fa0, fa1; CK_TRF(fb, vbm, (ks) * 1024); CK_TRF(fa0, vx, (ks) * 1024); CK_TRF(fa1, vx, 4096 + (ks) * 1024); \
        acc0 = __builtin_amdgcn_mfma_f32_32x32x16_bf16(fa0, fb, acc0, 0, 0, 0); acc1 = __builtin_amdgcn_mfma_f32_32x32x16_bf16(fa1, fb, acc1, 0, 0, 0); } while (0)
        CK_STEP(0); CK_STEP(1); CK_STEP(2); CK_STEP(3);
#undef CK_STEP
    }
    float* Sp = S + (((size_t)b * NCH + c) * 4 + 2 * g + hh) * 8192 + (size_t)(32 * j + r32) * 64;
#pragma unroll
    for (int q = 0; q < 4; ++q) { *(pg8::f32x4*)(Sp + 8 * q + 4 * hi) = (pg8::f32x4){acc0[4 * q], acc0[4 * q + 1], acc0[4 * q + 2], acc0[4 * q + 3]};
                                  *(pg8::f32x4*)(Sp + 32 + 8 * q + 4 * hi) = (pg8::f32x4){acc1[4 * q], acc1[4 * q + 1], acc1[4 * q + 2], acc1[4 * q + 3]}; }
    __syncthreads();
}

__device__ __forceinline__ void ml_s1_unit(int unit, const bf16_t* qka, const bf16_t* proj, const float* projf, const float* ig_bias, const float* fg_bias, float* U, float* nU, float* dec,
                                           LAS unsigned char* shm, int wave) {
    const int hp = unit & 1, c = (unit >> 1) & (NCH - 1), b = unit >> 7;
    int lane = lane_id(); asm volatile("" : "+v"(lane));
    const int tid = wave * 64 + lane; const size_t m0 = (size_t)b * SEQ + (size_t)c * CL;
    LAS float* wtab = (LAS float*)(shm + 65536);
    if (wave < 2) { const int h = 2 * hp + wave; const float igb = ig_bias[h], fgb = fg_bias[h];
        const float f0 = projf[(m0 + 2 * lane) * PROJF_W + PF_MF + h] + fgb, f1 = projf[(m0 + 2 * lane + 1) * PROJF_W + PF_MF + h] + fgb;
        const float l0 = fminf(f0, 0.f) - log1pf(__expf(-fabsf(f0))), l1 = fminf(f1, 0.f) - log1pf(__expf(-fabsf(f1)));
        const float i0 = projf[(m0 + 2 * lane) * PROJF_W + PF_MI + h] + igb, i1 = projf[(m0 + 2 * lane + 1) * PROJF_W + PF_MI + h] + igb;
        float s0, s1; scan128(l0, l1, lane, s0, s1);
        const float blast = __shfl(s1, 63);
        wtab[wave * 128 + 2 * lane] = __expf(blast - s0 + i0); wtab[wave * 128 + 2 * lane + 1] = __expf(blast - s1 + i1);
        if (lane == 0) dec[((size_t)b * NCH + c) * 4 + h] = __expf(blast); }
    __syncthreads();
#pragma unroll
    for (int hh = 0; hh < 2; ++hh)
#pragma unroll
        for (int rt = 0; rt < 2; ++rt) {
            stage_v64(shm + (hh * 2 + rt) * 8192, qka + (m0 + rt * 64) * 512 + 256 + (2 * hp + hh) * 64, 512, tid, wtab + hh * 128 + rt * 64);
            stage_v64(shm + 32768 + (hh * 2 + rt) * 8192, proj + (m0 + rt * 64) * PROJ_W + PC_MV + (2 * hp + hh) * 64, PROJ_W, tid, nullptr); }
    __syncthreads();
    const int hh = wave >> 2, db = (wave >> 1) & 1, eb = wave & 1, r32 = lane & 31, hi = lane >> 5; const int lo = tr_lane_off(lane);
    f32x16 acc = f32x16{};
#pragma unroll
    for (int rt = 0; rt < 2; ++rt) {
        const int vk = (int)(unsigned)(size_t)(shm + (hh * 2 + rt) * 8192) + lo + db * 4096, vv = (int)(unsigned)(size_t)(shm + 32768 + (hh * 2 + rt) * 8192) + lo + eb * 4096;
#define CK_STEP(ks) do { bf16x8 fa, fb; CK_TRF(fa, vv, (ks) * 1024); CK_TRF(fb, vk, (ks) * 1024); acc = __builtin_amdgcn_mfma_f32_32x32x16_bf16(fa, fb, acc, 0, 0, 0); } while (0)
        CK_STEP(0); CK_STEP(1); CK_STEP(2); CK_STEP(3);
#undef CK_STEP
    }
    const size_t ub = ((size_t)b * NCH + c) * 4 + 2 * hp + hh;
    float* Up = U + ub * 4096 + (size_t)(32 * db + r32) * 64 + 32 * eb;
#pragma unroll
    for (int q = 0; q < 4; ++q) *(pg8::f32x4*)(Up + 8 * q + 4 * hi) = (pg8::f32x4){acc[4 * q], acc[4 * q + 1], acc[4 * q + 2], acc[4 * q + 3]};
    if (tid < 128) { const int h2 = tid >> 6, d = tid & 63; float s = 0.f;
        for (int rt = 0; rt < 2; ++rt) { const LAS bf16_t* kp = (const LAS bf16_t*)(shm + (h2 * 2 + rt) * 8192 + (d >> 5) * 4096) + (d & 31);
            for (int r = 0; r < 64; ++r) s += bf2f(kp[r * 32]); }
        nU[(((size_t)b * NCH + c) * 4 + 2 * hp + h2) * 64 + d] = s; }
    __syncthreads();
}

__device__ __forceinline__ void scan_phase(int gtid, int ngt, const float* S, const float* sdec, bf16_t* prevT, const float* U, const float* nU, const float* mdec, bf16_t* Cst, float* nst) {
    constexpr int N1 = 2 * 4 * 8192, N2 = 2 * 4 * 4096, N3 = 2 * 4 * 64;
#define SCAN_RUN(SRC, DEC, STRIDE, STORE) do { float st = 0.f; \
        for (int c0 = 0; c0 < NCH; c0 += 16) { float sv[16], dv[16]; \
            _Pragma("unroll") for (int k = 0; k < 16; ++k) { const size_t u = ((size_t)b * NCH + c0 + k) * 4 + h; sv[k] = SRC[u * STRIDE + e]; dv[k] = DEC[u]; } \
            _Pragma("unroll") for (int k = 0; k < 16; ++k) { const size_t u = ((size_t)b * NCH + c0 + k) * 4 + h; STORE; st = dv[k] * st + sv[k]; } } } while (0)
    for (int idx = gtid; idx < N1 + N2 + N3; idx += ngt) {
        if (idx < N1) { const int e = idx & 8191, h = (idx >> 13) & 3, b = idx >> 15; SCAN_RUN(S, sdec, 8192, prevT[u * 8192 + e] = f2bf(st)); }
        else if (idx < N1 + N2) { const int i2 = idx - N1, e = i2 & 4095, h = (i2 >> 12) & 3, b = i2 >> 14; SCAN_RUN(U, mdec, 4096, Cst[u * 4096 + e] = f2bf(st)); }
        else { const int i3 = idx - N1 - N2, e = i3 & 63, h = (i3 >> 6) & 3, b = i3 >> 8; SCAN_RUN(nU, mdec, 64, nst[u * 64 + e] = st); }
    }
#undef SCAN_RUN
}

#define CK_PACK(p0, p1, pw0, pw1, pw2, pw3) do { \
    pw0 = (u32x4){cvtpk(p0[0], p0[1]), cvtpk(p0[2], p0[3]), cvtpk(p0[4], p0[5]), cvtpk(p0[6], p0[7])}; \
    pw1 = (u32x4){cvtpk(p0[8], p0[9]), cvtpk(p0[10], p0[11]), cvtpk(p0[12], p0[13]), cvtpk(p0[14], p0[15])}; \
    pw2 = (u32x4){cvtpk(p1[0], p1[1]), cvtpk(p1[2], p1[3]), cvtpk(p1[4], p1[5]), cvtpk(p1[6], p1[7])}; \
    pw3 = (u32x4){cvtpk(p1[8], p1[9]), cvtpk(p1[10], p1[11]), cvtpk(p1[12], p1[13]), cvtpk(p1[14], p1[15])}; } while (0)
__device__ __forceinline__ bf16x8 pv_afrag(const bf16_t* rowp, int ks, int hi, float scale) {
    const us4 a = *(const us4*)(rowp + 16 * ks + 4 * hi), b2 = *(const us4*)(rowp + 16 * ks + 8 + 4 * hi);
    u32x4 w; w.x = cvtpk(bf2f(a.x) * scale, bf2f(a.y) * scale); w.y = cvtpk(bf2f(a.z) * scale, bf2f(a.w) * scale);
    w.z = cvtpk(bf2f(b2.x) * scale, bf2f(b2.y) * scale); w.w = cvtpk(bf2f(b2.z) * scale, bf2f(b2.w) * scale);
    return __builtin_bit_cast(bf16x8, w);
}

__device__ __forceinline__ void ssd_s3_unit(int unit, const bf16_t* xbca, const bf16_t* proj, const float* projf, const float* dt_bias, const float* a_log, const float* d_skip, const float* norm_g,
                                            const bf16_t* prevT, bf16_t* ycat, LAS unsigned char* shm, int wave) {
    const int g = unit & 1, c = (unit >> 1) & (NCH - 1), b = unit >> 7;
    int lane = lane_id(); asm volatile("" : "+v"(lane));
    const int tid = wave * 64 + lane; const size_t m0 = (size_t)b * SEQ + (size_t)c * CL;
    LAS float* acum = (LAS float*)(shm + 98304); LAS float* dtt = acum + 256; LAS float* ssq = dtt + 256;
    if (wave < 2) { const int h = 2 * g + wave; const float a = -__expf(a_log[h]), dtb = dt_bias[h];
        const float d0 = softplus_f(projf[(m0 + 2 * lane) * PROJF_W + PF_DT + h] + dtb), d1 = softplus_f(projf[(m0 + 2 * lane + 1) * PROJF_W + PF_DT + h] + dtb);
        float s0, s1; scan128(d0 * a, d1 * a, lane, s0, s1);
        acum[wave * 128 + 2 * lane] = s0; acum[wave * 128 + 2 * lane + 1] = s1; dtt[wave * 128 + 2 * lane] = d0; dtt[wave * 128 + 2 * lane + 1] = d1; }
#pragma unroll
    for (int rt = 0; rt < 2; ++rt) stage_k64<128>(shm + rt * 16384, xbca + (m0 + rt * 64) * 768 + 256 + g * 128, 768, tid);
#pragma unroll
    for (int hh = 0; hh < 2; ++hh)
#pragma unroll
        for (int rt = 0; rt < 2; ++rt) {
            stage_v64(shm + 32768 + (hh * 2 + rt) * 8192, xbca + (m0 + rt * 64) * 768 + (2 * g + hh) * 64, 768, tid, nullptr);
            stage_v64(shm + 65536 + (hh * 2 + rt) * 8192, prevT + (((size_t)b * NCH + c) * 4 + 2 * g + hh) * 8192 + rt * 64 * 64, 64, tid, nullptr); }
    __syncthreads();
    const int hh = wave >> 2, rw = wave & 3, r32 = lane & 31, hi = lane >> 5, h = 2 * g + hh; const int lo = tr_lane_off(lane);
    const int l = 32 * rw + r32;
    const bf16_t* crowp = xbca + (m0 + l) * 768 + 512 + g * 128;
    f32x16 o[2]; o[0] = f32x16{}; o[1] = f32x16{};
    {
        bf16x8 qr[8];
#pragma unroll
        for (int d0 = 0; d0 < 8; ++d0) qr[d0] = *reinterpret_cast<const bf16x8*>(crowp + d0 * 16 + hi * 8);
        const float al = acum[hh * 128 + l];
        const int ntile = (rw >= 2) ? 2 : 1;
        for (int t = 0; t < ntile; ++t) {
            f32x16 p0 = f32x16{}, p1 = f32x16{};
            const LAS unsigned char* kb = shm + t * 16384 + hi * 1024 + r32 * 16;
#pragma unroll
            for (int d0 = 0; d0 < 8; ++d0) { const bf16x8 b0 = *(const LAS bf16x8*)(kb + d0 * 2048), b1 = *(const LAS bf16x8*)(kb + d0 * 2048 + 512);
                p0 = __builtin_amdgcn_mfma_f32_32x32x16_bf16(b0, qr[d0], p0, 0, 0, 0); p1 = __builtin_amdgcn_mfma_f32_32x32x16_bf16(b1, qr[d0], p1, 0, 0, 0); }
#pragma unroll
            for (int r = 0; r < 16; ++r) { const int s = 64 * t + crow(r, hi);
                const float w0 = (s <= l) ? __expf(al - acum[hh * 128 + s]) * dtt[hh * 128 + s] : 0.f, w1 = (s + 32 <= l) ? __expf(al - acum[hh * 128 + s + 32]) * dtt[hh * 128 + s + 32] : 0.f;
                p0[r] *= w0; p1[r] *= w1; }
            u32x4 pw0, pw1, pw2, pw3; CK_PACK(p0, p1, pw0, pw1, pw2, pw3);
            att::pv(o, (int)(unsigned)(size_t)(shm + 32768 + (hh * 2 + t) * 8192) + lo, __builtin_bit_cast(bf16x8, pw0), __builtin_bit_cast(bf16x8, pw1), __builtin_bit_cast(bf16x8, pw2), __builtin_bit_cast(bf16x8, pw3));
        }
        const float ea = __expf(al);
#pragma unroll
        for (int nt = 0; nt < 2; ++nt)
            att::pv(o, (int)(unsigned)(size_t)(shm + 65536 + (hh * 2 + nt) * 8192) + lo, pv_afrag(crowp + 64 * nt, 0, hi, ea), pv_afrag(crowp + 64 * nt, 1, hi, ea), pv_afrag(crowp + 64 * nt, 2, hi, ea), pv_afrag(crowp + 64 * nt, 3, hi, ea));
    }
    __syncthreads();
    LAS float* stg = (LAS float*)(shm + wave * 8704);
#pragma unroll
    for (int r = 0; r < 16; ++r) { const int orow = crow(r, hi); stg[orow * 68 + r32] = o[0][r]; stg[orow * 68 + 32 + r32] = o[1][r]; }
    asm volatile("s_waitcnt lgkmcnt(0)" ::: "memory");
    {
        const int row = lane >> 1, ch = lane & 1, lr = 32 * rw + row; const size_t m = m0 + lr;
        const float dsk = d_skip[h];
        float y[32]; float ss = 0.f;
#pragma unroll
        for (int q = 0; q < 4; ++q) { const us8 xv = *(const us8*)(xbca + m * 768 + h * 64 + ch * 32 + 8 * q), zv = *(const us8*)(proj + m * PROJ_W + PC_Z + h * 64 + ch * 32 + 8 * q);
#pragma unroll
            for (int i = 0; i < 8; ++i) { const float v = (stg[row * 68 + ch * 32 + 8 * q + i] + dsk * bf2f(xv[i])) * silu_f(bf2f(zv[i])); y[8 * q + i] = v; ss += v * v; } }
        ss += __shfl_xor(ss, 1);
        if (ch == 0) ssq[hh * 128 + lr] = ss;
        __syncthreads();
        const float tot = ssq[lr] + ssq[128 + lr];
        const float rstd = rsqrtf(tot * (1.f / 128.f) + EPS);
        const float* gp = norm_g + h * 64 + ch * 32;
        bf16_t* op = ycat + m * DM + 256 + h * 64 + ch * 32;
#pragma unroll
        for (int q = 0; q < 4; ++q) { v4u w; w.x = pk2(y[8 * q] * rstd * gp[8 * q], y[8 * q + 1] * rstd * gp[8 * q + 1]); w.y = pk2(y[8 * q + 2] * rstd * gp[8 * q + 2], y[8 * q + 3] * rstd * gp[8 * q + 3]);
            w.z = pk2(y[8 * q + 4] * rstd * gp[8 * q + 4], y[8 * q + 5] * rstd * gp[8 * q + 5]); w.w = pk2(y[8 * q + 6] * rstd * gp[8 * q + 6], y[8 * q + 7] * rstd * gp[8 * q + 7]);
            *(v4u*)(op + 8 * q) = w; }
    }
    __syncthreads();
}

__device__ __forceinline__ void ml_s3_unit(int unit, const bf16_t* qka, const bf16_t* proj, const float* projf, const float* ig_bias, const float* fg_bias, const float* norm_g,
                                           const bf16_t* Cst, const float* nst, bf16_t* ycat, LAS unsigned char* shm, int wave) {
    const int hp = unit & 1, c = (unit >> 1) & (NCH - 1), b = unit >> 7;
    int lane = lane_id(); asm volatile("" : "+v"(lane));
    const int tid = wave * 64 + lane; const size_t m0 = (size_t)b * SEQ + (size_t)c * CL;
    LAS float* bt = (LAS float*)(shm + 98304); LAS float* igt = bt + 256; LAS float* nt_ = igt + 256;
    LAS float* wsf = (LAS float*)(shm + 98304 + 4096) + wave * 64;
    if (wave < 2) { const int h = 2 * hp + wave; const float igb = ig_bias[h], fgb = fg_bias[h];
        const float f0 = projf[(m0 + 2 * lane) * PROJF_W + PF_MF + h] + fgb, f1 = projf[(m0 + 2 * lane + 1) * PROJF_W + PF_MF + h] + fgb;
        const float l0 = fminf(f0, 0.f) - log1pf(__expf(-fabsf(f0))), l1 = fminf(f1, 0.f) - log1pf(__expf(-fabsf(f1)));
        float s0, s1; scan128(l0, l1, lane, s0, s1);
        bt[wave * 128 + 2 * lane] = s0; bt[wave * 128 + 2 * lane + 1] = s1;
        igt[wave * 128 + 2 * lane] = projf[(m0 + 2 * lane) * PROJF_W + PF_MI + h] + igb; igt[wave * 128 + 2 * lane + 1] = projf[(m0 + 2 * lane + 1) * PROJF_W + PF_MI + h] + igb;
        nt_[wave * 64 + lane] = nst[(((size_t)b * NCH + c) * 4 + h) * 64 + lane]; }
#pragma unroll
    for (int hh = 0; hh < 2; ++hh) {
#pragma unroll
        for (int rt = 0; rt < 2; ++rt) {
            stage_k64<64>(shm + (hh * 2 + rt) * 8192, qka + (m0 + rt * 64) * 512 + 256 + (2 * hp + hh) * 64, 512, tid);
            stage_v64(shm + 32768 + (hh * 2 + rt) * 8192, proj + (m0 + rt * 64) * PROJ_W + PC_MV + (2 * hp + hh) * 64, PROJ_W, tid, nullptr); }
        stage_v64(shm + 65536 + hh * 8192, Cst + (((size_t)b * NCH + c) * 4 + 2 * hp + hh) * 4096, 64, tid, nullptr); }
    __syncthreads();
    const int hh = wave >> 2, rw = wave & 3, r32 = lane & 31, hi = lane >> 5, h = 2 * hp + hh; const int lo = tr_lane_off(lane);
    const int l = 32 * rw + r32;
    const bf16_t* qrowp = qka + (m0 + l) * 512 + h * 64;
    f32x16 o[2]; o[0] = f32x16{}; o[1] = f32x16{};
    float den = 0.f;
    {
        bf16x8 qr[4];
#pragma unroll
        for (int d0 = 0; d0 < 4; ++d0) qr[d0] = *reinterpret_cast<const bf16x8*>(qrowp + d0 * 16 + hi * 8);
        const float bl = bt[hh * 128 + l];
        const int ntile = (rw >= 2) ? 2 : 1;
        for (int t = 0; t < ntile; ++t) {
            f32x16 p0 = f32x16{}, p1 = f32x16{};
            const LAS unsigned char* kb = shm + (hh * 2 + t) * 8192 + hi * 1024 + r32 * 16;
#pragma unroll
            for (int d0 = 0; d0 < 4; ++d0) { const bf16x8 b0 = *(const LAS bf16x8*)(kb + d0 * 2048), b1 = *(const LAS bf16x8*)(kb + d0 * 2048 + 512);
                p0 = __builtin_amdgcn_mfma_f32_32x32x16_bf16(b0, qr[d0], p0, 0, 0, 0); p1 = __builtin_amdgcn_mfma_f32_32x32x16_bf16(b1, qr[d0], p1, 0, 0, 0); }
#pragma unroll
            for (int r = 0; r < 16; ++r) { const int s = 64 * t + crow(r, hi);
                const float w0 = (s <= l) ? __expf(bl - bt[hh * 128 + s] + igt[hh * 128 + s]) : 0.f, w1 = (s + 32 <= l) ? __expf(bl - bt[hh * 128 + s + 32] + igt[hh * 128 + s + 32]) : 0.f;
                p0[r] *= w0; p1[r] *= w1; den += p0[r] + p1[r]; }
            u32x4 pw0, pw1, pw2, pw3; CK_PACK(p0, p1, pw0, pw1, pw2, pw3);
            att::pv(o, (int)(unsigned)(size_t)(shm + 32768 + (hh * 2 + t) * 8192) + lo, __builtin_bit_cast(bf16x8, pw0), __builtin_bit_cast(bf16x8, pw1), __builtin_bit_cast(bf16x8, pw2), __builtin_bit_cast(bf16x8, pw3));
        }
        const float eb = __expf(bl);
        att::pv(o, (int)(unsigned)(size_t)(shm + 65536 + hh * 8192) + lo, pv_afrag(qrowp, 0, hi, eb), pv_afrag(qrowp, 1, hi, eb), pv_afrag(qrowp, 2, hi, eb), pv_afrag(qrowp, 3, hi, eb));
        float qn = 0.f;
#pragma unroll
        for (int d0 = 0; d0 < 4; ++d0)
#pragma unroll
            for (int i = 0; i < 8; ++i) qn += bf2f((bf16_t)qr[d0][i]) * nt_[hh * 64 + 16 * d0 + 8 * hi + i];
        den = xhalf_sum(den + eb * qn);
    }
    if (hi == 0) wsf[r32] = 1.f / fmaxf(fabsf(den), 1.f);
    asm volatile("s_waitcnt lgkmcnt(0)" ::: "memory");
    float rli[16];
#pragma unroll
    for (int r = 0; r < 16; ++r) rli[r] = wsf[crow(r, hi)];
    __syncthreads();
    LAS float* stg = (LAS float*)(shm + wave * 8704);
#pragma unroll
    for (int r = 0; r < 16; ++r) { const int orow = crow(r, hi); stg[orow * 68 + r32] = o[0][r] * rli[r]; stg[orow * 68 + 32 + r32] = o[1][r] * rli[r]; }
    asm volatile("s_waitcnt lgkmcnt(0)" ::: "memory");
    {
        const int row = lane >> 1, ch = lane & 1, lr = 32 * rw + row; const size_t m = m0 + lr;
        float y[32]; float ss = 0.f;
#pragma unroll
        for (int q = 0; q < 4; ++q) { const us8 ov = *(const us8*)(proj + m * PROJ_W + PC_MO + h * 64 + ch * 32 + 8 * q);
#pragma unroll
            for (int i = 0; i < 8; ++i) { const float v = stg[row * 68 + ch * 32 + 8 * q + i] * sigmoid_f(bf2f(ov[i])); y[8 * q + i] = v; ss += v * v; } }
        ss += __shfl_xor(ss, 1);
        const float rstd = rsqrtf(ss * (1.f / 64.f) + EPS);
        const float* gp = norm_g + h * 64 + ch * 32;
        bf16_t* op = ycat + m * DM + 512 + h * 64 + ch * 32;
#pragma unroll
        for (int q = 0; q < 4; ++q) { v4u w; w.x = pk2(y[8 * q] * rstd * gp[8 * q], y[8 * q + 1] * rstd * gp[8 * q + 1]); w.y = pk2(y[8 * q + 2] * rstd * gp[8 * q + 2], y[8 * q + 3] * rstd * gp[8 * q + 3]);
            w.z = pk2(y[8 * q + 4] * rstd * gp[8 * q + 4], y[8 * q + 5] * rstd * gp[8 * q + 5]); w.w = pk2(y[8 * q + 6] * rstd * gp[8 * q + 6], y[8 * q + 7] * rstd * gp[8 * q + 7]);
            *(v4u*)(op + 8 * q) = w; }
    }
    __syncthreads();
}
#undef CK_TRF
#undef CK_PACK
}
#ifndef EN_P_MOE
#define EN_P_MOE 1
#endif
#ifndef EN_P_SCAN
#define EN_P_SCAN 1
#endif
#ifndef EN_P_CONV
#define EN_P_CONV 1
#endif
#ifndef EN_P_INPROJ
#define EN_P_INPROJ 1
#endif
#ifndef EN_P_PREP
#define EN_P_PREP 1
#endif
#ifndef EN_P_MLAUP
#define EN_P_MLAUP 1
#endif
#ifndef EN_P_ATTN
#define EN_P_ATTN 1
#endif
#ifndef EN_P_OUTPROJ
#define EN_P_OUTPROJ 1
#endif
constexpr int NPH = 11, PH_FINAL = 2 * NPH;
enum { P_CONV = 0, P_INPROJ = 1, P_PREP = 2, P_MLAUP = 3, P_SCAN = 4, P_ATTN = 5, P_OUTPROJ = 6, P_ROUTE = 7, P_SORT = 8, P_MOEUP = 9, P_MOEDOWN = 10 };

__global__ void __launch_bounds__(NWAVES * 64, 2) mk_fwd(Args args) {
    extern __shared__ __attribute__((aligned(16))) unsigned char lds_raw[];
    LAS unsigned char* lds0p = (LAS unsigned char*)lds_raw; LAS unsigned char* lds = lds0p;
    volatile LAS unsigned* MISC = (volatile LAS unsigned*)(lds + MISC_OFF);
    const int tid = threadIdx.x, lane0 = tid & 63, wave = __builtin_amdgcn_readfirstlane(tid >> 6);
    const int G = gridDim.x; const int bx = blockIdx.x; const int vcu = (G % 8 == 0) ? (bx % 8) * (G / 8) + bx / 8 : bx;
    unsigned char* ws = args.ws;
    gu32* ctl = (gu32*)(ws + WS_CTL);
    for (int u = tid; u < (LDS_BYTES - LDSCTL_OFF) / 4; u += NWAVES * 64) ((LAS unsigned*)(lds + LDSCTL_OFF))[u] = 0u;
    __syncthreads();
    if (tid == 0) { LAS unsigned long long* tb = (LAS unsigned long long*)(lds + PTR_OFF);
#pragma unroll
        for (int i = 0; i < 29; ++i) tb[i] = (unsigned long long)args.in[i]; }
    __syncthreads();
#define INP(i) in_ptr(lds, (i))
    XcdBarrier bar = xcd_barrier_post((unsigned*)(ctl + CW_BAR) + args.bli * XCD_BAR_WORDS, MISC + 8);
    const int lo = args.ph_lo, hi = args.ph_hi;
#define IN(k) (lo <= (k) && (k) < hi)
#define SEAM(k) do { if (IN(k) && IN((k) + 1)) xcd_barrier(bar); } while (0)
    float* X = args.out;
    bf16_t* ACT = (bf16_t*)(ws + WS_ACT); bf16_t* PROJ = (bf16_t*)(ws + WS_PROJ); float* PROJF = (float*)(ws + WS_PROJF);
    bf16_t* WinT = (bf16_t*)(ws + WS_WIN); bf16_t* WoutT = (bf16_t*)(ws + WS_WOUT); bf16_t* WuqT = (bf16_t*)(ws + WS_WUQ); bf16_t* WukvT = (bf16_t*)(ws + WS_WUKV);
    bf16_t* XBCA = (bf16_t*)(ws + WS_XBCA); bf16_t* QKA = (bf16_t*)(ws + WS_QKA); bf16_t* QM = (bf16_t*)(ws + WS_QM); bf16_t* KM = (bf16_t*)(ws + WS_KM); bf16_t* VM = (bf16_t*)(ws + WS_VM);
    bf16_t* WupT = (bf16_t*)(ws + WS_WUP); bf16_t* WdnT = (bf16_t*)(ws + WS_WDN); bf16_t* XS = (bf16_t*)(ws + WS_XS); bf16_t* HID = (bf16_t*)(ws + WS_HID);
    int* STOK = (int*)(ws + WS_STOK); float* SW1 = (float*)(ws + WS_SW1); float* SW2 = (float*)(ws + WS_SW2);
    int* TCLS = (int*)(ws + WS_TCLS); int* TPOS = (int*)(ws + WS_TPOS); float* TW1 = (float*)(ws + WS_TW1); float* TW2 = (float*)(ws + WS_TW2);
    float* S1S = (float*)(ws + WS_ACT); float* S1U = (float*)(ws + WS_ACT + 16 * MiB); float* S1N = (float*)(ws + WS_ACT + 24 * MiB); float* S1SD = (float*)(ws + WS_ACT + 25 * MiB); float* S1MD = S1SD + 1024;
    bf16_t* PREVT = (bf16_t*)(ws + WS_PREVT); bf16_t* CST = (bf16_t*)(ws + WS_CST); float* NST = (float*)(ws + WS_NST);
    bf16_t* CQN = (bf16_t*)(ws + WS_CQN); bf16_t* CKVN = (bf16_t*)(ws + WS_CKVN); float* ROPE = (float*)(ws + WS_ROPE); float* KMEAN = (float*)(ws + WS_KMEAN);
    const int gw = vcu * NWAVES + wave, NGW = G * NWAVES;

    for (int l = 0; l < DEPTH; ++l) {
        const int pb = l * NPH;
        { unsigned lv = (unsigned)(size_t)lds0p; asm volatile("" : "+s"(lv)); lds = (LAS unsigned char*)(size_t)lv; }
        if (EN_P_CONV && IN(pb + P_CONV)) {
            int lane = (int)__builtin_amdgcn_mbcnt_hi(~0u, __builtin_amdgcn_mbcnt_lo(~0u, 0u)); asm volatile("" : "+v"(lane));
            LAS float* scr = (LAS float*)(lds + RING_OFF + wave * 16384);
            constexpr int I_IN = (DM / 64) * (PROJ_N / 32), I_OUT = (DM / 64) * (DM / 32), I_UQ = (256 / 64) * (512 / 32), I_UKV = (128 / 64) * (512 / 32);
            const MapInProj mi{INP(3) + (size_t)l * DM * NIN};
            const MapPlain mo{INP(19) + (size_t)l * DM * DM, DM, 1.f};
            const MapPlain muq{INP(16) + (size_t)l * 256 * 384, 384, C2M};
            const MapPlain mukv{INP(18) + (size_t)l * 128 * 512, 512, 1.f};
            for (int it = gw; it < I_IN + I_OUT + I_UQ + I_UKV; it += NGW) {
                if (it < I_IN) conv_item(mi, NIN, DM, WinT, PROJ_N / 32, scr, it, lane);
                else if (it < I_IN + I_OUT) conv_item(mo, DM, DM, WoutT, DM / 32, scr, it - I_IN, lane);
                else if (it < I_IN + I_OUT + I_UQ) conv_item(muq, 384, 256, WuqT, 512 / 32, scr, it - I_IN - I_OUT, lane);
                else conv_item(mukv, 512, 128, WukvT, 512 / 32, scr, it - I_IN - I_OUT - I_UQ, lane);
            }
            const float* xsrc = (l == 0) ? INP(0) : X;
            for (int m = gw; m < M; m += NGW) rms_row_to_bf16(xsrc + (size_t)m * DM, INP(2) + l * DM, ACT + (size_t)m * DM, nullptr, lane);
        }
        SEAM(pb + P_CONV);
        if (EN_P_INPROJ && IN(pb + P_INPROJ)) {
            pg8::StaticOrder S; S.init(ACT, WinT, DM, DM, DM, M, PROJ_N, G, bx);
            const EpiInProj E{PROJ, PROJF};
            pg8::gemm_phase(lds + RING_OFF, wave, pg8::Dims{DM, DM, DM}, S, E);
        }
        SEAM(pb + P_INPROJ);
        if (EN_P_PREP && IN(pb + P_PREP)) {
            int lane = (int)__builtin_amdgcn_mbcnt_hi(~0u, __builtin_amdgcn_mbcnt_lo(~0u, 0u)); asm volatile("" : "+v"(lane));
            if (wave == 0) for (int it = vcu; it < 256; it += G) kmean_item(it, lane, PROJ, KMEAN);
            for (int m = gw; m < M; m += NGW) mla_prep_token(m, lane, PROJ, PROJF, (const int*)INP(1), INP(15) + l * 256, INP(17) + l * 128, CQN, CKVN, KM, ROPE);
            for (int wt = gw; wt < (M / 32) * 3; wt += NGW) { const int seg = wt / 3, part = wt - seg * 3;
                if (part == 0) conv_seg(PROJ, seg * 32, PC_XBC, lane, 768, INP(4) + l * 4 * 768, INP(5) + l * 768, XBCA, 1.f);
                else if (part == 1) { if (lane < 32) conv_seg(PROJ, seg * 32, PC_XBC, 64 + lane, 768, INP(4) + l * 4 * 768, INP(5) + l * 768, XBCA, 1.f); }
                else conv_seg(PROJ, seg * 32, PC_MQK, lane, 512, INP(10) + l * 4 * 512, INP(11) + l * 512, QKA, lane >= 32 ? 0.125f : 1.f); }
        }
        SEAM(pb + P_PREP);
        if (EN_P_MLAUP && IN(pb + P_MLAUP)) {
            const int half = G / 2;
            if (bx < half) { pg8::StaticOrder S; S.init(CQN, WuqT, 256, 256, 256, M, 512, half, bx); const EpiMlaQ E{QM, ROPE}; pg8::gemm_phase(lds + RING_OFF, wave, pg8::Dims{256, 256, 256}, S, E); }
            else { pg8::StaticOrder S; S.init(CKVN, WukvT, 128, 128, 128, M, 512, G - half, bx - half); const EpiMlaKVf E{KM, VM}; pg8::gemm_phase(lds + RING_OFF, wave, pg8::Dims{128, 128, 128}, S, E); }
            for (int u = vcu; u < 512; u += G) {
                if (u < 256) ck::ssd_s1_unit(u, XBCA, PROJF, INP(6) + l * 4, INP(7) + l * 4, S1S, S1SD, lds + RING_OFF, wave);
                else ck::ml_s1_unit(u - 256, QKA, PROJ, PROJF, INP(12) + l * 4, INP(13) + l * 4, S1U, S1N, S1MD, lds + RING_OFF, wave);
            }
        }
        SEAM(pb + P_MLAUP);
        if (EN_P_SCAN && IN(pb + P_SCAN)) {
            const int lane = (int)__builtin_amdgcn_mbcnt_hi(~0u, __builtin_amdgcn_mbcnt_lo(~0u, 0u));
            ck::scan_phase(gw * 64 + lane, NGW * 64, S1S, S1SD, PREVT, S1U, S1N, S1MD, CST, NST);
        }
        SEAM(pb + P_SCAN);
        if (EN_P_ATTN && IN(pb + P_ATTN)) {
            for (int u = vcu; u < 512; u += G) {
                const int bh = (u & 255) >> 5, qs = u & 31, b = bh >> 2, hh = bh & 3;
                if (u < 256) att::attn_unit<96, false>(b, hh, qs, QM, 384, hh * 96, KM, 384, hh * 96, VM, 256, hh * 64, ACT, 768 + hh * 64, nullptr, lds + RING_OFF, wave);
                else att::attn_unit<64, true>(b, hh, 31 - qs, PROJ, PROJ_W, PC_AQ + hh * 64, PROJ, PROJ_W, PC_AK + hh * 64, PROJ, PROJ_W, PC_AV + hh * 64, ACT, hh * 64, KMEAN, lds + RING_OFF, wave);
            }
            for (int u = vcu; u < 512; u += G) {
                if (u < 256) ck::ssd_s3_unit(u, XBCA, PROJ, PROJF, INP(6) + l * 4, INP(7) + l * 4, INP(8) + l * 4, INP(9) + l * 256, PREVT, ACT, lds + RING_OFF, wave);
                else ck::ml_s3_unit(u - 256, QKA, PROJ, PROJF, INP(12) + l * 4, INP(13) + l * 4, INP(14) + l * 256, CST, NST, ACT, lds + RING_OFF, wave);
            }
        }
        SEAM(pb + P_ATTN);
        if (EN_P_OUTPROJ && IN(pb + P_OUTPROJ)) {
            pg8::StaticOrder S; S.init(ACT, WoutT, DM, DM, DM, M, DM, G, bx);
            const EpiResidualF32 E{X, (l == 0) ? INP(0) : (const float*)X};
            pg8::gemm_phase(lds + RING_OFF, wave, pg8::Dims{DM, DM, DM}, S, E);
            int lane = (int)__builtin_amdgcn_mbcnt_hi(~0u, __builtin_amdgcn_mbcnt_lo(~0u, 0u)); asm volatile("" : "+v"(lane));
            LAS float* scr = (LAS float*)(lds + RING_OFF + wave * 16384);
            const float* wgate = INP(25) + (size_t)l * 16 * 1024 * 256; const float* wup = INP(26) + (size_t)l * 16 * 1024 * 256; const float* wdn = INP(27) + (size_t)l * 16 * 256 * 1024;
            for (int it = gw; it < 16 * 256 + 16 * 128; it += NGW) {
                if (it < 16 * 256) { const int e = it >> 8, q = ((it & 255) & 15) >> 2;
                    if (q & 1) { const MapMoeUp mu{wup + (size_t)e * 1024 * 256, (q >> 1) * 128}; conv_item(mu, 256, 1024, WupT + (size_t)e * 512 * 1024, 512 / 32, scr, it & 255, lane); }
                    else { const MapMoeUp mu{wgate + (size_t)e * 1024 * 256, (q >> 1) * 128}; conv_item(mu, 256, 1024, WupT + (size_t)e * 512 * 1024, 512 / 32, scr, it & 255, lane); } }
                else { const int r = it - 16 * 256, e = r >> 7; const MapPlain md{wdn + (size_t)e * 256 * 1024, 1024, 1.f};
                    conv_item(md, 1024, 256, WdnT + (size_t)e * 1024 * 256, 1024 / 32, scr, r & 127, lane); }
            }
        }
        SEAM(pb + P_OUTPROJ);
        unsigned* mcnt = (unsigned*)(ctl + CW_MOECNT + l * 1024);
        if (EN_P_MOE && IN(pb + P_ROUTE)) {
            int lane = (int)__builtin_amdgcn_mbcnt_hi(~0u, __builtin_amdgcn_mbcnt_lo(~0u, 0u)); asm volatile("" : "+v"(lane));
            LAS float* rw = (LAS float*)(lds + RING_OFF);
            { const float* wg = INP(21) + (size_t)l * DM * 4; const float* wr = INP(23) + (size_t)l * DM * 16; const int tid2 = wave * 64 + lane;
              for (int i = tid2; i < DM; i += NWAVES * 64) { const f32x4 w = *(const GAS f32x4*)(wg + 4 * i); rw[0 * RW_PITCH + i] = w.x; rw[1 * RW_PITCH + i] = w.y; rw[2 * RW_PITCH + i] = w.z; rw[3 * RW_PITCH + i] = w.w; }
              for (int i = tid2; i < DM * 4; i += NWAVES * 64) { const int k = i >> 2, c = i & 3; const f32x4 w = *(const GAS f32x4*)(wr + 4 * i);
                  rw[(4 + 4 * c) * RW_PITCH + k] = w.x; rw[(5 + 4 * c) * RW_PITCH + k] = w.y; rw[(6 + 4 * c) * RW_PITCH + k] = w.z; rw[(7 + 4 * c) * RW_PITCH + k] = w.w; } }
            __syncthreads();
            for (int m = gw; m < M; m += NGW) route_token(m, lane, X, INP(20) + l * DM, rw, INP(22) + l * 4, INP(24) + l * 16, ACT, mcnt, TCLS, TPOS, TW1, TW2);
            __syncthreads();
        }
        SEAM(pb + P_ROUTE);
        if (EN_P_MOE && IN(pb + P_SORT)) {
            int lane = (int)__builtin_amdgcn_mbcnt_hi(~0u, __builtin_amdgcn_mbcnt_lo(~0u, 0u)); asm volatile("" : "+v"(lane));
            (void)moe_tiles(mcnt, lds, wave == 0 && lane == 0);
            const LAS int* offs = (const LAS int*)(lds + OFFS_OFF);
            if (bx < 24) { const int beg = offs[bx] + (int)mcnt[32 * bx], end = offs[bx + 1];
                for (int r = beg + wave * 64 + lane; r < end; r += NWAVES * 64) { st_wt(STOK + r, -1); st_wt(SW1 + r, 0.f); st_wt(SW2 + r, 0.f); }
#ifndef PADZERO_OFF
                for (int r = beg + wave; r < end; r += NWAVES) { v4u* dst = (v4u*)(XS + (size_t)r * DM); dst[lane] = (v4u){0u, 0u, 0u, 0u}; dst[64 + lane] = (v4u){0u, 0u, 0u, 0u}; }
#endif
            }
            for (int m = gw; m < M; m += NGW) { const int row = offs[TCLS[m]] + TPOS[m];
                if (lane == 0) { st_wt(STOK + row, m); st_wt(SW1 + row, TW1[m]); st_wt(SW2 + row, TW2[m]); }
                const v4u* src = (const v4u*)(ACT + (size_t)m * DM); v4u* dst = (v4u*)(XS + (size_t)row * DM);
                const v4u a = __builtin_nontemporal_load(src + lane), b = __builtin_nontemporal_load(src + 64 + lane); dst[lane] = a; dst[64 + lane] = b; }
        }
        SEAM(pb + P_SORT);
        if (EN_P_MOE && IN(pb + P_MOEUP)) {
            const int lane = (int)__builtin_amdgcn_mbcnt_hi(~0u, __builtin_amdgcn_mbcnt_lo(~0u, 0u));
            const int ntile = moe_tiles(mcnt, lds, wave == 0 && lane == 0);
            const int nu = ntile * 4;
            unsigned* tdone = (unsigned*)(ctl + 210000 + l * 128);
            const EpiMoeUp E{HID, SW1, SW2};
            for (int L = bx; L < nu; L += G) {
                const MoeOrder S{XS, WupT, DM, DM, (size_t)512 * 1024, DM, ntile, 1 << 20, L, lds + TCLS_OFF, false};
                pg8::gemm_phase(lds + RING_OFF, wave, pg8::Dims{DM, DM, DM}, S, E);
                asm volatile("s_waitcnt vmcnt(0)" ::: "memory");
                __syncthreads();
                if (wave == 0 && lane == 0) { __builtin_amdgcn_fence(__ATOMIC_RELEASE, "agent"); asm volatile("s_waitcnt vmcnt(0)" ::: "memory");
                    (void)__hip_atomic_fetch_add(tdone + (L >> 2), 1u, __ATOMIC_RELAXED, __HIP_MEMORY_SCOPE_AGENT); }
            }
            const int maxu = (nu + G - 1) / G; int two = nu - (maxu - 1) * G; if (two >= G) two = 0;
            const int c2 = (bx >= two) ? bx - two : bx + (G - two);
            const EpiMoeDown E2{X, STOK};
            for (int L = c2; L < nu; L += G) {
                if (wave == 0 && lane == 0) { unsigned sp = 0u;
                    while (__hip_atomic_load(tdone + (L >> 2), __ATOMIC_RELAXED, __HIP_MEMORY_SCOPE_AGENT) < 4u && ++sp < (1u << 22)) __builtin_amdgcn_s_sleep(2);
                    __builtin_amdgcn_fence(__ATOMIC_ACQUIRE, "agent"); asm volatile("s_waitcnt vmcnt(0)" ::: "memory"); }
                __syncthreads();
                const MoeOrder S2{HID, WdnT, 512, 256, (size_t)1024 * 256, 512, ntile, 1 << 20, L, lds + TCLS_OFF, true};
                pg8::gemm_phase(lds + RING_OFF, wave, pg8::Dims{512, 512, 256}, S2, E2);
            }
        }
        SEAM(pb + P_MOEDOWN);
    }
    if (IN(PH_FINAL)) {
        int lane = (int)__builtin_amdgcn_mbcnt_hi(~0u, __builtin_amdgcn_mbcnt_lo(~0u, 0u)); asm volatile("" : "+v"(lane));
        for (int m = gw; m < M; m += NGW) rms_row_to_f32(X + (size_t)m * DM, INP(28), X + (size_t)m * DM, lane);
    }
#undef IN
#undef SEAM
}
static void launch_mk(Args a, int lo, int hi, int bli, int grid, hipStream_t stream) {
    a.ph_lo = lo; a.ph_hi = hi; a.bli = bli; a.pad = 0;
    hipLaunchKernelGGL(mk_fwd, dim3(grid), dim3(NWAVES * 64), LDS_BYTES, stream, a);
}
extern "C" void kernel_launch(void* const* d_in, const int* in_sizes, int n_in, void* d_out, int out_size, void* d_ws, size_t ws_size, hipStream_t stream) {
    static int grid = 0;
    if (grid == 0) {
        int dev = 0, cus = 0;
        if (hipGetDevice(&dev) != hipSuccess || hipDeviceGetAttribute(&cus, hipDeviceAttributeMultiprocessorCount, dev) != hipSuccess) { grid = -1; return; }
        if (hipFuncSetAttribute((const void*)mk_fwd, hipFuncAttributeMaxDynamicSharedMemorySize, LDS_BYTES) != hipSuccess) { grid = -1; return; }
        int per_cu = 0;
        (void)hipOccupancyMaxActiveBlocksPerMultiprocessor(&per_cu, (const void*)mk_fwd, NWAVES * 64, LDS_BYTES);
        (void)hipGetLastError();
        grid = cus;
        if (n_in != 29 || ws_size < WS_END) { grid = -1; return; }
    }
    if (grid < 0) return;
    (void)hipMemsetAsync((char*)d_ws + WS_CTL, 0, CTL_ZERO_BYTES, stream);
    Args a{};
    for (int i = 0; i < 29; ++i) a.in[i] = (const float*)d_in[i];
    a.out = (float*)d_out; a.ws = (unsigned char*)d_ws;
    launch_mk(a, 0, PH_FINAL + 1, 0, grid, stream);
}
```

```cpp
#include <hip/hip_runtime.h>
#include <stdint.h>
#include <math.h>

typedef unsigned short bf16_t;
typedef unsigned short us8 __attribute__((ext_vector_type(8)));
typedef unsigned short us4 __attribute__((ext_vector_type(4)));

constexpr int BATCH = 2, SEQ = 8192, DM = 1024, M = BATCH * SEQ, DEPTH = 2;
constexpr int NIN = 3244;
constexpr float EPS = 1e-6f;
constexpr float LOG2E = 1.4426950408889634f;
constexpr float C2A = 0.125f * LOG2E;
constexpr float C2M = 0.10206207261596575f * LOG2E;
constexpr int PC_AQ = 0, PC_AK = 256, PC_AV = 512, PC_Z = 768, PC_XBC = 1024, PC_MQK = 1792, PC_MV = 2304, PC_MO = 2560, PC_CQ = 2816, PROJ_W = 3072;
constexpr int PF_CKV = 0, PF_KR = 128, PF_DT = 160, PF_MI = 164, PF_MF = 168, PROJF_W = 256;

__host__ __device__ inline int dst_col(int n) {
    if (n < 1792) return n;
    if (n < 1796) return PROJ_W + PF_DT + (n - 1792);
    if (n < 2308) return PC_MQK + (n - 1796);
    if (n < 2564) return PC_MV + (n - 2308);
    if (n < 2568) return PROJ_W + PF_MI + (n - 2564);
    if (n < 2572) return PROJ_W + PF_MF + (n - 2568);
    if (n < 2828) return PC_MO + (n - 2572);
    if (n < 3084) return PC_CQ + (n - 2828);
    if (n < 3212) return PROJ_W + PF_CKV + (n - 3084);
    return PROJ_W + PF_KR + (n - 3212);
}

__device__ __forceinline__ float bf2f(bf16_t v) { return __uint_as_float(((unsigned)v) << 16); }
__device__ __forceinline__ bf16_t f2bf(float f) { unsigned u = __float_as_uint(f); return (bf16_t)((u + 0x7fffu + ((u >> 16) & 1u)) >> 16); }
__device__ __forceinline__ float silu_f(float x) { return x / (1.f + __expf(-x)); }
__device__ __forceinline__ float sigmoid_f(float x) { return 1.f / (1.f + __expf(-x)); }
__device__ __forceinline__ float softplus_f(float x) { return x > 20.f ? x : log1pf(__expf(x)); }

#ifdef WAVE_SUM_SHFL
__device__ __forceinline__ float wave_sum(float v) {
#pragma unroll
    for (int o = 1; o < 64; o <<= 1) v += __shfl_xor(v, o);
    return v;
}
#else
#define WS_DPP(v, ctrl) ((v) + __int_as_float(__builtin_amdgcn_update_dpp(0, __float_as_int(v), (ctrl), 0xf, 0xf, true)))
__device__ __forceinline__ float wave_sum(float v) {
    v = WS_DPP(v, 0xB1);
    v = WS_DPP(v, 0x4E);
    v = WS_DPP(v, 0x141);
    v = WS_DPP(v, 0x140);
    { auto rr = __builtin_amdgcn_permlane16_swap(__float_as_uint(v), __float_as_uint(v), false, false); v = __uint_as_float(rr[0]) + __uint_as_float(rr[1]); }
    { auto rr = __builtin_amdgcn_permlane32_swap(__float_as_uint(v), __float_as_uint(v), false, false); v = __uint_as_float(rr[0]) + __uint_as_float(rr[1]); }
    return v;
}
#endif
__device__ __forceinline__ float block_sum256(float v, float* sh) {
    v = wave_sum(v);
    __syncthreads();
    if ((threadIdx.x & 63) == 0) sh[threadIdx.x >> 6] = v;
    __syncthreads();
    return sh[0] + sh[1] + sh[2] + sh[3];
}

__global__ __launch_bounds__(256) void k_rmsnorm_bf16(const float* __restrict__ x, const float* __restrict__ g, bf16_t* __restrict__ out) {
    __shared__ float sh[4];
    const int m = blockIdx.x, t = threadIdx.x;
    const float4 v = ((const float4*)(x + (size_t)m * DM))[t];
    const float ss = block_sum256(v.x * v.x + v.y * v.y + v.z * v.z + v.w * v.w, sh);
    const float r = rsqrtf(ss * (1.f / DM) + EPS);
    const float4 gg = ((const float4*)g)[t];
    us4 o; o.x = f2bf(v.x * r * gg.x); o.y = f2bf(v.y * r * gg.y); o.z = f2bf(v.z * r * gg.z); o.w = f2bf(v.w * r * gg.w);
    ((us4*)(out + (size_t)m * DM))[t] = o;
}
__global__ __launch_bounds__(256) void k_rmsnorm_f32(const float* x, const float* __restrict__ g, float* out) {
    __shared__ float sh[4];
    const int m = blockIdx.x, t = threadIdx.x;
    const float4 v = ((const float4*)(x + (size_t)m * DM))[t];
    const float ss = block_sum256(v.x * v.x + v.y * v.y + v.z * v.z + v.w * v.w, sh);
    const float r = rsqrtf(ss * (1.f / DM) + EPS);
    const float4 gg = ((const float4*)g)[t];
    float4 o; o.x = v.x * r * gg.x; o.y = v.y * r * gg.y; o.z = v.z * r * gg.z; o.w = v.w * r * gg.w;
    ((float4*)(out + (size_t)m * DM))[t] = o;
}

template <class Epi>
__global__ __launch_bounds__(256) void k_gemm(const bf16_t* __restrict__ A, int lda, const float* __restrict__ W, int ldw, int N, int K, Epi epi) {
    __shared__ float As[16][68];
    __shared__ float Bs[16][68];
    const int tid = threadIdx.x, tx = tid & 15, ty = tid >> 4;
    const int m0 = blockIdx.y * 64, n0 = blockIdx.x * 64;
    float acc[4][4];
#pragma unroll
    for (int i = 0; i < 4; ++i)
#pragma unroll
        for (int j = 0; j < 4; ++j) acc[i][j] = 0.f;
    for (int k0 = 0; k0 < K; k0 += 16) {
        {
            const int r = tid >> 2, kq = (tid & 3) * 4;
            const us4 v = *(const us4*)(A + (size_t)(m0 + r) * lda + k0 + kq);
            As[kq + 0][r] = bf2f(v.x); As[kq + 1][r] = bf2f(v.y); As[kq + 2][r] = bf2f(v.z); As[kq + 3][r] = bf2f(v.w);
        }
        {
            const int kk = tid >> 4, nq = (tid & 15) * 4, n = n0 + nq;
            float4 v = make_float4(0.f, 0.f, 0.f, 0.f);
            if (n < N) v = *(const float4*)(W + (size_t)(k0 + kk) * ldw + n);
            Bs[kk][nq + 0] = v.x; Bs[kk][nq + 1] = v.y; Bs[kk][nq + 2] = v.z; Bs[kk][nq + 3] = v.w;
        }
        __syncthreads();
#pragma unroll
        for (int kk = 0; kk < 16; ++kk) {
            float a[4], b[4];
#pragma unroll
            for (int i = 0; i < 4; ++i) { a[i] = As[kk][ty * 4 + i]; b[i] = Bs[kk][tx * 4 + i]; }
#pragma unroll
            for (int i = 0; i < 4; ++i)
#pragma unroll
                for (int j = 0; j < 4; ++j) acc[i][j] += a[i] * b[j];
        }
        __syncthreads();
    }
#pragma unroll
    for (int i = 0; i < 4; ++i)
#pragma unroll
        for (int j = 0; j < 4; ++j) { const int n = n0 + tx * 4 + j; if (n < N) epi(m0 + ty * 4 + i, n, acc[i][j]); }
}

struct EpiInProjNaive {
    bf16_t* proj; float* projf;
    __device__ void operator()(int m, int n, float v) const {
        const int c = dst_col(n);
        if (c < PROJ_W) { if (c < 256) v *= C2A; proj[(size_t)m * PROJ_W + c] = f2bf(v); }
        else projf[(size_t)m * PROJF_W + (c - PROJ_W)] = v;
    }
};
struct EpiResidual {
    float* x;
    __device__ void operator()(int m, int n, float v) const { x[(size_t)m * DM + n] += v; }
};
struct EpiF32 {
    float* out; int ld; int pad;
    __device__ void operator()(int m, int n, float v) const { out[(size_t)m * ld + n] = v; }
};
struct EpiMlaKV {
    bf16_t* km; bf16_t* vm;
    __device__ void operator()(int m, int n, float v) const {
        const int h = n >> 7, d = n & 127;
        if (d < 64) km[(size_t)m * 384 + h * 96 + d] = f2bf(v); else vm[(size_t)m * 256 + h * 64 + (d - 64)] = f2bf(v);
    }
};

__global__ __launch_bounds__(256) void k_conv_silu(const bf16_t* __restrict__ src, int ld, int c0, int C, const float* __restrict__ w, const float* __restrict__ b, bf16_t* __restrict__ dst) {
    const size_t idx = (size_t)blockIdx.x * 256 + threadIdx.x;
    if (idx >= (size_t)M * C) return;
    const int m = (int)(idx / C), c = (int)(idx % C), t = m % SEQ;
    float acc = b[c];
#pragma unroll
    for (int i = 0; i < 4; ++i) { const int tt = t - 3 + i; if (tt >= 0) acc += w[i * C + c] * bf2f(src[(size_t)(m - 3 + i) * ld + c0 + c]); }
    dst[(size_t)m * C + c] = f2bf(silu_f(acc));
}

__global__ __launch_bounds__(256) void k_ssd_scan(const bf16_t* __restrict__ xbca, const bf16_t* __restrict__ proj, const float* __restrict__ projf,
                                                  const float* __restrict__ dt_bias, const float* __restrict__ a_log, const float* __restrict__ d_skip, float* __restrict__ yg) {
    const int blk = blockIdx.x, ps = blk & 3, h = (blk >> 2) & 3, b = blk >> 4;
    const int tid = threadIdx.x, pl = tid >> 4, ns = tid & 15, p = ps * 16 + pl, g = h >> 1;
    const float a = -__expf(a_log[h]), dtb = dt_bias[h], dsk = d_skip[h];
    float st[8];
#pragma unroll
    for (int i = 0; i < 8; ++i) st[i] = 0.f;
    const size_t m0 = (size_t)b * SEQ;
    for (int t = 0; t < SEQ; ++t) {
        const size_t m = m0 + t;
        const float dtv = softplus_f(projf[m * PROJF_W + PF_DT + h] + dtb);
        const float dA = __expf(dtv * a);
        const float xv = bf2f(xbca[m * 768 + h * 64 + p]);
        const us8 Bv = *(const us8*)(xbca + m * 768 + 256 + g * 128 + ns * 8);
        const us8 Cv = *(const us8*)(xbca + m * 768 + 512 + g * 128 + ns * 8);
        const float dx = dtv * xv;
        float y = 0.f;
#pragma unroll
        for (int i = 0; i < 8; ++i) { st[i] = dA * st[i] + dx * bf2f(Bv[i]); y += bf2f(Cv[i]) * st[i]; }
        y += __shfl_xor(y, 1); y += __shfl_xor(y, 2); y += __shfl_xor(y, 4); y += __shfl_xor(y, 8);
        if (ns == 0) {
            const float z = bf2f(proj[m * PROJ_W + PC_Z + h * 64 + p]);
            yg[m * 256 + h * 64 + p] = (y + dsk * xv) * silu_f(z);
        }
    }
}
__global__ __launch_bounds__(256) void k_group_norm(const float* __restrict__ yg, const float* __restrict__ g, int gsz_log2, bf16_t* __restrict__ ycat, int col0) {
    const int wave = (blockIdx.x * 256 + threadIdx.x) >> 6, lane = threadIdx.x & 63;
    const int m = wave >> 1, half = wave & 1;
    if (m >= M) return;
    const float v0 = yg[(size_t)m * 256 + half * 128 + lane * 2], v1 = yg[(size_t)m * 256 + half * 128 + lane * 2 + 1];
    float ss = v0 * v0 + v1 * v1;
    const int nl = (1 << gsz_log2) >> 1;
    for (int o = 1; o < nl; o <<= 1) ss += __shfl_xor(ss, o);
    const float r = rsqrtf(ss / (float)(1 << gsz_log2) + EPS);
    const int c = half * 128 + lane * 2;
    ycat[(size_t)m * DM + col0 + c] = f2bf(v0 * r * g[c]);
    ycat[(size_t)m * DM + col0 + c + 1] = f2bf(v1 * r * g[c + 1]);
}

__global__ __launch_bounds__(256) void k_mlstm_scan(const bf16_t* __restrict__ qka, const bf16_t* __restrict__ proj, const float* __restrict__ projf,
                                                    const float* __restrict__ ig_bias, const float* __restrict__ fg_bias, float* __restrict__ hg) {
    const int blk = blockIdx.x, es = blk & 3, h = (blk >> 2) & 3, b = blk >> 4;
    const int tid = threadIdx.x, el = tid >> 4, ds = tid & 15, e = es * 16 + el;
    const float igb = ig_bias[h], fgb = fg_bias[h];
    float C[4] = {0.f, 0.f, 0.f, 0.f}, nn[4] = {0.f, 0.f, 0.f, 0.f};
    const size_t m0 = (size_t)b * SEQ;
    for (int t = 0; t < SEQ; ++t) {
        const size_t m = m0 + t;
        const float f = sigmoid_f(projf[m * PROJF_W + PF_MF + h] + fgb);
        const float ig = __expf(projf[m * PROJF_W + PF_MI + h] + igb);
        const us4 qv = *(const us4*)(qka + m * 512 + h * 64 + ds * 4);
        const us4 kv = *(const us4*)(qka + m * 512 + 256 + h * 64 + ds * 4);
        const float v = bf2f(proj[m * PROJ_W + PC_MV + h * 64 + e]);
        float num = 0.f, den = 0.f;
#pragma unroll
        for (int i = 0; i < 4; ++i) {
            const float k = bf2f(kv[i]) * 0.125f, q = bf2f(qv[i]);
            C[i] = f * C[i] + ig * k * v; nn[i] = f * nn[i] + ig * k;
            num += q * C[i]; den += q * nn[i];
        }
        num += __shfl_xor(num, 1); num += __shfl_xor(num, 2); num += __shfl_xor(num, 4); num += __shfl_xor(num, 8);
        den += __shfl_xor(den, 1); den += __shfl_xor(den, 2); den += __shfl_xor(den, 4); den += __shfl_xor(den, 8);
        if (ds == 0) {
            const float o = sigmoid_f(bf2f(proj[m * PROJ_W + PC_MO + h * 64 + e]));
            hg[m * 256 + h * 64 + e] = o * num / fmaxf(fabsf(den), 1.f);
        }
    }
}

__global__ __launch_bounds__(256) void k_moba_kmean(const bf16_t* __restrict__ proj, float* __restrict__ kmean) {
    const int jg = blockIdx.x, c = threadIdx.x;
    float s = 0.f;
    for (int r = 0; r < 256; ++r) s += bf2f(proj[(size_t)(jg * 256 + r) * PROJ_W + PC_AK + c]);
    kmean[jg * 256 + c] = s * (1.f / 256.f);
}
__global__ __launch_bounds__(256) void k_moba_attn(const bf16_t* __restrict__ proj, const float* __restrict__ kmean, bf16_t* __restrict__ ycat) {
    __shared__ float km[32][64];
    __shared__ float Ks[32][64];
    __shared__ float Vs[32][64];
    const int blk = blockIdx.x, cur = blk & 31, h = (blk >> 5) & 3, b = blk >> 7;
    const int tid = threadIdx.x, t = cur * 256 + tid;
    const size_t mq = (size_t)b * SEQ + t;
    float q[64];
#pragma unroll
    for (int d8 = 0; d8 < 8; ++d8) { const us8 v = *(const us8*)(proj + mq * PROJ_W + PC_AQ + h * 64 + d8 * 8);
#pragma unroll
        for (int i = 0; i < 8; ++i) q[d8 * 8 + i] = bf2f(v[i]); }
    for (int i = tid; i < 32 * 64; i += 256) { const int j = i >> 6, d = i & 63; km[j][d] = kmean[(b * 32 + j) * 256 + h * 64 + d]; }
    __syncthreads();
    float v0 = -INFINITY, v1 = -INFINITY, v2 = -INFINITY; int i0 = -1, i1 = -1, i2 = -1;
    for (int j = 0; j < cur; ++j) {
        float gq = 0.f;
#pragma unroll
        for (int d = 0; d < 64; ++d) gq += q[d] * km[j][d];
        if (gq > v0) { v2 = v1; i2 = i1; v1 = v0; i1 = i0; v0 = gq; i0 = j; }
        else if (gq > v1) { v2 = v1; i2 = i1; v1 = gq; i1 = j; }
        else if (gq > v2) { v2 = gq; i2 = j; }
    }
    unsigned sel = 0u;
    if (i0 >= 0) sel |= 1u << i0;
    if (i1 >= 0) sel |= 1u << i1;
    if (i2 >= 0) sel |= 1u << i2;
    float o[64];
#pragma unroll
    for (int d = 0; d < 64; ++d) o[d] = 0.f;
    float mx = -INFINITY, l = 0.f;
    for (int jb = 0; jb <= cur; ++jb) {
        for (int kt = 0; kt < 8; ++kt) {
            __syncthreads();
            for (int i = tid; i < 32 * 64; i += 256) { const int r = i >> 6, d = i & 63; const size_t mk = (size_t)b * SEQ + jb * 256 + kt * 32 + r;
                Ks[r][d] = bf2f(proj[mk * PROJ_W + PC_AK + h * 64 + d]); Vs[r][d] = bf2f(proj[mk * PROJ_W + PC_AV + h * 64 + d]); }
            __syncthreads();
            const bool use = (jb == cur) || ((sel >> jb) & 1u);
            if (use) {
                for (int kk = 0; kk < 32; ++kk) {
                    const int key = jb * 256 + kt * 32 + kk;
                    if (key > t) break;
                    float s = 0.f;
#pragma unroll
                    for (int d = 0; d < 64; ++d) s += q[d] * Ks[kk][d];
                    if (s > mx) { const float f = exp2f(mx - s); l *= f;
#pragma unroll
                        for (int d = 0; d < 64; ++d) o[d] *= f;
                        mx = s; }
                    const float p = exp2f(s - mx); l += p;
#pragma unroll
                    for (int d = 0; d < 64; ++d) o[d] += p * Vs[kk][d];
                }
            }
        }
    }
    const float rl = 1.f / l;
#pragma unroll
    for (int d = 0; d < 64; ++d) ycat[mq * DM + 0 + h * 64 + d] = f2bf(o[d] * rl);
}

__global__ __launch_bounds__(256) void k_mla_prep(const bf16_t* __restrict__ proj, const float* __restrict__ projf, const int* __restrict__ positions,
                                                  const float* __restrict__ gq, const float* __restrict__ gkv, bf16_t* __restrict__ cqn, bf16_t* __restrict__ ckvn, bf16_t* __restrict__ km) {
    __shared__ float sh[4];
    const int m = blockIdx.x, tid = threadIdx.x;
    const float cq = bf2f(proj[(size_t)m * PROJ_W + PC_CQ + tid]);
    const float s1 = block_sum256(cq * cq, sh);
    cqn[(size_t)m * 256 + tid] = f2bf(cq * rsqrtf(s1 * (1.f / 256.f) + EPS) * gq[tid]);
    const float ck = tid < 128 ? projf[(size_t)m * PROJF_W + PF_CKV + tid] : 0.f;
    const float s2 = block_sum256(ck * ck, sh);
    if (tid < 128) ckvn[(size_t)m * 128 + tid] = f2bf(ck * rsqrtf(s2 * (1.f / 128.f) + EPS) * gkv[tid]);
    if (tid < 16) {
        const float pos = (float)positions[m];
        const float inv = powf(10000.f, -(float)(2 * tid) / 32.f);
        const float ang = pos * inv; float sn, cs; sincosf(ang, &sn, &cs);
        const float x1 = projf[(size_t)m * PROJF_W + PF_KR + tid], x2 = projf[(size_t)m * PROJF_W + PF_KR + 16 + tid];
        const bf16_t o1 = f2bf(x1 * cs - x2 * sn), o2 = f2bf(x2 * cs + x1 * sn);
#pragma unroll
        for (int h = 0; h < 4; ++h) { km[(size_t)m * 384 + h * 96 + 64 + tid] = o1; km[(size_t)m * 384 + h * 96 + 80 + tid] = o2; }
    }
}
__global__ __launch_bounds__(256) void k_mla_qfinish(const float* __restrict__ qraw, const int* __restrict__ positions, bf16_t* __restrict__ qm) {
    const size_t idx = (size_t)blockIdx.x * 256 + threadIdx.x;
    if (idx >= (size_t)M * 384) return;
    const int m = (int)(idx / 384), c = (int)(idx % 384), h = c / 96, d = c % 96;
    float v;
    if (d < 64) v = qraw[idx];
    else {
        const int i = (d - 64) & 15; const bool second = (d - 64) >= 16;
        const float pos = (float)positions[m];
        const float inv = powf(10000.f, -(float)(2 * i) / 32.f);
        float sn, cs; sincosf(pos * inv, &sn, &cs);
        const float x1 = qraw[(size_t)m * 384 + h * 96 + 64 + i], x2 = qraw[(size_t)m * 384 + h * 96 + 80 + i];
        v = second ? (x2 * cs + x1 * sn) : (x1 * cs - x2 * sn);
    }
    qm[idx] = f2bf(v * C2M);
}
__global__ __launch_bounds__(256) void k_mla_attn(const bf16_t* __restrict__ qm, const bf16_t* __restrict__ km, const bf16_t* __restrict__ vm, bf16_t* __restrict__ ycat) {
    __shared__ float Ks[32][96];
    __shared__ float Vs[32][64];
    const int blk = blockIdx.x, qb = 31 - (blk & 31), h = (blk >> 5) & 3, b = blk >> 7;
    const int tid = threadIdx.x, t = qb * 256 + tid;
    const size_t mq = (size_t)b * SEQ + t;
    float q[96];
#pragma unroll
    for (int d8 = 0; d8 < 12; ++d8) { const us8 v = *(const us8*)(qm + mq * 384 + h * 96 + d8 * 8);
#pragma unroll
        for (int i = 0; i < 8; ++i) q[d8 * 8 + i] = bf2f(v[i]); }
    float o[64];
#pragma unroll
    for (int d = 0; d < 64; ++d) o[d] = 0.f;
    float mx = -INFINITY, l = 0.f;
    const int ntiles = (qb + 1) * 8;
    for (int kt = 0; kt < ntiles; ++kt) {
        __syncthreads();
        for (int i = tid; i < 32 * 96; i += 256) { const int r = i / 96, d = i % 96; Ks[r][d] = bf2f(km[((size_t)b * SEQ + kt * 32 + r) * 384 + h * 96 + d]); }
        for (int i = tid; i < 32 * 64; i += 256) { const int r = i >> 6, d = i & 63; Vs[r][d] = bf2f(vm[((size_t)b * SEQ + kt * 32 + r) * 256 + h * 64 + d]); }
        __syncthreads();
        for (int kk = 0; kk < 32; ++kk) {
            const int key = kt * 32 + kk;
            if (key > t) break;
            float s = 0.f;
#pragma unroll
            for (int d = 0; d < 96; ++d) s += q[d] * Ks[kk][d];
            if (s > mx) { const float f = exp2f(mx - s); l *= f;
#pragma unroll
                for (int d = 0; d < 64; ++d) o[d] *= f;
                mx = s; }
            const float p = exp2f(s - mx); l += p;
#pragma unroll
            for (int d = 0; d < 64; ++d) o[d] += p * Vs[kk][d];
        }
    }
    const float rl = 1.f / l;
#pragma unroll
    for (int d = 0; d < 64; ++d) ycat[mq * DM + 768 + h * 64 + d] = f2bf(o[d] * rl);
}

__global__ __launch_bounds__(256) void k_moe_naive(float* x, const float* __restrict__ gn, const float* __restrict__ wg, const float* __restrict__ bg,
                                                   const float* __restrict__ wr, const float* __restrict__ br, const float* __restrict__ wgate, const float* __restrict__ wup, const float* __restrict__ wdown) {
    __shared__ float h2[1024];
    __shared__ float red[4][20];
    __shared__ float sh[4];
    __shared__ float hid[2][256];
    __shared__ int sE[2]; __shared__ float sW[2];
    __shared__ float slg[20]; __shared__ float spe[4];
    const int m = blockIdx.x, tid = threadIdx.x, lane = tid & 63, wv = tid >> 6;
    const float4 v = ((const float4*)(x + (size_t)m * DM))[tid];
    const float ss = block_sum256(v.x * v.x + v.y * v.y + v.z * v.z + v.w * v.w, sh);
    const float r = rsqrtf(ss * (1.f / DM) + EPS);
    const float4 gg = ((const float4*)gn)[tid];
    const float hv[4] = {v.x * r * gg.x, v.y * r * gg.y, v.z * r * gg.z, v.w * r * gg.w};
#pragma unroll
    for (int i = 0; i < 4; ++i) h2[tid * 4 + i] = hv[i];
    float part[20];
#pragma unroll
    for (int j = 0; j < 20; ++j) part[j] = 0.f;
#pragma unroll
    for (int i = 0; i < 4; ++i) { const int d = tid * 4 + i;
#pragma unroll
        for (int j = 0; j < 4; ++j) part[j] += hv[i] * wg[d * 4 + j];
#pragma unroll
        for (int j = 0; j < 16; ++j) part[4 + j] += hv[i] * wr[d * 16 + j]; }
#pragma unroll
    for (int j = 0; j < 20; ++j) { const float s = wave_sum(part[j]); if (lane == 0) red[wv][j] = s; }
    __syncthreads();
    if (tid < 20) slg[tid] = red[0][tid] + red[1][tid] + red[2][tid] + red[3][tid] + (tid < 4 ? bg[tid] : br[tid - 4]);
    __syncthreads();
    if (tid == 0) {
        int gi = 0; float gm = slg[0];
        for (int j = 1; j < 4; ++j) if (slg[j] > gm) { gm = slg[j]; gi = j; }
        float gs = 0.f; for (int j = 0; j < 4; ++j) gs += __expf(slg[j] - gm);
        const float g_w = 1.f / gs;
        float em = -INFINITY;
        for (int j = 0; j < 4; ++j) em = fmaxf(em, slg[4 + gi * 4 + j]);
        float es = 0.f;
        for (int j = 0; j < 4; ++j) { const float p = __expf(slg[4 + gi * 4 + j] - em); spe[j] = p; es += p; }
        int e0 = 0; float p0 = spe[0];
        for (int j = 1; j < 4; ++j) if (spe[j] > p0) { p0 = spe[j]; e0 = j; }
        int e1 = -1; float p1 = -1.f;
        for (int j = 0; j < 4; ++j) if (j != e0 && spe[j] > p1) { p1 = spe[j]; e1 = j; }
        p0 /= es; p1 /= es;
        const float sw = p0 + p1;
        sE[0] = gi * 4 + e0; sE[1] = gi * 4 + e1; sW[0] = g_w * p0 / sw; sW[1] = g_w * p1 / sw;
    }
    __syncthreads();
#pragma unroll
    for (int j = 0; j < 2; ++j) {
        const int E = sE[j];
        const float* G = wgate + (size_t)E * 1024 * 256 + tid; const float* U = wup + (size_t)E * 1024 * 256 + tid;
        float ga = 0.f, ua = 0.f;
        for (int d = 0; d < 1024; ++d) { const float hd = h2[d]; ga += hd * G[(size_t)d * 256]; ua += hd * U[(size_t)d * 256]; }
        hid[j][tid] = silu_f(ga) * ua * sW[j];
    }
    __syncthreads();
    float out[4] = {0.f, 0.f, 0.f, 0.f};
#pragma unroll
    for (int j = 0; j < 2; ++j) {
        const float* Dn = wdown + (size_t)sE[j] * 256 * 1024;
        for (int f = 0; f < 256; ++f) { const float hf = hid[j][f];
#pragma unroll
            for (int i = 0; i < 4; ++i) out[i] += hf * Dn[(size_t)f * 1024 + tid + 256 * i]; }
    }
#pragma unroll
    for (int i = 0; i < 4; ++i) x[(size_t)m * DM + tid + 256 * i] += out[i];
}

#define ATOMIC_ROUTE 1
#define ST_WT_OFF 1
#define LOADS_OFF 1
#define PADZERO_OFF 1
#define NO_ENTRY_BARRIER 1
#define NO_EXIT_BARRIER 1
namespace pg8 {
#define PG8_LAS __attribute__((address_space(3)))
typedef short bf16x8 __attribute__((ext_vector_type(8)));
typedef float f32x4 __attribute__((ext_vector_type(4)));
typedef unsigned u32x4 __attribute__((ext_vector_type(4)));
constexpr int BM = 256, BK = 64, HALF = 128, HTB = HALF * BK * 2  , STAGE_BYTES = 8 * HTB, NXCD = 8, WGM = 8;

__host__ __device__ __forceinline__ int lds_byte(int r, int c) { const int st = (r >> 4) * 2 + (c >> 5), rr = r & 15, cc = c & 31, ob = rr * 64 + cc * 2; return st * 1024 + (ob ^ (((ob >> 9) & 1) << 5)); }
__host__ __device__ __forceinline__ void stage_rc(int b, int& R, int& C) { const int st = b / 1024, sb = b % 1024, swz = sb ^ (((sb >> 9) & 1) << 5); R = (st >> 1) * 16 + swz / 64; C = (st & 1) * 32 + (swz % 64) / 2; }
__host__ __device__ __forceinline__ int perm32(int rho) { const int n = rho >> 4, i = rho & 15; return 8 * (i >> 2) + 4 * n + (i & 3); }

struct Unit { int pm, pn; };
struct Dims { int K, lda, ldb; };

struct StaticOrder {
    const bf16_t* A; const bf16_t* Bt; int lda, ldb, K;
    int nM, nN, nwg, G, c;
    __device__ void init(const bf16_t* A_, const bf16_t* Bt_, int lda_, int ldb_, int K_, int Mrows, int N, int G_, int c_) { A = A_; Bt = Bt_; lda = lda_; ldb = ldb_; K = K_; nM = Mrows / BM; nN = N / BM; nwg = nM * nN; G = G_; c = c_; }
    __device__ bool next(int i, Unit& u) const {
        const long L = (long)i * G + c; if (L >= nwg) return false;
        int wgid = (int)L; { const int q = nwg / NXCD, r = nwg % NXCD, xcd = wgid % NXCD, off = wgid / NXCD; wgid = (xcd < r ? xcd * (q + 1) : r * (q + 1) + (xcd - r) * q) + off; }
        const int nig = WGM * nN, gid = wgid / nig, fm = gid * WGM, gsz = (nM - fm) < WGM ? (nM - fm) : WGM;
        u.pm = fm + ((wgid % nig) % gsz); u.pn = (wgid % nig) / gsz; return true;
    }
    __device__ __forceinline__ const char* a_ptr(const Unit& u) const { return (const char*)A + (size_t)u.pm * BM * lda * 2; }
    __device__ __forceinline__ const char* b_ptr(const Unit& u, int half) const { return (const char*)Bt + (size_t)u.pn * BM * ldb * 2 + (half ? (size_t)(K / 2) * 2 : 0); }
};

__device__ __forceinline__ unsigned cvt_pk_bf16(float lo, float hi) { unsigned r; asm volatile("v_cvt_pk_bf16_f32 %0, %1, %2" : "=v"(r) : "v"(lo), "v"(hi)); return r; }

template <class Epi, class Sched>
__device__ __forceinline__ void gemm_phase(PG8_LAS unsigned char* lds, const int wid, const Dims g, const Sched& S, const Epi& E) {
    int lane = (int)__builtin_amdgcn_mbcnt_hi(~0u, __builtin_amdgcn_mbcnt_lo(~0u, 0u)); asm volatile("" : "+v"(lane));
    const int tid = wid * 64 + lane, wr = wid >> 2, wc = wid & 3, fr = lane & 15, fq = lane >> 4;
    int K = g.K, lda = g.lda, ldb = g.ldb; asm volatile("" : "+s"(K), "+s"(lda), "+s"(ldb));
    const int nt = K / BK, nth = nt / 2;
    unsigned voffA[2], voffB[2];
#pragma unroll
    for (int i = 0; i < 2; ++i) { int R, C; stage_rc(tid * 16 + i * 8192, R, C); const int Rb = (R & ~31) + perm32(R & 31);
        voffA[i] = (unsigned)(R * lda + C) * 2u; voffB[i] = (unsigned)(Rb * ldb + C) * 2u; }
    const size_t kstep = (size_t)(BK * 2);
    const size_t hstepA = (size_t)HALF * lda * 2, hstepB = (size_t)HALF * ldb * 2;
    const unsigned ldsw = (unsigned)wid * 1024u;
    const int aoff = lds_byte(wr * 64 + fr, fq * 8), boff = lds_byte(wc * 32 + fr, fq * 8);
#define PG8_SA(b, h) (((b) * 2 + (h)) * HTB)
#define PG8_SB(b, h) ((4 + (b) * 2 + (h)) * HTB)
#define PG8_STAGE(bufoff, gbase, voff) do { _Pragma("unroll") for (int _i = 0; _i < 2; ++_i) \
        __builtin_amdgcn_global_load_lds((const unsigned*)((const char*)(gbase) + (voff)[_i]), (PG8_LAS unsigned*)(lds + (bufoff) + ldsw + _i * 8192), 16, 0, 0); } while (0)
#define PG8_LDA(dst, b, h) do { _Pragma("unroll") for (int m = 0; m < 4; ++m) _Pragma("unroll") for (int k = 0; k < 2; ++k) dst[m][k] = *(const PG8_LAS bf16x8*)(lds + PG8_SA(b, h) + aoff + m * 2048 + k * 1024); } while (0)
#define PG8_LDB(dst, b, h) do { _Pragma("unroll") for (int n = 0; n < 2; ++n) _Pragma("unroll") for (int k = 0; k < 2; ++k) dst[n][k] = *(const PG8_LAS bf16x8*)(lds + PG8_SB(b, h) + boff + n * 2048 + k * 1024); } while (0)
#define PG8_MMA(ai, bj, At, Bt) do { __builtin_amdgcn_s_setprio(1); _Pragma("unroll") for (int m = 0; m < 4; ++m) _Pragma("unroll") for (int n = 0; n < 2; ++n) _Pragma("unroll") for (int k = 0; k < 2; ++k) \
        acc[ai][bj][m][n] = __builtin_amdgcn_mfma_f32_16x16x32_bf16(Bt[n][k], At[m][k], acc[ai][bj][m][n], 0, 0, 0); __builtin_amdgcn_s_setprio(0); } while (0)
#define PG8_WAIT_V(n) asm volatile("s_waitcnt vmcnt(" #n ")" ::: "memory")
#define PG8_WAIT_L(n) asm volatile("s_waitcnt lgkmcnt(" #n ")" ::: "memory")
#define PG8_BAR __builtin_amdgcn_s_barrier()
#define PG8_SCHED __builtin_amdgcn_sched_barrier(0)
#define PG8_BP(b0, b1, t) (((t) < nth) ? ((b0) + (size_t)(t) * kstep) : ((b1) + (size_t)((t) - nth) * kstep))
    Unit cur, nxt; int ui = 0;
    if (!S.next(0, cur)) return;
    f32x4 acc[2][2][4][2];
#pragma unroll
    for (int a = 0; a < 2; ++a)
#pragma unroll
        for (int b = 0; b < 2; ++b)
#pragma unroll
            for (int m = 0; m < 4; ++m)
#pragma unroll
                for (int n = 0; n < 2; ++n) acc[a][b][m][n] = (f32x4){0.f, 0.f, 0.f, 0.f};
    bf16x8 At[4][2], B0[2][2], B1[2][2];
    const char* cA = S.a_ptr(cur); const char* cB0 = S.b_ptr(cur, 0); const char* cB1 = S.b_ptr(cur, 1);
    {
        const char* b0 = PG8_BP(cB0, cB1, 0); const char* b1 = PG8_BP(cB0, cB1, 1);
        PG8_STAGE(PG8_SB(0, 0), b0, voffB); PG8_STAGE(PG8_SB(0, 1), b0 + hstepB, voffB); PG8_STAGE(PG8_SA(0, 0), cA, voffA); PG8_STAGE(PG8_SA(0, 1), cA + hstepA, voffA);
        if (wr == 1) PG8_BAR;
        PG8_WAIT_V(2); PG8_BAR;
        PG8_STAGE(PG8_SB(1, 0), b1, voffB); PG8_STAGE(PG8_SA(1, 0), cA + kstep, voffA); PG8_STAGE(PG8_SB(1, 1), b1 + hstepB, voffB);
        PG8_WAIT_V(6); PG8_BAR;
    }
    for (;;) {
        const bool has_next = S.next(ui + 1, nxt);
        const char* nA = has_next ? S.a_ptr(nxt) : cA; const char* nB0 = has_next ? S.b_ptr(nxt, 0) : cB0; const char* nB1 = has_next ? S.b_ptr(nxt, 1) : cB1;
        for (int t = 0; t < nt; t += 2) {
            const bool last = (t == nt - 2);
            const char* a1 = cA + (size_t)(t + 1) * kstep;
            const char* a2 = last ? nA : cA + (size_t)(t + 2) * kstep;
            const char* a3 = a2 + kstep;
            const char* b2 = last ? PG8_BP(nB0, nB1, 0) : PG8_BP(cB0, cB1, t + 2);
            const char* b3 = last ? PG8_BP(nB0, nB1, 1) : PG8_BP(cB0, cB1, t + 3);
            PG8_LDB(B0, 0, 0); PG8_LDB(B1, 0, 1); PG8_SCHED; PG8_LDA(At, 0, 0); PG8_STAGE(PG8_SA(1, 1), a1 + hstepA, voffA);
            PG8_WAIT_V(8); PG8_WAIT_L(0); PG8_BAR; PG8_MMA(0, 0, At, B0); PG8_MMA(0, 1, At, B1); PG8_BAR; PG8_SCHED;
            PG8_LDA(At, 0, 1); PG8_STAGE(PG8_SB(0, 0), b2, voffB); PG8_STAGE(PG8_SB(0, 1), b2 + hstepB, voffB); PG8_STAGE(PG8_SA(0, 0), a2, voffA);
            PG8_WAIT_V(8); PG8_WAIT_L(0); PG8_BAR; PG8_MMA(1, 0, At, B0); PG8_MMA(1, 1, At, B1); PG8_BAR; PG8_SCHED;
            PG8_LDB(B0, 1, 0); PG8_LDB(B1, 1, 1); PG8_SCHED; PG8_LDA(At, 1, 0); PG8_STAGE(PG8_SA(0, 1), a2 + hstepA, voffA);
            PG8_WAIT_V(8); PG8_WAIT_L(0); PG8_BAR; PG8_MMA(0, 0, At, B0); PG8_MMA(0, 1, At, B1); PG8_BAR; PG8_SCHED;
            PG8_LDA(At, 1, 1); PG8_STAGE(PG8_SB(1, 0), b3, voffB); PG8_STAGE(PG8_SB(1, 1), b3 + hstepB, voffB); PG8_STAGE(PG8_SA(1, 0), a3, voffA);
            PG8_WAIT_V(8); PG8_WAIT_L(0); PG8_BAR; PG8_MMA(1, 0, At, B0); PG8_MMA(1, 1, At, B1); PG8_BAR; PG8_SCHED;
        }
        if (wr == 0) PG8_BAR;
        E(acc, cur, wr, wc, fr, fq);
        if (!has_next) break;
#pragma unroll
        for (int a = 0; a < 2; ++a)
#pragma unroll
            for (int b = 0; b < 2; ++b)
#pragma unroll
                for (int m = 0; m < 4; ++m)
#pragma unroll
                    for (int n = 0; n < 2; ++n) acc[a][b][m][n] = (f32x4){0.f, 0.f, 0.f, 0.f};
        cur = nxt; cA = nA; cB0 = nB0; cB1 = nB1; ++ui;
        if (wr == 1) PG8_BAR;
    }
    PG8_WAIT_V(0);
    PG8_BAR;
#undef PG8_SA
#undef PG8_SB
#undef PG8_STAGE
#undef PG8_LDA
#undef PG8_LDB
#undef PG8_MMA
#undef PG8_WAIT_V
#undef PG8_WAIT_L
#undef PG8_BAR
#undef PG8_SCHED
#undef PG8_BP
}
}
#define GAS __attribute__((address_space(1)))
#define LAS __attribute__((address_space(3)))
typedef GAS unsigned gu32;
#define RLX_AGENT __ATOMIC_RELAXED, __HIP_MEMORY_SCOPE_AGENT
#define XB_TMO      128
#define XB_XCNT(j)  (256  + 64 * (j))
#define XB_XSUB(j)  (1280 + 64 * (j))
#define XB_XGEN(j)  (2304 + 64 * (j))
#define XB_TOP      3328
#define XB_TOPGEN   3392
#define XCD_BAR_WORDS 3456
#define XB_SPIN_CAP (1u << 18)

__device__ __forceinline__ unsigned xb_ld(unsigned* p)              { return __hip_atomic_load(p, __ATOMIC_RELAXED, __HIP_MEMORY_SCOPE_AGENT); }
__device__ __forceinline__ unsigned xb_add(unsigned* p, unsigned v) { return __hip_atomic_fetch_add(p, v, __ATOMIC_RELAXED, __HIP_MEMORY_SCOPE_AGENT); }
__device__ __forceinline__ unsigned xb_xcc_id() { return (unsigned)__builtin_amdgcn_s_getreg((3 << 11) | 20) & 0xFu; }
#define XB_SPIN(cond, bar) do { unsigned _sp = 0; while (cond) { __builtin_amdgcn_s_sleep(1); \
    if ((++_sp & 255u) == 0u) { if (xb_ld(&(bar)[XB_TMO])) break; if (_sp > XB_SPIN_CAP) { atomicAdd(&(bar)[XB_TMO], 1u); break; } } } } while (0)

struct XcdBarrier {
    unsigned* bar; unsigned x;
    unsigned w0;
    volatile LAS unsigned* st;
};

__device__ __forceinline__ XcdBarrier xcd_barrier_post(unsigned* bar, volatile LAS unsigned* st) {
    XcdBarrier b; b.bar = bar; b.x = xb_xcc_id(); b.st = st; b.w0 = (__builtin_amdgcn_readfirstlane(threadIdx.x >> 6) == 0) ? 1u : 0u;
    if (threadIdx.x == 0) (void)xb_add(&bar[XB_XCNT(b.x)], 1u);
    return b;
}
__device__ __forceinline__ void xcd_barrier_complete(unsigned* bar, unsigned x, unsigned& nloc, unsigned& nx) {
    const unsigned G = gridDim.x * gridDim.y * gridDim.z;
    unsigned sum, cnt, mine, sp = 0u;
    for (;;) {
        sum = 0u; cnt = 0u; mine = 0u;
#pragma unroll
        for (unsigned j = 0; j < 16; ++j) { const unsigned c = xb_ld(&bar[XB_XCNT(j)]); sum += c; cnt += (c > 0u) ? 1u : 0u; mine = (j == x) ? c : mine; }
        if (sum == G) break;
        __builtin_amdgcn_s_sleep(1);
        if ((++sp & 255u) == 0u) { if (xb_ld(&bar[XB_TMO])) break; if (sp > XB_SPIN_CAP) { atomicAdd(&bar[XB_TMO], 1u); break; } }
    }
    nloc = mine > 0u ? mine : 1u; nx = cnt > 0u ? cnt : 1u;
}

__device__ __forceinline__ void xcd_barrier(const XcdBarrier& b) {
    asm volatile("s_waitcnt vmcnt(0)" ::: "memory");
    __syncthreads();
    if (b.w0 && __builtin_amdgcn_mbcnt_hi(~0u, __builtin_amdgcn_mbcnt_lo(~0u, 0u)) == 0u) {
        unsigned* bar = b.bar;
        __builtin_amdgcn_s_waitcnt(0);
        unsigned nloc = b.st[0], nx = b.st[1];
        if (nloc == 0u) { xcd_barrier_complete(bar, b.x, nloc, nx); b.st[0] = nloc; b.st[1] = nx; }
        const unsigned old = xb_add(&bar[XB_XSUB(b.x)], 1u);
        const unsigned gen = old / nloc;
        if (old + 1u == (gen + 1u) * nloc) {
            __builtin_amdgcn_fence(__ATOMIC_RELEASE, "agent");
            asm volatile("s_waitcnt vmcnt(0)" ::: "memory");
            const unsigned og = xb_add(&bar[XB_TOP], 1u);
            const unsigned tg = og / nx;
            if (og + 1u == (tg + 1u) * nx) xb_add(&bar[XB_TOPGEN], 1u);
            else XB_SPIN(xb_ld(&bar[XB_TOPGEN]) == tg, bar);
            __builtin_amdgcn_fence(__ATOMIC_ACQUIRE, "agent");
            xb_add(&bar[XB_XGEN(b.x)], 1u);
            asm volatile("s_waitcnt vmcnt(0)" ::: "memory");
        } else {
            XB_SPIN(xb_ld(&bar[XB_XGEN(b.x)]) == gen, bar);
            __builtin_amdgcn_fence(__ATOMIC_ACQUIRE, "agent");
            asm volatile("s_waitcnt vmcnt(0)" ::: "memory");
        }
    }
    __syncthreads();
}
constexpr int NWAVES = 8;
constexpr size_t MiB = 1u << 20;
constexpr size_t WS_CTL = 0, CTL_ZERO_BYTES = 1 * MiB;
constexpr size_t WS_KMEAN = 1 * MiB;
constexpr size_t WS_WIN = 2 * MiB, WS_WOUT = 9 * MiB, WS_WUQ = 11 * MiB, WS_WUKV = 11 * MiB + 512 * 1024;
constexpr size_t WS_ACT = 12 * MiB, WS_PROJ = 44 * MiB, WS_PROJF = 140 * MiB, WS_XBCA = 156 * MiB, WS_QKA = 180 * MiB, WS_QM = 196 * MiB, WS_KM = 208 * MiB, WS_VM = 220 * MiB;
constexpr size_t WS_PREVT = 242 * MiB, WS_CST = 250 * MiB, WS_NST = 254 * MiB;
constexpr size_t WS_ROPE = 228 * MiB, WS_CQN = 230 * MiB, WS_CKVN = 238 * MiB, WS_ST = 230 * MiB  , WS_END = 256 * MiB;
constexpr int CW_BAR = 4096;
constexpr int MAX_BAR_REGIONS = 24;
static_assert((CW_BAR + MAX_BAR_REGIONS * 3456) * 4 <= (int)CTL_ZERO_BYTES, "CTL words inside the memset region");
constexpr int PROJ_N = 3328;
constexpr int RING_OFF = 0, RING_BYTES = 131072, LDSCTL_OFF = RING_BYTES, MISC_OFF = LDSCTL_OFF + 320, PTR_OFF = MISC_OFF + 128, LDS_BYTES = 147456;

__host__ __device__ inline int src_col(int c) {
    if (c < 1792) return c;
    if (c < 2304) return 1796 + (c - 1792);
    if (c < 2560) return 2308 + (c - 2304);
    if (c < 2816) return 2572 + (c - 2560);
    if (c < 3072) return 2828 + (c - 2816);
    const int f = c - 3072;
    if (f < 128) return 3084 + f;
    if (f < 160) return 3212 + (f - 128);
    if (f < 164) return 1792 + (f - 160);
    if (f < 168) return 2564 + (f - 164);
    if (f < 172) return 2568 + (f - 168);
    return -1;
}

typedef unsigned v4u __attribute__((ext_vector_type(4)));
typedef float f32x4 __attribute__((ext_vector_type(4)));
#define LDS_WAIT() asm volatile("s_waitcnt lgkmcnt(0)" ::: "memory")
#define VM_WAIT() asm volatile("s_waitcnt vmcnt(0)" ::: "memory")
__device__ __forceinline__ unsigned pk2(float lo, float hi) { return (unsigned)f2bf(lo) | ((unsigned)f2bf(hi) << 16); }

__device__ __forceinline__ const float* in_ptr(LAS unsigned char* lds, int i) {
    const unsigned long long v = ((const LAS unsigned long long*)(lds + PTR_OFF))[i];
    const unsigned lo = __builtin_amdgcn_readfirstlane((unsigned)v), hi = __builtin_amdgcn_readfirstlane((unsigned)(v >> 32));
    return (const float*)(((unsigned long long)hi << 32) | lo);
}
#ifdef ST_WT_OFF
__device__ __forceinline__ void st_wt(float* p, float v) { *p = v; }
__device__ __forceinline__ void st_wt(int* p, int v) { *p = v; }
#else
__device__ __forceinline__ void st_wt(float* p, float v) { __hip_atomic_store(p, v, __ATOMIC_RELAXED, __HIP_MEMORY_SCOPE_AGENT); }
__device__ __forceinline__ void st_wt(int* p, int v) { __hip_atomic_store(p, v, __ATOMIC_RELAXED, __HIP_MEMORY_SCOPE_AGENT); }
#endif
struct Args {
    const float* in[29]; float* out; unsigned char* ws; int ph_lo, ph_hi, bli, pad;
};

struct MapInProj { const float* W; __device__ const float* ptr(int) const { return W; } __device__ int col(int n) const { return src_col(n); } __device__ float scale(int n) const { return n < 256 ? C2A : 1.f; } };
struct MapPlain { const float* W; int ncols; float sc; __device__ const float* ptr(int) const { return W; } __device__ int col(int n) const { return n < ncols ? n : -1; } __device__ float scale(int) const { return sc; } };
template <class Map>
__device__ __forceinline__ void conv_item(const Map& mp, int ldw, int K, bf16_t* WT, int nblk, LAS float* scr, int item, int lane) {
    const int kb = item / nblk, nb = item % nblk, k0 = 64 * kb, n0 = 32 * nb;
    const int c4 = lane & 7, kr = lane >> 3;
    const int nd = n0 + 4 * c4; const int sc = mp.col(nd); const float scl = mp.scale(nd); const float* base = mp.ptr(nd);
    f32x4 v[8];
#pragma unroll
    for (int i = 0; i < 8; ++i) v[i] = sc >= 0 ? __builtin_nontemporal_load((const GAS f32x4*)(base + (size_t)(k0 + 8 * i + kr) * ldw + sc)) : (f32x4){0.f, 0.f, 0.f, 0.f};
#pragma unroll
    for (int i = 0; i < 8; ++i) { LAS float* d = scr + (8 * i + kr) * 33 + 4 * c4; d[0] = v[i].x * scl; d[1] = v[i].y * scl; d[2] = v[i].z * scl; d[3] = v[i].w * scl; }
    LDS_WAIT(); asm volatile("" ::: "memory");
    const int c = lane & 7;
#pragma unroll
    for (int j = 0; j < 4; ++j) { const int n = (lane >> 3) + 8 * j; const LAS float* s = scr + (8 * c) * 33 + n;
        v4u o; o.x = pk2(s[0 * 33], s[1 * 33]); o.y = pk2(s[2 * 33], s[3 * 33]); o.z = pk2(s[4 * 33], s[5 * 33]); o.w = pk2(s[6 * 33], s[7 * 33]);
        *(GAS v4u*)(WT + (size_t)(n0 + n) * K + k0 + 8 * c) = o; }
    LDS_WAIT(); asm volatile("" ::: "memory");
}
__device__ __forceinline__ void rms_row_to_bf16(const float* xrow, const float* g, bf16_t* orow, float* xcopy, int lane) {
    const GAS f32x4* xr = (const GAS f32x4*)xrow + lane; const GAS f32x4* gr = (const GAS f32x4*)g + lane;
    f32x4 v[4]; float s = 0.f;
#pragma unroll
    for (int j = 0; j < 4; ++j) { v[j] = __builtin_nontemporal_load(xr + 64 * j); s += (v[j].x * v[j].x + v[j].y * v[j].y) + (v[j].z * v[j].z + v[j].w * v[j].w); }
    const float rstd = rsqrtf(wave_sum(s) * (1.f / DM) + EPS);
    if (xcopy) { GAS f32x4* xc = (GAS f32x4*)xcopy + lane;
#pragma unroll
        for (int j = 0; j < 4; ++j) xc[64 * j] = v[j]; }
    GAS unsigned long long* o8 = (GAS unsigned long long*)orow + lane;
#pragma unroll
    for (int j = 0; j < 4; ++j) { const f32x4 gg = gr[64 * j];
        o8[64 * j] = (unsigned long long)pk2(v[j].x * rstd * gg.x, v[j].y * rstd * gg.y) | ((unsigned long long)pk2(v[j].z * rstd * gg.z, v[j].w * rstd * gg.w) << 32); }
}
__device__ __forceinline__ void rms_row_to_f32(const float* xrow, const float* g, float* orow, int lane) {
    const GAS f32x4* xr = (const GAS f32x4*)xrow + lane; const GAS f32x4* gr = (const GAS f32x4*)g + lane;
    f32x4 v[4]; float s = 0.f;
#pragma unroll
    for (int j = 0; j < 4; ++j) { v[j] = __builtin_nontemporal_load(xr + 64 * j); s += (v[j].x * v[j].x + v[j].y * v[j].y) + (v[j].z * v[j].z + v[j].w * v[j].w); }
    const float rstd = rsqrtf(wave_sum(s) * (1.f / DM) + EPS);
    GAS f32x4* o = (GAS f32x4*)orow + lane;
#pragma unroll
    for (int j = 0; j < 4; ++j) { const f32x4 gg = gr[64 * j]; __builtin_nontemporal_store((f32x4){v[j].x * rstd * gg.x, v[j].y * rstd * gg.y, v[j].z * rstd * gg.z, v[j].w * rstd * gg.w}, o + 64 * j); }
}

struct EpiInProj {
    bf16_t* proj; float* projf;
    __device__ __forceinline__ void operator()(const pg8::f32x4 (&acc)[2][2][4][2], const pg8::Unit& u, int wr, int wc, int fr, int fq) const {
        const int row0 = u.pm * 256 + wr * 64 + fr, col0 = wc * 32 + 8 * fq;
        if (u.pn < 12) {
#pragma unroll
            for (int ai = 0; ai < 2; ++ai)
#pragma unroll
                for (int m = 0; m < 4; ++m) { bf16_t* rowp = proj + (size_t)(row0 + ai * 128 + m * 16) * PROJ_W + u.pn * 256 + col0;
#pragma unroll
                    for (int bj = 0; bj < 2; ++bj) { const pg8::f32x4 v0 = acc[ai][bj][m][0], v1 = acc[ai][bj][m][1]; pg8::u32x4 w;
                        w.x = pg8::cvt_pk_bf16(v0[0], v0[1]); w.y = pg8::cvt_pk_bf16(v0[2], v0[3]); w.z = pg8::cvt_pk_bf16(v1[0], v1[1]); w.w = pg8::cvt_pk_bf16(v1[2], v1[3]);
                        *(pg8::u32x4*)(rowp + bj * 128) = w; } }
        } else {
#pragma unroll
            for (int ai = 0; ai < 2; ++ai)
#pragma unroll
                for (int m = 0; m < 4; ++m) { float* rowp = projf + (size_t)(row0 + ai * 128 + m * 16) * PROJF_W + col0;
#pragma unroll
                    for (int bj = 0; bj < 2; ++bj) { *(pg8::f32x4*)(rowp + bj * 128) = acc[ai][bj][m][0]; *(pg8::f32x4*)(rowp + bj * 128 + 4) = acc[ai][bj][m][1]; } }
        }
    }
};
struct EpiResidualF32 {
    float* x; const float* src;
    __device__ __forceinline__ void operator()(const pg8::f32x4 (&acc)[2][2][4][2], const pg8::Unit& u, int wr, int wc, int fr, int fq) const {
        const int row0 = u.pm * 256 + wr * 64 + fr, col0 = u.pn * 256 + wc * 32 + 8 * fq;
#pragma unroll
        for (int ai = 0; ai < 2; ++ai)
#pragma unroll
            for (int m = 0; m < 4; ++m) { float* rowp = x + (size_t)(row0 + ai * 128 + m * 16) * DM + col0; const float* srcp = src + (size_t)(row0 + ai * 128 + m * 16) * DM + col0;
#pragma unroll
                for (int bj = 0; bj < 2; ++bj) { pg8::f32x4* p = (pg8::f32x4*)(rowp + bj * 128); const GAS pg8::f32x4* q = (const GAS pg8::f32x4*)(srcp + bj * 128); const pg8::f32x4 a = q[0] + acc[ai][bj][m][0], b = q[1] + acc[ai][bj][m][1]; p[0] = a; p[1] = b; }
                asm volatile("" ::: "memory"); }
    }
};


struct EpiMlaQ {
    bf16_t* qm; const float* rope;
    __device__ __forceinline__ void operator()(const pg8::f32x4 (&acc)[2][2][4][2], const pg8::Unit& u, int wr, int wc, int fr, int fq) const {
        const int row0 = u.pm * 256 + wr * 64 + fr;
#pragma unroll
        for (int bj = 0; bj < 2; ++bj) {
            const int colg = u.pn * 256 + bj * 128 + wc * 32;
            if (colg >= 384) continue;
            const bool is_rope = ((colg >> 5) % 3) == 2;
#pragma unroll
            for (int ai = 0; ai < 2; ++ai)
#pragma unroll
                for (int m = 0; m < 4; ++m) {
                    const int row = row0 + ai * 128 + m * 16;
                    pg8::f32x4 v0 = acc[ai][bj][m][0], v1 = acc[ai][bj][m][1];
                    if (is_rope) {
                        pg8::f32x4 w0, w1;
#pragma unroll
                        for (int j = 0; j < 4; ++j) { w0[j] = __shfl_xor(v0[j], 32); w1[j] = __shfl_xor(v1[j], 32); }
                        const int i0 = (8 * fq) & 15;
                        const float* rp = rope + (size_t)row * 32 + i0;
                        const pg8::f32x4 c0 = *(const pg8::f32x4*)rp, c1 = *(const pg8::f32x4*)(rp + 4), s0 = *(const pg8::f32x4*)(rp + 16), s1 = *(const pg8::f32x4*)(rp + 20);
                        if (fq < 2) { v0 = v0 * c0 - w0 * s0; v1 = v1 * c1 - w1 * s1; } else { v0 = v0 * c0 + w0 * s0; v1 = v1 * c1 + w1 * s1; }
                    }
                    pg8::u32x4 w; w.x = pg8::cvt_pk_bf16(v0[0], v0[1]); w.y = pg8::cvt_pk_bf16(v0[2], v0[3]); w.z = pg8::cvt_pk_bf16(v1[0], v1[1]); w.w = pg8::cvt_pk_bf16(v1[2], v1[3]);
                    *(pg8::u32x4*)(qm + (size_t)row * 384 + colg + 8 * fq) = w;
                }
        }
    }
};
struct EpiMlaKVf {
    bf16_t* km; bf16_t* vm;
    __device__ __forceinline__ void operator()(const pg8::f32x4 (&acc)[2][2][4][2], const pg8::Unit& u, int wr, int wc, int fr, int fq) const {
        const int row0 = u.pm * 256 + wr * 64 + fr;
#pragma unroll
        for (int bj = 0; bj < 2; ++bj) {
            const int col = u.pn * 256 + bj * 128 + wc * 32 + 8 * fq, hh = col >> 7, d = col & 127;
#pragma unroll
            for (int ai = 0; ai < 2; ++ai)
#pragma unroll
                for (int m = 0; m < 4; ++m) {
                    const int row = row0 + ai * 128 + m * 16;
                    const pg8::f32x4 v0 = acc[ai][bj][m][0], v1 = acc[ai][bj][m][1];
                    pg8::u32x4 w; w.x = pg8::cvt_pk_bf16(v0[0], v0[1]); w.y = pg8::cvt_pk_bf16(v0[2], v0[3]); w.z = pg8::cvt_pk_bf16(v1[0], v1[1]); w.w = pg8::cvt_pk_bf16(v1[2], v1[3]);
                    bf16_t* dst = (d < 64) ? km + (size_t)row * 384 + hh * 96 + d : vm + (size_t)row * 256 + hh * 64 + (d - 64);
                    *(pg8::u32x4*)dst = w;
                }
        }
    }
};

__device__ __forceinline__ void conv_chunk(const bf16_t* proj, int m, int c0, int ch, int C, const float* w, const float* bias, bf16_t* dst, float osc) {
    const int t = m & (SEQ - 1);
    float acc[8];
    { const f32x4 b0 = *(const f32x4*)(bias + ch * 8), b1 = *(const f32x4*)(bias + ch * 8 + 4);
      acc[0] = b0.x; acc[1] = b0.y; acc[2] = b0.z; acc[3] = b0.w; acc[4] = b1.x; acc[5] = b1.y; acc[6] = b1.z; acc[7] = b1.w; }
#pragma unroll
    for (int i = 0; i < 4; ++i) {
        if (t - 3 + i >= 0) {
            const us8 x = *(const us8*)(proj + (size_t)(m - 3 + i) * PROJ_W + c0 + ch * 8);
            const f32x4 w0 = *(const f32x4*)(w + i * C + ch * 8), w1 = *(const f32x4*)(w + i * C + ch * 8 + 4);
            acc[0] += w0.x * bf2f(x[0]); acc[1] += w0.y * bf2f(x[1]); acc[2] += w0.z * bf2f(x[2]); acc[3] += w0.w * bf2f(x[3]);
            acc[4] += w1.x * bf2f(x[4]); acc[5] += w1.y * bf2f(x[5]); acc[6] += w1.z * bf2f(x[6]); acc[7] += w1.w * bf2f(x[7]);
        }
    }
    v4u o; o.x = pk2(silu_f(acc[0]) * osc, silu_f(acc[1]) * osc); o.y = pk2(silu_f(acc[2]) * osc, silu_f(acc[3]) * osc); o.z = pk2(silu_f(acc[4]) * osc, silu_f(acc[5]) * osc); o.w = pk2(silu_f(acc[6]) * osc, silu_f(acc[7]) * osc);
    *(v4u*)(dst + (size_t)m * C + ch * 8) = o;
}
__device__ __forceinline__ void conv_seg(const bf16_t* proj, int m0, int c0, int ch, int C, const float* w, const float* bias, bf16_t* dst, float osc) {
    const int t0 = m0 & (SEQ - 1);
    f32x4 wa[4], wb[4];
#pragma unroll
    for (int i = 0; i < 4; ++i) { wa[i] = *(const f32x4*)(w + i * C + ch * 8); wb[i] = *(const f32x4*)(w + i * C + ch * 8 + 4); }
    const f32x4 b0 = *(const f32x4*)(bias + ch * 8), b1 = *(const f32x4*)(bias + ch * 8 + 4);
    const bf16_t* src = proj + (size_t)m0 * PROJ_W + c0 + ch * 8;
    us8 x0 = us8{}, x1 = us8{}, x2 = us8{};
    if (t0 > 0) { x0 = *(const us8*)(src - 3 * (ptrdiff_t)PROJ_W); x1 = *(const us8*)(src - 2 * (ptrdiff_t)PROJ_W); x2 = *(const us8*)(src - (ptrdiff_t)PROJ_W); }
    for (int j = 0; j < 32; j += 8) {
        us8 xn[8];
#pragma unroll
        for (int k = 0; k < 8; ++k) xn[k] = __builtin_nontemporal_load((const us8*)(src + (size_t)(j + k) * PROJ_W));
#pragma unroll
        for (int k = 0; k < 8; ++k) {
            float acc[8] = {b0.x, b0.y, b0.z, b0.w, b1.x, b1.y, b1.z, b1.w};
#define CS_TAP(i, xv) do { acc[0] += wa[i].x * bf2f(xv[0]); acc[1] += wa[i].y * bf2f(xv[1]); acc[2] += wa[i].z * bf2f(xv[2]); acc[3] += wa[i].w * bf2f(xv[3]); \
                           acc[4] += wb[i].x * bf2f(xv[4]); acc[5] += wb[i].y * bf2f(xv[5]); acc[6] += wb[i].z * bf2f(xv[6]); acc[7] += wb[i].w * bf2f(xv[7]); } while (0)
            const bool h3 = (t0 + j + k) >= 3, h2 = (t0 + j + k) >= 2, h1 = (t0 + j + k) >= 1;
            if (h3) CS_TAP(0, x0);
            if (h2) CS_TAP(1, x1);
            if (h1) CS_TAP(2, x2);
            CS_TAP(3, xn[k]);
#undef CS_TAP
            v4u o; o.x = pk2(silu_f(acc[0]) * osc, silu_f(acc[1]) * osc); o.y = pk2(silu_f(acc[2]) * osc, silu_f(acc[3]) * osc); o.z = pk2(silu_f(acc[4]) * osc, silu_f(acc[5]) * osc); o.w = pk2(silu_f(acc[6]) * osc, silu_f(acc[7]) * osc);
            *(v4u*)(dst + (size_t)(m0 + j + k) * C + ch * 8) = o;
            x0 = x1; x1 = x2; x2 = xn[k];
        }
    }
}
__device__ __forceinline__ void mla_prep_token(int m, int lane, const bf16_t* proj, const float* projf, const int* positions, const float* gq, const float* gkv,
                                               bf16_t* cqn, bf16_t* ckvn, bf16_t* km, float* rope) {
    { const us4 v = *(const us4*)(proj + (size_t)m * PROJ_W + PC_CQ + lane * 4);
      const float a = bf2f(v.x), b = bf2f(v.y), c = bf2f(v.z), d = bf2f(v.w);
      const float r = rsqrtf(wave_sum(a * a + b * b + c * c + d * d) * (1.f / 256.f) + EPS);
      const f32x4 g = *(const f32x4*)(gq + lane * 4);
      *(unsigned long long*)(cqn + (size_t)m * 256 + lane * 4) = (unsigned long long)pk2(a * r * g.x, b * r * g.y) | ((unsigned long long)pk2(c * r * g.z, d * r * g.w) << 32); }
    { const float a = projf[(size_t)m * PROJF_W + PF_CKV + lane * 2], b = projf[(size_t)m * PROJF_W + PF_CKV + lane * 2 + 1];
      const float r = rsqrtf(wave_sum(a * a + b * b) * (1.f / 128.f) + EPS);
      *(unsigned*)(ckvn + (size_t)m * 128 + lane * 2) = pk2(a * r * gkv[lane * 2], b * r * gkv[lane * 2 + 1]); }
    if (lane < 16) {
        const float pos = (float)positions[m];
        const float inv = powf(10000.f, -(float)(2 * lane) / 32.f);
        float sn, cs; sincosf(pos * inv, &sn, &cs);
        rope[(size_t)m * 32 + lane] = cs; rope[(size_t)m * 32 + 16 + lane] = sn;
        const float x1 = projf[(size_t)m * PROJF_W + PF_KR + lane], x2 = projf[(size_t)m * PROJF_W + PF_KR + 16 + lane];
        const bf16_t o1 = f2bf(x1 * cs - x2 * sn), o2 = f2bf(x2 * cs + x1 * sn);
#pragma unroll
        for (int hh = 0; hh < 4; ++hh) { km[(size_t)m * 384 + hh * 96 + 64 + lane] = o1; km[(size_t)m * 384 + hh * 96 + 80 + lane] = o2; }
    }
}
__device__ __forceinline__ void kmean_item(int item, int lane, const bf16_t* proj, float* kmean) {
    const int jg = item >> 2, hh = item & 3, cc = lane & 7, rg = lane >> 3;
    float acc[8];
#pragma unroll
    for (int i = 0; i < 8; ++i) acc[i] = 0.f;
#pragma unroll 8
    for (int r = 0; r < 32; ++r) { const us8 x = *(const us8*)(proj + (size_t)(jg * 256 + rg * 32 + r) * PROJ_W + PC_AK + hh * 64 + cc * 8);
#pragma unroll
        for (int i = 0; i < 8; ++i) acc[i] += bf2f(x[i]); }
#pragma unroll
    for (int i = 0; i < 8; ++i) { float v = acc[i]; v += __shfl_xor(v, 8); v += __shfl_xor(v, 16); v += __shfl_xor(v, 32); acc[i] = v * (1.f / 256.f); }
    if (rg == 0) { *(f32x4*)(kmean + jg * 256 + hh * 64 + cc * 8) = (f32x4){acc[0], acc[1], acc[2], acc[3]}; *(f32x4*)(kmean + jg * 256 + hh * 64 + cc * 8 + 4) = (f32x4){acc[4], acc[5], acc[6], acc[7]}; }
}

constexpr size_t WS_WUP = 44 * MiB, WS_WDN = 60 * MiB, WS_XS = 68 * MiB, WS_HID = 112 * MiB, WS_STOK = 134 * MiB, WS_SW1 = WS_STOK + 128 * 1024, WS_SW2 = WS_STOK + 256 * 1024,
                 WS_TCLS = 135 * MiB, WS_TPOS = WS_TCLS + 64 * 1024, WS_TW1 = WS_TCLS + 128 * 1024, WS_TW2 = WS_TCLS + 192 * 1024;
constexpr int MOE_MAXTILES = 88, CW_MOECNT = 200000;
constexpr int TCLS_OFF = LDSCTL_OFF, OFFS_OFF = LDSCTL_OFF + 128;
__device__ __forceinline__ void pair_decode(int pr, int& a, int& b) { a = (pr < 3) ? 0 : ((pr < 5) ? 1 : 2); b = (pr < 3) ? pr + 1 : ((pr < 5) ? pr - 1 : 3); }
__device__ __forceinline__ int moe_tiles(const unsigned* cnt, LAS unsigned char* lds, bool t0) {
    LAS unsigned char* tcls = lds + TCLS_OFF; LAS int* offs = (LAS int*)(lds + OFFS_OFF);
    __syncthreads();
    if (threadIdx.x < 24) offs[threadIdx.x] = (int)cnt[32 * threadIdx.x];
    __syncthreads();
    if (t0) { int off = 0;
        _Pragma("unroll 1") for (int c = 0; c < 24; ++c) { const int n = offs[c]; offs[c] = off; const int nt = (n + 255) >> 8; _Pragma("unroll 1") for (int t = 0; t < nt; ++t) tcls[(off >> 8) + t] = (unsigned char)c; off += nt << 8; }
        offs[24] = off; }
    __syncthreads();
    return offs[24] >> 8;
}
struct MoeOrder {
    const bf16_t* A; const bf16_t* W; int lda, ldb; size_t estride; int K; int ntile, G, c; const LAS unsigned char* tcls; bool down;
    __device__ bool next(int i, pg8::Unit& u) const { const int L = i * G + c; if (L >= ntile * 4) return false; u.pm = L >> 2; u.pn = L & 3; return true; }
    __device__ __forceinline__ const char* a_ptr(const pg8::Unit& u) const { return (const char*)A + (size_t)u.pm * 256 * lda * 2; }
    __device__ __forceinline__ const char* b_ptr(const pg8::Unit& u, int half) const {
        const int cls = tcls[u.pm], g = cls / 6; int ea, eb; pair_decode(cls - g * 6, ea, eb);
        if (down) { const int e = g * 4 + (half ? eb : ea); return (const char*)(W + (size_t)e * estride + (size_t)u.pn * 256 * ldb); }
        const int e = g * 4 + ((u.pn < 2) ? ea : eb); return (const char*)(W + (size_t)e * estride + (size_t)(u.pn & 1) * 256 * ldb + (half ? K / 2 : 0));
    }
};
struct EpiMoeUp {
    bf16_t* hid; const float* w1; const float* w2;
    __device__ __forceinline__ void operator()(const pg8::f32x4 (&acc)[2][2][4][2], const pg8::Unit& u, int wr, int wc, int fr, int fq) const {
        const int row0 = u.pm * 256 + wr * 64 + fr; const float* ws = (u.pn < 2) ? w1 : w2;
#pragma unroll
        for (int ai = 0; ai < 2; ++ai)
#pragma unroll
            for (int m = 0; m < 4; ++m) { const int row = row0 + ai * 128 + m * 16; const float wt = ws[row];
                const pg8::f32x4 g0 = acc[ai][0][m][0], g1 = acc[ai][0][m][1], u0 = acc[ai][1][m][0], u1 = acc[ai][1][m][1];
                pg8::u32x4 w;
                w.x = pg8::cvt_pk_bf16(silu_f(g0[0]) * u0[0] * wt, silu_f(g0[1]) * u0[1] * wt); w.y = pg8::cvt_pk_bf16(silu_f(g0[2]) * u0[2] * wt, silu_f(g0[3]) * u0[3] * wt);
                w.z = pg8::cvt_pk_bf16(silu_f(g1[0]) * u1[0] * wt, silu_f(g1[1]) * u1[1] * wt); w.w = pg8::cvt_pk_bf16(silu_f(g1[2]) * u1[2] * wt, silu_f(g1[3]) * u1[3] * wt);
                *(pg8::u32x4*)(hid + (size_t)row * 512 + u.pn * 128 + wc * 32 + 8 * fq) = w; }
    }
};
struct EpiMoeDown {
    float* x; const int* stok;
    __device__ __forceinline__ void operator()(const pg8::f32x4 (&acc)[2][2][4][2], const pg8::Unit& u, int wr, int wc, int fr, int fq) const {
        const int row0 = u.pm * 256 + wr * 64 + fr, col0 = u.pn * 256 + wc * 32 + 8 * fq;
#pragma unroll
        for (int ai = 0; ai < 2; ++ai)
#pragma unroll
            for (int m = 0; m < 4; ++m) { const int tok = stok[row0 + ai * 128 + m * 16];
                if (tok >= 0) { float* rowp = x + (size_t)tok * DM + col0;
#pragma unroll
                    for (int bj = 0; bj < 2; ++bj) { pg8::f32x4* p = (pg8::f32x4*)(rowp + bj * 128); const pg8::f32x4 a = p[0] + acc[ai][bj][m][0], b = p[1] + acc[ai][bj][m][1]; p[0] = a; p[1] = b; } }
                asm volatile("" ::: "memory"); }
    }
};
struct MapMoeUp { const float* W; int fbase;
    __device__ const float* ptr(int) const { return W; } __device__ int col(int n) const { return fbase + (n & 127); } __device__ float scale(int) const { return 1.f; } };
constexpr int RW_PITCH = 1028;
__device__ __forceinline__ void route_token(int m, int lane, const float* X, const float* g, const LAS float* rw, const float* bg, const float* br, bf16_t* xn2,
                                            unsigned* cnt, int* tcls, int* tpos, float* tw1, float* tw2) {
    asm volatile("" : "+v"(lane));
    const GAS f32x4* xr = (const GAS f32x4*)(X + (size_t)m * DM) + lane; const GAS f32x4* gr = (const GAS f32x4*)g + lane;
    f32x4 v[4]; float s = 0.f;
#pragma unroll
    for (int j = 0; j < 4; ++j) { v[j] = __builtin_nontemporal_load(xr + 64 * j); s += (v[j].x * v[j].x + v[j].y * v[j].y) + (v[j].z * v[j].z + v[j].w * v[j].w); }
    const float rstd = rsqrtf(wave_sum(s) * (1.f / DM) + EPS);
    GAS unsigned long long* o8 = (GAS unsigned long long*)(xn2 + (size_t)m * DM) + lane;
#pragma unroll
    for (int j = 0; j < 4; ++j) { const f32x4 gg = gr[64 * j]; v[j] = (f32x4){v[j].x * rstd * gg.x, v[j].y * rstd * gg.y, v[j].z * rstd * gg.z, v[j].w * rstd * gg.w};
        o8[64 * j] = (unsigned long long)pk2(v[j].x, v[j].y) | ((unsigned long long)pk2(v[j].z, v[j].w) << 32); }
    float lg[20];
#pragma unroll
    for (int q = 0; q < 20; ++q) { float p = 0.f;
#pragma unroll
        for (int j = 0; j < 4; ++j) { const f32x4 w = *(const LAS f32x4*)(rw + q * RW_PITCH + 4 * (64 * j + lane)); p += (v[j].x * w.x + v[j].y * w.y) + (v[j].z * w.z + v[j].w * w.w); }
        lg[q] = wave_sum(p) + (q < 4 ? bg[q] : br[q - 4]); }
    int gi = 0; float gm = lg[0];
#pragma unroll
    for (int j = 1; j < 4; ++j) if (lg[j] > gm) { gm = lg[j]; gi = j; }
    float gs = 0.f;
#pragma unroll
    for (int j = 0; j < 4; ++j) gs += __expf(lg[j] - gm);
    const float g_w = 1.f / gs;
    float el[4];
#pragma unroll
    for (int j = 0; j < 4; ++j) el[j] = (gi == 0) ? lg[4 + j] : (gi == 1) ? lg[8 + j] : (gi == 2) ? lg[12 + j] : lg[16 + j];
    const float em = fmaxf(fmaxf(el[0], el[1]), fmaxf(el[2], el[3]));
    float pe[4]; float es = 0.f;
#pragma unroll
    for (int j = 0; j < 4; ++j) { pe[j] = __expf(el[j] - em); es += pe[j]; }
    int e0 = 0; float p0 = pe[0];
#pragma unroll
    for (int j = 1; j < 4; ++j) if (pe[j] > p0) { p0 = pe[j]; e0 = j; }
    int e1 = -1; float p1 = -1.f;
#pragma unroll
    for (int j = 0; j < 4; ++j) if (j != e0 && pe[j] > p1) { p1 = pe[j]; e1 = j; }
    p0 /= es; p1 /= es;
    const float sw = p0 + p1; const float w0 = g_w * p0 / sw, w1 = g_w * p1 / sw;
    const int ea = e0 < e1 ? e0 : e1, eb = e0 < e1 ? e1 : e0; const float wa = e0 < e1 ? w0 : w1, wb = e0 < e1 ? w1 : w0;
    const int pr = (ea == 0) ? eb - 1 : (ea == 1) ? eb + 1 : 5;
    const int cls = gi * 6 + pr;
    if (lane == 0) { const unsigned pos = __hip_atomic_fetch_add(cnt + 32 * cls, 1u, __ATOMIC_RELAXED, __HIP_MEMORY_SCOPE_AGENT);
        tcls[m] = cls; tpos[m] = (int)pos; tw1[m] = wa; tw2[m] = wb; }
}
namespace att {
using bf16x8 = __attribute__((ext_vector_type(8))) short;
using s16x4 = __attribute__((ext_vector_type(4))) short;
using f32x16 = __attribute__((ext_vector_type(16))) float;
using u32x4 = __attribute__((ext_vector_type(4))) unsigned;
typedef short v4i16_t __attribute__((ext_vector_type(4)));
constexpr int NW = 8, QBLK = 32, QB = 256, KVBLK = 64;
constexpr int NSLOT = 3, KSLOT = 12288, VSLOT = 8192;
constexpr int LDS_K = 0, LDS_V = NSLOT * KSLOT, LDS_WS = LDS_V + NSLOT * VSLOT, LDS_OST = LDS_WS + NW * 256, LDS_BYTES_ATT = LDS_OST + NW * 4096;
__device__ __forceinline__ int crow(int r, int hi) { return (r & 3) + 8 * (r >> 2) + 4 * hi; }
__device__ __forceinline__ void glds16(const void* gsrc, unsigned lds_dst) { unsigned keep;
    asm volatile("s_mov_b32 %0, m0\n\ts_mov_b32 m0, %2\n\ts_nop 0\n\tglobal_load_lds_dwordx4 %1, off\n\ts_mov_b32 m0, %0" : "=&s"(keep) : "v"(gsrc), "s"(lds_dst) : "memory"); }
__device__ __forceinline__ unsigned cvtpk(float lo, float hi) { unsigned r; asm("v_cvt_pk_bf16_f32 %0, %1, %2" : "=v"(r) : "v"(lo), "v"(hi)); return r; }
__device__ __forceinline__ float xhalf_max(float m) { auto rr = __builtin_amdgcn_permlane32_swap(__float_as_uint(m), __float_as_uint(m), false, false); return fmaxf(__uint_as_float(rr[0]), __uint_as_float(rr[1])); }
__device__ __forceinline__ float xhalf_sum(float m) { auto rr = __builtin_amdgcn_permlane32_swap(__float_as_uint(m), __float_as_uint(m), false, false); return __uint_as_float(rr[0]) + __uint_as_float(rr[1]); }
__device__ __forceinline__ void pv(f32x16* o, int vb, bf16x8 pa0, bf16x8 pa1, bf16x8 pa2, bf16x8 pa3) {
#pragma unroll
    for (int d0 = 0; d0 < 2; ++d0) { s16x4 lo[4], hi[4];
#pragma unroll
        for (int ks = 0; ks < 4; ++ks) {
            asm volatile("ds_read_b64_tr_b16 %0,%1 offset:%c2" : "=&v"(lo[ks]) : "v"(vb), "i"(d0 * 4096 + ks * 1024) : "memory");
            asm volatile("ds_read_b64_tr_b16 %0,%1 offset:%c2" : "=&v"(hi[ks]) : "v"(vb), "i"(d0 * 4096 + ks * 1024 + 512) : "memory"); }
        asm volatile("s_waitcnt lgkmcnt(0)" ::: "memory"); __builtin_amdgcn_sched_barrier(0);
#define ATT_PK(k) (bf16x8){lo[k][0], lo[k][1], lo[k][2], lo[k][3], hi[k][0], hi[k][1], hi[k][2], hi[k][3]}
        o[d0] = __builtin_amdgcn_mfma_f32_32x32x16_bf16(pa0, ATT_PK(0), o[d0], 0, 0, 0);
        o[d0] = __builtin_amdgcn_mfma_f32_32x32x16_bf16(pa1, ATT_PK(1), o[d0], 0, 0, 0);
        o[d0] = __builtin_amdgcn_mfma_f32_32x32x16_bf16(pa2, ATT_PK(2), o[d0], 0, 0, 0);
        o[d0] = __builtin_amdgcn_mfma_f32_32x32x16_bf16(pa3, ATT_PK(3), o[d0], 0, 0, 0);
#undef ATT_PK
    }
}
#define ATT_WAIT_BAR(N) asm volatile("s_waitcnt vmcnt(" #N ") lgkmcnt(0)\n\ts_barrier" ::: "memory")

template <int DQK, bool MOBA>
__device__ __forceinline__ void attn_unit(int b, int h, int qb, const bf16_t* Q, int qpitch, int qcol0, const bf16_t* K, int kpitch, int kcol0, const bf16_t* V, int vpitch, int vcol0,
                                          bf16_t* O, int ocol0, const float* kmean, LAS unsigned char* shm, const int wid) {
    constexpr int ND0 = DQK / 16;
    int lane = (int)__builtin_amdgcn_mbcnt_hi(~0u, __builtin_amdgcn_mbcnt_lo(~0u, 0u)); asm volatile("" : "+v"(lane));
    const int r32 = lane & 31, hi = lane >> 5;
    const long rowbase = (long)b * SEQ; const int q0 = qb * QB;
    const bf16_t* Qw = Q + (rowbase + q0 + wid * QBLK) * qpitch + qcol0;
    const bf16_t* Kh = K + rowbase * kpitch + kcol0; const bf16_t* Vh = V + rowbase * vpitch + vcol0;
    const unsigned lds0 = (unsigned)(size_t)shm;
    LAS float* wsf = (LAS float*)(shm + LDS_WS) + wid * 64;
    const bf16_t* ksrc0 = Kh + (long)lane * kpitch + wid * 8;
    const bf16_t* ksrc1 = Kh + (long)lane * kpitch + (8 + (wid & 3)) * 8;
    const bf16_t* vsrc = Vh + (long)(16 * (wid & 3) + (lane >> 2)) * vpitch + (wid >> 2) * 32 + (lane & 3) * 8;
    const unsigned kdst0 = lds0 + LDS_K + wid * 1024, kdst1 = lds0 + LDS_K + (8 + (wid & 3)) * 1024, vdst = lds0 + LDS_V + wid * 1024;
#define ATT_DMA(t, slot) do { glds16(ksrc0 + (long)(t) * KVBLK * kpitch, (unsigned)__builtin_amdgcn_readfirstlane(kdst0 + (slot) * KSLOT)); \
        if (DQK == 96) glds16(ksrc1 + (long)(t) * KVBLK * kpitch, (unsigned)__builtin_amdgcn_readfirstlane(kdst1 + (slot) * KSLOT)); \
        glds16(vsrc + (long)(t) * KVBLK * vpitch, (unsigned)__builtin_amdgcn_readfirstlane(vdst + (slot) * VSLOT)); } while (0)
    const int NT = (q0 + QB) / KVBLK;
    ATT_DMA(0, 0); ATT_DMA(1, 1);
    bf16x8 qr[ND0];
#pragma unroll
    for (int d0 = 0; d0 < ND0; ++d0) qr[d0] = *reinterpret_cast<const bf16x8*>(&Qw[(long)r32 * qpitch + d0 * 16 + hi * 8]);
    unsigned sel = 0xffffffffu;
    if (MOBA) {
        float v0 = -INFINITY, v1 = -INFINITY, v2 = -INFINITY; int i0 = -1, i1 = -1, i2 = -1;
#ifdef ATT_KM_GLOBAL
        const float* kmb = kmean + (size_t)(b * 32) * 256 + h * 64 + hi * 8;
#else
        constexpr int LDS_KM = 98304;
        static_assert(NSLOT == 3, "LDS_KM assumes the 3-slot layout");
        LAS float* kml = (LAS float*)(shm + LDS_KM);
        { const float* kmg = kmean + (size_t)(b * 32) * 256 + h * 64; const int tid_ = wid * 64 + lane;
          for (int i = tid_; i < qb * 16; i += NW * 64) { const int j = i >> 4, c4 = i & 15; *(LAS pg8::f32x4*)(kml + j * 64 + c4 * 4) = *(const pg8::f32x4*)(kmg + (size_t)j * 256 + c4 * 4); }
          asm volatile("s_waitcnt vmcnt(0) lgkmcnt(0)\n\ts_barrier" ::: "memory"); }
        const LAS float* kmb = kml + hi * 8;
#endif
        for (int j = 0; j < qb; ++j) {
            float g = 0.f;
#pragma unroll
            for (int d0 = 0; d0 < 4; ++d0) {
#ifdef ATT_KM_GLOBAL
                const pg8::f32x4 ka = *(const pg8::f32x4*)(kmb + j * 256 + d0 * 16), kb2 = *(const pg8::f32x4*)(kmb + j * 256 + d0 * 16 + 4);
#else
                const pg8::f32x4 ka = *(const LAS pg8::f32x4*)(kmb + j * 64 + d0 * 16), kb2 = *(const LAS pg8::f32x4*)(kmb + j * 64 + d0 * 16 + 4);
#endif
                const bf16x8 qq = qr[d0];
                g += bf2f((bf16_t)qq[0]) * ka.x + bf2f((bf16_t)qq[1]) * ka.y + bf2f((bf16_t)qq[2]) * ka.z + bf2f((bf16_t)qq[3]) * ka.w
                   + bf2f((bf16_t)qq[4]) * kb2.x + bf2f((bf16_t)qq[5]) * kb2.y + bf2f((bf16_t)qq[6]) * kb2.z + bf2f((bf16_t)qq[7]) * kb2.w; }
            g = xhalf_sum(g);
            if (g > v0) { v2 = v1; i2 = i1; v1 = v0; i1 = i0; v0 = g; i0 = j; }
            else if (g > v1) { v2 = v1; i2 = i1; v1 = g; i1 = j; }
            else if (g > v2) { v2 = g; i2 = j; }
        }
        sel = 0u;
        if (i0 >= 0) sel |= 1u << i0;
        if (i1 >= 0) sel |= 1u << i1;
        if (i2 >= 0) sel |= 1u << i2;
    }
    float m_run = -1e30f, l_run = 0.f; f32x16 o[2]; o[0] = f32x16{}; o[1] = f32x16{};
    const int qrel = wid * QBLK + r32;
    const int vb0 = (int)(lds0 + LDS_V) + ((lane >> 4) & 1) * 32 + (lane & 3) * 8 + (4 * hi + ((lane & 15) >> 2)) * 64;
    int slot = 0;
    for (int t = 0; t < NT; ++t) {
        if (t + 1 < NT) { if (DQK == 96) ATT_WAIT_BAR(3); else ATT_WAIT_BAR(2); } else ATT_WAIT_BAR(0);
        if (t + 2 < NT) { const int s2 = (slot == 0) ? 2 : slot - 1; ATT_DMA(t + 2, s2); }
        f32x16 p0, p1;
        { const LAS unsigned char* kb = shm + LDS_K + slot * KSLOT + hi * 1024 + r32 * 16;
#pragma unroll
          for (int d0 = 0; d0 < ND0; ++d0) {
              const bf16x8 b0 = *(const LAS bf16x8*)(kb + d0 * 2048), b1 = *(const LAS bf16x8*)(kb + d0 * 2048 + 512);
              if (d0 == 0) { p0 = __builtin_amdgcn_mfma_f32_32x32x16_bf16(b0, qr[0], f32x16{}, 0, 0, 0); p1 = __builtin_amdgcn_mfma_f32_32x32x16_bf16(b1, qr[0], f32x16{}, 0, 0, 0); }
              else { p0 = __builtin_amdgcn_mfma_f32_32x32x16_bf16(b0, qr[d0], p0, 0, 0, 0); p1 = __builtin_amdgcn_mfma_f32_32x32x16_bf16(b1, qr[d0], p1, 0, 0, 0); } } }
        const int jb = t - (NT - 4);
        if (jb >= 0) { const int kb0 = 64 * jb + 4 * hi;
#pragma unroll
            for (int r = 0; r < 16; ++r) { const int kv = kb0 + (r & 3) + 8 * (r >> 2); if (kv > qrel) p0[r] = -INFINITY; if (kv + 32 > qrel) p1[r] = -INFINITY; } }
        else if (MOBA) { if (!((sel >> (t >> 2)) & 1u)) {
#pragma unroll
            for (int r = 0; r < 16; ++r) { p0[r] = -INFINITY; p1[r] = -INFINITY; } } }
        float rm = fmaxf(p0[0], p1[0]);
#pragma unroll
        for (int r = 1; r < 16; ++r) rm = fmaxf(rm, fmaxf(p0[r], p1[r]));
        rm = xhalf_max(rm);
        const float m_new = fmaxf(m_run, rm); const float alpha = __builtin_amdgcn_exp2f(m_run - m_new); m_run = m_new;
        float ls = 0.f;
#pragma unroll
        for (int r = 0; r < 16; ++r) { p0[r] = __builtin_amdgcn_exp2f(p0[r] - m_new); p1[r] = __builtin_amdgcn_exp2f(p1[r] - m_new); ls += p0[r] + p1[r]; }
        l_run = l_run * alpha + ls;
        if (hi == 0) wsf[r32] = alpha;
        asm volatile("s_waitcnt lgkmcnt(0)" ::: "memory");
#pragma unroll
        for (int r = 0; r < 16; ++r) { const float a = wsf[crow(r, hi)]; o[0][r] *= a; o[1][r] *= a; }
        u32x4 pw0, pw1, pw2, pw3;
        pw0 = (u32x4){cvtpk(p0[0], p0[1]), cvtpk(p0[2], p0[3]), cvtpk(p0[4], p0[5]), cvtpk(p0[6], p0[7])};
        pw1 = (u32x4){cvtpk(p0[8], p0[9]), cvtpk(p0[10], p0[11]), cvtpk(p0[12], p0[13]), cvtpk(p0[14], p0[15])};
        pw2 = (u32x4){cvtpk(p1[0], p1[1]), cvtpk(p1[2], p1[3]), cvtpk(p1[4], p1[5]), cvtpk(p1[6], p1[7])};
        pw3 = (u32x4){cvtpk(p1[8], p1[9]), cvtpk(p1[10], p1[11]), cvtpk(p1[12], p1[13]), cvtpk(p1[14], p1[15])};
        asm volatile("s_waitcnt lgkmcnt(0)" ::: "memory");
        pv(o, vb0 + slot * VSLOT, __builtin_bit_cast(bf16x8, pw0), __builtin_bit_cast(bf16x8, pw1), __builtin_bit_cast(bf16x8, pw2), __builtin_bit_cast(bf16x8, pw3));
        slot = (slot == 2) ? 0 : slot + 1;
    }
    l_run = xhalf_sum(l_run);
    if (hi == 0) wsf[32 + r32] = l_run;
    asm volatile("s_waitcnt lgkmcnt(0)" ::: "memory");
    float rli[16];
#pragma unroll
    for (int r = 0; r < 16; ++r) rli[r] = __builtin_amdgcn_rcpf(wsf[32 + crow(r, hi)]);
    bf16_t* Ow = O + (rowbase + q0 + wid * QBLK) * DM + ocol0;
    { LAS bf16_t* stg = (LAS bf16_t*)(shm + LDS_OST) + wid * 2048;
#pragma unroll
      for (int r = 0; r < 16; ++r) { const int orow = crow(r, hi);
#pragma unroll
          for (int d0 = 0; d0 < 2; ++d0) stg[orow * 64 + d0 * 32 + r32] = f2bf(o[d0][r] * rli[r]); }
      asm volatile("s_waitcnt lgkmcnt(0)" ::: "memory");
#pragma unroll
      for (int i = 0; i < 4; ++i) { const int row = i * 8 + (lane >> 3), ch = lane & 7; const u32x4 v = *(const LAS u32x4*)(stg + row * 64 + ch * 8); *(u32x4*)(Ow + (long)row * DM + ch * 8) = v; } }
    asm volatile("s_waitcnt vmcnt(0) lgkmcnt(0)\n\ts_barrier" ::: "memory");
#undef ATT_DMA
}
#undef ATT_WAIT_BAR
}
namespace ck {
using att::bf16x8; using att::s16x4; using att::f32x16; using att::u32x4; using att::crow; using att::cvtpk; using att::xhalf_sum;
constexpr int CL = 128, NCH = SEQ / CL;
__device__ __forceinline__ int lane_id() { return (int)__builtin_amdgcn_mbcnt_hi(~0u, __builtin_amdgcn_mbcnt_lo(~0u, 0u)); }
#define CK_TRF(dst, vb, OFF) do { s16x4 lo_, hi_; \
    asm volatile("ds_read_b64_tr_b16 %0,%1 offset:%c2" : "=&v"(lo_) : "v"(vb), "i"(OFF) : "memory"); \
    asm volatile("ds_read_b64_tr_b16 %0,%1 offset:%c2" : "=&v"(hi_) : "v"(vb), "i"((OFF) + 512) : "memory"); \
    asm volatile("s_waitcnt lgkmcnt(0)" ::: "memory"); \
    dst = (bf16x8){lo_[0], lo_[1], lo_[2], lo_[3], hi_[0], hi_[1], hi_[2], hi_[3]}; } while (0)
__device__ __forceinline__ int tr_lane_off(int lane) { const int hi = lane >> 5; return ((lane >> 4) & 1) * 32 + (lane & 3) * 8 + (4 * hi + ((lane & 15) >> 2)) * 64; }
__device__ __forceinline__ void stage_v64(LAS unsigned char* dst, const bf16_t* src, int gp, int tid, const LAS float* rowscale) {
    const int row = tid >> 3, j = tid & 7;
    us8 v = *(const us8*)(src + (size_t)row * gp + 8 * j);
    if (rowscale) { const float s = rowscale[row];
#pragma unroll
        for (int i = 0; i < 8; ++i) v[i] = f2bf(bf2f(v[i]) * s); }
    *(LAS us8*)(dst + (j >> 2) * 4096 + row * 64 + (j & 3) * 16) = v;
}
template <int DQ> __device__ __forceinline__ void stage_k64(LAS unsigned char* dst, const bf16_t* src, int gp, int tid) {
#pragma unroll
    for (int pc = tid; pc < 64 * (DQ / 8); pc += 512) { const int row = pc / (DQ / 8), c = pc % (DQ / 8);
        *(LAS us8*)(dst + c * 1024 + row * 16) = *(const us8*)(src + (size_t)row * gp + 8 * c); }
}
__device__ __forceinline__ void scan128(float a0, float a1, int lane, float& s0, float& s1) {
    float t = a0 + a1;
#pragma unroll
    for (int o = 1; o < 64; o <<= 1) { const float u = __shfl_up(t, o); if (lane >= o) t += u; }
    s1 = t; s0 = t - a1;
}

__device__ __forceinline__ void ssd_s1_unit(int unit, const bf16_t* xbca, const float* projf, const float* dt_bias, const float* a_log, float* S, float* dec, LAS unsigned char* shm, int wave) {
    const int g = unit & 1, c = (unit >> 1) & (NCH - 1), b = unit >> 7;
    int lane = lane_id(); asm volatile("" : "+v"(lane));
    const int tid = wave * 64 + lane; const size_t m0 = (size_t)b * SEQ + (size_t)c * CL;
    LAS float* wtab = (LAS float*)(shm + 65536);
    if (wave < 2) { const int h = 2 * g + wave; const float a = -__expf(a_log[h]), dtb = dt_bias[h];
        const float d0 = softplus_f(projf[(m0 + 2 * lane) * PROJF_W + PF_DT + h] + dtb), d1 = softplus_f(projf[(m0 + 2 * lane + 1) * PROJF_W + PF_DT + h] + dtb);
        float s0, s1; scan128(d0 * a, d1 * a, lane, s0, s1);
        const float alast = __shfl(s1, 63);
        wtab[wave * 128 + 2 * lane] = __expf(alast - s0) * d0; wtab[wave * 128 + 2 * lane + 1] = __expf(alast - s1) * d1;
        if (lane == 0) dec[((size_t)b * NCH + c) * 4 + h] = __expf(alast); }
    __syncthreads();
#pragma unroll
    for (int hh = 0; hh < 2; ++hh)
#pragma unroll
        for (int rt = 0; rt < 2; ++rt) stage_v64(shm + (hh * 2 + rt) * 8192, xbca + (m0 + rt * 64) * 768 + (2 * g + hh) * 64, 768, tid, wtab + hh * 128 + rt * 64);
#pragma unroll
    for (int rt = 0; rt < 2; ++rt)
#pragma unroll
        for (int ct = 0; ct < 2; ++ct) stage_v64(shm + 32768 + (rt * 2 + ct) * 8192, xbca + (m0 + rt * 64) * 768 + 256 + g * 128 + ct * 64, 768, tid, nullptr);
    __syncthreads();
    const int hh = wave >> 2, j = wave & 3, r32 = lane & 31, hi = lane >> 5; const int lo = tr_lane_off(lane);
    f32x16 acc0 = f32x16{}, acc1 = f32x16{};
#pragma unroll
    for (int rt = 0; rt < 2; ++rt) {
        const int vx = (int)(unsigned)(size_t)(shm + (hh * 2 + rt) * 8192) + lo, vbm = (int)(unsigned)(size_t)(shm + 32768 + (rt * 2 + (j >> 1)) * 8192) + lo + (j & 1) * 4096;
#define CK_STEP(ks) do { bf16x8 fb, fa0, fa1; CK_TRF(fb, vbm, (ks) * 1024); CK_TRF(fa0, vx, (ks) * 1024); CK_TRF(fa1, vx, 4096 + (ks) * 1024); \
        acc0 = __builtin_amdgcn_mfma_f32_32x32x16_bf16(fa0, fb, acc0, 0, 0, 0); acc1 = __builtin_amdgcn_mfma_f32_32x32x16_bf16(fa1, fb, acc1, 0, 0, 0); } while (0)
        CK_STEP(0); CK_STEP(1); CK_STEP(2); CK_STEP(3);
#undef CK_STEP
    }
    float* Sp = S + (((size_t)b * NCH + c) * 4 + 2 * g + hh) * 8192 + (size_t)(32 * j + r32) * 64;
#pragma unroll
    for (int q = 0; q < 4; ++q) { *(pg8::f32x4*)(Sp + 8 * q + 4 * hi) = (pg8::f32x4){acc0[4 * q], acc0[4 * q + 1], acc0[4 * q + 2], acc0[4 * q + 3]};
                                  *(pg8::f32x4*)(Sp + 32 + 8 * q + 4 * hi) = (pg8::f32x4){acc1[4 * q], acc1[4 * q + 1], acc1[4 * q + 2], acc1[4 * q + 3]}; }
    __syncthreads();
}

__device__ __forceinline__ void ml_s1_unit(int unit, const bf16_t* qka, const bf16_t* proj, const float* projf, const float* ig_bias, const float* fg_bias, float* U, float* nU, float* dec,
                                           LAS unsigned char* shm, int wave) {
    const int hp = unit & 1, c = (unit >> 1) & (NCH - 1), b = unit >> 7;
    int lane = lane_id(); asm volatile("" : "+v"(lane));
    const int tid = wave * 64 + lane; const size_t m0 = (size_t)b * SEQ + (size_t)c * CL;
    LAS float* wtab = (LAS float*)(shm + 65536);
    if (wave < 2) { const int h = 2 * hp + wave; const float igb = ig_bias[h], fgb = fg_bias[h];
        const float f0 = projf[(m0 + 2 * lane) * PROJF_W + PF_MF + h] + fgb, f1 = projf[(m0 + 2 * lane + 1) * PROJF_W + PF_MF + h] + fgb;
        const float l0 = fminf(f0, 0.f) - log1pf(__expf(-fabsf(f0))), l1 = fminf(f1, 0.f) - log1pf(__expf(-fabsf(f1)));
        const float i0 = projf[(m0 + 2 * lane) * PROJF_W + PF_MI + h] + igb, i1 = projf[(m0 + 2 * lane + 1) * PROJF_W + PF_MI + h] + igb;
        float s0, s1; scan128(l0, l1, lane, s0, s1);
        const float blast = __shfl(s1, 63);
        wtab[wave * 128 + 2 * lane] = __expf(blast - s0 + i0); wtab[wave * 128 + 2 * lane + 1] = __expf(blast - s1 + i1);
        if (lane == 0) dec[((size_t)b * NCH + c) * 4 + h] = __expf(blast); }
    __syncthreads();
#pragma unroll
    for (int hh = 0; hh < 2; ++hh)
#pragma unroll
        for (int rt = 0; rt < 2; ++rt) {
            stage_v64(shm + (hh * 2 + rt) * 8192, qka + (m0 + rt * 64) * 512 + 256 + (2 * hp + hh) * 64, 512, tid, wtab + hh * 128 + rt * 64);
            stage_v64(shm + 32768 + (hh * 2 + rt) * 8192, proj + (m0 + rt * 64) * PROJ_W + PC_MV + (2 * hp + hh) * 64, PROJ_W, tid, nullptr); }
    __syncthreads();
    const int hh = wave >> 2, db = (wave >> 1) & 1, eb = wave & 1, r32 = lane & 31, hi = lane >> 5; const int lo = tr_lane_off(lane);
    f32x16 acc = f32x16{};
#pragma unroll
    for (int rt = 0; rt < 2; ++rt) {
        const int vk = (int)(unsigned)(size_t)(shm + (hh * 2 + rt) * 8192) + lo + db * 4096, vv = (int)(unsigned)(size_t)(shm + 32768 + (hh * 2 + rt) * 8192) + lo + eb * 4096;
#define CK_STEP(ks) do { bf16x8 fa, fb; CK_TRF(fa, vv, (ks) * 1024); CK_TRF(fb, vk, (ks) * 1024); acc = __builtin_amdgcn_mfma_f32_32x32x16_bf16(fa, fb, acc, 0, 0, 0); } while (0)
        CK_STEP(0); CK_STEP(1); CK_STEP(2); CK_STEP(3);
#undef CK_STEP
    }
    const size_t ub = ((size_t)b * NCH + c) * 4 + 2 * hp + hh;
    float* Up = U + ub * 4096 + (size_t)(32 * db + r32) * 64 + 32 * eb;
#pragma unroll
    for (int q = 0; q < 4; ++q) *(pg8::f32x4*)(Up + 8 * q + 4 * hi) = (pg8::f32x4){acc[4 * q], acc[4 * q + 1], acc[4 * q + 2], acc[4 * q + 3]};
    if (tid < 128) { const int h2 = tid >> 6, d = tid & 63; float s = 0.f;
        for (int rt = 0; rt < 2; ++rt) { const LAS bf16_t* kp = (const LAS bf16_t*)(shm + (h2 * 2 + rt) * 8192 + (d >> 5) * 4096) + (d & 31);
            for (int r = 0; r < 64; ++r) s += bf2f(kp[r * 32]); }
        nU[(((size_t)b * NCH + c) * 4 + 2 * hp + h2) * 64 + d] = s; }
    __syncthreads();
}

__device__ __forceinline__ void scan_phase(int gtid, int ngt, const float* S, const float* sdec, bf16_t* prevT, const float* U, const float* nU, const float* mdec, bf16_t* Cst, float* nst) {
    constexpr int N1 = 2 * 4 * 8192, N2 = 2 * 4 * 4096, N3 = 2 * 4 * 64;
#define SCAN_RUN(SRC, DEC, STRIDE, STORE) do { float st = 0.f; \
        for (int c0 = 0; c0 < NCH; c0 += 16) { float sv[16], dv[16]; \
            _Pragma("unroll") for (int k = 0; k < 16; ++k) { const size_t u = ((size_t)b * NCH + c0 + k) * 4 + h; sv[k] = SRC[u * STRIDE + e]; dv[k] = DEC[u]; } \
            _Pragma("unroll") for (int k = 0; k < 16; ++k) { const size_t u = ((size_t)b * NCH + c0 + k) * 4 + h; STORE; st = dv[k] * st + sv[k]; } } } while (0)
    for (int idx = gtid; idx < N1 + N2 + N3; idx += ngt) {
        if (idx < N1) { const int e = idx & 8191, h = (idx >> 13) & 3, b = idx >> 15; SCAN_RUN(S, sdec, 8192, prevT[u * 8192 + e] = f2bf(st)); }
        else if (idx < N1 + N2) { const int i2 = idx - N1, e = i2 & 4095, h = (i2 >> 12) & 3, b = i2 >> 14; SCAN_RUN(U, mdec, 4096, Cst[u * 4096 + e] = f2bf(st)); }
        else { const int i3 = idx - N1 - N2, e = i3 & 63, h = (i3 >> 6) & 3, b = i3 >> 8; SCAN_RUN(nU, mdec, 64, nst[u * 64 + e] = st); }
    }
#undef SCAN_RUN
}

#define CK_PACK(p0, p1, pw0, pw1, pw2, pw3) do { \
    pw0 = (u32x4){cvtpk(p0[0], p0[1]), cvtpk(p0[2], p0[3]), cvtpk(p0[4], p0[5]), cvtpk(p0[6], p0[7])}; \
    pw1 = (u32x4){cvtpk(p0[8], p0[9]), cvtpk(p0[10], p0[11]), cvtpk(p0[12], p0[13]), cvtpk(p0[14], p0[15])}; \
    pw2 = (u32x4){cvtpk(p1[0], p1[1]), cvtpk(p1[2], p1[3]), cvtpk(p1[4], p1[5]), cvtpk(p1[6], p1[7])}; \
    pw3 = (u32x4){cvtpk(p1[8], p1[9]), cvtpk(p1[10], p1[11]), cvtpk(p1[12], p1[13]), cvtpk(p1[14], p1[15])}; } while (0)
__device__ __forceinline__ bf16x8 pv_afrag(const bf16_t* rowp, int ks, int hi, float scale) {
    const us4 a = *(const us4*)(rowp + 16 * ks + 4 * hi), b2 = *(const us4*)(rowp + 16 * ks + 8 + 4 * hi);
    u32x4 w; w.x = cvtpk(bf2f(a.x) * scale, bf2f(a.y) * scale); w.y = cvtpk(bf2f(a.z) * scale, bf2f(a.w) * scale);
    w.z = cvtpk(bf2f(b2.x) * scale, bf2f(b2.y) * scale); w.w = cvtpk(bf2f(b2.z) * scale, bf2f(b2.w) * scale);
    return __builtin_bit_cast(bf16x8, w);
}

__device__ __forceinline__ void ssd_s3_unit(int unit, const bf16_t* xbca, const bf16_t* proj, const float* projf, const float* dt_bias, const float* a_log, const float* d_skip, const float* norm_g,
                                            const bf16_t* prevT, bf16_t* ycat, LAS unsigned char* shm, int wave) {
    const int g = unit & 1, c = (unit >> 1) & (NCH - 1), b = unit >> 7;
    int lane = lane_id(); asm volatile("" : "+v"(lane));
    const int tid = wave * 64 + lane; const size_t m0 = (size_t)b * SEQ + (size_t)c * CL;
    LAS float* acum = (LAS float*)(shm + 98304); LAS float* dtt = acum + 256; LAS float* ssq = dtt + 256;
    if (wave < 2) { const int h = 2 * g + wave; const float a = -__expf(a_log[h]), dtb = dt_bias[h];
        const float d0 = softplus_f(projf[(m0 + 2 * lane) * PROJF_W + PF_DT + h] + dtb), d1 = softplus_f(projf[(m0 + 2 * lane + 1) * PROJF_W + PF_DT + h] + dtb);
        float s0, s1; scan128(d0 * a, d1 * a, lane, s0, s1);
        acum[wave * 128 + 2 * lane] = s0; acum[wave * 128 + 2 * lane + 1] = s1; dtt[wave * 128 + 2 * lane] = d0; dtt[wave * 128 + 2 * lane + 1] = d1; }
#pragma unroll
    for (int rt = 0; rt < 2; ++rt) stage_k64<128>(shm + rt * 16384, xbca + (m0 + rt * 64) * 768 + 256 + g * 128, 768, tid);
#pragma unroll
    for (int hh = 0; hh < 2; ++hh)
#pragma unroll
        for (int rt = 0; rt < 2; ++rt) {
            stage_v64(shm + 32768 + (hh * 2 + rt) * 8192, xbca + (m0 + rt * 64) * 768 + (2 * g + hh) * 64, 768, tid, nullptr);
            stage_v64(shm + 65536 + (hh * 2 + rt) * 8192, prevT + (((size_t)b * NCH + c) * 4 + 2 * g + hh) * 8192 + rt * 64 * 64, 64, tid, nullptr); }
    __syncthreads();
    const int hh = wave >> 2, rw = wave & 3, r32 = lane & 31, hi = lane >> 5, h = 2 * g + hh; const int lo = tr_lane_off(lane);
    const int l = 32 * rw + r32;
    const bf16_t* crowp = xbca + (m0 + l) * 768 + 512 + g * 128;
    f32x16 o[2]; o[0] = f32x16{}; o[1] = f32x16{};
    {
        bf16x8 qr[8];
#pragma unroll
        for (int d0 = 0; d0 < 8; ++d0) qr[d0] = *reinterpret_cast<const bf16x8*>(crowp + d0 * 16 + hi * 8);
        const float al = acum[hh * 128 + l];
        const int ntile = (rw >= 2) ? 2 : 1;
        for (int t = 0; t < ntile; ++t) {
            f32x16 p0 = f32x16{}, p1 = f32x16{};
            const LAS unsigned char* kb = shm + t * 16384 + hi * 1024 + r32 * 16;
#pragma unroll
            for (int d0 = 0; d0 < 8; ++d0) { const bf16x8 b0 = *(const LAS bf16x8*)(kb + d0 * 2048), b1 = *(const LAS bf16x8*)(kb + d0 * 2048 + 512);
                p0 = __builtin_amdgcn_mfma_f32_32x32x16_bf16(b0, qr[d0], p0, 0, 0, 0); p1 = __builtin_amdgcn_mfma_f32_32x32x16_bf16(b1, qr[d0], p1, 0, 0, 0); }
#pragma unroll
            for (int r = 0; r < 16; ++r) { const int s = 64 * t + crow(r, hi);
                const float w0 = (s <= l) ? __expf(al - acum[hh * 128 + s]) * dtt[hh * 128 + s] : 0.f, w1 = (s + 32 <= l) ? __expf(al - acum[hh * 128 + s + 32]) * dtt[hh * 128 + s + 32] : 0.f;
                p0[r] *= w0; p1[r] *= w1; }
            u32x4 pw0, pw1, pw2, pw3; CK_PACK(p0, p1, pw0, pw1, pw2, pw3);
            att::pv(o, (int)(unsigned)(size_t)(shm + 32768 + (hh * 2 + t) * 8192) + lo, __builtin_bit_cast(bf16x8, pw0), __builtin_bit_cast(bf16x8, pw1), __builtin_bit_cast(bf16x8, pw2), __builtin_bit_cast(bf16x8, pw3));
        }
        const float ea = __expf(al);
#pragma unroll
        for (int nt = 0; nt < 2; ++nt)
            att::pv(o, (int)(unsigned)(size_t)(shm + 65536 + (hh * 2 + nt) * 8192) + lo, pv_afrag(crowp + 64 * nt, 0, hi, ea), pv_afrag(crowp + 64 * nt, 1, hi, ea), pv_afrag(crowp + 64 * nt, 2, hi, ea), pv_afrag(crowp + 64 * nt, 3, hi, ea));
    }
    __syncthreads();
    LAS float* stg = (LAS float*)(shm + wave * 8704);
#pragma unroll
    for (int r = 0; r < 16; ++r) { const int orow = crow(r, hi); stg[orow * 68 + r32] = o[0][r]; stg[orow * 68 + 32 + r32] = o[1][r]; }
    asm volatile("s_waitcnt lgkmcnt(0)" ::: "memory");
    {
        const int row = lane >> 1, ch = lane & 1, lr = 32 * rw + row; const size_t m = m0 + lr;
        const float dsk = d_skip[h];
        float y[32]; float ss = 0.f;
#pragma unroll
        for (int q = 0; q < 4; ++q) { const us8 xv = *(const us8*)(xbca + m * 768 + h * 64 + ch * 32 + 8 * q), zv = *(const us8*)(proj + m * PROJ_W + PC_Z + h * 64 + ch * 32 + 8 * q);
#pragma unroll
            for (int i = 0; i < 8; ++i) { const float v = (stg[row * 68 + ch * 32 + 8 * q + i] + dsk * bf2f(xv[i])) * silu_f(bf2f(zv[i])); y[8 * q + i] = v; ss += v * v; } }
        ss += __shfl_xor(ss, 1);
        if (ch == 0) ssq[hh * 128 + lr] = ss;
        __syncthreads();
        const float tot = ssq[lr] + ssq[128 + lr];
        const float rstd = rsqrtf(tot * (1.f / 128.f) + EPS);
        const float* gp = norm_g + h * 64 + ch * 32;
        bf16_t* op = ycat + m * DM + 256 + h * 64 + ch * 32;
#pragma unroll
        for (int q = 0; q < 4; ++q) { v4u w; w.x = pk2(y[8 * q] * rstd * gp[8 * q], y[8 * q + 1] * rstd * gp[8 * q + 1]); w.y = pk2(y[8 * q + 2] * rstd * gp[8 * q + 2], y[8 * q + 3] * rstd * gp[8 * q + 3]);
            w.z = pk2(y[8 * q + 4] * rstd * gp[8 * q + 4], y[8 * q + 5] * rstd * gp[8 * q + 5]); w.w = pk2(y[8 * q + 6] * rstd * gp[8 * q + 6], y[8 * q + 7] * rstd * gp[8 * q + 7]);
            *(v4u*)(op + 8 * q) = w; }
    }
    __syncthreads();
}

__device__ __forceinline__ void ml_s3_unit(int unit, const bf16_t* qka, const bf16_t* proj, const float* projf, const float* ig_bias, const float* fg_bias, const float* norm_g,
                                           const bf16_t* Cst, const float* nst, bf16_t* ycat, LAS unsigned char* shm, int wave) {
    const int hp = unit & 1, c = (unit >> 1) & (NCH - 1), b = unit >> 7;
    int lane = lane_id(); asm volatile("" : "+v"(lane));
    const int tid = wave * 64 + lane; const size_t m0 = (size_t)b * SEQ + (size_t)c * CL;
    LAS float* bt = (LAS float*)(shm + 98304); LAS float* igt = bt + 256; LAS float* nt_ = igt + 256;
    LAS float* wsf = (LAS float*)(shm + 98304 + 4096) + wave * 64;
    if (wave < 2) { const int h = 2 * hp + wave; const float igb = ig_bias[h], fgb = fg_bias[h];
        const float f0 = projf[(m0 + 2 * lane) * PROJF_W + PF_MF + h] + fgb, f1 = projf[(m0 + 2 * lane + 1) * PROJF_W + PF_MF + h] + fgb;
        const float l0 = fminf(f0, 0.f) - log1pf(__expf(-fabsf(f0))), l1 = fminf(f1, 0.f) - log1pf(__expf(-fabsf(f1)));
        float s0, s1; scan128(l0, l1, lane, s0, s1);
        bt[wave * 128 + 2 * lane] = s0; bt[wave * 128 + 2 * lane + 1] = s1;
        igt[wave * 128 + 2 * lane] = projf[(m0 + 2 * lane) * PROJF_W + PF_MI + h] + igb; igt[wave * 128 + 2 * lane + 1] = projf[(m0 + 2 * lane + 1) * PROJF_W + PF_MI + h] + igb;
        nt_[wave * 64 + lane] = nst[(((size_t)b * NCH + c) * 4 + h) * 64 + lane]; }
#pragma unroll
    for (int hh = 0; hh < 2; ++hh) {
#pragma unroll
        for (int rt = 0; rt < 2; ++rt) {
            stage_k64<64>(shm + (hh * 2 + rt) * 8192, qka + (m0 + rt * 64) * 512 + 256 + (2 * hp + hh) * 64, 512, tid);
            stage_v64(shm + 32768 + (hh * 2 + rt) * 8192, proj + (m0 + rt * 64) * PROJ_W + PC_MV + (2 * hp + hh) * 64, PROJ_W, tid, nullptr); }
        stage_v64(shm + 65536 + hh * 8192, Cst + (((size_t)b * NCH + c) * 4 + 2 * hp + hh) * 4096, 64, tid, nullptr); }
    __syncthreads();
    const int hh = wave >> 2, rw = wave & 3, r32 = lane & 31, hi = lane >> 5, h = 2 * hp + hh; const int lo = tr_lane_off(lane);
    const int l = 32 * rw + r32;
    const bf16_t* qrowp = qka + (m0 + l) * 512 + h * 64;
    f32x16 o[2]; o[0] = f32x16{}; o[1] = f32x16{};
    float den = 0.f;
    {
        bf16x8 qr[4];
#pragma unroll
        for (int d0 = 0; d0 < 4; ++d0) qr[d0] = *reinterpret_cast<const bf16x8*>(qrowp + d0 * 16 + hi * 8);
        const float bl = bt[hh * 128 + l];
        const int ntile = (rw >= 2) ? 2 : 1;
        for (int t = 0; t < ntile; ++t) {
            f32x16 p0 = f32x16{}, p1 = f32x16{};
            const LAS unsigned char* kb = shm + (hh * 2 + t) * 8192 + hi * 1024 + r32 * 16;
#pragma unroll
            for (int d0 = 0; d0 < 4; ++d0) { const bf16x8 b0 = *(const LAS bf16x8*)(kb + d0 * 2048), b1 = *(const LAS bf16x8*)(kb + d0 * 2048 + 512);
                p0 = __builtin_amdgcn_mfma_f32_32x32x16_bf16(b0, qr[d0], p0, 0, 0, 0); p1 = __builtin_amdgcn_mfma_f32_32x32x16_bf16(b1, qr[d0], p1, 0, 0, 0); }
#pragma unroll
            for (int r = 0; r < 16; ++r) { const int s = 64 * t + crow(r, hi);
                const float w0 = (s <= l) ? __expf(bl - bt[hh * 128 + s] + igt[hh * 128 + s]) : 0.f, w1 = (s + 32 <= l) ? __expf(bl - bt[hh * 128 + s + 32] + igt[hh * 128 + s + 32]) : 0.f;
                p0[r] *= w0; p1[r] *= w1; den += p0[r] + p1[r]; }
            u32x4 pw0, pw1, pw2, pw3; CK_PACK(p0, p1, pw0, pw1, pw2, pw3);
            att::pv(o, (int)(unsigned)(size_t)(shm + 32768 + (hh * 2 + t) * 8192) + lo, __builtin_bit_cast(bf16x8, pw0), __builtin_bit_cast(bf16x8, pw1), __builtin_bit_cast(bf16x8, pw2), __builtin_bit_cast(bf16x8, pw3));
        }
        const float eb = __expf(bl);
        att::pv(o, (int)(unsigned)(size_t)(shm + 65536 + hh * 8192) + lo, pv_afrag(qrowp, 0, hi, eb), pv_afrag(qrowp, 1, hi, eb), pv_afrag(qrowp, 2, hi, eb), pv_afrag(qrowp, 3, hi, eb));
        float qn = 0.f;
#pragma unroll
        for (int d0 = 0; d0 < 4; ++d0)
#pragma unroll
            for (int i = 0; i < 8; ++i) qn += bf2f((bf16_t)qr[d0][i]) * nt_[hh * 64 + 16 * d0 + 8 * hi + i];
        den = xhalf_sum(den + eb * qn);
    }
    if (hi == 0) wsf[r32] = 1.f / fmaxf(fabsf(den), 1.f);
    asm volatile("s_waitcnt lgkmcnt(0)" ::: "memory");
    float rli[16];
#pragma unroll
    for (int r = 0; r < 16; ++r) rli[r] = wsf[crow(r, hi)];
    __syncthreads();
    LAS float* stg = (LAS float*)(shm + wave * 8704);
#pragma unroll
    for (int r = 0; r < 16; ++r) { const int orow = crow(r, hi); stg[orow * 68 + r32] = o[0][r] * rli[r]; stg[orow * 68 + 32 + r32] = o[1][r] * rli[r]; }
    asm volatile("s_waitcnt lgkmcnt(0)" ::: "memory");
    {
        const int row = lane >> 1, ch = lane & 1, lr = 32 * rw + row; const size_t m = m0 + lr;
        float y[32]; float ss = 0.f;
#pragma unroll
        for (int q = 0; q < 4; ++q) { const us8 ov = *(const us8*)(proj + m * PROJ_W + PC_MO + h * 64 + ch * 32 + 8 * q);
#pragma unroll
            for (int i = 0; i < 8; ++i) { const float v = stg[row * 68 + ch * 32 + 8 * q + i] * sigmoid_f(bf2f(ov[i])); y[8 * q + i] = v; ss += v * v; } }
        ss += __shfl_xor(ss, 1);
        const float rstd = rsqrtf(ss * (1.f / 64.f) + EPS);
        const float* gp = norm_g + h * 64 + ch * 32;
        bf16_t* op = ycat + m * DM + 512 + h * 64 + ch * 32;
#pragma unroll
        for (int q = 0; q < 4; ++q) { v4u w; w.x = pk2(y[8 * q] * rstd * gp[8 * q], y[8 * q + 1] * rstd * gp[8 * q + 1]); w.y = pk2(y[8 * q + 2] * rstd * gp[8 * q + 2], y[8 * q + 3] * rstd * gp[8 * q + 3]);
            w.z = pk2(y[8 * q + 4] * rstd * gp[8 * q + 4], y[8 * q + 5] * rstd * gp[8 * q + 5]); w.w = pk2(y[8 * q + 6] * rstd * gp[8 * q + 6], y[8 * q + 7] * rstd * gp[8 * q + 7]);
            *(v4u*)(op + 8 * q) = w; }
    }
    __syncthreads();
}
#undef CK_TRF
#undef CK_PACK
}
#ifndef EN_P_MOE
#define EN_P_MOE 1
#endif
#ifndef EN_P_SCAN
#define EN_P_SCAN 1
#endif
#ifndef EN_P_CONV
#define EN_P_CONV 1
#endif
#ifndef EN_P_INPROJ
#define EN_P_INPROJ 1
#endif
#ifndef EN_P_PREP
#define EN_P_PREP 1
#endif
#ifndef EN_P_MLAUP
#define EN_P_MLAUP 1
#endif
#ifndef EN_P_ATTN
#define EN_P_ATTN 1
#endif
#ifndef EN_P_OUTPROJ
#define EN_P_OUTPROJ 1
#endif
constexpr int NPH = 11, PH_FINAL = 2 * NPH;
enum { P_CONV = 0, P_INPROJ = 1, P_PREP = 2, P_MLAUP = 3, P_SCAN = 4, P_ATTN = 5, P_OUTPROJ = 6, P_ROUTE = 7, P_SORT = 8, P_MOEUP = 9, P_MOEDOWN = 10 };

__global__ void __launch_bounds__(NWAVES * 64, 2) mk_fwd(Args args) {
    extern __shared__ __attribute__((aligned(16))) unsigned char lds_raw[];
    LAS unsigned char* lds0p = (LAS unsigned char*)lds_raw; LAS unsigned char* lds = lds0p;
    volatile LAS unsigned* MISC = (volatile LAS unsigned*)(lds + MISC_OFF);
    const int tid = threadIdx.x, lane0 = tid & 63, wave = __builtin_amdgcn_readfirstlane(tid >> 6);
    const int G = gridDim.x; const int bx = blockIdx.x; const int vcu = (G % 8 == 0) ? (bx % 8) * (G / 8) + bx / 8 : bx;
    unsigned char* ws = args.ws;
    gu32* ctl = (gu32*)(ws + WS_CTL);
    for (int u = tid; u < (LDS_BYTES - LDSCTL_OFF) / 4; u += NWAVES * 64) ((LAS unsigned*)(lds + LDSCTL_OFF))[u] = 0u;
    __syncthreads();
    if (tid == 0) { LAS unsigned long long* tb = (LAS unsigned long long*)(lds + PTR_OFF);
#pragma unroll
        for (int i = 0; i < 29; ++i) tb[i] = (unsigned long long)args.in[i]; }
    __syncthreads();
#define INP(i) in_ptr(lds, (i))
    XcdBarrier bar = xcd_barrier_post((unsigned*)(ctl + CW_BAR) + args.bli * XCD_BAR_WORDS, MISC + 8);
    const int lo = args.ph_lo, hi = args.ph_hi;
#define IN(k) (lo <= (k) && (k) < hi)
#define SEAM(k) do { if (IN(k) && IN((k) + 1)) xcd_barrier(bar); } while (0)
    float* X = args.out;
    bf16_t* ACT = (bf16_t*)(ws + WS_ACT); bf16_t* PROJ = (bf16_t*)(ws + WS_PROJ); float* PROJF = (float*)(ws + WS_PROJF);
    bf16_t* WinT = (bf16_t*)(ws + WS_WIN); bf16_t* WoutT = (bf16_t*)(ws + WS_WOUT); bf16_t* WuqT = (bf16_t*)(ws + WS_WUQ); bf16_t* WukvT = (bf16_t*)(ws + WS_WUKV);
    bf16_t* XBCA = (bf16_t*)(ws + WS_XBCA); bf16_t* QKA = (bf16_t*)(ws + WS_QKA); bf16_t* QM = (bf16_t*)(ws + WS_QM); bf16_t* KM = (bf16_t*)(ws + WS_KM); bf16_t* VM = (bf16_t*)(ws + WS_VM);
    bf16_t* WupT = (bf16_t*)(ws + WS_WUP); bf16_t* WdnT = (bf16_t*)(ws + WS_WDN); bf16_t* XS = (bf16_t*)(ws + WS_XS); bf16_t* HID = (bf16_t*)(ws + WS_HID);
    int* STOK = (int*)(ws + WS_STOK); float* SW1 = (float*)(ws + WS_SW1); float* SW2 = (float*)(ws + WS_SW2);
    int* TCLS = (int*)(ws + WS_TCLS); int* TPOS = (int*)(ws + WS_TPOS); float* TW1 = (float*)(ws + WS_TW1); float* TW2 = (float*)(ws + WS_TW2);
    float* S1S = (float*)(ws + WS_ACT); float* S1U = (float*)(ws + WS_ACT + 16 * MiB); float* S1N = (float*)(ws + WS_ACT + 24 * MiB); float* S1SD = (float*)(ws + WS_ACT + 25 * MiB); float* S1MD = S1SD + 1024;
    bf16_t* PREVT = (bf16_t*)(ws + WS_PREVT); bf16_t* CST = (bf16_t*)(ws + WS_CST); float* NST = (float*)(ws + WS_NST);
    bf16_t* CQN = (bf16_t*)(ws + WS_CQN); bf16_t* CKVN = (bf16_t*)(ws + WS_CKVN); float* ROPE = (float*)(ws + WS_ROPE); float* KMEAN = (float*)(ws + WS_KMEAN);
    const int gw = vcu * NWAVES + wave, NGW = G * NWAVES;

    for (int l = 0; l < DEPTH; ++l) {
        const int pb = l * NPH;
        { unsigned lv = (unsigned)(size_t)lds0p; asm volatile("" : "+s"(lv)); lds = (LAS unsigned char*)(size_t)lv; }
        if (EN_P_CONV && IN(pb + P_CONV)) {
            int lane = (int)__builtin_amdgcn_mbcnt_hi(~0u, __builtin_amdgcn_mbcnt_lo(~0u, 0u)); asm volatile("" : "+v"(lane));
            LAS float* scr = (LAS float*)(lds + RING_OFF + wave * 16384);
            constexpr int I_IN = (DM / 64) * (PROJ_N / 32), I_OUT = (DM / 64) * (DM / 32), I_UQ = (256 / 64) * (512 / 32), I_UKV = (128 / 64) * (512 / 32);
            const MapInProj mi{INP(3) + (size_t)l * DM * NIN};
            const MapPlain mo{INP(19) + (size_t)l * DM * DM, DM, 1.f};
            const MapPlain muq{INP(16) + (size_t)l * 256 * 384, 384, C2M};
            const MapPlain mukv{INP(18) + (size_t)l * 128 * 512, 512, 1.f};
            for (int it = gw; it < I_IN + I_OUT + I_UQ + I_UKV; it += NGW) {
                if (it < I_IN) conv_item(mi, NIN, DM, WinT, PROJ_N / 32, scr, it, lane);
                else if (it < I_IN + I_OUT) conv_item(mo, DM, DM, WoutT, DM / 32, scr, it - I_IN, lane);
                else if (it < I_IN + I_OUT + I_UQ) conv_item(muq, 384, 256, WuqT, 512 / 32, scr, it - I_IN - I_OUT, lane);
                else conv_item(mukv, 512, 128, WukvT, 512 / 32, scr, it - I_IN - I_OUT - I_UQ, lane);
            }
            const float* xsrc = (l == 0) ? INP(0) : X;
            for (int m = gw; m < M; m += NGW) rms_row_to_bf16(xsrc + (size_t)m * DM, INP(2) + l * DM, ACT + (size_t)m * DM, nullptr, lane);
        }
        SEAM(pb + P_CONV);
        if (EN_P_INPROJ && IN(pb + P_INPROJ)) {
            pg8::StaticOrder S; S.init(ACT, WinT, DM, DM, DM, M, PROJ_N, G, bx);
            const EpiInProj E{PROJ, PROJF};
            pg8::gemm_phase(lds + RING_OFF, wave, pg8::Dims{DM, DM, DM}, S, E);
        }
        SEAM(pb + P_INPROJ);
        if (EN_P_PREP && IN(pb + P_PREP)) {
            int lane = (int)__builtin_amdgcn_mbcnt_hi(~0u, __builtin_amdgcn_mbcnt_lo(~0u, 0u)); asm volatile("" : "+v"(lane));
            if (wave == 0) for (int it = vcu; it < 256; it += G) kmean_item(it, lane, PROJ, KMEAN);
            for (int m = gw; m < M; m += NGW) mla_prep_token(m, lane, PROJ, PROJF, (const int*)INP(1), INP(15) + l * 256, INP(17) + l * 128, CQN, CKVN, KM, ROPE);
            for (int wt = gw; wt < (M / 32) * 3; wt += NGW) { const int seg = wt / 3, part = wt - seg * 3;
                if (part == 0) conv_seg(PROJ, seg * 32, PC_XBC, lane, 768, INP(4) + l * 4 * 768, INP(5) + l * 768, XBCA, 1.f);
                else if (part == 1) { if (lane < 32) conv_seg(PROJ, seg * 32, PC_XBC, 64 + lane, 768, INP(4) + l * 4 * 768, INP(5) + l * 768, XBCA, 1.f); }
                else conv_seg(PROJ, seg * 32, PC_MQK, lane, 512, INP(10) + l * 4 * 512, INP(11) + l * 512, QKA, lane >= 32 ? 0.125f : 1.f); }
        }
        SEAM(pb + P_PREP);
        if (EN_P_MLAUP && IN(pb + P_MLAUP)) {
            const int half = G / 2;
            if (bx < half) { pg8::StaticOrder S; S.init(CQN, WuqT, 256, 256, 256, M, 512, half, bx); const EpiMlaQ E{QM, ROPE}; pg8::gemm_phase(lds + RING_OFF, wave, pg8::Dims{256, 256, 256}, S, E); }
            else { pg8::StaticOrder S; S.init(CKVN, WukvT, 128, 128, 128, M, 512, G - half, bx - half); const EpiMlaKVf E{KM, VM}; pg8::gemm_phase(lds + RING_OFF, wave, pg8::Dims{128, 128, 128}, S, E); }
            for (int u = vcu; u < 512; u += G) {
                if (u < 256) ck::ssd_s1_unit(u, XBCA, PROJF, INP(6) + l * 4, INP(7) + l * 4, S1S, S1SD, lds + RING_OFF, wave);
                else ck::ml_s1_unit(u - 256, QKA, PROJ, PROJF, INP(12) + l * 4, INP(13) + l * 4, S1U, S1N, S1MD, lds + RING_OFF, wave);
            }
        }
        SEAM(pb + P_MLAUP);
        if (EN_P_SCAN && IN(pb + P_SCAN)) {
            const int lane = (int)__builtin_amdgcn_mbcnt_hi(~0u, __builtin_amdgcn_mbcnt_lo(~0u, 0u));
            ck::scan_phase(gw * 64 + lane, NGW * 64, S1S, S1SD, PREVT, S1U, S1N, S1MD, CST, NST);
        }
        SEAM(pb + P_SCAN);
        if (EN_P_ATTN && IN(pb + P_ATTN)) {
            for (int u = vcu; u < 512; u += G) {
                const int bh = (u & 255) >> 5, qs = u & 31, b = bh >> 2, hh = bh & 3;
                if (u < 256) att::attn_unit<96, false>(b, hh, qs, QM, 384, hh * 96, KM, 384, hh * 96, VM, 256, hh * 64, ACT, 768 + hh * 64, nullptr, lds + RING_OFF, wave);
                else att::attn_unit<64, true>(b, hh, 31 - qs, PROJ, PROJ_W, PC_AQ + hh * 64, PROJ, PROJ_W, PC_AK + hh * 64, PROJ, PROJ_W, PC_AV + hh * 64, ACT, hh * 64, KMEAN, lds + RING_OFF, wave);
            }
            for (int u = vcu; u < 512; u += G) {
                if (u < 256) ck::ssd_s3_unit(u, XBCA, PROJ, PROJF, INP(6) + l * 4, INP(7) + l * 4, INP(8) + l * 4, INP(9) + l * 256, PREVT, ACT, lds + RING_OFF, wave);
                else ck::ml_s3_unit(u - 256, QKA, PROJ, PROJF, INP(12) + l * 4, INP(13) + l * 4, INP(14) + l * 256, CST, NST, ACT, lds + RING_OFF, wave);
            }
        }
        SEAM(pb + P_ATTN);
        if (EN_P_OUTPROJ && IN(pb + P_OUTPROJ)) {
            pg8::StaticOrder S; S.init(ACT, WoutT, DM, DM, DM, M, DM, G, bx);
            const EpiResidualF32 E{X, (l == 0) ? INP(0) : (const float*)X};
            pg8::gemm_phase(lds + RING_OFF, wave, pg8::Dims{DM, DM, DM}, S, E);
            int lane = (int)__builtin_amdgcn_mbcnt_hi(~0u, __builtin_amdgcn_mbcnt_lo(~0u, 0u)); asm volatile("" : "+v"(lane));
            LAS float* scr = (LAS float*)(lds + RING_OFF + wave * 16384);
            const float* wgate = INP(25) + (size_t)l * 16 * 1024 * 256; const float* wup = INP(26) + (size_t)l * 16 * 1024 * 256; const float* wdn = INP(27) + (size_t)l * 16 * 256 * 1024;
            for (int it = gw; it < 16 * 256 + 16 * 128; it += NGW) {
                if (it < 16 * 256) { const int e = it >> 8, q = ((it & 255) & 15) >> 2;
                    if (q & 1) { const MapMoeUp mu{wup + (size_t)e * 1024 * 256, (q >> 1) * 128}; conv_item(mu, 256, 1024, WupT + (size_t)e * 512 * 1024, 512 / 32, scr, it & 255, lane); }
                    else { const MapMoeUp mu{wgate + (size_t)e * 1024 * 256, (q >> 1) * 128}; conv_item(mu, 256, 1024, WupT + (size_t)e * 512 * 1024, 512 / 32, scr, it & 255, lane); } }
                else { const int r = it - 16 * 256, e = r >> 7; const MapPlain md{wdn + (size_t)e * 256 * 1024, 1024, 1.f};
                    conv_item(md, 1024, 256, WdnT + (size_t)e * 1024 * 256, 1024 / 32, scr, r & 127, lane); }
            }
        }
        SEAM(pb + P_OUTPROJ);
        unsigned* mcnt = (unsigned*)(ctl + CW_MOECNT + l * 1024);
        if (EN_P_MOE && IN(pb + P_ROUTE)) {
            int lane = (int)__builtin_amdgcn_mbcnt_hi(~0u, __builtin_amdgcn_mbcnt_lo(~0u, 0u)); asm volatile("" : "+v"(lane));
            LAS float* rw = (LAS float*)(lds + RING_OFF);
            { const float* wg = INP(21) + (size_t)l * DM * 4; const float* wr = INP(23) + (size_t)l * DM * 16; const int tid2 = wave * 64 + lane;
              for (int i = tid2; i < DM; i += NWAVES * 64) { const f32x4 w = *(const GAS f32x4*)(wg + 4 * i); rw[0 * RW_PITCH + i] = w.x; rw[1 * RW_PITCH + i] = w.y; rw[2 * RW_PITCH + i] = w.z; rw[3 * RW_PITCH + i] = w.w; }
              for (int i = tid2; i < DM * 4; i += NWAVES * 64) { const int k = i >> 2, c = i & 3; const f32x4 w = *(const GAS f32x4*)(wr + 4 * i);
                  rw[(4 + 4 * c) * RW_PITCH + k] = w.x; rw[(5 + 4 * c) * RW_PITCH + k] = w.y; rw[(6 + 4 * c) * RW_PITCH + k] = w.z; rw[(7 + 4 * c) * RW_PITCH + k] = w.w; } }
            __syncthreads();
            for (int m = gw; m < M; m += NGW) route_token(m, lane, X, INP(20) + l * DM, rw, INP(22) + l * 4, INP(24) + l * 16, ACT, mcnt, TCLS, TPOS, TW1, TW2);
            __syncthreads();
        }
        SEAM(pb + P_ROUTE);
        if (EN_P_MOE && IN(pb + P_SORT)) {
            int lane = (int)__builtin_amdgcn_mbcnt_hi(~0u, __builtin_amdgcn_mbcnt_lo(~0u, 0u)); asm volatile("" : "+v"(lane));
            (void)moe_tiles(mcnt, lds, wave == 0 && lane == 0);
            const LAS int* offs = (const LAS int*)(lds + OFFS_OFF);
            if (bx < 24) { const int beg = offs[bx] + (int)mcnt[32 * bx], end = offs[bx + 1];
                for (int r = beg + wave * 64 + lane; r < end; r += NWAVES * 64) { st_wt(STOK + r, -1); st_wt(SW1 + r, 0.f); st_wt(SW2 + r, 0.f); }
#ifndef PADZERO_OFF
                for (int r = beg + wave; r < end; r += NWAVES) { v4u* dst = (v4u*)(XS + (size_t)r * DM); dst[lane] = (v4u){0u, 0u, 0u, 0u}; dst[64 + lane] = (v4u){0u, 0u, 0u, 0u}; }
#endif
            }
            for (int m = gw; m < M; m += NGW) { const int row = offs[TCLS[m]] + TPOS[m];
                if (lane == 0) { st_wt(STOK + row, m); st_wt(SW1 + row, TW1[m]); st_wt(SW2 + row, TW2[m]); }
                const v4u* src = (const v4u*)(ACT + (size_t)m * DM); v4u* dst = (v4u*)(XS + (size_t)row * DM);
                const v4u a = __builtin_nontemporal_load(src + lane), b = __builtin_nontemporal_load(src + 64 + lane); dst[lane] = a; dst[64 + lane] = b; }
        }
        SEAM(pb + P_SORT);
        if (EN_P_MOE && IN(pb + P_MOEUP)) {
            const int lane = (int)__builtin_amdgcn_mbcnt_hi(~0u, __builtin_amdgcn_mbcnt_lo(~0u, 0u));
            const int ntile = moe_tiles(mcnt, lds, wave == 0 && lane == 0);
            const int nu = ntile * 4;
            unsigned* tdone = (unsigned*)(ctl + 210000 + l * 128);
            const EpiMoeUp E{HID, SW1, SW2};
            for (int L = bx; L < nu; L += G) {
                const MoeOrder S{XS, WupT, DM, DM, (size_t)512 * 1024, DM, ntile, 1 << 20, L, lds + TCLS_OFF, false};
                pg8::gemm_phase(lds + RING_OFF, wave, pg8::Dims{DM, DM, DM}, S, E);
                asm volatile("s_waitcnt vmcnt(0)" ::: "memory");
                __syncthreads();
                if (wave == 0 && lane == 0) { __builtin_amdgcn_fence(__ATOMIC_RELEASE, "agent"); asm volatile("s_waitcnt vmcnt(0)" ::: "memory");
                    (void)__hip_atomic_fetch_add(tdone + (L >> 2), 1u, __ATOMIC_RELAXED, __HIP_MEMORY_SCOPE_AGENT); }
            }
            const int maxu = (nu + G - 1) / G; int two = nu - (maxu - 1) * G; if (two >= G) two = 0;
            const int c2 = (bx >= two) ? bx - two : bx + (G - two);
            const EpiMoeDown E2{X, STOK};
            for (int L = c2; L < nu; L += G) {
                if (wave == 0 && lane == 0) { unsigned sp = 0u;
                    while (__hip_atomic_load(tdone + (L >> 2), __ATOMIC_RELAXED, __HIP_MEMORY_SCOPE_AGENT) < 4u && ++sp < (1u << 22)) __builtin_amdgcn_s_sleep(2);
                    __builtin_amdgcn_fence(__ATOMIC_ACQUIRE, "agent"); asm volatile("s_waitcnt vmcnt(0)" ::: "memory"); }
                __syncthreads();
                const MoeOrder S2{HID, WdnT, 512, 256, (size_t)1024 * 256, 512, ntile, 1 << 20, L, lds + TCLS_OFF, true};
                pg8::gemm_phase(lds + RING_OFF, wave, pg8::Dims{512, 512, 256}, S2, E2);
            }
        }
        SEAM(pb + P_MOEDOWN);
    }
    if (IN(PH_FINAL)) {
        int lane = (int)__builtin_amdgcn_mbcnt_hi(~0u, __builtin_amdgcn_mbcnt_lo(~0u, 0u)); asm volatile("" : "+v"(lane));
        for (int m = gw; m < M; m += NGW) rms_row_to_f32(X + (size_t)m * DM, INP(28), X + (size_t)m * DM, lane);
    }
#undef IN
#undef SEAM
}
static void launch_mk(Args a, int lo, int hi, int bli, int grid, hipStream_t stream) {
    a.ph_lo = lo; a.ph_hi = hi; a.bli = bli; a.pad = 0;
    hipLaunchKernelGGL(mk_fwd, dim3(grid), dim3(NWAVES * 64), LDS_BYTES, stream, a);
}
extern "C" void kernel_launch(void* const* d_in, const int* in_sizes, int n_in, void* d_out, int out_size, void* d_ws, size_t ws_size, hipStream_t stream) {
    static int grid = 0;
    if (grid == 0) {
        int dev = 0, cus = 0;
        if (hipGetDevice(&dev) != hipSuccess || hipDeviceGetAttribute(&cus, hipDeviceAttributeMultiprocessorCount, dev) != hipSuccess) { grid = -1; return; }
        if (hipFuncSetAttribute((const void*)mk_fwd, hipFuncAttributeMaxDynamicSharedMemorySize, LDS_BYTES) != hipSuccess) { grid = -1; return; }
        int per_cu = 0;
        (void)hipOccupancyMaxActiveBlocksPerMultiprocessor(&per_cu, (const void*)mk_fwd, NWAVES * 64, LDS_BYTES);
        (void)hipGetLastError();
        grid = cus;
        if (n_in != 29 || ws_size < WS_END) { grid = -1; return; }
    }
    if (grid < 0) return;
    (void)hipMemsetAsync((char*)d_ws + WS_CTL, 0, CTL_ZERO_BYTES, stream);
    Args a{};
    for (int i = 0; i < 29; ++i) a.in[i] = (const float*)d_in[i];
    a.out = (float*)d_out; a.ws = (unsigned char*)d_ws;
    launch_mk(a, 0, PH_FINAL + 1, 0, grid, stream);
}
```

```cpp
#include <hip/hip_runtime.h>
#include <stdint.h>
#include <math.h>

typedef unsigned short bf16_t;
typedef unsigned short us8 __attribute__((ext_vector_type(8)));
typedef unsigned short us4 __attribute__((ext_vector_type(4)));

constexpr int BATCH = 2, SEQ = 8192, DM = 1024, M = BATCH * SEQ, DEPTH = 2;
constexpr int NIN = 3244;
constexpr float EPS = 1e-6f;
constexpr float LOG2E = 1.4426950408889634f;
constexpr float C2A = 0.125f * LOG2E;
constexpr float C2M = 0.10206207261596575f * LOG2E;
constexpr int PC_AQ = 0, PC_AK = 256, PC_AV = 512, PC_Z = 768, PC_XBC = 1024, PC_MQK = 1792, PC_MV = 2304, PC_MO = 2560, PC_CQ = 2816, PROJ_W = 3072;
constexpr int PF_CKV = 0, PF_KR = 128, PF_DT = 160, PF_MI = 164, PF_MF = 168, PROJF_W = 256;

__host__ __device__ inline int dst_col(int n) {
    if (n < 1792) return n;
    if (n < 1796) return PROJ_W + PF_DT + (n - 1792);
    if (n < 2308) return PC_MQK + (n - 1796);
    if (n < 2564) return PC_MV + (n - 2308);
    if (n < 2568) return PROJ_W + PF_MI + (n - 2564);
    if (n < 2572) return PROJ_W + PF_MF + (n - 2568);
    if (n < 2828) return PC_MO + (n - 2572);
    if (n < 3084) return PC_CQ + (n - 2828);
    if (n < 3212) return PROJ_W + PF_CKV + (n - 3084);
    return PROJ_W + PF_KR + (n - 3212);
}

__device__ __forceinline__ float bf2f(bf16_t v) { return __uint_as_float(((unsigned)v) << 16); }
__device__ __forceinline__ bf16_t f2bf(float f) { unsigned u = __float_as_uint(f); return (bf16_t)((u + 0x7fffu + ((u >> 16) & 1u)) >> 16); }
__device__ __forceinline__ float silu_f(float x) { return x / (1.f + __expf(-x)); }
__device__ __forceinline__ float sigmoid_f(float x) { return 1.f / (1.f + __expf(-x)); }
__device__ __forceinline__ float softplus_f(float x) { return x > 20.f ? x : log1pf(__expf(x)); }

#ifdef WAVE_SUM_SHFL
__device__ __forceinline__ float wave_sum(float v) {
#pragma unroll
    for (int o = 1; o < 64; o <<= 1) v += __shfl_xor(v, o);
    return v;
}
#else
#define WS_DPP(v, ctrl) ((v) + __int_as_float(__builtin_amdgcn_update_dpp(0, __float_as_int(v), (ctrl), 0xf, 0xf, true)))
__device__ __forceinline__ float wave_sum(float v) {
    v = WS_DPP(v, 0xB1);
    v = WS_DPP(v, 0x4E);
    v = WS_DPP(v, 0x141);
    v = WS_DPP(v, 0x140);
    { auto rr = __builtin_amdgcn_permlane16_swap(__float_as_uint(v), __float_as_uint(v), false, false); v = __uint_as_float(rr[0]) + __uint_as_float(rr[1]); }
    { auto rr = __builtin_amdgcn_permlane32_swap(__float_as_uint(v), __float_as_uint(v), false, false); v = __uint_as_float(rr[0]) + __uint_as_float(rr[1]); }
    return v;
}
#endif
__device__ __forceinline__ float block_sum256(float v, float* sh) {
    v = wave_sum(v);
    __syncthreads();
    if ((threadIdx.x & 63) == 0) sh[threadIdx.x >> 6] = v;
    __syncthreads();
    return sh[0] + sh[1] + sh[2] + sh[3];
}

__global__ __launch_bounds__(256) void k_rmsnorm_bf16(const float* __restrict__ x, const float* __restrict__ g, bf16_t* __restrict__ out) {
    __shared__ float sh[4];
    const int m = blockIdx.x, t = threadIdx.x;
    const float4 v = ((const float4*)(x + (size_t)m * DM))[t];
    const float ss = block_sum256(v.x * v.x + v.y * v.y + v.z * v.z + v.w * v.w, sh);
    const float r = rsqrtf(ss * (1.f / DM) + EPS);
    const float4 gg = ((const float4*)g)[t];
    us4 o; o.x = f2bf(v.x * r * gg.x); o.y = f2bf(v.y * r * gg.y); o.z = f2bf(v.z * r * gg.z); o.w = f2bf(v.w * r * gg.w);
    ((us4*)(out + (size_t)m * DM))[t] = o;
}
__global__ __launch_bounds__(256) void k_rmsnorm_f32(const float* x, const float* __restrict__ g, float* out) {
    __shared__ float sh[4];
    const int m = blockIdx.x, t = threadIdx.x;
    const float4 v = ((const float4*)(x + (size_t)m * DM))[t];
    const float ss = block_sum256(v.x * v.x + v.y * v.y + v.z * v.z + v.w * v.w, sh);
    const float r = rsqrtf(ss * (1.f / DM) + EPS);
    const float4 gg = ((const float4*)g)[t];
    float4 o; o.x = v.x * r * gg.x; o.y = v.y * r * gg.y; o.z = v.z * r * gg.z; o.w = v.w * r * gg.w;
    ((float4*)(out + (size_t)m * DM))[t] = o;
}

template <class Epi>
__global__ __launch_bounds__(256) void k_gemm(const bf16_t* __restrict__ A, int lda, const float* __restrict__ W, int ldw, int N, int K, Epi epi) {
    __shared__ float As[16][68];
    __shared__ float Bs[16][68];
    const int tid = threadIdx.x, tx = tid & 15, ty = tid >> 4;
    const int m0 = blockIdx.y * 64, n0 = blockIdx.x * 64;
    float acc[4][4];
#pragma unroll
    for (int i = 0; i < 4; ++i)
#pragma unroll
        for (int j = 0; j < 4; ++j) acc[i][j] = 0.f;
    for (int k0 = 0; k0 < K; k0 += 16) {
        {
            const int r = tid >> 2, kq = (tid & 3) * 4;
            const us4 v = *(const us4*)(A + (size_t)(m0 + r) * lda + k0 + kq);
            As[kq + 0][r] = bf2f(v.x); As[kq + 1][r] = bf2f(v.y); As[kq + 2][r] = bf2f(v.z); As[kq + 3][r] = bf2f(v.w);
        }
        {
            const int kk = tid >> 4, nq = (tid & 15) * 4, n = n0 + nq;
            float4 v = make_float4(0.f, 0.f, 0.f, 0.f);
            if (n < N) v = *(const float4*)(W + (size_t)(k0 + kk) * ldw + n);
            Bs[kk][nq + 0] = v.x; Bs[kk][nq + 1] = v.y; Bs[kk][nq + 2] = v.z; Bs[kk][nq + 3] = v.w;
        }
        __syncthreads();
#pragma unroll
        for (int kk = 0; kk < 16; ++kk) {
            float a[4], b[4];
#pragma unroll
            for (int i = 0; i < 4; ++i) { a[i] = As[kk][ty * 4 + i]; b[i] = Bs[kk][tx * 4 + i]; }
#pragma unroll
            for (int i = 0; i < 4; ++i)
#pragma unroll
                for (int j = 0; j < 4; ++j) acc[i][j] += a[i] * b[j];
        }
        __syncthreads();
    }
#pragma unroll
    for (int i = 0; i < 4; ++i)
#pragma unroll
        for (int j = 0; j < 4; ++j) { const int n = n0 + tx * 4 + j; if (n < N) epi(m0 + ty * 4 + i, n, acc[i][j]); }
}

struct EpiInProjNaive {
    bf16_t* proj; float* projf;
    __device__ void operator()(int m, int n, float v) const {
        const int c = dst_col(n);
        if (c < PROJ_W) { if (c < 256) v *= C2A; proj[(size_t)m * PROJ_W + c] = f2bf(v); }
        else projf[(size_t)m * PROJF_W + (c - PROJ_W)] = v;
    }
};
struct EpiResidual {
    float* x;
    __device__ void operator()(int m, int n, float v) const { x[(size_t)m * DM + n] += v; }
};
struct EpiF32 {
    float* out; int ld; int pad;
    __device__ void operator()(int m, int n, float v) const { out[(size_t)m * ld + n] = v; }
};
struct EpiMlaKV {
    bf16_t* km; bf16_t* vm;
    __device__ void operator()(int m, int n, float v) const {
        const int h = n >> 7, d = n & 127;
        if (d < 64) km[(size_t)m * 384 + h * 96 + d] = f2bf(v); else vm[(size_t)m * 256 + h * 64 + (d - 64)] = f2bf(v);
    }
};

__global__ __launch_bounds__(256) void k_conv_silu(const bf16_t* __restrict__ src, int ld, int c0, int C, const float* __restrict__ w, const float* __restrict__ b, bf16_t* __restrict__ dst) {
    const size_t idx = (size_t)blockIdx.x * 256 + threadIdx.x;
    if (idx >= (size_t)M * C) return;
    const int m = (int)(idx / C), c = (int)(idx % C), t = m % SEQ;
    float acc = b[c];
#pragma unroll
    for (int i = 0; i < 4; ++i) { const int tt = t - 3 + i; if (tt >= 0) acc += w[i * C + c] * bf2f(src[(size_t)(m - 3 + i) * ld + c0 + c]); }
    dst[(size_t)m * C + c] = f2bf(silu_f(acc));
}

__global__ __launch_bounds__(256) void k_ssd_scan(const bf16_t* __restrict__ xbca, const bf16_t* __restrict__ proj, const float* __restrict__ projf,
                                                  const float* __restrict__ dt_bias, const float* __restrict__ a_log, const float* __restrict__ d_skip, float* __restrict__ yg) {
    const int blk = blockIdx.x, ps = blk & 3, h = (blk >> 2) & 3, b = blk >> 4;
    const int tid = threadIdx.x, pl = tid >> 4, ns = tid & 15, p = ps * 16 + pl, g = h >> 1;
    const float a = -__expf(a_log[h]), dtb = dt_bias[h], dsk = d_skip[h];
    float st[8];
#pragma unroll
    for (int i = 0; i < 8; ++i) st[i] = 0.f;
    const size_t m0 = (size_t)b * SEQ;
    for (int t = 0; t < SEQ; ++t) {
        const size_t m = m0 + t;
        const float dtv = softplus_f(projf[m * PROJF_W + PF_DT + h] + dtb);
        const float dA = __expf(dtv * a);
        const float xv = bf2f(xbca[m * 768 + h * 64 + p]);
        const us8 Bv = *(const us8*)(xbca + m * 768 + 256 + g * 128 + ns * 8);
        const us8 Cv = *(const us8*)(xbca + m * 768 + 512 + g * 128 + ns * 8);
        const float dx = dtv * xv;
        float y = 0.f;
#pragma unroll
        for (int i = 0; i < 8; ++i) { st[i] = dA * st[i] + dx * bf2f(Bv[i]); y += bf2f(Cv[i]) * st[i]; }
        y += __shfl_xor(y, 1); y += __shfl_xor(y, 2); y += __shfl_xor(y, 4); y += __shfl_xor(y, 8);
        if (ns == 0) {
            const float z = bf2f(proj[m * PROJ_W + PC_Z + h * 64 + p]);
            yg[m * 256 + h * 64 + p] = (y + dsk * xv) * silu_f(z);
        }
    }
}
__global__ __launch_bounds__(256) void k_group_norm(const float* __restrict__ yg, const float* __restrict__ g, int gsz_log2, bf16_t* __restrict__ ycat, int col0) {
    const int wave = (blockIdx.x * 256 + threadIdx.x) >> 6, lane = threadIdx.x & 63;
    const int m = wave >> 1, half = wave & 1;
    if (m >= M) return;
    const float v0 = yg[(size_t)m * 256 + half * 128 + lane * 2], v1 = yg[(size_t)m * 256 + half * 128 + lane * 2 + 1];
    float ss = v0 * v0 + v1 * v1;
    const int nl = (1 << gsz_log2) >> 1;
    for (int o = 1; o < nl; o <<= 1) ss += __shfl_xor(ss, o);
    const float r = rsqrtf(ss / (float)(1 << gsz_log2) + EPS);
    const int c = half * 128 + lane * 2;
    ycat[(size_t)m * DM + col0 + c] = f2bf(v0 * r * g[c]);
    ycat[(size_t)m * DM + col0 + c + 1] = f2bf(v1 * r * g[c + 1]);
}

__global__ __launch_bounds__(256) void k_mlstm_scan(const bf16_t* __restrict__ qka, const bf16_t* __restrict__ proj, const float* __restrict__ projf,
                                                    const float* __restrict__ ig_bias, const float* __restrict__ fg_bias, float* __restrict__ hg) {
    const int blk = blockIdx.x, es = blk & 3, h = (blk >> 2) & 3, b = blk >> 4;
    const int tid = threadIdx.x, el = tid >> 4, ds = tid & 15, e = es * 16 + el;
    const float igb = ig_bias[h], fgb = fg_bias[h];
    float C[4] = {0.f, 0.f, 0.f, 0.f}, nn[4] = {0.f, 0.f, 0.f, 0.f};
    const size_t m0 = (size_t)b * SEQ;
    for (int t = 0; t < SEQ; ++t) {
        const size_t m = m0 + t;
        const float f = sigmoid_f(projf[m * PROJF_W + PF_MF + h] + fgb);
        const float ig = __expf(projf[m * PROJF_W + PF_MI + h] + igb);
        const us4 qv = *(const us4*)(qka + m * 512 + h * 64 + ds * 4);
        const us4 kv = *(const us4*)(qka + m * 512 + 256 + h * 64 + ds * 4);
        const float v = bf2f(proj[m * PROJ_W + PC_MV + h * 64 + e]);
        float num = 0.f, den = 0.f;
#pragma unroll
        for (int i = 0; i < 4; ++i) {
            const float k = bf2f(kv[i]) * 0.125f, q = bf2f(qv[i]);
            C[i] = f * C[i] + ig * k * v; nn[i] = f * nn[i] + ig * k;
            num += q * C[i]; den += q * nn[i];
        }
        num += __shfl_xor(num, 1); num += __shfl_xor(num, 2); num += __shfl_xor(num, 4); num += __shfl_xor(num, 8);
        den += __shfl_xor(den, 1); den += __shfl_xor(den, 2); den += __shfl_xor(den, 4); den += __shfl_xor(den, 8);
        if (ds == 0) {
            const float o = sigmoid_f(bf2f(proj[m * PROJ_W + PC_MO + h * 64 + e]));
            hg[m * 256 + h * 64 + e] = o * num / fmaxf(fabsf(den), 1.f);
        }
    }
}

__global__ __launch_bounds__(256) void k_moba_kmean(const bf16_t* __restrict__ proj, float* __restrict__ kmean) {
    const int jg = blockIdx.x, c = threadIdx.x;
    float s = 0.f;
    for (int r = 0; r < 256; ++r) s += bf2f(proj[(size_t)(jg * 256 + r) * PROJ_W + PC_AK + c]);
    kmean[jg * 256 + c] = s * (1.f / 256.f);
}
__global__ __launch_bounds__(256) void k_moba_attn(const bf16_t* __restrict__ proj, const float* __restrict__ kmean, bf16_t* __restrict__ ycat) {
    __shared__ float km[32][64];
    __shared__ float Ks[32][64];
    __shared__ float Vs[32][64];
    const int blk = blockIdx.x, cur = blk & 31, h = (blk >> 5) & 3, b = blk >> 7;
    const int tid = threadIdx.x, t = cur * 256 + tid;
    const size_t mq = (size_t)b * SEQ + t;
    float q[64];
#pragma unroll
    for (int d8 = 0; d8 < 8; ++d8) { const us8 v = *(const us8*)(proj + mq * PROJ_W + PC_AQ + h * 64 + d8 * 8);
#pragma unroll
        for (int i = 0; i < 8; ++i) q[d8 * 8 + i] = bf2f(v[i]); }
    for (int i = tid; i < 32 * 64; i += 256) { const int j = i >> 6, d = i & 63; km[j][d] = kmean[(b * 32 + j) * 256 + h * 64 + d]; }
    __syncthreads();
    float v0 = -INFINITY, v1 = -INFINITY, v2 = -INFINITY; int i0 = -1, i1 = -1, i2 = -1;
    for (int j = 0; j < cur; ++j) {
        float gq = 0.f;
#pragma unroll
        for (int d = 0; d < 64; ++d) gq += q[d] * km[j][d];
        if (gq > v0) { v2 = v1; i2 = i1; v1 = v0; i1 = i0; v0 = gq; i0 = j; }
        else if (gq > v1) { v2 = v1; i2 = i1; v1 = gq; i1 = j; }
        else if (gq > v2) { v2 = gq; i2 = j; }
    }
    unsigned sel = 0u;
    if (i0 >= 0) sel |= 1u << i0;
    if (i1 >= 0) sel |= 1u << i1;
    if (i2 >= 0) sel |= 1u << i2;
    float o[64];
#pragma unroll
    for (int d = 0; d < 64; ++d) o[d] = 0.f;
    float mx = -INFINITY, l = 0.f;
    for (int jb = 0; jb <= cur; ++jb) {
        for (int kt = 0; kt < 8; ++kt) {
            __syncthreads();
            for (int i = tid; i < 32 * 64; i += 256) { const int r = i >> 6, d = i & 63; const size_t mk = (size_t)b * SEQ + jb * 256 + kt * 32 + r;
                Ks[r][d] = bf2f(proj[mk * PROJ_W + PC_AK + h * 64 + d]); Vs[r][d] = bf2f(proj[mk * PROJ_W + PC_AV + h * 64 + d]); }
            __syncthreads();
            const bool use = (jb == cur) || ((sel >> jb) & 1u);
            if (use) {
                for (int kk = 0; kk < 32; ++kk) {
                    const int key = jb * 256 + kt * 32 + kk;
                    if (key > t) break;
                    float s = 0.f;
#pragma unroll
                    for (int d = 0; d < 64; ++d) s += q[d] * Ks[kk][d];
                    if (s > mx) { const float f = exp2f(mx - s); l *= f;
#pragma unroll
                        for (int d = 0; d < 64; ++d) o[d] *= f;
                        mx = s; }
                    const float p = exp2f(s - mx); l += p;
#pragma unroll
                    for (int d = 0; d < 64; ++d) o[d] += p * Vs[kk][d];
                }
            }
        }
    }
    const float rl = 1.f / l;
#pragma unroll
    for (int d = 0; d < 64; ++d) ycat[mq * DM + 0 + h * 64 + d] = f2bf(o[d] * rl);
}

__global__ __launch_bounds__(256) void k_mla_prep(const bf16_t* __restrict__ proj, const float* __restrict__ projf, const int* __restrict__ positions,
                                                  const float* __restrict__ gq, const float* __restrict__ gkv, bf16_t* __restrict__ cqn, bf16_t* __restrict__ ckvn, bf16_t* __restrict__ km) {
    __shared__ float sh[4];
    const int m = blockIdx.x, tid = threadIdx.x;
    const float cq = bf2f(proj[(size_t)m * PROJ_W + PC_CQ + tid]);
    const float s1 = block_sum256(cq * cq, sh);
    cqn[(size_t)m * 256 + tid] = f2bf(cq * rsqrtf(s1 * (1.f / 256.f) + EPS) * gq[tid]);
    const float ck = tid < 128 ? projf[(size_t)m * PROJF_W + PF_CKV + tid] : 0.f;
    const float s2 = block_sum256(ck * ck, sh);
    if (tid < 128) ckvn[(size_t)m * 128 + tid] = f2bf(ck * rsqrtf(s2 * (1.f / 128.f) + EPS) * gkv[tid]);
    if (tid < 16) {
        const float pos = (float)positions[m];
        const float inv = powf(10000.f, -(float)(2 * tid) / 32.f);
        const float ang = pos * inv; float sn, cs; sincosf(ang, &sn, &cs);
        const float x1 = projf[(size_t)m * PROJF_W + PF_KR + tid], x2 = projf[(size_t)m * PROJF_W + PF_KR + 16 + tid];
        const bf16_t o1 = f2bf(x1 * cs - x2 * sn), o2 = f2bf(x2 * cs + x1 * sn);
#pragma unroll
        for (int h = 0; h < 4; ++h) { km[(size_t)m * 384 + h * 96 + 64 + tid] = o1; km[(size_t)m * 384 + h * 96 + 80 + tid] = o2; }
    }
}
__global__ __launch_bounds__(256) void k_mla_qfinish(const float* __restrict__ qraw, const int* __restrict__ positions, bf16_t* __restrict__ qm) {
    const size_t idx = (size_t)blockIdx.x * 256 + threadIdx.x;
    if (idx >= (size_t)M * 384) return;
    const int m = (int)(idx / 384), c = (int)(idx % 384), h = c / 96, d = c % 96;
    float v;
    if (d < 64) v = qraw[idx];
    else {
        const int i = (d - 64) & 15; const bool second = (d - 64) >= 16;
        const float pos = (float)positions[m];
        const float inv = powf(10000.f, -(float)(2 * i) / 32.f);
        float sn, cs; sincosf(pos * inv, &sn, &cs);
        const float x1 = qraw[(size_t)m * 384 + h * 96 + 64 + i], x2 = qraw[(size_t)m * 384 + h * 96 + 80 + i];
        v = second ? (x2 * cs + x1 * sn) : (x1 * cs - x2 * sn);
    }
    qm[idx] = f2bf(v * C2M);
}
__global__ __launch_bounds__(256) void k_mla_attn(const bf16_t* __restrict__ qm, const bf16_t* __restrict__ km, const bf16_t* __restrict__ vm, bf16_t* __restrict__ ycat) {
    __shared__ float Ks[32][96];
    __shared__ float Vs[32][64];
    const int blk = blockIdx.x, qb = 31 - (blk & 31), h = (blk >> 5) & 3, b = blk >> 7;
    const int tid = threadIdx.x, t = qb * 256 + tid;
    const size_t mq = (size_t)b * SEQ + t;
    float q[96];
#pragma unroll
    for (int d8 = 0; d8 < 12; ++d8) { const us8 v = *(const us8*)(qm + mq * 384 + h * 96 + d8 * 8);
#pragma unroll
        for (int i = 0; i < 8; ++i) q[d8 * 8 + i] = bf2f(v[i]); }
    float o[64];
#pragma unroll
    for (int d = 0; d < 64; ++d) o[d] = 0.f;
    float mx = -INFINITY, l = 0.f;
    const int ntiles = (qb + 1) * 8;
    for (int kt = 0; kt < ntiles; ++kt) {
        __syncthreads();
        for (int i = tid; i < 32 * 96; i += 256) { const int r = i / 96, d = i % 96; Ks[r][d] = bf2f(km[((size_t)b * SEQ + kt * 32 + r) * 384 + h * 96 + d]); }
        for (int i = tid; i < 32 * 64; i += 256) { const int r = i >> 6, d = i & 63; Vs[r][d] = bf2f(vm[((size_t)b * SEQ + kt * 32 + r) * 256 + h * 64 + d]); }
        __syncthreads();
        for (int kk = 0; kk < 32; ++kk) {
            const int key = kt * 32 + kk;
            if (key > t) break;
            float s = 0.f;
#pragma unroll
            for (int d = 0; d < 96; ++d) s += q[d] * Ks[kk][d];
            if (s > mx) { const float f = exp2f(mx - s); l *= f;
#pragma unroll
                for (int d = 0; d < 64; ++d) o[d] *= f;
                mx = s; }
            const float p = exp2f(s - mx); l += p;
#pragma unroll
            for (int d = 0; d < 64; ++d) o[d] += p * Vs[kk][d];
        }
    }
    const float rl = 1.f / l;
#pragma unroll
    for (int d = 0; d < 64; ++d) ycat[mq * DM + 768 + h * 64 + d] = f2bf(o[d] * rl);
}

__global__ __launch_bounds__(256) void k_moe_naive(float* x, const float* __restrict__ gn, const float* __restrict__ wg, const float* __restrict__ bg,
                                                   const float* __restrict__ wr, const float* __restrict__ br, const float* __restrict__ wgate, const float* __restrict__ wup, const float* __restrict__ wdown) {
    __shared__ float h2[1024];
    __shared__ float red[4][20];
    __shared__ float sh[4];
    __shared__ float hid[2][256];
    __shared__ int sE[2]; __shared__ float sW[2];
    __shared__ float slg[20]; __shared__ float spe[4];
    const int m = blockIdx.x, tid = threadIdx.x, lane = tid & 63, wv = tid >> 6;
    const float4 v = ((const float4*)(x + (size_t)m * DM))[tid];
    const float ss = block_sum256(v.x * v.x + v.y * v.y + v.z * v.z + v.w * v.w, sh);
    const float r = rsqrtf(ss * (1.f / DM) + EPS);
    const float4 gg = ((const float4*)gn)[tid];
    const float hv[4] = {v.x * r * gg.x, v.y * r * gg.y, v.z * r * gg.z, v.w * r * gg.w};
#pragma unroll
    for (int i = 0; i < 4; ++i) h2[tid * 4 + i] = hv[i];
    float part[20];
#pragma unroll
    for (int j = 0; j < 20; ++j) part[j] = 0.f;
#pragma unroll
    for (int i = 0; i < 4; ++i) { const int d = tid * 4 + i;
#pragma unroll
        for (int j = 0; j < 4; ++j) part[j] += hv[i] * wg[d * 4 + j];
#pragma unroll
        for (int j = 0; j < 16; ++j) part[4 + j] += hv[i] * wr[d * 16 + j]; }
#pragma unroll
    for (int j = 0; j < 20; ++j) { const float s = wave_sum(part[j]); if (lane == 0) red[wv][j] = s; }
    __syncthreads();
    if (tid < 20) slg[tid] = red[0][tid] + red[1][tid] + red[2][tid] + red[3][tid] + (tid < 4 ? bg[tid] : br[tid - 4]);
    __syncthreads();
    if (tid == 0) {
        int gi = 0; float gm = slg[0];
        for (int j = 1; j < 4; ++j) if (slg[j] > gm) { gm = slg[j]; gi = j; }
        float gs = 0.f; for (int j = 0; j < 4; ++j) gs += __expf(slg[j] - gm);
        const float g_w = 1.f / gs;
        float em = -INFINITY;
        for (int j = 0; j < 4; ++j) em = fmaxf(em, slg[4 + gi * 4 + j]);
        float es = 0.f;
        for (int j = 0; j < 4; ++j) { const float p = __expf(slg[4 + gi * 4 + j] - em); spe[j] = p; es += p; }
        int e0 = 0; float p0 = spe[0];
        for (int j = 1; j < 4; ++j) if (spe[j] > p0) { p0 = spe[j]; e0 = j; }
        int e1 = -1; float p1 = -1.f;
        for (int j = 0; j < 4; ++j) if (j != e0 && spe[j] > p1) { p1 = spe[j]; e1 = j; }
        p0 /= es; p1 /= es;
        const float sw = p0 + p1;
        sE[0] = gi * 4 + e0; sE[1] = gi * 4 + e1; sW[0] = g_w * p0 / sw; sW[1] = g_w * p1 / sw;
    }
    __syncthreads();
#pragma unroll
    for (int j = 0; j < 2; ++j) {
        const int E = sE[j];
        const float* G = wgate + (size_t)E * 1024 * 256 + tid; const float* U = wup + (size_t)E * 1024 * 256 + tid;
        float ga = 0.f, ua = 0.f;
        for (int d = 0; d < 1024; ++d) { const float hd = h2[d]; ga += hd * G[(size_t)d * 256]; ua += hd * U[(size_t)d * 256]; }
        hid[j][tid] = silu_f(ga) * ua * sW[j];
    }
    __syncthreads();
    float out[4] = {0.f, 0.f, 0.f, 0.f};
#pragma unroll
    for (int j = 0; j < 2; ++j) {
        const float* Dn = wdown + (size_t)sE[j] * 256 * 1024;
        for (int f = 0; f < 256; ++f) { const float hf = hid[j][f];
#pragma unroll
            for (int i = 0; i < 4; ++i) out[i] += hf * Dn[(size_t)f * 1024 + tid + 256 * i]; }
    }
#pragma unroll
    for (int i = 0; i < 4; ++i) x[(size_t)m * DM + tid + 256 * i] += out[i];
}

#define ATOMIC_ROUTE 1
#define ST_WT_OFF 1
#define LOADS_OFF 1
#define PADZERO_OFF 1
#define NO_ENTRY_BARRIER 1
#define NO_EXIT_BARRIER 1
namespace pg8 {
#define PG8_LAS __attribute__((address_space(3)))
typedef short bf16x8 __attribute__((ext_vector_type(8)));
typedef float f32x4 __attribute__((ext_vector_type(4)));
typedef unsigned u32x4 __attribute__((ext_vector_type(4)));
constexpr int BM = 256, BK = 64, HALF = 128, HTB = HALF * BK * 2  , STAGE_BYTES = 8 * HTB, NXCD = 8, WGM = 8;

__host__ __device__ __forceinline__ int lds_byte(int r, int c) { const int st = (r >> 4) * 2 + (c >> 5), rr = r & 15, cc = c & 31, ob = rr * 64 + cc * 2; return st * 1024 + (ob ^ (((ob >> 9) & 1) << 5)); }
__host__ __device__ __forceinline__ void stage_rc(int b, int& R, int& C) { const int st = b / 1024, sb = b % 1024, swz = sb ^ (((sb >> 9) & 1) << 5); R = (st >> 1) * 16 + swz / 64; C = (st & 1) * 32 + (swz % 64) / 2; }
__host__ __device__ __forceinline__ int perm32(int rho) { const int n = rho >> 4, i = rho & 15; return 8 * (i >> 2) + 4 * n + (i & 3); }

struct Unit { int pm, pn; };
struct Dims { int K, lda, ldb; };

struct StaticOrder {
    const bf16_t* A; const bf16_t* Bt; int lda, ldb, K;
    int nM, nN, nwg, G, c;
    __device__ void init(const bf16_t* A_, const bf16_t* Bt_, int lda_, int ldb_, int K_, int Mrows, int N, int G_, int c_) { A = A_; Bt = Bt_; lda = lda_; ldb = ldb_; K = K_; nM = Mrows / BM; nN = N / BM; nwg = nM * nN; G = G_; c = c_; }
    __device__ bool next(int i, Unit& u) const {
        const long L = (long)i * G + c; if (L >= nwg) return false;
        int wgid = (int)L; { const int q = nwg / NXCD, r = nwg % NXCD, xcd = wgid % NXCD, off = wgid / NXCD; wgid = (xcd < r ? xcd * (q + 1) : r * (q + 1) + (xcd - r) * q) + off; }
        const int nig = WGM * nN, gid = wgid / nig, fm = gid * WGM, gsz = (nM - fm) < WGM ? (nM - fm) : WGM;
        u.pm = fm + ((wgid % nig) % gsz); u.pn = (wgid % nig) / gsz; return true;
    }
    __device__ __forceinline__ const char* a_ptr(const Unit& u) const { return (const char*)A + (size_t)u.pm * BM * lda * 2; }
    __device__ __forceinline__ const char* b_ptr(const Unit& u, int half) const { return (const char*)Bt + (size_t)u.pn * BM * ldb * 2 + (half ? (size_t)(K / 2) * 2 : 0); }
};

__device__ __forceinline__ unsigned cvt_pk_bf16(float lo, float hi) { unsigned r; asm volatile("v_cvt_pk_bf16_f32 %0, %1, %2" : "=v"(r) : "v"(lo), "v"(hi)); return r; }

template <class Epi, class Sched>
__device__ __forceinline__ void gemm_phase(PG8_LAS unsigned char* lds, const int wid, const Dims g, const Sched& S, const Epi& E) {
    int lane = (int)__builtin_amdgcn_mbcnt_hi(~0u, __builtin_amdgcn_mbcnt_lo(~0u, 0u)); asm volatile("" : "+v"(lane));
    const int tid = wid * 64 + lane, wr = wid >> 2, wc = wid & 3, fr = lane & 15, fq = lane >> 4;
    int K = g.K, lda = g.lda, ldb = g.ldb; asm volatile("" : "+s"(K), "+s"(lda), "+s"(ldb));
    const int nt = K / BK, nth = nt / 2;
    unsigned voffA[2], voffB[2];
#pragma unroll
    for (int i = 0; i < 2; ++i) { int R, C; stage_rc(tid * 16 + i * 8192, R, C); const int Rb = (R & ~31) + perm32(R & 31);
        voffA[i] = (unsigned)(R * lda + C) * 2u; voffB[i] = (unsigned)(Rb * ldb + C) * 2u; }
    const size_t kstep = (size_t)(BK * 2);
    const size_t hstepA = (size_t)HALF * lda * 2, hstepB = (size_t)HALF * ldb * 2;
    const unsigned ldsw = (unsigned)wid * 1024u;
    const int aoff = lds_byte(wr * 64 + fr, fq * 8), boff = lds_byte(wc * 32 + fr, fq * 8);
#define PG8_SA(b, h) (((b) * 2 + (h)) * HTB)
#define PG8_SB(b, h) ((4 + (b) * 2 + (h)) * HTB)
#define PG8_STAGE(bufoff, gbase, voff) do { _Pragma("unroll") for (int _i = 0; _i < 2; ++_i) \
        __builtin_amdgcn_global_load_lds((const unsigned*)((const char*)(gbase) + (voff)[_i]), (PG8_LAS unsigned*)(lds + (bufoff) + ldsw + _i * 8192), 16, 0, 0); } while (0)
#define PG8_LDA(dst, b, h) do { _Pragma("unroll") for (int m = 0; m < 4; ++m) _Pragma("unroll") for (int k = 0; k < 2; ++k) dst[m][k] = *(const PG8_LAS bf16x8*)(lds + PG8_SA(b, h) + aoff + m * 2048 + k * 1024); } while (0)
#define PG8_LDB(dst, b, h) do { _Pragma("unroll") for (int n = 0; n < 2; ++n) _Pragma("unroll") for (int k = 0; k < 2; ++k) dst[n][k] = *(const PG8_LAS bf16x8*)(lds + PG8_SB(b, h) + boff + n * 2048 + k * 1024); } while (0)
#define PG8_MMA(ai, bj, At, Bt) do { __builtin_amdgcn_s_setprio(1); _Pragma("unroll") for (int m = 0; m < 4; ++m) _Pragma("unroll") for (int n = 0; n < 2; ++n) _Pragma("unroll") for (int k = 0; k < 2; ++k) \
        acc[ai][bj][m][n] = __builtin_amdgcn_mfma_f32_16x16x32_bf16(Bt[n][k], At[m][k], acc[ai][bj][m][n], 0, 0, 0); __builtin_amdgcn_s_setprio(0); } while (0)
#define PG8_WAIT_V(n) asm volatile("s_waitcnt vmcnt(" #n ")" ::: "memory")
#define PG8_WAIT_L(n) asm volatile("s_waitcnt lgkmcnt(" #n ")" ::: "memory")
#define PG8_BAR __builtin_amdgcn_s_barrier()
#define PG8_SCHED __builtin_amdgcn_sched_barrier(0)
#define PG8_BP(b0, b1, t) (((t) < nth) ? ((b0) + (size_t)(t) * kstep) : ((b1) + (size_t)((t) - nth) * kstep))
    Unit cur, nxt; int ui = 0;
    if (!S.next(0, cur)) return;
    f32x4 acc[2][2][4][2];
#pragma unroll
    for (int a = 0; a < 2; ++a)
#pragma unroll
        for (int b = 0; b < 2; ++b)
#pragma unroll
            for (int m = 0; m < 4; ++m)
#pragma unroll
                for (int n = 0; n < 2; ++n) acc[a][b][m][n] = (f32x4){0.f, 0.f, 0.f, 0.f};
    bf16x8 At[4][2], B0[2][2], B1[2][2];
    const char* cA = S.a_ptr(cur); const char* cB0 = S.b_ptr(cur, 0); const char* cB1 = S.b_ptr(cur, 1);
    {
        const char* b0 = PG8_BP(cB0, cB1, 0); const char* b1 = PG8_BP(cB0, cB1, 1);
        PG8_STAGE(PG8_SB(0, 0), b0, voffB); PG8_STAGE(PG8_SB(0, 1), b0 + hstepB, voffB); PG8_STAGE(PG8_SA(0, 0), cA, voffA); PG8_STAGE(PG8_SA(0, 1), cA + hstepA, voffA);
        if (wr == 1) PG8_BAR;
        PG8_WAIT_V(2); PG8_BAR;
        PG8_STAGE(PG8_SB(1, 0), b1, voffB); PG8_STAGE(PG8_SA(1, 0), cA + kstep, voffA); PG8_STAGE(PG8_SB(1, 1), b1 + hstepB, voffB);
        PG8_WAIT_V(6); PG8_BAR;
    }
    for (;;) {
        const bool has_next = S.next(ui + 1, nxt);
        const char* nA = has_next ? S.a_ptr(nxt) : cA; const char* nB0 = has_next ? S.b_ptr(nxt, 0) : cB0; const char* nB1 = has_next ? S.b_ptr(nxt, 1) : cB1;
        for (int t = 0; t < nt; t += 2) {
            const bool last = (t == nt - 2);
            const char* a1 = cA + (size_t)(t + 1) * kstep;
            const char* a2 = last ? nA : cA + (size_t)(t + 2) * kstep;
            const char* a3 = a2 + kstep;
            const char* b2 = last ? PG8_BP(nB0, nB1, 0) : PG8_BP(cB0, cB1, t + 2);
            const char* b3 = last ? PG8_BP(nB0, nB1, 1) : PG8_BP(cB0, cB1, t + 3);
            PG8_LDB(B0, 0, 0); PG8_LDB(B1, 0, 1); PG8_SCHED; PG8_LDA(At, 0, 0); PG8_STAGE(PG8_SA(1, 1), a1 + hstepA, voffA);
            PG8_WAIT_V(8); PG8_WAIT_L(0); PG8_BAR; PG8_MMA(0, 0, At, B0); PG8_MMA(0, 1, At, B1); PG8_BAR; PG8_SCHED;
            PG8_LDA(At, 0, 1); PG8_STAGE(PG8_SB(0, 0), b2, voffB); PG8_STAGE(PG8_SB(0, 1), b2 + hstepB, voffB); PG8_STAGE(PG8_SA(0, 0), a2, voffA);
            PG8_WAIT_V(8); PG8_WAIT_L(0); PG8_BAR; PG8_MMA(1, 0, At, B0); PG8_MMA(1, 1, At, B1); PG8_BAR; PG8_SCHED;
            PG8_LDB(B0, 1, 0); PG8_LDB(B1, 1, 1); PG8_SCHED; PG8_LDA(At, 1, 0); PG8_STAGE(PG8_SA(0, 1), a2 + hstepA, voffA);
            PG8_WAIT_V(8); PG8_WAIT_L(0); PG8_BAR; PG8_MMA(0, 0, At, B0); PG8_MMA(0, 1, At, B1); PG8_BAR; PG8_SCHED;
            PG8_LDA(At, 1, 1); PG8_STAGE(PG8_SB(1, 0), b3, voffB); PG8_STAGE(PG8_SB(1, 1), b3 + hstepB, voffB); PG8_STAGE(PG8_SA(1, 0), a3, voffA);
            PG8_WAIT_V(8); PG8_WAIT_L(0); PG8_BAR; PG8_MMA(1, 0, At, B0); PG8_MMA(1, 1, At, B1); PG8_BAR; PG8_SCHED;
        }
        if (wr == 0) PG8_BAR;
        E(acc, cur, wr, wc, fr, fq);
        if (!has_next) break;
#pragma unroll
        for (int a = 0; a < 2; ++a)
#pragma unroll
            for (int b = 0; b < 2; ++b)
#pragma unroll
                for (int m = 0; m < 4; ++m)
#pragma unroll
                    for (int n = 0; n < 2; ++n) acc[a][b][m][n] = (f32x4){0.f, 0.f, 0.f, 0.f};
        cur = nxt; cA = nA; cB0 = nB0; cB1 = nB1; ++ui;
        if (wr == 1) PG8_BAR;
    }
    PG8_WAIT_V(0);
    PG8_BAR;
#undef PG8_SA
#undef PG8_SB
#undef PG8_STAGE
#undef PG8_LDA
#undef PG8_LDB
#undef PG8_MMA
#undef PG8_WAIT_V
#undef PG8_WAIT_L
#undef PG8_BAR
#undef PG8_SCHED
#undef PG8_BP
}
}
#define GAS __attribute__((address_space(1)))
#define LAS __attribute__((address_space(3)))
typedef GAS unsigned gu32;
#define RLX_AGENT __ATOMIC_RELAXED, __HIP_MEMORY_SCOPE_AGENT
#define XB_TMO      128
#define XB_XCNT(j)  (256  + 64 * (j))
#define XB_XSUB(j)  (1280 + 64 * (j))
#define XB_XGEN(j)  (2304 + 64 * (j))
#define XB_TOP      3328
#define XB_TOPGEN   3392
#define XCD_BAR_WORDS 3456
#define XB_SPIN_CAP (1u << 18)

__device__ __forceinline__ unsigned xb_ld(unsigned* p)              { return __hip_atomic_load(p, __ATOMIC_RELAXED, __HIP_MEMORY_SCOPE_AGENT); }
__device__ __forceinline__ unsigned xb_add(unsigned* p, unsigned v) { return __hip_atomic_fetch_add(p, v, __ATOMIC_RELAXED, __HIP_MEMORY_SCOPE_AGENT); }
__device__ __forceinline__ unsigned xb_xcc_id() { return (unsigned)__builtin_amdgcn_s_getreg((3 << 11) | 20) & 0xFu; }
#define XB_SPIN(cond, bar) do { unsigned _sp = 0; while (cond) { __builtin_amdgcn_s_sleep(1); \
    if ((++_sp & 255u) == 0u) { if (xb_ld(&(bar)[XB_TMO])) break; if (_sp > XB_SPIN_CAP) { atomicAdd(&(bar)[XB_TMO], 1u); break; } } } } while (0)

struct XcdBarrier {
    unsigned* bar; unsigned x;
    unsigned w0;
    volatile LAS unsigned* st;
};

__device__ __forceinline__ XcdBarrier xcd_barrier_post(unsigned* bar, volatile LAS unsigned* st) {
    XcdBarrier b; b.bar = bar; b.x = xb_xcc_id(); b.st = st; b.w0 = (__builtin_amdgcn_readfirstlane(threadIdx.x >> 6) == 0) ? 1u : 0u;
    if (threadIdx.x == 0) (void)xb_add(&bar[XB_XCNT(b.x)], 1u);
    return b;
}
__device__ __forceinline__ void xcd_barrier_complete(unsigned* bar, unsigned x, unsigned& nloc, unsigned& nx) {
    const unsigned G = gridDim.x * gridDim.y * gridDim.z;
    unsigned sum, cnt, mine, sp = 0u;
    for (;;) {
        sum = 0u; cnt = 0u; mine = 0u;
#pragma unroll
        for (unsigned j = 0; j < 16; ++j) { const unsigned c = xb_ld(&bar[XB_XCNT(j)]); sum += c; cnt += (c > 0u) ? 1u : 0u; mine = (j == x) ? c : mine; }
        if (sum == G) break;
        __builtin_amdgcn_s_sleep(1);
        if ((++sp & 255u) == 0u) { if (xb_ld(&bar[XB_TMO])) break; if (sp > XB_SPIN_CAP) { atomicAdd(&bar[XB_TMO], 1u); break; } }
    }
    nloc = mine > 0u ? mine : 1u; nx = cnt > 0u ? cnt : 1u;
}

__device__ __forceinline__ void xcd_barrier(const XcdBarrier& b) {
    asm volatile("s_waitcnt vmcnt(0)" ::: "memory");
    __syncthreads();
    if (b.w0 && __builtin_amdgcn_mbcnt_hi(~0u, __builtin_amdgcn_mbcnt_lo(~0u, 0u)) == 0u) {
        unsigned* bar = b.bar;
        __builtin_amdgcn_s_waitcnt(0);
        unsigned nloc = b.st[0], nx = b.st[1];
        if (nloc == 0u) { xcd_barrier_complete(bar, b.x, nloc, nx); b.st[0] = nloc; b.st[1] = nx; }
        const unsigned old = xb_add(&bar[XB_XSUB(b.x)], 1u);
        const unsigned gen = old / nloc;
        if (old + 1u == (gen + 1u) * nloc) {
            __builtin_amdgcn_fence(__ATOMIC_RELEASE, "agent");
            asm volatile("s_waitcnt vmcnt(0)" ::: "memory");
            const unsigned og = xb_add(&bar[XB_TOP], 1u);
            const unsigned tg = og / nx;
            if (og + 1u == (tg + 1u) * nx) xb_add(&bar[XB_TOPGEN], 1u);
            else XB_SPIN(xb_ld(&bar[XB_TOPGEN]) == tg, bar);
            __builtin_amdgcn_fence(__ATOMIC_ACQUIRE, "agent");
            xb_add(&bar[XB_XGEN(b.x)], 1u);
            asm volatile("s_waitcnt vmcnt(0)" ::: "memory");
        } else {
            XB_SPIN(xb_ld(&bar[XB_XGEN(b.x)]) == gen, bar);
            __builtin_amdgcn_fence(__ATOMIC_ACQUIRE, "agent");
            asm volatile("s_waitcnt vmcnt(0)" ::: "memory");
        }
    }
    __syncthreads();
}
constexpr int NWAVES = 8;
constexpr size_t MiB = 1u << 20;
constexpr size_t WS_CTL = 0, CTL_ZERO_BYTES = 1 * MiB;
constexpr size_t WS_KMEAN = 1 * MiB;
constexpr size_t WS_WIN = 2 * MiB, WS_WOUT = 9 * MiB, WS_WUQ = 11 * MiB, WS_WUKV = 11 * MiB + 512 * 1024;
constexpr size_t WS_ACT = 12 * MiB, WS_PROJ = 44 * MiB, WS_PROJF = 140 * MiB, WS_XBCA = 156 * MiB, WS_QKA = 180 * MiB, WS_QM = 196 * MiB, WS_KM = 208 * MiB, WS_VM = 220 * MiB;
constexpr size_t WS_PREVT = 242 * MiB, WS_CST = 250 * MiB, WS_NST = 254 * MiB;
constexpr size_t WS_ROPE = 228 * MiB, WS_CQN = 230 * MiB, WS_CKVN = 238 * MiB, WS_ST = 230 * MiB  , WS_END = 256 * MiB;
constexpr int CW_BAR = 4096;
constexpr int MAX_BAR_REGIONS = 24;
static_assert((CW_BAR + MAX_BAR_REGIONS * 3456) * 4 <= (int)CTL_ZERO_BYTES, "CTL words inside the memset region");
constexpr int PROJ_N = 3328;
constexpr int RING_OFF = 0, RING_BYTES = 131072, LDSCTL_OFF = RING_BYTES, MISC_OFF = LDSCTL_OFF + 320, PTR_OFF = MISC_OFF + 128, LDS_BYTES = 147456;

__host__ __device__ inline int src_col(int c) {
    if (c < 1792) return c;
    if (c < 2304) return 1796 + (c - 1792);
    if (c < 2560) return 2308 + (c - 2304);
    if (c < 2816) return 2572 + (c - 2560);
    if (c < 3072) return 2828 + (c - 2816);
    const int f = c - 3072;
    if (f < 128) return 3084 + f;
    if (f < 160) return 3212 + (f - 128);
    if (f < 164) return 1792 + (f - 160);
    if (f < 168) return 2564 + (f - 164);
    if (f < 172) return 2568 + (f - 168);
    return -1;
}

typedef unsigned v4u __attribute__((ext_vector_type(4)));
typedef float f32x4 __attribute__((ext_vector_type(4)));
#define LDS_WAIT() asm volatile("s_waitcnt lgkmcnt(0)" ::: "memory")
#define VM_WAIT() asm volatile("s_waitcnt vmcnt(0)" ::: "memory")
__device__ __forceinline__ unsigned pk2(float lo, float hi) { return (unsigned)f2bf(lo) | ((unsigned)f2bf(hi) << 16); }

__device__ __forceinline__ const float* in_ptr(LAS unsigned char* lds, int i) {
    const unsigned long long v = ((const LAS unsigned long long*)(lds + PTR_OFF))[i];
    const unsigned lo = __builtin_amdgcn_readfirstlane((unsigned)v), hi = __builtin_amdgcn_readfirstlane((unsigned)(v >> 32));
    return (const float*)(((unsigned long long)hi << 32) | lo);
}
#ifdef ST_WT_OFF
__device__ __forceinline__ void st_wt(float* p, float v) { *p = v; }
__device__ __forceinline__ void st_wt(int* p, int v) { *p = v; }
#else
__device__ __forceinline__ void st_wt(float* p, float v) { __hip_atomic_store(p, v, __ATOMIC_RELAXED, __HIP_MEMORY_SCOPE_AGENT); }
__device__ __forceinline__ void st_wt(int* p, int v) { __hip_atomic_store(p, v, __ATOMIC_RELAXED, __HIP_MEMORY_SCOPE_AGENT); }
#endif
struct Args {
    const float* in[29]; float* out; unsigned char* ws; int ph_lo, ph_hi, bli, pad;
};

struct MapInProj { const float* W; __device__ const float* ptr(int) const { return W; } __device__ int col(int n) const { return src_col(n); } __device__ float scale(int n) const { return n < 256 ? C2A : 1.f; } };
struct MapPlain { const float* W; int ncols; float sc; __device__ const float* ptr(int) const { return W; } __device__ int col(int n) const { return n < ncols ? n : -1; } __device__ float scale(int) const { return sc; } };
template <class Map>
__device__ __forceinline__ void conv_item(const Map& mp, int ldw, int K, bf16_t* WT, int nblk, LAS float* scr, int item, int lane) {
    const int kb = item / nblk, nb = item % nblk, k0 = 64 * kb, n0 = 32 * nb;
    const int c4 = lane & 7, kr = lane >> 3;
    const int nd = n0 + 4 * c4; const int sc = mp.col(nd); const float scl = mp.scale(nd); const float* base = mp.ptr(nd);
    f32x4 v[8];
#pragma unroll
    for (int i = 0; i < 8; ++i) v[i] = sc >= 0 ? __builtin_nontemporal_load((const GAS f32x4*)(base + (size_t)(k0 + 8 * i + kr) * ldw + sc)) : (f32x4){0.f, 0.f, 0.f, 0.f};
#pragma unroll
    for (int i = 0; i < 8; ++i) { LAS float* d = scr + (8 * i + kr) * 33 + 4 * c4; d[0] = v[i].x * scl; d[1] = v[i].y * scl; d[2] = v[i].z * scl; d[3] = v[i].w * scl; }
    LDS_WAIT(); asm volatile("" ::: "memory");
    const int c = lane & 7;
#pragma unroll
    for (int j = 0; j < 4; ++j) { const int n = (lane >> 3) + 8 * j; const LAS float* s = scr + (8 * c) * 33 + n;
        v4u o; o.x = pk2(s[0 * 33], s[1 * 33]); o.y = pk2(s[2 * 33], s[3 * 33]); o.z = pk2(s[4 * 33], s[5 * 33]); o.w = pk2(s[6 * 33], s[7 * 33]);
        *(GAS v4u*)(WT + (size_t)(n0 + n) * K + k0 + 8 * c) = o; }
    LDS_WAIT(); asm volatile("" ::: "memory");
}
__device__ __forceinline__ void rms_row_to_bf16(const float* xrow, const float* g, bf16_t* orow, float* xcopy, int lane) {
    const GAS f32x4* xr = (const GAS f32x4*)xrow + lane; const GAS f32x4* gr = (const GAS f32x4*)g + lane;
    f32x4 v[4]; float s = 0.f;
#pragma unroll
    for (int j = 0; j < 4; ++j) { v[j] = __builtin_nontemporal_load(xr + 64 * j); s += (v[j].x * v[j].x + v[j].y * v[j].y) + (v[j].z * v[j].z + v[j].w * v[j].w); }
    const float rstd = rsqrtf(wave_sum(s) * (1.f / DM) + EPS);
    if (xcopy) { GAS f32x4* xc = (GAS f32x4*)xcopy + lane;
#pragma unroll
        for (int j = 0; j < 4; ++j) xc[64 * j] = v[j]; }
    GAS unsigned long long* o8 = (GAS unsigned long long*)orow + lane;
#pragma unroll
    for (int j = 0; j < 4; ++j) { const f32x4 gg = gr[64 * j];
        o8[64 * j] = (unsigned long long)pk2(v[j].x * rstd * gg.x, v[j].y * rstd * gg.y) | ((unsigned long long)pk2(v[j].z * rstd * gg.z, v[j].w * rstd * gg.w) << 32); }
}
__device__ __forceinline__ void rms_row_to_f32(const float* xrow, const float* g, float* orow, int lane) {
    const GAS f32x4* xr = (const GAS f32x4*)xrow + lane; const GAS f32x4* gr = (const GAS f32x4*)g + lane;
    f32x4 v[4]; float s = 0.f;
#pragma unroll
    for (int j = 0; j < 4; ++j) { v[j] = __builtin_nontemporal_load(xr + 64 * j); s += (v[j].x * v[j].x + v[j].y * v[j].y) + (v[j].z * v[j].z + v[j].w * v[j].w); }
    const float rstd = rsqrtf(wave_sum(s) * (1.f / DM) + EPS);
    GAS f32x4* o = (GAS f32x4*)orow + lane;
#pragma unroll
    for (int j = 0; j < 4; ++j) { const f32x4 gg = gr[64 * j]; __builtin_nontemporal_store((f32x4){v[j].x * rstd * gg.x, v[j].y * rstd * gg.y, v[j].z * rstd * gg.z, v[j].w * rstd * gg.w}, o + 64 * j); }
}

struct EpiInProj {
    bf16_t* proj; float* projf;
    __device__ __forceinline__ void operator()(const pg8::f32x4 (&acc)[2][2][4][2], const pg8::Unit& u, int wr, int wc, int fr, int fq) const {
        const int row0 = u.pm * 256 + wr * 64 + fr, col0 = wc * 32 + 8 * fq;
        if (u.pn < 12) {
#pragma unroll
            for (int ai = 0; ai < 2; ++ai)
#pragma unroll
                for (int m = 0; m < 4; ++m) { bf16_t* rowp = proj + (size_t)(row0 + ai * 128 + m * 16) * PROJ_W + u.pn * 256 + col0;
#pragma unroll
                    for (int bj = 0; bj < 2; ++bj) { const pg8::f32x4 v0 = acc[ai][bj][m][0], v1 = acc[ai][bj][m][1]; pg8::u32x4 w;
                        w.x = pg8::cvt_pk_bf16(v0[0], v0[1]); w.y = pg8::cvt_pk_bf16(v0[2], v0[3]); w.z = pg8::cvt_pk_bf16(v1[0], v1[1]); w.w = pg8::cvt_pk_bf16(v1[2], v1[3]);
                        *(pg8::u32x4*)(rowp + bj * 128) = w; } }
        } else {
#pragma unroll
            for (int ai = 0; ai < 2; ++ai)
#pragma unroll
                for (int m = 0; m < 4; ++m) { float* rowp = projf + (size_t)(row0 + ai * 128 + m * 16) * PROJF_W + col0;
#pragma unroll
                    for (int bj = 0; bj < 2; ++bj) { *(pg8::f32x4*)(rowp + bj * 128) = acc[ai][bj][m][0]; *(pg8::f32x4*)(rowp + bj * 128 + 4) = acc[ai][bj][m][1]; } }
        }
    }
};
struct EpiResidualF32 {
    float* x; const float* src;
    __device__ __forceinline__ void operator()(const pg8::f32x4 (&acc)[2][2][4][2], const pg8::Unit& u, int wr, int wc, int fr, int fq) const {
        const int row0 = u.pm * 256 + wr * 64 + fr, col0 = u.pn * 256 + wc * 32 + 8 * fq;
#pragma unroll
        for (int ai = 0; ai < 2; ++ai)
#pragma unroll
            for (int m = 0; m < 4; m += 2) {
                pg8::f32x4 xv[2][2][2];
#pragma unroll
                for (int mm = 0; mm < 2; ++mm) { const float* srcp = src + (size_t)(row0 + ai * 128 + (m + mm) * 16) * DM + col0;
#pragma unroll
                    for (int bj = 0; bj < 2; ++bj) { const GAS pg8::f32x4* q = (const GAS pg8::f32x4*)(srcp + bj * 128); xv[mm][bj][0] = q[0]; xv[mm][bj][1] = q[1]; } }
#pragma unroll
                for (int mm = 0; mm < 2; ++mm) { float* rowp = x + (size_t)(row0 + ai * 128 + (m + mm) * 16) * DM + col0;
#pragma unroll
                    for (int bj = 0; bj < 2; ++bj) { pg8::f32x4* p = (pg8::f32x4*)(rowp + bj * 128); p[0] = xv[mm][bj][0] + acc[ai][bj][m + mm][0]; p[1] = xv[mm][bj][1] + acc[ai][bj][m + mm][1]; } }
                asm volatile("" ::: "memory"); }
    }
};


struct EpiMlaQ {
    bf16_t* qm; const float* rope;
    __device__ __forceinline__ void operator()(const pg8::f32x4 (&acc)[2][2][4][2], const pg8::Unit& u, int wr, int wc, int fr, int fq) const {
        const int row0 = u.pm * 256 + wr * 64 + fr;
#pragma unroll
        for (int bj = 0; bj < 2; ++bj) {
            const int colg = u.pn * 256 + bj * 128 + wc * 32;
            if (colg >= 384) continue;
            const bool is_rope = ((colg >> 5) % 3) == 2;
#pragma unroll
            for (int ai = 0; ai < 2; ++ai)
#pragma unroll
                for (int m = 0; m < 4; ++m) {
                    const int row = row0 + ai * 128 + m * 16;
                    pg8::f32x4 v0 = acc[ai][bj][m][0], v1 = acc[ai][bj][m][1];
                    if (is_rope) {
                        pg8::f32x4 w0, w1;
#pragma unroll
                        for (int j = 0; j < 4; ++j) { w0[j] = __shfl_xor(v0[j], 32); w1[j] = __shfl_xor(v1[j], 32); }
                        const int i0 = (8 * fq) & 15;
                        const float* rp = rope + (size_t)row * 32 + i0;
                        const pg8::f32x4 c0 = *(const pg8::f32x4*)rp, c1 = *(const pg8::f32x4*)(rp + 4), s0 = *(const pg8::f32x4*)(rp + 16), s1 = *(const pg8::f32x4*)(rp + 20);
                        if (fq < 2) { v0 = v0 * c0 - w0 * s0; v1 = v1 * c1 - w1 * s1; } else { v0 = v0 * c0 + w0 * s0; v1 = v1 * c1 + w1 * s1; }
                    }
                    pg8::u32x4 w; w.x = pg8::cvt_pk_bf16(v0[0], v0[1]); w.y = pg8::cvt_pk_bf16(v0[2], v0[3]); w.z = pg8::cvt_pk_bf16(v1[0], v1[1]); w.w = pg8::cvt_pk_bf16(v1[2], v1[3]);
                    *(pg8::u32x4*)(qm + (size_t)row * 384 + colg + 8 * fq) = w;
                }
        }
    }
};
struct EpiMlaKVf {
    bf16_t* km; bf16_t* vm;
    __device__ __forceinline__ void operator()(const pg8::f32x4 (&acc)[2][2][4][2], const pg8::Unit& u, int wr, int wc, int fr, int fq) const {
        const int row0 = u.pm * 256 + wr * 64 + fr;
#pragma unroll
        for (int bj = 0; bj < 2; ++bj) {
            const int col = u.pn * 256 + bj * 128 + wc * 32 + 8 * fq, hh = col >> 7, d = col & 127;
#pragma unroll
            for (int ai = 0; ai < 2; ++ai)
#pragma unroll
                for (int m = 0; m < 4; ++m) {
                    const int row = row0 + ai * 128 + m * 16;
                    const pg8::f32x4 v0 = acc[ai][bj][m][0], v1 = acc[ai][bj][m][1];
                    pg8::u32x4 w; w.x = pg8::cvt_pk_bf16(v0[0], v0[1]); w.y = pg8::cvt_pk_bf16(v0[2], v0[3]); w.z = pg8::cvt_pk_bf16(v1[0], v1[1]); w.w = pg8::cvt_pk_bf16(v1[2], v1[3]);
                    bf16_t* dst = (d < 64) ? km + (size_t)row * 384 + hh * 96 + d : vm + (size_t)row * 256 + hh * 64 + (d - 64);
                    *(pg8::u32x4*)dst = w;
                }
        }
    }
};

__device__ __forceinline__ void conv_chunk(const bf16_t* proj, int m, int c0, int ch, int C, const float* w, const float* bias, bf16_t* dst, float osc) {
    const int t = m & (SEQ - 1);
    float acc[8];
    { const f32x4 b0 = *(const f32x4*)(bias + ch * 8), b1 = *(const f32x4*)(bias + ch * 8 + 4);
      acc[0] = b0.x; acc[1] = b0.y; acc[2] = b0.z; acc[3] = b0.w; acc[4] = b1.x; acc[5] = b1.y; acc[6] = b1.z; acc[7] = b1.w; }
#pragma unroll
    for (int i = 0; i < 4; ++i) {
        if (t - 3 + i >= 0) {
            const us8 x = *(const us8*)(proj + (size_t)(m - 3 + i) * PROJ_W + c0 + ch * 8);
            const f32x4 w0 = *(const f32x4*)(w + i * C + ch * 8), w1 = *(const f32x4*)(w + i * C + ch * 8 + 4);
            acc[0] += w0.x * bf2f(x[0]); acc[1] += w0.y * bf2f(x[1]); acc[2] += w0.z * bf2f(x[2]); acc[3] += w0.w * bf2f(x[3]);
            acc[4] += w1.x * bf2f(x[4]); acc[5] += w1.y * bf2f(x[5]); acc[6] += w1.z * bf2f(x[6]); acc[7] += w1.w * bf2f(x[7]);
        }
    }
    v4u o; o.x = pk2(silu_f(acc[0]) * osc, silu_f(acc[1]) * osc); o.y = pk2(silu_f(acc[2]) * osc, silu_f(acc[3]) * osc); o.z = pk2(silu_f(acc[4]) * osc, silu_f(acc[5]) * osc); o.w = pk2(silu_f(acc[6]) * osc, silu_f(acc[7]) * osc);
    *(v4u*)(dst + (size_t)m * C + ch * 8) = o;
}
__device__ __forceinline__ void conv_seg(const bf16_t* proj, int m0, int c0, int ch, int C, const float* w, const float* bias, bf16_t* dst, float osc) {
    const int t0 = m0 & (SEQ - 1);
    f32x4 wa[4], wb[4];
#pragma unroll
    for (int i = 0; i < 4; ++i) { wa[i] = *(const f32x4*)(w + i * C + ch * 8); wb[i] = *(const f32x4*)(w + i * C + ch * 8 + 4); }
    const f32x4 b0 = *(const f32x4*)(bias + ch * 8), b1 = *(const f32x4*)(bias + ch * 8 + 4);
    const bf16_t* src = proj + (size_t)m0 * PROJ_W + c0 + ch * 8;
    us8 x0 = us8{}, x1 = us8{}, x2 = us8{};
    if (t0 > 0) { x0 = *(const us8*)(src - 3 * (ptrdiff_t)PROJ_W); x1 = *(const us8*)(src - 2 * (ptrdiff_t)PROJ_W); x2 = *(const us8*)(src - (ptrdiff_t)PROJ_W); }
    for (int j = 0; j < 32; j += 8) {
        us8 xn[8];
#pragma unroll
        for (int k = 0; k < 8; ++k) xn[k] = __builtin_nontemporal_load((const us8*)(src + (size_t)(j + k) * PROJ_W));
#pragma unroll
        for (int k = 0; k < 8; ++k) {
            float acc[8] = {b0.x, b0.y, b0.z, b0.w, b1.x, b1.y, b1.z, b1.w};
#define CS_TAP(i, xv) do { acc[0] += wa[i].x * bf2f(xv[0]); acc[1] += wa[i].y * bf2f(xv[1]); acc[2] += wa[i].z * bf2f(xv[2]); acc[3] += wa[i].w * bf2f(xv[3]); \
                           acc[4] += wb[i].x * bf2f(xv[4]); acc[5] += wb[i].y * bf2f(xv[5]); acc[6] += wb[i].z * bf2f(xv[6]); acc[7] += wb[i].w * bf2f(xv[7]); } while (0)
            const bool h3 = (t0 + j + k) >= 3, h2 = (t0 + j + k) >= 2, h1 = (t0 + j + k) >= 1;
            if (h3) CS_TAP(0, x0);
            if (h2) CS_TAP(1, x1);
            if (h1) CS_TAP(2, x2);
            CS_TAP(3, xn[k]);
#undef CS_TAP
            v4u o; o.x = pk2(silu_f(acc[0]) * osc, silu_f(acc[1]) * osc); o.y = pk2(silu_f(acc[2]) * osc, silu_f(acc[3]) * osc); o.z = pk2(silu_f(acc[4]) * osc, silu_f(acc[5]) * osc); o.w = pk2(silu_f(acc[6]) * osc, silu_f(acc[7]) * osc);
            *(v4u*)(dst + (size_t)(m0 + j + k) * C + ch * 8) = o;
            x0 = x1; x1 = x2; x2 = xn[k];
        }
    }
}
__device__ __forceinline__ void mla_prep_token(int m, int lane, const bf16_t* proj, const float* projf, const int* positions, const float* gq, const float* gkv,
                                               bf16_t* cqn, bf16_t* ckvn, bf16_t* km, float* rope) {
    { const us4 v = *(const us4*)(proj + (size_t)m * PROJ_W + PC_CQ + lane * 4);
      const float a = bf2f(v.x), b = bf2f(v.y), c = bf2f(v.z), d = bf2f(v.w);
      const float r = rsqrtf(wave_sum(a * a + b * b + c * c + d * d) * (1.f / 256.f) + EPS);
      const f32x4 g = *(const f32x4*)(gq + lane * 4);
      *(unsigned long long*)(cqn + (size_t)m * 256 + lane * 4) = (unsigned long long)pk2(a * r * g.x, b * r * g.y) | ((unsigned long long)pk2(c * r * g.z, d * r * g.w) << 32); }
    { const float a = projf[(size_t)m * PROJF_W + PF_CKV + lane * 2], b = projf[(size_t)m * PROJF_W + PF_CKV + lane * 2 + 1];
      const float r = rsqrtf(wave_sum(a * a + b * b) * (1.f / 128.f) + EPS);
      *(unsigned*)(ckvn + (size_t)m * 128 + lane * 2) = pk2(a * r * gkv[lane * 2], b * r * gkv[lane * 2 + 1]); }
    if (lane < 16) {
        const float pos = (float)positions[m];
        const float inv = powf(10000.f, -(float)(2 * lane) / 32.f);
        float sn, cs; sincosf(pos * inv, &sn, &cs);
        rope[(size_t)m * 32 + lane] = cs; rope[(size_t)m * 32 + 16 + lane] = sn;
        const float x1 = projf[(size_t)m * PROJF_W + PF_KR + lane], x2 = projf[(size_t)m * PROJF_W + PF_KR + 16 + lane];
        const bf16_t o1 = f2bf(x1 * cs - x2 * sn), o2 = f2bf(x2 * cs + x1 * sn);
#pragma unroll
        for (int hh = 0; hh < 4; ++hh) { km[(size_t)m * 384 + hh * 96 + 64 + lane] = o1; km[(size_t)m * 384 + hh * 96 + 80 + lane] = o2; }
    }
}
__device__ __forceinline__ void kmean_item(int item, int lane, const bf16_t* proj, float* kmean) {
    const int jg = item >> 2, hh = item & 3, cc = lane & 7, rg = lane >> 3;
    float acc[8];
#pragma unroll
    for (int i = 0; i < 8; ++i) acc[i] = 0.f;
#pragma unroll 8
    for (int r = 0; r < 32; ++r) { const us8 x = *(const us8*)(proj + (size_t)(jg * 256 + rg * 32 + r) * PROJ_W + PC_AK + hh * 64 + cc * 8);
#pragma unroll
        for (int i = 0; i < 8; ++i) acc[i] += bf2f(x[i]); }
#pragma unroll
    for (int i = 0; i < 8; ++i) { float v = acc[i]; v += __shfl_xor(v, 8); v += __shfl_xor(v, 16); v += __shfl_xor(v, 32); acc[i] = v * (1.f / 256.f); }
    if (rg == 0) { *(f32x4*)(kmean + jg * 256 + hh * 64 + cc * 8) = (f32x4){acc[0], acc[1], acc[2], acc[3]}; *(f32x4*)(kmean + jg * 256 + hh * 64 + cc * 8 + 4) = (f32x4){acc[4], acc[5], acc[6], acc[7]}; }
}

constexpr size_t WS_WUP = 44 * MiB, WS_WDN = 60 * MiB, WS_XS = 68 * MiB, WS_HID = 112 * MiB, WS_STOK = 134 * MiB, WS_SW1 = WS_STOK + 128 * 1024, WS_SW2 = WS_STOK + 256 * 1024,
                 WS_TCLS = 135 * MiB, WS_TPOS = WS_TCLS + 64 * 1024, WS_TW1 = WS_TCLS + 128 * 1024, WS_TW2 = WS_TCLS + 192 * 1024;
constexpr int MOE_MAXTILES = 88, CW_MOECNT = 200000;
constexpr int TCLS_OFF = LDSCTL_OFF, OFFS_OFF = LDSCTL_OFF + 128;
__device__ __forceinline__ void pair_decode(int pr, int& a, int& b) { a = (pr < 3) ? 0 : ((pr < 5) ? 1 : 2); b = (pr < 3) ? pr + 1 : ((pr < 5) ? pr - 1 : 3); }
__device__ __forceinline__ int moe_tiles(const unsigned* cnt, LAS unsigned char* lds, bool t0) {
    LAS unsigned char* tcls = lds + TCLS_OFF; LAS int* offs = (LAS int*)(lds + OFFS_OFF);
    __syncthreads();
    if (threadIdx.x < 24) offs[threadIdx.x] = (int)cnt[32 * threadIdx.x];
    __syncthreads();
    if (t0) { int off = 0;
        _Pragma("unroll 1") for (int c = 0; c < 24; ++c) { const int n = offs[c]; offs[c] = off; const int nt = (n + 255) >> 8; _Pragma("unroll 1") for (int t = 0; t < nt; ++t) tcls[(off >> 8) + t] = (unsigned char)c; off += nt << 8; }
        offs[24] = off; }
    __syncthreads();
    return offs[24] >> 8;
}
struct MoeOrder {
    const bf16_t* A; const bf16_t* W; int lda, ldb; size_t estride; int K; int ntile, G, c; const LAS unsigned char* tcls; bool down;
    __device__ bool next(int i, pg8::Unit& u) const { const int L = i * G + c; if (L >= ntile * 4) return false; u.pm = L >> 2; u.pn = L & 3; return true; }
    __device__ __forceinline__ const char* a_ptr(const pg8::Unit& u) const { return (const char*)A + (size_t)u.pm * 256 * lda * 2; }
    __device__ __forceinline__ const char* b_ptr(const pg8::Unit& u, int half) const {
        const int cls = tcls[u.pm], g = cls / 6; int ea, eb; pair_decode(cls - g * 6, ea, eb);
        if (down) { const int e = g * 4 + (half ? eb : ea); return (const char*)(W + (size_t)e * estride + (size_t)u.pn * 256 * ldb); }
        const int e = g * 4 + ((u.pn < 2) ? ea : eb); return (const char*)(W + (size_t)e * estride + (size_t)(u.pn & 1) * 256 * ldb + (half ? K / 2 : 0));
    }
};
struct EpiMoeUp {
    bf16_t* hid; const float* w1; const float* w2;
    __device__ __forceinline__ void operator()(const pg8::f32x4 (&acc)[2][2][4][2], const pg8::Unit& u, int wr, int wc, int fr, int fq) const {
        const int row0 = u.pm * 256 + wr * 64 + fr; const float* ws = (u.pn < 2) ? w1 : w2;
#pragma unroll
        for (int ai = 0; ai < 2; ++ai)
#pragma unroll
            for (int m = 0; m < 4; ++m) { const int row = row0 + ai * 128 + m * 16; const float wt = ws[row];
                const pg8::f32x4 g0 = acc[ai][0][m][0], g1 = acc[ai][0][m][1], u0 = acc[ai][1][m][0], u1 = acc[ai][1][m][1];
                pg8::u32x4 w;
                w.x = pg8::cvt_pk_bf16(silu_f(g0[0]) * u0[0] * wt, silu_f(g0[1]) * u0[1] * wt); w.y = pg8::cvt_pk_bf16(silu_f(g0[2]) * u0[2] * wt, silu_f(g0[3]) * u0[3] * wt);
                w.z = pg8::cvt_pk_bf16(silu_f(g1[0]) * u1[0] * wt, silu_f(g1[1]) * u1[1] * wt); w.w = pg8::cvt_pk_bf16(silu_f(g1[2]) * u1[2] * wt, silu_f(g1[3]) * u1[3] * wt);
                *(pg8::u32x4*)(hid + (size_t)row * 512 + u.pn * 128 + wc * 32 + 8 * fq) = w; }
    }
};
struct EpiMoeDown {
    float* x; const int* stok;
    __device__ __forceinline__ void operator()(const pg8::f32x4 (&acc)[2][2][4][2], const pg8::Unit& u, int wr, int wc, int fr, int fq) const {
        const int row0 = u.pm * 256 + wr * 64 + fr, col0 = u.pn * 256 + wc * 32 + 8 * fq;
        int toks[2][4];
#pragma unroll
        for (int ai = 0; ai < 2; ++ai)
#pragma unroll
            for (int m = 0; m < 4; ++m) toks[ai][m] = stok[row0 + ai * 128 + m * 16];
#pragma unroll
        for (int ai = 0; ai < 2; ++ai)
#pragma unroll
            for (int m = 0; m < 4; m += 2) {
                pg8::f32x4 xv[2][2][2];
#pragma unroll
                for (int mm = 0; mm < 2; ++mm) { const int tok = toks[ai][m + mm];
                    if (tok >= 0) { const float* rowp = x + (size_t)tok * DM + col0;
#pragma unroll
                        for (int bj = 0; bj < 2; ++bj) { const pg8::f32x4* p = (const pg8::f32x4*)(rowp + bj * 128); xv[mm][bj][0] = p[0]; xv[mm][bj][1] = p[1]; } } }
#pragma unroll
                for (int mm = 0; mm < 2; ++mm) { const int tok = toks[ai][m + mm];
                    if (tok >= 0) { float* rowp = x + (size_t)tok * DM + col0;
#pragma unroll
                        for (int bj = 0; bj < 2; ++bj) { pg8::f32x4* p = (pg8::f32x4*)(rowp + bj * 128); p[0] = xv[mm][bj][0] + acc[ai][bj][m + mm][0]; p[1] = xv[mm][bj][1] + acc[ai][bj][m + mm][1]; } } }
                asm volatile("" ::: "memory"); }
    }
};
struct MapMoeUp { const float* W; int fbase;
    __device__ const float* ptr(int) const { return W; } __device__ int col(int n) const { return fbase + (n & 127); } __device__ float scale(int) const { return 1.f; } };
constexpr int RW_PITCH = 1028;
__device__ __forceinline__ void route_token(int m, int lane, const float* X, const float* g, const LAS float* rw, const float* bg, const float* br, bf16_t* xn2,
                                            unsigned* cnt, int* tcls, int* tpos, float* tw1, float* tw2) {
    asm volatile("" : "+v"(lane));
    const GAS f32x4* xr = (const GAS f32x4*)(X + (size_t)m * DM) + lane; const GAS f32x4* gr = (const GAS f32x4*)g + lane;
    f32x4 v[4]; float s = 0.f;
#pragma unroll
    for (int j = 0; j < 4; ++j) { v[j] = __builtin_nontemporal_load(xr + 64 * j); s += (v[j].x * v[j].x + v[j].y * v[j].y) + (v[j].z * v[j].z + v[j].w * v[j].w); }
    const float rstd = rsqrtf(wave_sum(s) * (1.f / DM) + EPS);
    GAS unsigned long long* o8 = (GAS unsigned long long*)(xn2 + (size_t)m * DM) + lane;
#pragma unroll
    for (int j = 0; j < 4; ++j) { const f32x4 gg = gr[64 * j]; v[j] = (f32x4){v[j].x * rstd * gg.x, v[j].y * rstd * gg.y, v[j].z * rstd * gg.z, v[j].w * rstd * gg.w};
        o8[64 * j] = (unsigned long long)pk2(v[j].x, v[j].y) | ((unsigned long long)pk2(v[j].z, v[j].w) << 32); }
    float lg[20];
#pragma unroll
    for (int q = 0; q < 20; ++q) { float p = 0.f;
#pragma unroll
        for (int j = 0; j < 4; ++j) { const f32x4 w = *(const LAS f32x4*)(rw + q * RW_PITCH + 4 * (64 * j + lane)); p += (v[j].x * w.x + v[j].y * w.y) + (v[j].z * w.z + v[j].w * w.w); }
        lg[q] = wave_sum(p) + (q < 4 ? bg[q] : br[q - 4]); }
    int gi = 0; float gm = lg[0];
#pragma unroll
    for (int j = 1; j < 4; ++j) if (lg[j] > gm) { gm = lg[j]; gi = j; }
    float gs = 0.f;
#pragma unroll
    for (int j = 0; j < 4; ++j) gs += __expf(lg[j] - gm);
    const float g_w = 1.f / gs;
    float el[4];
#pragma unroll
    for (int j = 0; j < 4; ++j) el[j] = (gi == 0) ? lg[4 + j] : (gi == 1) ? lg[8 + j] : (gi == 2) ? lg[12 + j] : lg[16 + j];
    const float em = fmaxf(fmaxf(el[0], el[1]), fmaxf(el[2], el[3]));
    float pe[4]; float es = 0.f;
#pragma unroll
    for (int j = 0; j < 4; ++j) { pe[j] = __expf(el[j] - em); es += pe[j]; }
    int e0 = 0; float p0 = pe[0];
#pragma unroll
    for (int j = 1; j < 4; ++j) if (pe[j] > p0) { p0 = pe[j]; e0 = j; }
    int e1 = -1; float p1 = -1.f;
#pragma unroll
    for (int j = 0; j < 4; ++j) if (j != e0 && pe[j] > p1) { p1 = pe[j]; e1 = j; }
    p0 /= es; p1 /= es;
    const float sw = p0 + p1; const float w0 = g_w * p0 / sw, w1 = g_w * p1 / sw;
    const int ea = e0 < e1 ? e0 : e1, eb = e0 < e1 ? e1 : e0; const float wa = e0 < e1 ? w0 : w1, wb = e0 < e1 ? w1 : w0;
    const int pr = (ea == 0) ? eb - 1 : (ea == 1) ? eb + 1 : 5;
    const int cls = gi * 6 + pr;
    if (lane == 0) { const unsigned pos = __hip_atomic_fetch_add(cnt + 32 * cls, 1u, __ATOMIC_RELAXED, __HIP_MEMORY_SCOPE_AGENT);
        tcls[m] = cls; tpos[m] = (int)pos; tw1[m] = wa; tw2[m] = wb; }
}
namespace att {
using bf16x8 = __attribute__((ext_vector_type(8))) short;
using s16x4 = __attribute__((ext_vector_type(4))) short;
using f32x16 = __attribute__((ext_vector_type(16))) float;
using u32x4 = __attribute__((ext_vector_type(4))) unsigned;
typedef short v4i16_t __attribute__((ext_vector_type(4)));
constexpr int NW = 8, QBLK = 32, QB = 256, KVBLK = 64;
constexpr int NSLOT = 3, KSLOT = 12288, VSLOT = 8192;
constexpr int LDS_K = 0, LDS_V = NSLOT * KSLOT, LDS_WS = LDS_V + NSLOT * VSLOT, LDS_OST = LDS_WS + NW * 256, LDS_BYTES_ATT = LDS_OST + NW * 4096;
__device__ __forceinline__ int crow(int r, int hi) { return (r & 3) + 8 * (r >> 2) + 4 * hi; }
__device__ __forceinline__ void glds16(const void* gsrc, unsigned lds_dst) { unsigned keep;
    asm volatile("s_mov_b32 %0, m0\n\ts_mov_b32 m0, %2\n\ts_nop 0\n\tglobal_load_lds_dwordx4 %1, off\n\ts_mov_b32 m0, %0" : "=&s"(keep) : "v"(gsrc), "s"(lds_dst) : "memory"); }
__device__ __forceinline__ unsigned cvtpk(float lo, float hi) { unsigned r; asm("v_cvt_pk_bf16_f32 %0, %1, %2" : "=v"(r) : "v"(lo), "v"(hi)); return r; }
__device__ __forceinline__ float xhalf_max(float m) { auto rr = __builtin_amdgcn_permlane32_swap(__float_as_uint(m), __float_as_uint(m), false, false); return fmaxf(__uint_as_float(rr[0]), __uint_as_float(rr[1])); }
__device__ __forceinline__ float xhalf_sum(float m) { auto rr = __builtin_amdgcn_permlane32_swap(__float_as_uint(m), __float_as_uint(m), false, false); return __uint_as_float(rr[0]) + __uint_as_float(rr[1]); }
__device__ __forceinline__ void pv(f32x16* o, int vb, bf16x8 pa0, bf16x8 pa1, bf16x8 pa2, bf16x8 pa3) {
#pragma unroll
    for (int d0 = 0; d0 < 2; ++d0) { s16x4 lo[4], hi[4];
#pragma unroll
        for (int ks = 0; ks < 4; ++ks) {
            asm volatile("ds_read_b64_tr_b16 %0,%1 offset:%c2" : "=&v"(lo[ks]) : "v"(vb), "i"(d0 * 4096 + ks * 1024) : "memory");
            asm volatile("ds_read_b64_tr_b16 %0,%1 offset:%c2" : "=&v"(hi[ks]) : "v"(vb), "i"(d0 * 4096 + ks * 1024 + 512) : "memory"); }
        asm volatile("s_waitcnt lgkmcnt(0)" ::: "memory"); __builtin_amdgcn_sched_barrier(0);
#define ATT_PK(k) (bf16x8){lo[k][0], lo[k][1], lo[k][2], lo[k][3], hi[k][0], hi[k][1], hi[k][2], hi[k][3]}
        o[d0] = __builtin_amdgcn_mfma_f32_32x32x16_bf16(pa0, ATT_PK(0), o[d0], 0, 0, 0);
        o[d0] = __builtin_amdgcn_mfma_f32_32x32x16_bf16(pa1, ATT_PK(1), o[d0], 0, 0, 0);
        o[d0] = __builtin_amdgcn_mfma_f32_32x32x16_bf16(pa2, ATT_PK(2), o[d0], 0, 0, 0);
        o[d0] = __builtin_amdgcn_mfma_f32_32x32x16_bf16(pa3, ATT_PK(3), o[d0], 0, 0, 0);
#undef ATT_PK
    }
}
#define ATT_WAIT_BAR(N) asm volatile("s_waitcnt vmcnt(" #N ") lgkmcnt(0)\n\ts_barrier" ::: "memory")

template <int DQK, bool MOBA>
__device__ __forceinline__ void attn_unit(int b, int h, int qb, const bf16_t* Q, int qpitch, int qcol0, const bf16_t* K, int kpitch, int kcol0, const bf16_t* V, int vpitch, int vcol0,
                                          bf16_t* O, int ocol0, const float* kmean, LAS unsigned char* shm, const int wid) {
    constexpr int ND0 = DQK / 16;
    int lane = (int)__builtin_amdgcn_mbcnt_hi(~0u, __builtin_amdgcn_mbcnt_lo(~0u, 0u)); asm volatile("" : "+v"(lane));
    const int r32 = lane & 31, hi = lane >> 5;
    const long rowbase = (long)b * SEQ; const int q0 = qb * QB;
    const bf16_t* Qw = Q + (rowbase + q0 + wid * QBLK) * qpitch + qcol0;
    const bf16_t* Kh = K + rowbase * kpitch + kcol0; const bf16_t* Vh = V + rowbase * vpitch + vcol0;
    const unsigned lds0 = (unsigned)(size_t)shm;
    LAS float* wsf = (LAS float*)(shm + LDS_WS) + wid * 64;
    const bf16_t* ksrc0 = Kh + (long)lane * kpitch + wid * 8;
    const bf16_t* ksrc1 = Kh + (long)lane * kpitch + (8 + (wid & 3)) * 8;
    const bf16_t* vsrc = Vh + (long)(16 * (wid & 3) + (lane >> 2)) * vpitch + (wid >> 2) * 32 + (lane & 3) * 8;
    const unsigned kdst0 = lds0 + LDS_K + wid * 1024, kdst1 = lds0 + LDS_K + (8 + (wid & 3)) * 1024, vdst = lds0 + LDS_V + wid * 1024;
#define ATT_DMA(t, slot) do { glds16(ksrc0 + (long)(t) * KVBLK * kpitch, (unsigned)__builtin_amdgcn_readfirstlane(kdst0 + (slot) * KSLOT)); \
        if (DQK == 96) glds16(ksrc1 + (long)(t) * KVBLK * kpitch, (unsigned)__builtin_amdgcn_readfirstlane(kdst1 + (slot) * KSLOT)); \
        glds16(vsrc + (long)(t) * KVBLK * vpitch, (unsigned)__builtin_amdgcn_readfirstlane(vdst + (slot) * VSLOT)); } while (0)
    const int NT = (q0 + QB) / KVBLK;
    ATT_DMA(0, 0); ATT_DMA(1, 1);
    bf16x8 qr[ND0];
#pragma unroll
    for (int d0 = 0; d0 < ND0; ++d0) qr[d0] = *reinterpret_cast<const bf16x8*>(&Qw[(long)r32 * qpitch + d0 * 16 + hi * 8]);
    unsigned sel = 0xffffffffu;
    if (MOBA) {
        float v0 = -INFINITY, v1 = -INFINITY, v2 = -INFINITY; int i0 = -1, i1 = -1, i2 = -1;
#ifdef ATT_KM_GLOBAL
        const float* kmb = kmean + (size_t)(b * 32) * 256 + h * 64 + hi * 8;
#else
        constexpr int LDS_KM = 98304;
        static_assert(NSLOT == 3, "LDS_KM assumes the 3-slot layout");
        LAS float* kml = (LAS float*)(shm + LDS_KM);
        { const float* kmg = kmean + (size_t)(b * 32) * 256 + h * 64; const int tid_ = wid * 64 + lane;
          for (int i = tid_; i < qb * 16; i += NW * 64) { const int j = i >> 4, c4 = i & 15; *(LAS pg8::f32x4*)(kml + j * 64 + c4 * 4) = *(const pg8::f32x4*)(kmg + (size_t)j * 256 + c4 * 4); }
          asm volatile("s_waitcnt vmcnt(0) lgkmcnt(0)\n\ts_barrier" ::: "memory"); }
        const LAS float* kmb = kml + hi * 8;
#endif
        for (int j = 0; j < qb; ++j) {
            float g = 0.f;
#pragma unroll
            for (int d0 = 0; d0 < 4; ++d0) {
#ifdef ATT_KM_GLOBAL
                const pg8::f32x4 ka = *(const pg8::f32x4*)(kmb + j * 256 + d0 * 16), kb2 = *(const pg8::f32x4*)(kmb + j * 256 + d0 * 16 + 4);
#else
                const pg8::f32x4 ka = *(const LAS pg8::f32x4*)(kmb + j * 64 + d0 * 16), kb2 = *(const LAS pg8::f32x4*)(kmb + j * 64 + d0 * 16 + 4);
#endif
                const bf16x8 qq = qr[d0];
                g += bf2f((bf16_t)qq[0]) * ka.x + bf2f((bf16_t)qq[1]) * ka.y + bf2f((bf16_t)qq[2]) * ka.z + bf2f((bf16_t)qq[3]) * ka.w
                   + bf2f((bf16_t)qq[4]) * kb2.x + bf2f((bf16_t)qq[5]) * kb2.y + bf2f((bf16_t)qq[6]) * kb2.z + bf2f((bf16_t)qq[7]) * kb2.w; }
            g = xhalf_sum(g);
            if (g > v0) { v2 = v1; i2 = i1; v1 = v0; i1 = i0; v0 = g; i0 = j; }
            else if (g > v1) { v2 = v1; i2 = i1; v1 = g; i1 = j; }
            else if (g > v2) { v2 = g; i2 = j; }
        }
        sel = 0u;
        if (i0 >= 0) sel |= 1u << i0;
        if (i1 >= 0) sel |= 1u << i1;
        if (i2 >= 0) sel |= 1u << i2;
    }
    float m_run = -1e30f, l_run = 0.f; f32x16 o[2]; o[0] = f32x16{}; o[1] = f32x16{};
    const int qrel = wid * QBLK + r32;
    const int vb0 = (int)(lds0 + LDS_V) + ((lane >> 4) & 1) * 32 + (lane & 3) * 8 + (4 * hi + ((lane & 15) >> 2)) * 64;
    int slot = 0;
    for (int t = 0; t < NT; ++t) {
        if (t + 1 < NT) { if (DQK == 96) ATT_WAIT_BAR(3); else ATT_WAIT_BAR(2); } else ATT_WAIT_BAR(0);
        if (t + 2 < NT) { const int s2 = (slot == 0) ? 2 : slot - 1; ATT_DMA(t + 2, s2); }
        f32x16 p0, p1;
        { const LAS unsigned char* kb = shm + LDS_K + slot * KSLOT + hi * 1024 + r32 * 16;
#pragma unroll
          for (int d0 = 0; d0 < ND0; ++d0) {
              const bf16x8 b0 = *(const LAS bf16x8*)(kb + d0 * 2048), b1 = *(const LAS bf16x8*)(kb + d0 * 2048 + 512);
              if (d0 == 0) { p0 = __builtin_amdgcn_mfma_f32_32x32x16_bf16(b0, qr[0], f32x16{}, 0, 0, 0); p1 = __builtin_amdgcn_mfma_f32_32x32x16_bf16(b1, qr[0], f32x16{}, 0, 0, 0); }
              else { p0 = __builtin_amdgcn_mfma_f32_32x32x16_bf16(b0, qr[d0], p0, 0, 0, 0); p1 = __builtin_amdgcn_mfma_f32_32x32x16_bf16(b1, qr[d0], p1, 0, 0, 0); } } }
        const int jb = t - (NT - 4);
        if (jb >= 0) { const int kb0 = 64 * jb + 4 * hi;
#pragma unroll
            for (int r = 0; r < 16; ++r) { const int kv = kb0 + (r & 3) + 8 * (r >> 2); if (kv > qrel) p0[r] = -INFINITY; if (kv + 32 > qrel) p1[r] = -INFINITY; } }
        else if (MOBA) { if (!((sel >> (t >> 2)) & 1u)) {
#pragma unroll
            for (int r = 0; r < 16; ++r) { p0[r] = -INFINITY; p1[r] = -INFINITY; } } }
        float rm = fmaxf(p0[0], p1[0]);
#pragma unroll
        for (int r = 1; r < 16; ++r) rm = fmaxf(rm, fmaxf(p0[r], p1[r]));
        rm = xhalf_max(rm);
        const float m_new = fmaxf(m_run, rm); const float alpha = __builtin_amdgcn_exp2f(m_run - m_new); m_run = m_new;
        float ls = 0.f;
#pragma unroll
        for (int r = 0; r < 16; ++r) { p0[r] = __builtin_amdgcn_exp2f(p0[r] - m_new); p1[r] = __builtin_amdgcn_exp2f(p1[r] - m_new); ls += p0[r] + p1[r]; }
        l_run = l_run * alpha + ls;
        if (hi == 0) wsf[r32] = alpha;
        asm volatile("s_waitcnt lgkmcnt(0)" ::: "memory");
#pragma unroll
        for (int r = 0; r < 16; ++r) { const float a = wsf[crow(r, hi)]; o[0][r] *= a; o[1][r] *= a; }
        u32x4 pw0, pw1, pw2, pw3;
        pw0 = (u32x4){cvtpk(p0[0], p0[1]), cvtpk(p0[2], p0[3]), cvtpk(p0[4], p0[5]), cvtpk(p0[6], p0[7])};
        pw1 = (u32x4){cvtpk(p0[8], p0[9]), cvtpk(p0[10], p0[11]), cvtpk(p0[12], p0[13]), cvtpk(p0[14], p0[15])};
        pw2 = (u32x4){cvtpk(p1[0], p1[1]), cvtpk(p1[2], p1[3]), cvtpk(p1[4], p1[5]), cvtpk(p1[6], p1[7])};
        pw3 = (u32x4){cvtpk(p1[8], p1[9]), cvtpk(p1[10], p1[11]), cvtpk(p1[12], p1[13]), cvtpk(p1[14], p1[15])};
        asm volatile("s_waitcnt lgkmcnt(0)" ::: "memory");
        pv(o, vb0 + slot * VSLOT, __builtin_bit_cast(bf16x8, pw0), __builtin_bit_cast(bf16x8, pw1), __builtin_bit_cast(bf16x8, pw2), __builtin_bit_cast(bf16x8, pw3));
        slot = (slot == 2) ? 0 : slot + 1;
    }
    l_run = xhalf_sum(l_run);
    if (hi == 0) wsf[32 + r32] = l_run;
    asm volatile("s_waitcnt lgkmcnt(0)" ::: "memory");
    float rli[16];
#pragma unroll
    for (int r = 0; r < 16; ++r) rli[r] = __builtin_amdgcn_rcpf(wsf[32 + crow(r, hi)]);
    bf16_t* Ow = O + (rowbase + q0 + wid * QBLK) * DM + ocol0;
    { LAS bf16_t* stg = (LAS bf16_t*)(shm + LDS_OST) + wid * 2048;
#pragma unroll
      for (int r = 0; r < 16; ++r) { const int orow = crow(r, hi);
#pragma unroll
          for (int d0 = 0; d0 < 2; ++d0) stg[orow * 64 + d0 * 32 + r32] = f2bf(o[d0][r] * rli[r]); }
      asm volatile("s_waitcnt lgkmcnt(0)" ::: "memory");
#pragma unroll
      for (int i = 0; i < 4; ++i) { const int row = i * 8 + (lane >> 3), ch = lane & 7; const u32x4 v = *(const LAS u32x4*)(stg + row * 64 + ch * 8); *(u32x4*)(Ow + (long)row * DM + ch * 8) = v; } }
    asm volatile("s_waitcnt vmcnt(0) lgkmcnt(0)\n\ts_barrier" ::: "memory");
#undef ATT_DMA
}
#undef ATT_WAIT_BAR
}
namespace ck {
using att::bf16x8; using att::s16x4; using att::f32x16; using att::u32x4; using att::crow; using att::cvtpk; using att::xhalf_sum;
constexpr int CL = 128, NCH = SEQ / CL;
__device__ __forceinline__ int lane_id() { return (int)__builtin_amdgcn_mbcnt_hi(~0u, __builtin_amdgcn_mbcnt_lo(~0u, 0u)); }
#define CK_TRF(dst, vb, OFF) do { s16x4 lo_, hi_; \
    asm volatile("ds_read_b64_tr_b16 %0,%1 offset:%c2" : "=&v"(lo_) : "v"(vb), "i"(OFF) : "memory"); \
    asm volatile("ds_read_b64_tr_b16 %0,%1 offset:%c2" : "=&v"(hi_) : "v"(vb), "i"((OFF) + 512) : "memory"); \
    asm volatile("s_waitcnt lgkmcnt(0)" ::: "memory"); \
    dst = (bf16x8){lo_[0], lo_[1], lo_[2], lo_[3], hi_[0], hi_[1], hi_[2], hi_[3]}; } while (0)
__device__ __forceinline__ int tr_lane_off(int lane) { const int hi = lane >> 5; return ((lane >> 4) & 1) * 32 + (lane & 3) * 8 + (4 * hi + ((lane & 15) >> 2)) * 64; }
__device__ __forceinline__ void stage_v64(LAS unsigned char* dst, const bf16_t* src, int gp, int tid, const LAS float* rowscale) {
    const int row = tid >> 3, j = tid & 7;
    us8 v = *(const us8*)(src + (size_t)row * gp + 8 * j);
    if (rowscale) { const float s = rowscale[row];
#pragma unroll
        for (int i = 0; i < 8; ++i) v[i] = f2bf(bf2f(v[i]) * s); }
    *(LAS us8*)(dst + (j >> 2) * 4096 + row * 64 + (j & 3) * 16) = v;
}
template <int DQ> __device__ __forceinline__ void stage_k64(LAS unsigned char* dst, const bf16_t* src, int gp, int tid) {
#pragma unroll
    for (int pc = tid; pc < 64 * (DQ / 8); pc += 512) { const int row = pc / (DQ / 8), c = pc % (DQ / 8);
        *(LAS us8*)(dst + c * 1024 + row * 16) = *(const us8*)(src + (size_t)row * gp + 8 * c); }
}
__device__ __forceinline__ void scan128(float a0, float a1, int lane, float& s0, float& s1) {
    float t = a0 + a1;
#pragma unroll
    for (int o = 1; o < 64; o <<= 1) { const float u = __shfl_up(t, o); if (lane >= o) t += u; }
    s1 = t; s0 = t - a1;
}

__device__ __forceinline__ void ssd_s1_unit(int unit, const bf16_t* xbca, const float* projf, const float* dt_bias, const float* a_log, float* S, float* dec, LAS unsigned char* shm, int wave) {
    const int g = unit & 1, c = (unit >> 1) & (NCH - 1), b = unit >> 7;
    int lane = lane_id(); asm volatile("" : "+v"(lane));
    const int tid = wave * 64 + lane; const size_t m0 = (size_t)b * SEQ + (size_t)c * CL;
    LAS float* wtab = (LAS float*)(shm + 65536);
    if (wave < 2) { const int h = 2 * g + wave; const float a = -__expf(a_log[h]), dtb = dt_bias[h];
        const float d0 = softplus_f(projf[(m0 + 2 * lane) * PROJF_W + PF_DT + h] + dtb), d1 = softplus_f(projf[(m0 + 2 * lane + 1) * PROJF_W + PF_DT + h] + dtb);
        float s0, s1; scan128(d0 * a, d1 * a, lane, s0, s1);
        const float alast = __shfl(s1, 63);
        wtab[wave * 128 + 2 * lane] = __expf(alast - s0) * d0; wtab[wave * 128 + 2 * lane + 1] = __expf(alast - s1) * d1;
        if (lane == 0) dec[((size_t)b * NCH + c) * 4 + h] = __expf(alast); }
    __syncthreads();
#pragma unroll
    for (int hh = 0; hh < 2; ++hh)
#pragma unroll
        for (int rt = 0; rt < 2; ++rt) stage_v64(shm + (hh * 2 + rt) * 8192, xbca + (m0 + rt * 64) * 768 + (2 * g + hh) * 64, 768, tid, wtab + hh * 128 + rt * 64);
#pragma unroll
    for (int rt = 0; rt < 2; ++rt)
#pragma unroll
        for (int ct = 0; ct < 2; ++ct) stage_v64(shm + 32768 + (rt * 2 + ct) * 8192, xbca + (m0 + rt * 64) * 768 + 256 + g * 128 + ct * 64, 768, tid, nullptr);
    __syncthreads();
    const int hh = wave >> 2, j = wave & 3, r32 = lane & 31, hi = lane >> 5; const int lo = tr_lane_off(lane);
    f32x16 acc0 = f32x16{}, acc1 = f32x16{};
#pragma unroll
    for (int rt = 0; rt < 2; ++rt) {
        const int vx = (int)(unsigned)(size_t)(shm + (hh * 2 + rt) * 8192) + lo, vbm = (int)(unsigned)(size_t)(shm + 32768 + (rt * 2 + (j >> 1)) * 8192) + lo + (j & 1) * 4096;
#define CK_STEP(ks) do { bf16x8 fb, fa0, fa1; CK_TRF(fb, vbm, (ks) * 1024); CK_TRF(fa0, vx, (ks) * 1024); CK_TRF(fa1, vx, 4096 + (ks) * 1024); \
        acc0 = __builtin_amdgcn_mfma_f32_32x32x16_bf16(fa0, fb, acc0, 0, 0, 0); acc1 = __builtin_amdgcn_mfma_f32_32x32x16_bf16(fa1, fb, acc1, 0, 0, 0); } while (0)
        CK_STEP(0); CK_STEP(1); CK_STEP(2); CK_STEP(3);
#undef CK_STEP
    }
    float* Sp = S + (((size_t)b * NCH + c) * 4 + 2 * g + hh) * 8192 + (size_t)(32 * j + r32) * 64;
#pragma unroll
    for (int q = 0; q < 4; ++q) { *(pg8::f32x4*)(Sp + 8 * q + 4 * hi) = (pg8::f32x4){acc0[4 * q], acc0[4 * q + 1], acc0[4 * q + 2], acc0[4 * q + 3]};
                                  *(pg8::f32x4*)(Sp + 32 + 8 * q + 4 * hi) = (pg8::f32x4){acc1[4 * q], acc1[4 * q + 1], acc1[4 * q + 2], acc1[4 * q + 3]}; }
    __syncthreads();
}

__device__ __forceinline__ void ml_s1_unit(int unit, const bf16_t* qka, const bf16_t* proj, const float* projf, const float* ig_bias, const float* fg_bias, float* U, float* nU, float* dec,
                                           LAS unsigned char* shm, int wave) {
    const int hp = unit & 1, c = (unit >> 1) & (NCH - 1), b = unit >> 7;
    int lane = lane_id(); asm volatile("" : "+v"(lane));
    const int tid = wave * 64 + lane; const size_t m0 = (size_t)b * SEQ + (size_t)c * CL;
    LAS float* wtab = (LAS float*)(shm + 65536);
    if (wave < 2) { const int h = 2 * hp + wave; const float igb = ig_bias[h], fgb = fg_bias[h];
        const float f0 = projf[(m0 + 2 * lane) * PROJF_W + PF_MF + h] + fgb, f1 = projf[(m0 + 2 * lane + 1) * PROJF_W + PF_MF + h] + fgb;
        const float l0 = fminf(f0, 0.f) - log1pf(__expf(-fabsf(f0))), l1 = fminf(f1, 0.f) - log1pf(__expf(-fabsf(f1)));
        const float i0 = projf[(m0 + 2 * lane) * PROJF_W + PF_MI + h] + igb, i1 = projf[(m0 + 2 * lane + 1) * PROJF_W + PF_MI + h] + igb;
        float s0, s1; scan128(l0, l1, lane, s0, s1);
        const float blast = __shfl(s1, 63);
        wtab[wave * 128 + 2 * lane] = __expf(blast - s0 + i0); wtab[wave * 128 + 2 * lane + 1] = __expf(blast - s1 + i1);
        if (lane == 0) dec[((size_t)b * NCH + c) * 4 + h] = __expf(blast); }
    __syncthreads();
#pragma unroll
    for (int hh = 0; hh < 2; ++hh)
#pragma unroll
        for (int rt = 0; rt < 2; ++rt) {
            stage_v64(shm + (hh * 2 + rt) * 8192, qka + (m0 + rt * 64) * 512 + 256 + (2 * hp + hh) * 64, 512, tid, wtab + hh * 128 + rt * 64);
            stage_v64(shm + 32768 + (hh * 2 + rt) * 8192, proj + (m0 + rt * 64) * PROJ_W + PC_MV + (2 * hp + hh) * 64, PROJ_W, tid, nullptr); }
    __syncthreads();
    const int hh = wave >> 2, db = (wave >> 1) & 1, eb = wave & 1, r32 = lane & 31, hi = lane >> 5; const int lo = tr_lane_off(lane);
    f32x16 acc = f32x16{};
#pragma unroll
    for (int rt = 0; rt < 2; ++rt) {
        const int vk = (int)(unsigned)(size_t)(shm + (hh * 2 + rt) * 8192) + lo + db * 4096, vv = (int)(unsigned)(size_t)(shm + 32768 + (hh * 2 + rt) * 8192) + lo + eb * 4096;
#define CK_STEP(ks) do { bf16x8 fa, fb; CK_TRF(fa, vv, (ks) * 1024); CK_TRF(fb, vk, (ks) * 1024); acc = __builtin_amdgcn_mfma_f32_32x32x16_bf16(fa, fb, acc, 0, 0, 0); } while (0)
        CK_STEP(0); CK_STEP(1); CK_STEP(2); CK_STEP(3);
#undef CK_STEP
    }
    const size_t ub = ((size_t)b * NCH + c) * 4 + 2 * hp + hh;
    float* Up = U + ub * 4096 + (size_t)(32 * db + r32) * 64 + 32 * eb;
#pragma unroll
    for (int q = 0; q < 4; ++q) *(pg8::f32x4*)(Up + 8 * q + 4 * hi) = (pg8::f32x4){acc[4 * q], acc[4 * q + 1], acc[4 * q + 2], acc[4 * q + 3]};
    if (tid < 128) { const int h2 = tid >> 6, d = tid & 63; float s = 0.f;
        for (int rt = 0; rt < 2; ++rt) { const LAS bf16_t* kp = (const LAS bf16_t*)(shm + (h2 * 2 + rt) * 8192 + (d >> 5) * 4096) + (d & 31);
            for (int r = 0; r < 64; ++r) s += bf2f(kp[r * 32]); }
        nU[(((size_t)b * NCH + c) * 4 + 2 * hp + h2) * 64 + d] = s; }
    __syncthreads();
}

__device__ __forceinline__ void scan_phase(int gtid, int ngt, const float* S, const float* sdec, bf16_t* prevT, const float* U, const float* nU, const float* mdec, bf16_t* Cst, float* nst) {
    constexpr int N1 = 2 * 4 * 8192, N2 = 2 * 4 * 4096, N3 = 2 * 4 * 64;
#define SCAN_RUN(SRC, DEC, STRIDE, STORE) do { float st = 0.f; \
        for (int c0 = 0; c0 < NCH; c0 += 16) { float sv[16], dv[16]; \
            _Pragma("unroll") for (int k = 0; k < 16; ++k) { const size_t u = ((size_t)b * NCH + c0 + k) * 4 + h; sv[k] = SRC[u * STRIDE + e]; dv[k] = DEC[u]; } \
            _Pragma("unroll") for (int k = 0; k < 16; ++k) { const size_t u = ((size_t)b * NCH + c0 + k) * 4 + h; STORE; st = dv[k] * st + sv[k]; } } } while (0)
    for (int idx = gtid; idx < N1 + N2 + N3; idx += ngt) {
        if (idx < N1) { const int e = idx & 8191, h = (idx >> 13) & 3, b = idx >> 15; SCAN_RUN(S, sdec, 8192, prevT[u * 8192 + e] = f2bf(st)); }
        else if (idx < N1 + N2) { const int i2 = idx - N1, e = i2 & 4095, h = (i2 >> 12) & 3, b = i2 >> 14; SCAN_RUN(U, mdec, 4096, Cst[u * 4096 + e] = f2bf(st)); }
        else { const int i3 = idx - N1 - N2, e = i3 & 63, h = (i3 >> 6) & 3, b = i3 >> 8; SCAN_RUN(nU, mdec, 64, nst[u * 64 + e] = st); }
    }
#undef SCAN_RUN
}

#define CK_PACK(p0, p1, pw0, pw1, pw2, pw3) do { \
    pw0 = (u32x4){cvtpk(p0[0], p0[1]), cvtpk(p0[2], p0[3]), cvtpk(p0[4], p0[5]), cvtpk(p0[6], p0[7])}; \
    pw1 = (u32x4){cvtpk(p0[8], p0[9]), cvtpk(p0[10], p0[11]), cvtpk(p0[12], p0[13]), cvtpk(p0[14], p0[15])}; \
    pw2 = (u32x4){cvtpk(p1[0], p1[1]), cvtpk(p1[2], p1[3]), cvtpk(p1[4], p1[5]), cvtpk(p1[6], p1[7])}; \
    pw3 = (u32x4){cvtpk(p1[8], p1[9]), cvtpk(p1[10], p1[11]), cvtpk(p1[12], p1[13]), cvtpk(p1[14], p1[15])}; } while (0)
__device__ __forceinline__ bf16x8 pv_afrag(const bf16_t* rowp, int ks, int hi, float scale) {
    const us4 a = *(const us4*)(rowp + 16 * ks + 4 * hi), b2 = *(const us4*)(rowp + 16 * ks + 8 + 4 * hi);
    u32x4 w; w.x = cvtpk(bf2f(a.x) * scale, bf2f(a.y) * scale); w.y = cvtpk(bf2f(a.z) * scale, bf2f(a.w) * scale);
    w.z = cvtpk(bf2f(b2.x) * scale, bf2f(b2.y) * scale); w.w = cvtpk(bf2f(b2.z) * scale, bf2f(b2.w) * scale);
    return __builtin_bit_cast(bf16x8, w);
}

__device__ __forceinline__ void ssd_s3_unit(int unit, const bf16_t* xbca, const bf16_t* proj, const float* projf, const float* dt_bias, const float* a_log, const float* d_skip, const float* norm_g,
                                            const bf16_t* prevT, bf16_t* ycat, LAS unsigned char* shm, int wave) {
    const int g = unit & 1, c = (unit >> 1) & (NCH - 1), b = unit >> 7;
    int lane = lane_id(); asm volatile("" : "+v"(lane));
    const int tid = wave * 64 + lane; const size_t m0 = (size_t)b * SEQ + (size_t)c * CL;
    LAS float* acum = (LAS float*)(shm + 98304); LAS float* dtt = acum + 256; LAS float* ssq = dtt + 256;
    if (wave < 2) { const int h = 2 * g + wave; const float a = -__expf(a_log[h]), dtb = dt_bias[h];
        const float d0 = softplus_f(projf[(m0 + 2 * lane) * PROJF_W + PF_DT + h] + dtb), d1 = softplus_f(projf[(m0 + 2 * lane + 1) * PROJF_W + PF_DT + h] + dtb);
        float s0, s1; scan128(d0 * a, d1 * a, lane, s0, s1);
        acum[wave * 128 + 2 * lane] = s0; acum[wave * 128 + 2 * lane + 1] = s1; dtt[wave * 128 + 2 * lane] = d0; dtt[wave * 128 + 2 * lane + 1] = d1; }
#pragma unroll
    for (int rt = 0; rt < 2; ++rt) stage_k64<128>(shm + rt * 16384, xbca + (m0 + rt * 64) * 768 + 256 + g * 128, 768, tid);
#pragma unroll
    for (int hh = 0; hh < 2; ++hh)
#pragma unroll
        for (int rt = 0; rt < 2; ++rt) {
            stage_v64(shm + 32768 + (hh * 2 + rt) * 8192, xbca + (m0 + rt * 64) * 768 + (2 * g + hh) * 64, 768, tid, nullptr);
            stage_v64(shm + 65536 + (hh * 2 + rt) * 8192, prevT + (((size_t)b * NCH + c) * 4 + 2 * g + hh) * 8192 + rt * 64 * 64, 64, tid, nullptr); }
    __syncthreads();
    const int hh = wave >> 2, rw = wave & 3, r32 = lane & 31, hi = lane >> 5, h = 2 * g + hh; const int lo = tr_lane_off(lane);
    const int l = 32 * rw + r32;
    const bf16_t* crowp = xbca + (m0 + l) * 768 + 512 + g * 128;
    f32x16 o[2]; o[0] = f32x16{}; o[1] = f32x16{};
    {
        bf16x8 qr[8];
#pragma unroll
        for (int d0 = 0; d0 < 8; ++d0) qr[d0] = *reinterpret_cast<const bf16x8*>(crowp + d0 * 16 + hi * 8);
        const float al = acum[hh * 128 + l];
        const int ntile = (rw >= 2) ? 2 : 1;
        for (int t = 0; t < ntile; ++t) {
            f32x16 p0 = f32x16{}, p1 = f32x16{};
            const LAS unsigned char* kb = shm + t * 16384 + hi * 1024 + r32 * 16;
#pragma unroll
            for (int d0 = 0; d0 < 8; ++d0) { const bf16x8 b0 = *(const LAS bf16x8*)(kb + d0 * 2048), b1 = *(const LAS bf16x8*)(kb + d0 * 2048 + 512);
                p0 = __builtin_amdgcn_mfma_f32_32x32x16_bf16(b0, qr[d0], p0, 0, 0, 0); p1 = __builtin_amdgcn_mfma_f32_32x32x16_bf16(b1, qr[d0], p1, 0, 0, 0); }
#pragma unroll
            for (int r = 0; r < 16; ++r) { const int s = 64 * t + crow(r, hi);
                const float w0 = (s <= l) ? __expf(al - acum[hh * 128 + s]) * dtt[hh * 128 + s] : 0.f, w1 = (s + 32 <= l) ? __expf(al - acum[hh * 128 + s + 32]) * dtt[hh * 128 + s + 32] : 0.f;
                p0[r] *= w0; p1[r] *= w1; }
            u32x4 pw0, pw1, pw2, pw3; CK_PACK(p0, p1, pw0, pw1, pw2, pw3);
            att::pv(o, (int)(unsigned)(size_t)(shm + 32768 + (hh * 2 + t) * 8192) + lo, __builtin_bit_cast(bf16x8, pw0), __builtin_bit_cast(bf16x8, pw1), __builtin_bit_cast(bf16x8, pw2), __builtin_bit_cast(bf16x8, pw3));
        }
        const float ea = __expf(al);
#pragma unroll
        for (int nt = 0; nt < 2; ++nt)
            att::pv(o, (int)(unsigned)(size_t)(shm + 65536 + (hh * 2 + nt) * 8192) + lo, pv_afrag(crowp + 64 * nt, 0, hi, ea), pv_afrag(crowp + 64 * nt, 1, hi, ea), pv_afrag(crowp + 64 * nt, 2, hi, ea), pv_afrag(crowp + 64 * nt, 3, hi, ea));
    }
    __syncthreads();
    LAS float* stg = (LAS float*)(shm + wave * 8704);
#pragma unroll
    for (int r = 0; r < 16; ++r) { const int orow = crow(r, hi); stg[orow * 68 + r32] = o[0][r]; stg[orow * 68 + 32 + r32] = o[1][r]; }
    asm volatile("s_waitcnt lgkmcnt(0)" ::: "memory");
    {
        const int row = lane >> 1, ch = lane & 1, lr = 32 * rw + row; const size_t m = m0 + lr;
        const float dsk = d_skip[h];
        float y[32]; float ss = 0.f;
#pragma unroll
        for (int q = 0; q < 4; ++q) { const us8 xv = *(const us8*)(xbca + m * 768 + h * 64 + ch * 32 + 8 * q), zv = *(const us8*)(proj + m * PROJ_W + PC_Z + h * 64 + ch * 32 + 8 * q);
#pragma unroll
            for (int i = 0; i < 8; ++i) { const float v = (stg[row * 68 + ch * 32 + 8 * q + i] + dsk * bf2f(xv[i])) * silu_f(bf2f(zv[i])); y[8 * q + i] = v; ss += v * v; } }
        ss += __shfl_xor(ss, 1);
        if (ch == 0) ssq[hh * 128 + lr] = ss;
        __syncthreads();
        const float tot = ssq[lr] + ssq[128 + lr];
        const float rstd = rsqrtf(tot * (1.f / 128.f) + EPS);
        const float* gp = norm_g + h * 64 + ch * 32;
        bf16_t* op = ycat + m * DM + 256 + h * 64 + ch * 32;
#pragma unroll
        for (int q = 0; q < 4; ++q) { v4u w; w.x = pk2(y[8 * q] * rstd * gp[8 * q], y[8 * q + 1] * rstd * gp[8 * q + 1]); w.y = pk2(y[8 * q + 2] * rstd * gp[8 * q + 2], y[8 * q + 3] * rstd * gp[8 * q + 3]);
            w.z = pk2(y[8 * q + 4] * rstd * gp[8 * q + 4], y[8 * q + 5] * rstd * gp[8 * q + 5]); w.w = pk2(y[8 * q + 6] * rstd * gp[8 * q + 6], y[8 * q + 7] * rstd * gp[8 * q + 7]);
            *(v4u*)(op + 8 * q) = w; }
    }
    __syncthreads();
}

__device__ __forceinline__ void ml_s3_unit(int unit, const bf16_t* qka, const bf16_t* proj, const float* projf, const float* ig_bias, const float* fg_bias, const float* norm_g,
                                           const bf16_t* Cst, const float* nst, bf16_t* ycat, LAS unsigned char* shm, int wave) {
    const int hp = unit & 1, c = (unit >> 1) & (NCH - 1), b = unit >> 7;
    int lane = lane_id(); asm volatile("" : "+v"(lane));
    const int tid = wave * 64 + lane; const size_t m0 = (size_t)b * SEQ + (size_t)c * CL;
    LAS float* bt = (LAS float*)(shm + 98304); LAS float* igt = bt + 256; LAS float* nt_ = igt + 256;
    LAS float* wsf = (LAS float*)(shm + 98304 + 4096) + wave * 64;
    if (wave < 2) { const int h = 2 * hp + wave; const float igb = ig_bias[h], fgb = fg_bias[h];
        const float f0 = projf[(m0 + 2 * lane) * PROJF_W + PF_MF + h] + fgb, f1 = projf[(m0 + 2 * lane + 1) * PROJF_W + PF_MF + h] + fgb;
        const float l0 = fminf(f0, 0.f) - log1pf(__expf(-fabsf(f0))), l1 = fminf(f1, 0.f) - log1pf(__expf(-fabsf(f1)));
        float s0, s1; scan128(l0, l1, lane, s0, s1);
        bt[wave * 128 + 2 * lane] = s0; bt[wave * 128 + 2 * lane + 1] = s1;
        igt[wave * 128 + 2 * lane] = projf[(m0 + 2 * lane) * PROJF_W + PF_MI + h] + igb; igt[wave * 128 + 2 * lane + 1] = projf[(m0 + 2 * lane + 1) * PROJF_W + PF_MI + h] + igb;
        nt_[wave * 64 + lane] = nst[(((size_t)b * NCH + c) * 4 + h) * 64 + lane]; }
#pragma unroll
    for (int hh = 0; hh < 2; ++hh) {
#pragma unroll
        for (int rt = 0; rt < 2; ++rt) {
            stage_k64<64>(shm + (hh * 2 + rt) * 8192, qka + (m0 + rt * 64) * 512 + 256 + (2 * hp + hh) * 64, 512, tid);
            stage_v64(shm + 32768 + (hh * 2 + rt) * 8192, proj + (m0 + rt * 64) * PROJ_W + PC_MV + (2 * hp + hh) * 64, PROJ_W, tid, nullptr); }
        stage_v64(shm + 65536 + hh * 8192, Cst + (((size_t)b * NCH + c) * 4 + 2 * hp + hh) * 4096, 64, tid, nullptr); }
    __syncthreads();
    const int hh = wave >> 2, rw = wave & 3, r32 = lane & 31, hi = lane >> 5, h = 2 * hp + hh; const int lo = tr_lane_off(lane);
    const int l = 32 * rw + r32;
    const bf16_t* qrowp = qka + (m0 + l) * 512 + h * 64;
    f32x16 o[2]; o[0] = f32x16{}; o[1] = f32x16{};
    float den = 0.f;
    {
        bf16x8 qr[4];
#pragma unroll
        for (int d0 = 0; d0 < 4; ++d0) qr[d0] = *reinterpret_cast<const bf16x8*>(qrowp + d0 * 16 + hi * 8);
        const float bl = bt[hh * 128 + l];
        const int ntile = (rw >= 2) ? 2 : 1;
        for (int t = 0; t < ntile; ++t) {
            f32x16 p0 = f32x16{}, p1 = f32x16{};
            const LAS unsigned char* kb = shm + (hh * 2 + t) * 8192 + hi * 1024 + r32 * 16;
#pragma unroll
            for (int d0 = 0; d0 < 4; ++d0) { const bf16x8 b0 = *(const LAS bf16x8*)(kb + d0 * 2048), b1 = *(const LAS bf16x8*)(kb + d0 * 2048 + 512);
                p0 = __builtin_amdgcn_mfma_f32_32x32x16_bf16(b0, qr[d0], p0, 0, 0, 0); p1 = __builtin_amdgcn_mfma_f32_32x32x16_bf16(b1, qr[d0], p1, 0, 0, 0); }
#pragma unroll
            for (int r = 0; r < 16; ++r) { const int s = 64 * t + crow(r, hi);
                const float w0 = (s <= l) ? __expf(bl - bt[hh * 128 + s] + igt[hh * 128 + s]) : 0.f, w1 = (s + 32 <= l) ? __expf(bl - bt[hh * 128 + s + 32] + igt[hh * 128 + s + 32]) : 0.f;
                p0[r] *= w0; p1[r] *= w1; den += p0[r] + p1[r]; }
            u32x4 pw0, pw1, pw2, pw3; CK_PACK(p0, p1, pw0, pw1, pw2, pw3);
            att::pv(o, (int)(unsigned)(size_t)(shm + 32768 + (hh * 2 + t) * 8192) + lo, __builtin_bit_cast(bf16x8, pw0), __builtin_bit_cast(bf16x8, pw1), __builtin_bit_cast(bf16x8, pw2), __builtin_bit_cast(bf16x8, pw3));
        }
        const float eb = __expf(bl);
        att::pv(o, (int)(unsigned)(size_t)(shm + 65536 + hh * 8192) + lo, pv_afrag(qrowp, 0, hi, eb), pv_afrag(qrowp, 1, hi, eb), pv_afrag(qrowp, 2, hi, eb), pv_afrag(qrowp, 3, hi, eb));
        float qn = 0.f;
#pragma unroll
        for (int d0 = 0; d0 < 4; ++d0)
#pragma unroll
            for (int i = 0; i < 8; ++i) qn += bf2f((bf16_t)qr[d0][i]) * nt_[hh * 64 + 16 * d0 + 8 * hi + i];
        den = xhalf_sum(den + eb * qn);
    }
    if (hi == 0) wsf[r32] = 1.f / fmaxf(fabsf(den), 1.f);
    asm volatile("s_waitcnt lgkmcnt(0)" ::: "memory");
    float rli[16];
#pragma unroll
    for (int r = 0; r < 16; ++r) rli[r] = wsf[crow(r, hi)];
    __syncthreads();
    LAS float* stg = (LAS float*)(shm + wave * 8704);
#pragma unroll
    for (int r = 0; r < 16; ++r) { const int orow = crow(r, hi); stg[orow * 68 + r32] = o[0][r] * rli[r]; stg[orow * 68 + 32 + r32] = o[1][r] * rli[r]; }
    asm volatile("s_waitcnt lgkmcnt(0)" ::: "memory");
    {
        const int row = lane >> 1, ch = lane & 1, lr = 32 * rw + row; const size_t m = m0 + lr;
        float y[32]; float ss = 0.f;
#pragma unroll
        for (int q = 0; q < 4; ++q) { const us8 ov = *(const us8*)(proj + m * PROJ_W + PC_MO + h * 64 + ch * 32 + 8 * q);
#pragma unroll
            for (int i = 0; i < 8; ++i) { const float v = stg[row * 68 + ch * 32 + 8 * q + i] * sigmoid_f(bf2f(ov[i])); y[8 * q + i] = v; ss += v * v; } }
        ss += __shfl_xor(ss, 1);
        const float rstd = rsqrtf(ss * (1.f / 64.f) + EPS);
        const float* gp = norm_g + h * 64 + ch * 32;
        bf16_t* op = ycat + m * DM + 512 + h * 64 + ch * 32;
#pragma unroll
        for (int q = 0; q < 4; ++q) { v4u w; w.x = pk2(y[8 * q] * rstd * gp[8 * q], y[8 * q + 1] * rstd * gp[8 * q + 1]); w.y = pk2(y[8 * q + 2] * rstd * gp[8 * q + 2], y[8 * q + 3] * rstd * gp[8 * q + 3]);
            w.z = pk2(y[8 * q + 4] * rstd * gp[8 * q + 4], y[8 * q + 5] * rstd * gp[8 * q + 5]); w.w = pk2(y[8 * q + 6] * rstd * gp[8 * q + 6], y[8 * q + 7] * rstd * gp[8 * q + 7]);
            *(v4u*)(op + 8 * q) = w; }
    }
    __syncthreads();
}
#undef CK_TRF
#undef CK_PACK
}
#ifndef EN_P_MOE
#define EN_P_MOE 1
#endif
#ifndef EN_P_SCAN
#define EN_P_SCAN 1
#endif
#ifndef EN_P_CONV
#define EN_P_CONV 1
#endif
#ifndef EN_P_INPROJ
#define EN_P_INPROJ 1
#endif
#ifndef EN_P_PREP
#define EN_P_PREP 1
#endif
#ifndef EN_P_MLAUP
#define EN_P_MLAUP 1
#endif
#ifndef EN_P_ATTN
#define EN_P_ATTN 1
#endif
#ifndef EN_P_OUTPROJ
#define EN_P_OUTPROJ 1
#endif
constexpr int NPH = 11, PH_FINAL = 2 * NPH;
enum { P_CONV = 0, P_INPROJ = 1, P_PREP = 2, P_MLAUP = 3, P_SCAN = 4, P_ATTN = 5, P_OUTPROJ = 6, P_ROUTE = 7, P_SORT = 8, P_MOEUP = 9, P_MOEDOWN = 10 };

__global__ void __launch_bounds__(NWAVES * 64, 2) mk_fwd(Args args) {
    extern __shared__ __attribute__((aligned(16))) unsigned char lds_raw[];
    LAS unsigned char* lds0p = (LAS unsigned char*)lds_raw; LAS unsigned char* lds = lds0p;
    volatile LAS unsigned* MISC = (volatile LAS unsigned*)(lds + MISC_OFF);
    const int tid = threadIdx.x, lane0 = tid & 63, wave = __builtin_amdgcn_readfirstlane(tid >> 6);
    const int G = gridDim.x; const int bx = blockIdx.x; const int vcu = (G % 8 == 0) ? (bx % 8) * (G / 8) + bx / 8 : bx;
    unsigned char* ws = args.ws;
    gu32* ctl = (gu32*)(ws + WS_CTL);
    for (int u = tid; u < (LDS_BYTES - LDSCTL_OFF) / 4; u += NWAVES * 64) ((LAS unsigned*)(lds + LDSCTL_OFF))[u] = 0u;
    __syncthreads();
    if (tid == 0) { LAS unsigned long long* tb = (LAS unsigned long long*)(lds + PTR_OFF);
#pragma unroll
        for (int i = 0; i < 29; ++i) tb[i] = (unsigned long long)args.in[i]; }
    __syncthreads();
#define INP(i) in_ptr(lds, (i))
    XcdBarrier bar = xcd_barrier_post((unsigned*)(ctl + CW_BAR) + args.bli * XCD_BAR_WORDS, MISC + 8);
    const int lo = args.ph_lo, hi = args.ph_hi;
#define IN(k) (lo <= (k) && (k) < hi)
#define SEAM(k) do { if (IN(k) && IN((k) + 1)) xcd_barrier(bar); } while (0)
    float* X = args.out;
    bf16_t* ACT = (bf16_t*)(ws + WS_ACT); bf16_t* PROJ = (bf16_t*)(ws + WS_PROJ); float* PROJF = (float*)(ws + WS_PROJF);
    bf16_t* WinT = (bf16_t*)(ws + WS_WIN); bf16_t* WoutT = (bf16_t*)(ws + WS_WOUT); bf16_t* WuqT = (bf16_t*)(ws + WS_WUQ); bf16_t* WukvT = (bf16_t*)(ws + WS_WUKV);
    bf16_t* XBCA = (bf16_t*)(ws + WS_XBCA); bf16_t* QKA = (bf16_t*)(ws + WS_QKA); bf16_t* QM = (bf16_t*)(ws + WS_QM); bf16_t* KM = (bf16_t*)(ws + WS_KM); bf16_t* VM = (bf16_t*)(ws + WS_VM);
    bf16_t* WupT = (bf16_t*)(ws + WS_WUP); bf16_t* WdnT = (bf16_t*)(ws + WS_WDN); bf16_t* XS = (bf16_t*)(ws + WS_XS); bf16_t* HID = (bf16_t*)(ws + WS_HID);
    int* STOK = (int*)(ws + WS_STOK); float* SW1 = (float*)(ws + WS_SW1); float* SW2 = (float*)(ws + WS_SW2);
    int* TCLS = (int*)(ws + WS_TCLS); int* TPOS = (int*)(ws + WS_TPOS); float* TW1 = (float*)(ws + WS_TW1); float* TW2 = (float*)(ws + WS_TW2);
    float* S1S = (float*)(ws + WS_ACT); float* S1U = (float*)(ws + WS_ACT + 16 * MiB); float* S1N = (float*)(ws + WS_ACT + 24 * MiB); float* S1SD = (float*)(ws + WS_ACT + 25 * MiB); float* S1MD = S1SD + 1024;
    bf16_t* PREVT = (bf16_t*)(ws + WS_PREVT); bf16_t* CST = (bf16_t*)(ws + WS_CST); float* NST = (float*)(ws + WS_NST);
    bf16_t* CQN = (bf16_t*)(ws + WS_CQN); bf16_t* CKVN = (bf16_t*)(ws + WS_CKVN); float* ROPE = (float*)(ws + WS_ROPE); float* KMEAN = (float*)(ws + WS_KMEAN);
    const int gw = vcu * NWAVES + wave, NGW = G * NWAVES;

    for (int l = 0; l < DEPTH; ++l) {
        const int pb = l * NPH;
        { unsigned lv = (unsigned)(size_t)lds0p; asm volatile("" : "+s"(lv)); lds = (LAS unsigned char*)(size_t)lv; }
        if (EN_P_CONV && IN(pb + P_CONV)) {
            int lane = (int)__builtin_amdgcn_mbcnt_hi(~0u, __builtin_amdgcn_mbcnt_lo(~0u, 0u)); asm volatile("" : "+v"(lane));
            LAS float* scr = (LAS float*)(lds + RING_OFF + wave * 16384);
            constexpr int I_IN = (DM / 64) * (PROJ_N / 32), I_OUT = (DM / 64) * (DM / 32), I_UQ = (256 / 64) * (512 / 32), I_UKV = (128 / 64) * (512 / 32);
            const MapInProj mi{INP(3) + (size_t)l * DM * NIN};
            const MapPlain mo{INP(19) + (size_t)l * DM * DM, DM, 1.f};
            const MapPlain muq{INP(16) + (size_t)l * 256 * 384, 384, C2M};
            const MapPlain mukv{INP(18) + (size_t)l * 128 * 512, 512, 1.f};
            for (int it = gw; it < I_IN + I_OUT + I_UQ + I_UKV; it += NGW) {
                if (it < I_IN) conv_item(mi, NIN, DM, WinT, PROJ_N / 32, scr, it, lane);
                else if (it < I_IN + I_OUT) conv_item(mo, DM, DM, WoutT, DM / 32, scr, it - I_IN, lane);
                else if (it < I_IN + I_OUT + I_UQ) conv_item(muq, 384, 256, WuqT, 512 / 32, scr, it - I_IN - I_OUT, lane);
                else conv_item(mukv, 512, 128, WukvT, 512 / 32, scr, it - I_IN - I_OUT - I_UQ, lane);
            }
            const float* xsrc = (l == 0) ? INP(0) : X;
            for (int m = gw; m < M; m += NGW) rms_row_to_bf16(xsrc + (size_t)m * DM, INP(2) + l * DM, ACT + (size_t)m * DM, nullptr, lane);
        }
        SEAM(pb + P_CONV);
        if (EN_P_INPROJ && IN(pb + P_INPROJ)) {
            pg8::StaticOrder S; S.init(ACT, WinT, DM, DM, DM, M, PROJ_N, G, bx);
            const EpiInProj E{PROJ, PROJF};
            pg8::gemm_phase(lds + RING_OFF, wave, pg8::Dims{DM, DM, DM}, S, E);
        }
        SEAM(pb + P_INPROJ);
        if (EN_P_PREP && IN(pb + P_PREP)) {
            int lane = (int)__builtin_amdgcn_mbcnt_hi(~0u, __builtin_amdgcn_mbcnt_lo(~0u, 0u)); asm volatile("" : "+v"(lane));
            if (wave == 0) for (int it = vcu; it < 256; it += G) kmean_item(it, lane, PROJ, KMEAN);
            for (int m = gw; m < M; m += NGW) mla_prep_token(m, lane, PROJ, PROJF, (const int*)INP(1), INP(15) + l * 256, INP(17) + l * 128, CQN, CKVN, KM, ROPE);
            for (int wt = gw; wt < (M / 32) * 3; wt += NGW) { const int seg = wt / 3, part = wt - seg * 3;
                if (part == 0) conv_seg(PROJ, seg * 32, PC_XBC, lane, 768, INP(4) + l * 4 * 768, INP(5) + l * 768, XBCA, 1.f);
                else if (part == 1) { if (lane < 32) conv_seg(PROJ, seg * 32, PC_XBC, 64 + lane, 768, INP(4) + l * 4 * 768, INP(5) + l * 768, XBCA, 1.f); }
                else conv_seg(PROJ, seg * 32, PC_MQK, lane, 512, INP(10) + l * 4 * 512, INP(11) + l * 512, QKA, lane >= 32 ? 0.125f : 1.f); }
        }
        SEAM(pb + P_PREP);
        if (EN_P_MLAUP && IN(pb + P_MLAUP)) {
            const int half = G / 2;
            if (bx < half) { pg8::StaticOrder S; S.init(CQN, WuqT, 256, 256, 256, M, 512, half, bx); const EpiMlaQ E{QM, ROPE}; pg8::gemm_phase(lds + RING_OFF, wave, pg8::Dims{256, 256, 256}, S, E); }
            else { pg8::StaticOrder S; S.init(CKVN, WukvT, 128, 128, 128, M, 512, G - half, bx - half); const EpiMlaKVf E{KM, VM}; pg8::gemm_phase(lds + RING_OFF, wave, pg8::Dims{128, 128, 128}, S, E); }
            for (int u = vcu; u < 512; u += G) {
                if (u < 256) ck::ssd_s1_unit(u, XBCA, PROJF, INP(6) + l * 4, INP(7) + l * 4, S1S, S1SD, lds + RING_OFF, wave);
                else ck::ml_s1_unit(u - 256, QKA, PROJ, PROJF, INP(12) + l * 4, INP(13) + l * 4, S1U, S1N, S1MD, lds + RING_OFF, wave);
            }
        }
        SEAM(pb + P_MLAUP);
        if (EN_P_SCAN && IN(pb + P_SCAN)) {
            const int lane = (int)__builtin_amdgcn_mbcnt_hi(~0u, __builtin_amdgcn_mbcnt_lo(~0u, 0u));
            ck::scan_phase(gw * 64 + lane, NGW * 64, S1S, S1SD, PREVT, S1U, S1N, S1MD, CST, NST);
        }
        SEAM(pb + P_SCAN);
        if (EN_P_ATTN && IN(pb + P_ATTN)) {
            for (int u = vcu; u < 512; u += G) {
                const int bh = (u & 255) >> 5, qs = u & 31, b = bh >> 2, hh = bh & 3;
                if (u < 256) att::attn_unit<96, false>(b, hh, qs, QM, 384, hh * 96, KM, 384, hh * 96, VM, 256, hh * 64, ACT, 768 + hh * 64, nullptr, lds + RING_OFF, wave);
                else att::attn_unit<64, true>(b, hh, 31 - qs, PROJ, PROJ_W, PC_AQ + hh * 64, PROJ, PROJ_W, PC_AK + hh * 64, PROJ, PROJ_W, PC_AV + hh * 64, ACT, hh * 64, KMEAN, lds + RING_OFF, wave);
            }
            for (int u = vcu; u < 512; u += G) {
                if (u < 256) ck::ssd_s3_unit(u, XBCA, PROJ, PROJF, INP(6) + l * 4, INP(7) + l * 4, INP(8) + l * 4, INP(9) + l * 256, PREVT, ACT, lds + RING_OFF, wave);
                else ck::ml_s3_unit(u - 256, QKA, PROJ, PROJF, INP(12) + l * 4, INP(13) + l * 4, INP(14) + l * 256, CST, NST, ACT, lds + RING_OFF, wave);
            }
        }
        SEAM(pb + P_ATTN);
        if (EN_P_OUTPROJ && IN(pb + P_OUTPROJ)) {
            pg8::StaticOrder S; S.init(ACT, WoutT, DM, DM, DM, M, DM, G, bx);
            const EpiResidualF32 E{X, (l == 0) ? INP(0) : (const float*)X};
            pg8::gemm_phase(lds + RING_OFF, wave, pg8::Dims{DM, DM, DM}, S, E);
            int lane = (int)__builtin_amdgcn_mbcnt_hi(~0u, __builtin_amdgcn_mbcnt_lo(~0u, 0u)); asm volatile("" : "+v"(lane));
            LAS float* scr = (LAS float*)(lds + RING_OFF + wave * 16384);
            const float* wgate = INP(25) + (size_t)l * 16 * 1024 * 256; const float* wup = INP(26) + (size_t)l * 16 * 1024 * 256; const float* wdn = INP(27) + (size_t)l * 16 * 256 * 1024;
            for (int it = gw; it < 16 * 256 + 16 * 128; it += NGW) {
                if (it < 16 * 256) { const int e = it >> 8, q = ((it & 255) & 15) >> 2;
                    if (q & 1) { const MapMoeUp mu{wup + (size_t)e * 1024 * 256, (q >> 1) * 128}; conv_item(mu, 256, 1024, WupT + (size_t)e * 512 * 1024, 512 / 32, scr, it & 255, lane); }
                    else { const MapMoeUp mu{wgate + (size_t)e * 1024 * 256, (q >> 1) * 128}; conv_item(mu, 256, 1024, WupT + (size_t)e * 512 * 1024, 512 / 32, scr, it & 255, lane); } }
                else { const int r = it - 16 * 256, e = r >> 7; const MapPlain md{wdn + (size_t)e * 256 * 1024, 1024, 1.f};
                    conv_item(md, 1024, 256, WdnT + (size_t)e * 1024 * 256, 1024 / 32, scr, r & 127, lane); }
            }
        }
        SEAM(pb + P_OUTPROJ);
        unsigned* mcnt = (unsigned*)(ctl + CW_MOECNT + l * 1024);
        if (EN_P_MOE && IN(pb + P_ROUTE)) {
            int lane = (int)__builtin_amdgcn_mbcnt_hi(~0u, __builtin_amdgcn_mbcnt_lo(~0u, 0u)); asm volatile("" : "+v"(lane));
            LAS float* rw = (LAS float*)(lds + RING_OFF);
            { const float* wg = INP(21) + (size_t)l * DM * 4; const float* wr = INP(23) + (size_t)l * DM * 16; const int tid2 = wave * 64 + lane;
              for (int i = tid2; i < DM; i += NWAVES * 64) { const f32x4 w = *(const GAS f32x4*)(wg + 4 * i); rw[0 * RW_PITCH + i] = w.x; rw[1 * RW_PITCH + i] = w.y; rw[2 * RW_PITCH + i] = w.z; rw[3 * RW_PITCH + i] = w.w; }
              for (int i = tid2; i < DM * 4; i += NWAVES * 64) { const int k = i >> 2, c = i & 3; const f32x4 w = *(const GAS f32x4*)(wr + 4 * i);
                  rw[(4 + 4 * c) * RW_PITCH + k] = w.x; rw[(5 + 4 * c) * RW_PITCH + k] = w.y; rw[(6 + 4 * c) * RW_PITCH + k] = w.z; rw[(7 + 4 * c) * RW_PITCH + k] = w.w; } }
            __syncthreads();
            for (int m = gw; m < M; m += NGW) route_token(m, lane, X, INP(20) + l * DM, rw, INP(22) + l * 4, INP(24) + l * 16, ACT, mcnt, TCLS, TPOS, TW1, TW2);
            __syncthreads();
        }
        SEAM(pb + P_ROUTE);
        if (EN_P_MOE && IN(pb + P_SORT)) {
            int lane = (int)__builtin_amdgcn_mbcnt_hi(~0u, __builtin_amdgcn_mbcnt_lo(~0u, 0u)); asm volatile("" : "+v"(lane));
            (void)moe_tiles(mcnt, lds, wave == 0 && lane == 0);
            const LAS int* offs = (const LAS int*)(lds + OFFS_OFF);
            if (bx < 24) { const int beg = offs[bx] + (int)mcnt[32 * bx], end = offs[bx + 1];
                for (int r = beg + wave * 64 + lane; r < end; r += NWAVES * 64) { st_wt(STOK + r, -1); st_wt(SW1 + r, 0.f); st_wt(SW2 + r, 0.f); }
#ifndef PADZERO_OFF
                for (int r = beg + wave; r < end; r += NWAVES) { v4u* dst = (v4u*)(XS + (size_t)r * DM); dst[lane] = (v4u){0u, 0u, 0u, 0u}; dst[64 + lane] = (v4u){0u, 0u, 0u, 0u}; }
#endif
            }
            for (int m = gw; m < M; m += NGW) { const int row = offs[TCLS[m]] + TPOS[m];
                if (lane == 0) { st_wt(STOK + row, m); st_wt(SW1 + row, TW1[m]); st_wt(SW2 + row, TW2[m]); }
                const v4u* src = (const v4u*)(ACT + (size_t)m * DM); v4u* dst = (v4u*)(XS + (size_t)row * DM);
                const v4u a = __builtin_nontemporal_load(src + lane), b = __builtin_nontemporal_load(src + 64 + lane); dst[lane] = a; dst[64 + lane] = b; }
        }
        SEAM(pb + P_SORT);
        if (EN_P_MOE && IN(pb + P_MOEUP)) {
            const int lane = (int)__builtin_amdgcn_mbcnt_hi(~0u, __builtin_amdgcn_mbcnt_lo(~0u, 0u));
            const int ntile = moe_tiles(mcnt, lds, wave == 0 && lane == 0);
            const int nu = ntile * 4;
            unsigned* tdone = (unsigned*)(ctl + 210000 + l * 128);
            const EpiMoeUp E{HID, SW1, SW2};
            for (int L = bx; L < nu; L += G) {
                const MoeOrder S{XS, WupT, DM, DM, (size_t)512 * 1024, DM, ntile, 1 << 20, L, lds + TCLS_OFF, false};
                pg8::gemm_phase(lds + RING_OFF, wave, pg8::Dims{DM, DM, DM}, S, E);
                asm volatile("s_waitcnt vmcnt(0)" ::: "memory");
                __syncthreads();
                if (wave == 0 && lane == 0) { __builtin_amdgcn_fence(__ATOMIC_RELEASE, "agent"); asm volatile("s_waitcnt vmcnt(0)" ::: "memory");
                    (void)__hip_atomic_fetch_add(tdone + (L >> 2), 1u, __ATOMIC_RELAXED, __HIP_MEMORY_SCOPE_AGENT); }
            }
            const int maxu = (nu + G - 1) / G; int two = nu - (maxu - 1) * G; if (two >= G) two = 0;
            const int c2 = (bx >= two) ? bx - two : bx + (G - two);
            const EpiMoeDown E2{X, STOK};
            for (int L = c2; L < nu; L += G) {
                if (wave == 0 && lane == 0) { unsigned sp = 0u;
                    while (__hip_atomic_load(tdone + (L >> 2), __ATOMIC_RELAXED, __HIP_MEMORY_SCOPE_AGENT) < 4u && ++sp < (1u << 22)) __builtin_amdgcn_s_sleep(2);
                    __builtin_amdgcn_fence(__ATOMIC_ACQUIRE, "agent"); asm volatile("s_waitcnt vmcnt(0)" ::: "memory"); }
                __syncthreads();
                const MoeOrder S2{HID, WdnT, 512, 256, (size_t)1024 * 256, 512, ntile, 1 << 20, L, lds + TCLS_OFF, true};
                pg8::gemm_phase(lds + RING_OFF, wave, pg8::Dims{512, 512, 256}, S2, E2);
            }
        }
        SEAM(pb + P_MOEDOWN);
    }
    if (IN(PH_FINAL)) {
        int lane = (int)__builtin_amdgcn_mbcnt_hi(~0u, __builtin_amdgcn_mbcnt_lo(~0u, 0u)); asm volatile("" : "+v"(lane));
        for (int m = gw; m < M; m += NGW) rms_row_to_f32(X + (size_t)m * DM, INP(28), X + (size_t)m * DM, lane);
    }
#undef IN
#undef SEAM
}
static void launch_mk(Args a, int lo, int hi, int bli, int grid, hipStream_t stream) {
    a.ph_lo = lo; a.ph_hi = hi; a.bli = bli; a.pad = 0;
    hipLaunchKernelGGL(mk_fwd, dim3(grid), dim3(NWAVES * 64), LDS_BYTES, stream, a);
}
extern "C" void kernel_launch(void* const* d_in, const int* in_sizes, int n_in, void* d_out, int out_size, void* d_ws, size_t ws_size, hipStream_t stream) {
    static int grid = 0;
    if (grid == 0) {
        int dev = 0, cus = 0;
        if (hipGetDevice(&dev) != hipSuccess || hipDeviceGetAttribute(&cus, hipDeviceAttributeMultiprocessorCount, dev) != hipSuccess) { grid = -1; return; }
        if (hipFuncSetAttribute((const void*)mk_fwd, hipFuncAttributeMaxDynamicSharedMemorySize, LDS_BYTES) != hipSuccess) { grid = -1; return; }
        int per_cu = 0;
        (void)hipOccupancyMaxActiveBlocksPerMultiprocessor(&per_cu, (const void*)mk_fwd, NWAVES * 64, LDS_BYTES);
        (void)hipGetLastError();
        grid = cus;
        if (n_in != 29 || ws_size < WS_END) { grid = -1; return; }
    }
    if (grid < 0) return;
    (void)hipMemsetAsync((char*)d_ws + WS_CTL, 0, CTL_ZERO_BYTES, stream);
    Args a{};
    for (int i = 0; i < 29; ++i) a.in[i] = (const float*)d_in[i];
    a.out = (float*)d_out; a.ws = (unsigned char*)d_ws;
    launch_mk(a, 0, PH_FINAL + 1, 0, grid, stream);
}
```

```cpp
#include <hip/hip_runtime.h>
#include <stdint.h>
#include <math.h>

typedef unsigned short bf16_t;
typedef unsigned short us8 __attribute__((ext_vector_type(8)));
typedef unsigned short us4 __attribute__((ext_vector_type(4)));

constexpr int BATCH = 2, SEQ = 8192, DM = 1024, M = BATCH * SEQ, DEPTH = 2;
constexpr int NIN = 3244;
constexpr float EPS = 1e-6f;
constexpr float LOG2E = 1.4426950408889634f;
constexpr float C2A = 0.125f * LOG2E;
constexpr float C2M = 0.10206207261596575f * LOG2E;
constexpr int PC_AQ = 0, PC_AK = 256, PC_AV = 512, PC_Z = 768, PC_XBC = 1024, PC_MQK = 1792, PC_MV = 2304, PC_MO = 2560, PC_CQ = 2816, PROJ_W = 3072;
constexpr int PF_CKV = 0, PF_KR = 128, PF_DT = 160, PF_MI = 164, PF_MF = 168, PROJF_W = 256;

__host__ __device__ inline int dst_col(int n) {
    if (n < 1792) return n;
    if (n < 1796) return PROJ_W + PF_DT + (n - 1792);
    if (n < 2308) return PC_MQK + (n - 1796);
    if (n < 2564) return PC_MV + (n - 2308);
    if (n < 2568) return PROJ_W + PF_MI + (n - 2564);
    if (n < 2572) return PROJ_W + PF_MF + (n - 2568);
    if (n < 2828) return PC_MO + (n - 2572);
    if (n < 3084) return PC_CQ + (n - 2828);
    if (n < 3212) return PROJ_W + PF_CKV + (n - 3084);
    return PROJ_W + PF_KR + (n - 3212);
}

__device__ __forceinline__ float bf2f(bf16_t v) { return __uint_as_float(((unsigned)v) << 16); }
__device__ __forceinline__ bf16_t f2bf(float f) { unsigned u = __float_as_uint(f); return (bf16_t)((u + 0x7fffu + ((u >> 16) & 1u)) >> 16); }
__device__ __forceinline__ float silu_f(float x) { return x / (1.f + __expf(-x)); }
__device__ __forceinline__ float sigmoid_f(float x) { return 1.f / (1.f + __expf(-x)); }
__device__ __forceinline__ float softplus_f(float x) { return x > 20.f ? x : log1pf(__expf(x)); }

#ifdef WAVE_SUM_SHFL
__device__ __forceinline__ float wave_sum(float v) {
#pragma unroll
    for (int o = 1; o < 64; o <<= 1) v += __shfl_xor(v, o);
    return v;
}
#else
#define WS_DPP(v, ctrl) ((v) + __int_as_float(__builtin_amdgcn_update_dpp(0, __float_as_int(v), (ctrl), 0xf, 0xf, true)))
__device__ __forceinline__ float wave_sum(float v) {
    v = WS_DPP(v, 0xB1);
    v = WS_DPP(v, 0x4E);
    v = WS_DPP(v, 0x141);
    v = WS_DPP(v, 0x140);
    { auto rr = __builtin_amdgcn_permlane16_swap(__float_as_uint(v), __float_as_uint(v), false, false); v = __uint_as_float(rr[0]) + __uint_as_float(rr[1]); }
    { auto rr = __builtin_amdgcn_permlane32_swap(__float_as_uint(v), __float_as_uint(v), false, false); v = __uint_as_float(rr[0]) + __uint_as_float(rr[1]); }
    return v;
}
#endif
__device__ __forceinline__ float block_sum256(float v, float* sh) {
    v = wave_sum(v);
    __syncthreads();
    if ((threadIdx.x & 63) == 0) sh[threadIdx.x >> 6] = v;
    __syncthreads();
    return sh[0] + sh[1] + sh[2] + sh[3];
}

__global__ __launch_bounds__(256) void k_rmsnorm_bf16(const float* __restrict__ x, const float* __restrict__ g, bf16_t* __restrict__ out) {
    __shared__ float sh[4];
    const int m = blockIdx.x, t = threadIdx.x;
    const float4 v = ((const float4*)(x + (size_t)m * DM))[t];
    const float ss = block_sum256(v.x * v.x + v.y * v.y + v.z * v.z + v.w * v.w, sh);
    const float r = rsqrtf(ss * (1.f / DM) + EPS);
    const float4 gg = ((const float4*)g)[t];
    us4 o; o.x = f2bf(v.x * r * gg.x); o.y = f2bf(v.y * r * gg.y); o.z = f2bf(v.z * r * gg.z); o.w = f2bf(v.w * r * gg.w);
    ((us4*)(out + (size_t)m * DM))[t] = o;
}
__global__ __launch_bounds__(256) void k_rmsnorm_f32(const float* x, const float* __restrict__ g, float* out) {
    __shared__ float sh[4];
    const int m = blockIdx.x, t = threadIdx.x;
    const float4 v = ((const float4*)(x + (size_t)m * DM))[t];
    const float ss = block_sum256(v.x * v.x + v.y * v.y + v.z * v.z + v.w * v.w, sh);
    const float r = rsqrtf(ss * (1.f / DM) + EPS);
    const float4 gg = ((const float4*)g)[t];
    float4 o; o.x = v.x * r * gg.x; o.y = v.y * r * gg.y; o.z = v.z * r * gg.z; o.w = v.w * r * gg.w;
    ((float4*)(out + (size_t)m * DM))[t] = o;
}

template <class Epi>
__global__ __launch_bounds__(256) void k_gemm(const bf16_t* __restrict__ A, int lda, const float* __restrict__ W, int ldw, int N, int K, Epi epi) {
    __shared__ float As[16][68];
    __shared__ float Bs[16][68];
    const int tid = threadIdx.x, tx = tid & 15, ty = tid >> 4;
    const int m0 = blockIdx.y * 64, n0 = blockIdx.x * 64;
    float acc[4][4];
#pragma unroll
    for (int i = 0; i < 4; ++i)
#pragma unroll
        for (int j = 0; j < 4; ++j) acc[i][j] = 0.f;
    for (int k0 = 0; k0 < K; k0 += 16) {
        {
            const int r = tid >> 2, kq = (tid & 3) * 4;
            const us4 v = *(const us4*)(A + (size_t)(m0 + r) * lda + k0 + kq);
            As[kq + 0][r] = bf2f(v.x); As[kq + 1][r] = bf2f(v.y); As[kq + 2][r] = bf2f(v.z); As[kq + 3][r] = bf2f(v.w);
        }
        {
            const int kk = tid >> 4, nq = (tid & 15) * 4, n = n0 + nq;
            float4 v = make_float4(0.f, 0.f, 0.f, 0.f);
            if (n < N) v = *(const float4*)(W + (size_t)(k0 + kk) * ldw + n);
            Bs[kk][nq + 0] = v.x; Bs[kk][nq + 1] = v.y; Bs[kk][nq + 2] = v.z; Bs[kk][nq + 3] = v.w;
        }
        __syncthreads();
#pragma unroll
        for (int kk = 0; kk < 16; ++kk) {
            float a[4], b[4];
#pragma unroll
            for (int i = 0; i < 4; ++i) { a[i] = As[kk][ty * 4 + i]; b[i] = Bs[kk][tx * 4 + i]; }
#pragma unroll
            for (int i = 0; i < 4; ++i)
#pragma unroll
                for (int j = 0; j < 4; ++j) acc[i][j] += a[i] * b[j];
        }
        __syncthreads();
    }
#pragma unroll
    for (int i = 0; i < 4; ++i)
#pragma unroll
        for (int j = 0; j < 4; ++j) { const int n = n0 + tx * 4 + j; if (n < N) epi(m0 + ty * 4 + i, n, acc[i][j]); }
}

struct EpiInProjNaive {
    bf16_t* proj; float* projf;
    __device__ void operator()(int m, int n, float v) const {
        const int c = dst_col(n);
        if (c < PROJ_W) { if (c < 256) v *= C2A; proj[(size_t)m * PROJ_W + c] = f2bf(v); }
        else projf[(size_t)m * PROJF_W + (c - PROJ_W)] = v;
    }
};
struct EpiResidual {
    float* x;
    __device__ void operator()(int m, int n, float v) const { x[(size_t)m * DM + n] += v; }
};
struct EpiF32 {
    float* out; int ld; int pad;
    __device__ void operator()(int m, int n, float v) const { out[(size_t)m * ld + n] = v; }
};
struct EpiMlaKV {
    bf16_t* km; bf16_t* vm;
    __device__ void operator()(int m, int n, float v) const {
        const int h = n >> 7, d = n & 127;
        if (d < 64) km[(size_t)m * 384 + h * 96 + d] = f2bf(v); else vm[(size_t)m * 256 + h * 64 + (d - 64)] = f2bf(v);
    }
};

__global__ __launch_bounds__(256) void k_conv_silu(const bf16_t* __restrict__ src, int ld, int c0, int C, const float* __restrict__ w, const float* __restrict__ b, bf16_t* __restrict__ dst) {
    const size_t idx = (size_t)blockIdx.x * 256 + threadIdx.x;
    if (idx >= (size_t)M * C) return;
    const int m = (int)(idx / C), c = (int)(idx % C), t = m % SEQ;
    float acc = b[c];
#pragma unroll
    for (int i = 0; i < 4; ++i) { const int tt = t - 3 + i; if (tt >= 0) acc += w[i * C + c] * bf2f(src[(size_t)(m - 3 + i) * ld + c0 + c]); }
    dst[(size_t)m * C + c] = f2bf(silu_f(acc));
}

__global__ __launch_bounds__(256) void k_ssd_scan(const bf16_t* __restrict__ xbca, const bf16_t* __restrict__ proj, const float* __restrict__ projf,
                                                  const float* __restrict__ dt_bias, const float* __restrict__ a_log, const float* __restrict__ d_skip, float* __restrict__ yg) {
    const int blk = blockIdx.x, ps = blk & 3, h = (blk >> 2) & 3, b = blk >> 4;
    const int tid = threadIdx.x, pl = tid >> 4, ns = tid & 15, p = ps * 16 + pl, g = h >> 1;
    const float a = -__expf(a_log[h]), dtb = dt_bias[h], dsk = d_skip[h];
    float st[8];
#pragma unroll
    for (int i = 0; i < 8; ++i) st[i] = 0.f;
    const size_t m0 = (size_t)b * SEQ;
    for (int t = 0; t < SEQ; ++t) {
        const size_t m = m0 + t;
        const float dtv = softplus_f(projf[m * PROJF_W + PF_DT + h] + dtb);
        const float dA = __expf(dtv * a);
        const float xv = bf2f(xbca[m * 768 + h * 64 + p]);
        const us8 Bv = *(const us8*)(xbca + m * 768 + 256 + g * 128 + ns * 8);
        const us8 Cv = *(const us8*)(xbca + m * 768 + 512 + g * 128 + ns * 8);
        const float dx = dtv * xv;
        float y = 0.f;
#pragma unroll
        for (int i = 0; i < 8; ++i) { st[i] = dA * st[i] + dx * bf2f(Bv[i]); y += bf2f(Cv[i]) * st[i]; }
        y += __shfl_xor(y, 1); y += __shfl_xor(y, 2); y += __shfl_xor(y, 4); y += __shfl_xor(y, 8);
        if (ns == 0) {
            const float z = bf2f(proj[m * PROJ_W + PC_Z + h * 64 + p]);
            yg[m * 256 + h * 64 + p] = (y + dsk * xv) * silu_f(z);
        }
    }
}
__global__ __launch_bounds__(256) void k_group_norm(const float* __restrict__ yg, const float* __restrict__ g, int gsz_log2, bf16_t* __restrict__ ycat, int col0) {
    const int wave = (blockIdx.x * 256 + threadIdx.x) >> 6, lane = threadIdx.x & 63;
    const int m = wave >> 1, half = wave & 1;
    if (m >= M) return;
    const float v0 = yg[(size_t)m * 256 + half * 128 + lane * 2], v1 = yg[(size_t)m * 256 + half * 128 + lane * 2 + 1];
    float ss = v0 * v0 + v1 * v1;
    const int nl = (1 << gsz_log2) >> 1;
    for (int o = 1; o < nl; o <<= 1) ss += __shfl_xor(ss, o);
    const float r = rsqrtf(ss / (float)(1 << gsz_log2) + EPS);
    const int c = half * 128 + lane * 2;
    ycat[(size_t)m * DM + col0 + c] = f2bf(v0 * r * g[c]);
    ycat[(size_t)m * DM + col0 + c + 1] = f2bf(v1 * r * g[c + 1]);
}

__global__ __launch_bounds__(256) void k_mlstm_scan(const bf16_t* __restrict__ qka, const bf16_t* __restrict__ proj, const float* __restrict__ projf,
                                                    const float* __restrict__ ig_bias, const float* __restrict__ fg_bias, float* __restrict__ hg) {
    const int blk = blockIdx.x, es = blk & 3, h = (blk >> 2) & 3, b = blk >> 4;
    const int tid = threadIdx.x, el = tid >> 4, ds = tid & 15, e = es * 16 + el;
    const float igb = ig_bias[h], fgb = fg_bias[h];
    float C[4] = {0.f, 0.f, 0.f, 0.f}, nn[4] = {0.f, 0.f, 0.f, 0.f};
    const size_t m0 = (size_t)b * SEQ;
    for (int t = 0; t < SEQ; ++t) {
        const size_t m = m0 + t;
        const float f = sigmoid_f(projf[m * PROJF_W + PF_MF + h] + fgb);
        const float ig = __expf(projf[m * PROJF_W + PF_MI + h] + igb);
        const us4 qv = *(const us4*)(qka + m * 512 + h * 64 + ds * 4);
        const us4 kv = *(const us4*)(qka + m * 512 + 256 + h * 64 + ds * 4);
        const float v = bf2f(proj[m * PROJ_W + PC_MV + h * 64 + e]);
        float num = 0.f, den = 0.f;
#pragma unroll
        for (int i = 0; i < 4; ++i) {
            const float k = bf2f(kv[i]) * 0.125f, q = bf2f(qv[i]);
            C[i] = f * C[i] + ig * k * v; nn[i] = f * nn[i] + ig * k;
            num += q * C[i]; den += q * nn[i];
        }
        num += __shfl_xor(num, 1); num += __shfl_xor(num, 2); num += __shfl_xor(num, 4); num += __shfl_xor(num, 8);
        den += __shfl_xor(den, 1); den += __shfl_xor(den, 2); den += __shfl_xor(den, 4); den += __shfl_xor(den, 8);
        if (ds == 0) {
            const float o = sigmoid_f(bf2f(proj[m * PROJ_W + PC_MO + h * 64 + e]));
            hg[m * 256 + h * 64 + e] = o * num / fmaxf(fabsf(den), 1.f);
        }
    }
}

__global__ __launch_bounds__(256) void k_moba_kmean(const bf16_t* __restrict__ proj, float* __restrict__ kmean) {
    const int jg = blockIdx.x, c = threadIdx.x;
    float s = 0.f;
    for (int r = 0; r < 256; ++r) s += bf2f(proj[(size_t)(jg * 256 + r) * PROJ_W + PC_AK + c]);
    kmean[jg * 256 + c] = s * (1.f / 256.f);
}
__global__ __launch_bounds__(256) void k_moba_attn(const bf16_t* __restrict__ proj, const float* __restrict__ kmean, bf16_t* __restrict__ ycat) {
    __shared__ float km[32][64];
    __shared__ float Ks[32][64];
    __shared__ float Vs[32][64];
    const int blk = blockIdx.x, cur = blk & 31, h = (blk >> 5) & 3, b = blk >> 7;
    const int tid = threadIdx.x, t = cur * 256 + tid;
    const size_t mq = (size_t)b * SEQ + t;
    float q[64];
#pragma unroll
    for (int d8 = 0; d8 < 8; ++d8) { const us8 v = *(const us8*)(proj + mq * PROJ_W + PC_AQ + h * 64 + d8 * 8);
#pragma unroll
        for (int i = 0; i < 8; ++i) q[d8 * 8 + i] = bf2f(v[i]); }
    for (int i = tid; i < 32 * 64; i += 256) { const int j = i >> 6, d = i & 63; km[j][d] = kmean[(b * 32 + j) * 256 + h * 64 + d]; }
    __syncthreads();
    float v0 = -INFINITY, v1 = -INFINITY, v2 = -INFINITY; int i0 = -1, i1 = -1, i2 = -1;
    for (int j = 0; j < cur; ++j) {
        float gq = 0.f;
#pragma unroll
        for (int d = 0; d < 64; ++d) gq += q[d] * km[j][d];
        if (gq > v0) { v2 = v1; i2 = i1; v1 = v0; i1 = i0; v0 = gq; i0 = j; }
        else if (gq > v1) { v2 = v1; i2 = i1; v1 = gq; i1 = j; }
        else if (gq > v2) { v2 = gq; i2 = j; }
    }
    unsigned sel = 0u;
    if (i0 >= 0) sel |= 1u << i0;
    if (i1 >= 0) sel |= 1u << i1;
    if (i2 >= 0) sel |= 1u << i2;
    float o[64];
#pragma unroll
    for (int d = 0; d < 64; ++d) o[d] = 0.f;
    float mx = -INFINITY, l = 0.f;
    for (int jb = 0; jb <= cur; ++jb) {
        for (int kt = 0; kt < 8; ++kt) {
            __syncthreads();
            for (int i = tid; i < 32 * 64; i += 256) { const int r = i >> 6, d = i & 63; const size_t mk = (size_t)b * SEQ + jb * 256 + kt * 32 + r;
                Ks[r][d] = bf2f(proj[mk * PROJ_W + PC_AK + h * 64 + d]); Vs[r][d] = bf2f(proj[mk * PROJ_W + PC_AV + h * 64 + d]); }
            __syncthreads();
            const bool use = (jb == cur) || ((sel >> jb) & 1u);
            if (use) {
                for (int kk = 0; kk < 32; ++kk) {
                    const int key = jb * 256 + kt * 32 + kk;
                    if (key > t) break;
                    float s = 0.f;
#pragma unroll
                    for (int d = 0; d < 64; ++d) s += q[d] * Ks[kk][d];
                    if (s > mx) { const float f = exp2f(mx - s); l *= f;
#pragma unroll
                        for (int d = 0; d < 64; ++d) o[d] *= f;
                        mx = s; }
                    const float p = exp2f(s - mx); l += p;
#pragma unroll
                    for (int d = 0; d < 64; ++d) o[d] += p * Vs[kk][d];
                }
            }
        }
    }
    const float rl = 1.f / l;
#pragma unroll
    for (int d = 0; d < 64; ++d) ycat[mq * DM + 0 + h * 64 + d] = f2bf(o[d] * rl);
}

__global__ __launch_bounds__(256) void k_mla_prep(const bf16_t* __restrict__ proj, const float* __restrict__ projf, const int* __restrict__ positions,
                                                  const float* __restrict__ gq, const float* __restrict__ gkv, bf16_t* __restrict__ cqn, bf16_t* __restrict__ ckvn, bf16_t* __restrict__ km) {
    __shared__ float sh[4];
    const int m = blockIdx.x, tid = threadIdx.x;
    const float cq = bf2f(proj[(size_t)m * PROJ_W + PC_CQ + tid]);
    const float s1 = block_sum256(cq * cq, sh);
    cqn[(size_t)m * 256 + tid] = f2bf(cq * rsqrtf(s1 * (1.f / 256.f) + EPS) * gq[tid]);
    const float ck = tid < 128 ? projf[(size_t)m * PROJF_W + PF_CKV + tid] : 0.f;
    const float s2 = block_sum256(ck * ck, sh);
    if (tid < 128) ckvn[(size_t)m * 128 + tid] = f2bf(ck * rsqrtf(s2 * (1.f / 128.f) + EPS) * gkv[tid]);
    if (tid < 16) {
        const float pos = (float)positions[m];
        const float inv = powf(10000.f, -(float)(2 * tid) / 32.f);
        const float ang = pos * inv; float sn, cs; sincosf(ang, &sn, &cs);
        const float x1 = projf[(size_t)m * PROJF_W + PF_KR + tid], x2 = projf[(size_t)m * PROJF_W + PF_KR + 16 + tid];
        const bf16_t o1 = f2bf(x1 * cs - x2 * sn), o2 = f2bf(x2 * cs + x1 * sn);
#pragma unroll
        for (int h = 0; h < 4; ++h) { km[(size_t)m * 384 + h * 96 + 64 + tid] = o1; km[(size_t)m * 384 + h * 96 + 80 + tid] = o2; }
    }
}
__global__ __launch_bounds__(256) void k_mla_qfinish(const float* __restrict__ qraw, const int* __restrict__ positions, bf16_t* __restrict__ qm) {
    const size_t idx = (size_t)blockIdx.x * 256 + threadIdx.x;
    if (idx >= (size_t)M * 384) return;
    const int m = (int)(idx / 384), c = (int)(idx % 384), h = c / 96, d = c % 96;
    float v;
    if (d < 64) v = qraw[idx];
    else {
        const int i = (d - 64) & 15; const bool second = (d - 64) >= 16;
        const float pos = (float)positions[m];
        const float inv = powf(10000.f, -(float)(2 * i) / 32.f);
        float sn, cs; sincosf(pos * inv, &sn, &cs);
        const float x1 = qraw[(size_t)m * 384 + h * 96 + 64 + i], x2 = qraw[(size_t)m * 384 + h * 96 + 80 + i];
        v = second ? (x2 * cs + x1 * sn) : (x1 * cs - x2 * sn);
    }
    qm[idx] = f2bf(v * C2M);
}
__global__ __launch_bounds__(256) void k_mla_attn(const bf16_t* __restrict__ qm, const bf16_t* __restrict__ km, const bf16_t* __restrict__ vm, bf16_t* __restrict__ ycat) {
    __shared__ float Ks[32][96];
    __shared__ float Vs[32][64];
    const int blk = blockIdx.x, qb = 31 - (blk & 31), h = (blk >> 5) & 3, b = blk >> 7;
    const int tid = threadIdx.x, t = qb * 256 + tid;
    const size_t mq = (size_t)b * SEQ + t;
    float q[96];
#pragma unroll
    for (int d8 = 0; d8 < 12; ++d8) { const us8 v = *(const us8*)(qm + mq * 384 + h * 96 + d8 * 8);
#pragma unroll
        for (int i = 0; i < 8; ++i) q[d8 * 8 + i] = bf2f(v[i]); }
    float o[64];
#pragma unroll
    for (int d = 0; d < 64; ++d) o[d] = 0.f;
    float mx = -INFINITY, l = 0.f;
    const int ntiles = (qb + 1) * 8;
    for (int kt = 0; kt < ntiles; ++kt) {
        __syncthreads();
        for (int i = tid; i < 32 * 96; i += 256) { const int r = i / 96, d = i % 96; Ks[r][d] = bf2f(km[((size_t)b * SEQ + kt * 32 + r) * 384 + h * 96 + d]); }
        for (int i = tid; i < 32 * 64; i += 256) { const int r = i >> 6, d = i & 63; Vs[r][d] = bf2f(vm[((size_t)b * SEQ + kt * 32 + r) * 256 + h * 64 + d]); }
        __syncthreads();
        for (int kk = 0; kk < 32; ++kk) {
            const int key = kt * 32 + kk;
            if (key > t) break;
            float s = 0.f;
#pragma unroll
            for (int d = 0; d < 96; ++d) s += q[d] * Ks[kk][d];
            if (s > mx) { const float f = exp2f(mx - s); l *= f;
#pragma unroll
                for (int d = 0; d < 64; ++d) o[d] *= f;
                mx = s; }
            const float p = exp2f(s - mx); l += p;
#pragma unroll
            for (int d = 0; d < 64; ++d) o[d] += p * Vs[kk][d];
        }
    }
    const float rl = 1.f / l;
#pragma unroll
    for (int d = 0; d < 64; ++d) ycat[mq * DM + 768 + h * 64 + d] = f2bf(o[d] * rl);
}

__global__ __launch_bounds__(256) void k_moe_naive(float* x, const float* __restrict__ gn, const float* __restrict__ wg, const float* __restrict__ bg,
                                                   const float* __restrict__ wr, const float* __restrict__ br, const float* __restrict__ wgate, const float* __restrict__ wup, const float* __restrict__ wdown) {
    __shared__ float h2[1024];
    __shared__ float red[4][20];
    __shared__ float sh[4];
    __shared__ float hid[2][256];
    __shared__ int sE[2]; __shared__ float sW[2];
    __shared__ float slg[20]; __shared__ float spe[4];
    const int m = blockIdx.x, tid = threadIdx.x, lane = tid & 63, wv = tid >> 6;
    const float4 v = ((const float4*)(x + (size_t)m * DM))[tid];
    const float ss = block_sum256(v.x * v.x + v.y * v.y + v.z * v.z + v.w * v.w, sh);
    const float r = rsqrtf(ss * (1.f / DM) + EPS);
    const float4 gg = ((const float4*)gn)[tid];
    const float hv[4] = {v.x * r * gg.x, v.y * r * gg.y, v.z * r * gg.z, v.w * r * gg.w};
#pragma unroll
    for (int i = 0; i < 4; ++i) h2[tid * 4 + i] = hv[i];
    float part[20];
#pragma unroll
    for (int j = 0; j < 20; ++j) part[j] = 0.f;
#pragma unroll
    for (int i = 0; i < 4; ++i) { const int d = tid * 4 + i;
#pragma unroll
        for (int j = 0; j < 4; ++j) part[j] += hv[i] * wg[d * 4 + j];
#pragma unroll
        for (int j = 0; j < 16; ++j) part[4 + j] += hv[i] * wr[d * 16 + j]; }
#pragma unroll
    for (int j = 0; j < 20; ++j) { const float s = wave_sum(part[j]); if (lane == 0) red[wv][j] = s; }
    __syncthreads();
    if (tid < 20) slg[tid] = red[0][tid] + red[1][tid] + red[2][tid] + red[3][tid] + (tid < 4 ? bg[tid] : br[tid - 4]);
    __syncthreads();
    if (tid == 0) {
        int gi = 0; float gm = slg[0];
        for (int j = 1; j < 4; ++j) if (slg[j] > gm) { gm = slg[j]; gi = j; }
        float gs = 0.f; for (int j = 0; j < 4; ++j) gs += __expf(slg[j] - gm);
        const float g_w = 1.f / gs;
        float em = -INFINITY;
        for (int j = 0; j < 4; ++j) em = fmaxf(em, slg[4 + gi * 4 + j]);
        float es = 0.f;
        for (int j = 0; j < 4; ++j) { const float p = __expf(slg[4 + gi * 4 + j] - em); spe[j] = p; es += p; }
        int e0 = 0; float p0 = spe[0];
        for (int j = 1; j < 4; ++j) if (spe[j] > p0) { p0 = spe[j]; e0 = j; }
        int e1 = -1; float p1 = -1.f;
        for (int j = 0; j < 4; ++j) if (j != e0 && spe[j] > p1) { p1 = spe[j]; e1 = j; }
        p0 /= es; p1 /= es;
        const float sw = p0 + p1;
        sE[0] = gi * 4 + e0; sE[1] = gi * 4 + e1; sW[0] = g_w * p0 / sw; sW[1] = g_w * p1 / sw;
    }
    __syncthreads();
#pragma unroll
    for (int j = 0; j < 2; ++j) {
        const int E = sE[j];
        const float* G = wgate + (size_t)E * 1024 * 256 + tid; const float* U = wup + (size_t)E * 1024 * 256 + tid;
        float ga = 0.f, ua = 0.f;
        for (int d = 0; d < 1024; ++d) { const float hd = h2[d]; ga += hd * G[(size_t)d * 256]; ua += hd * U[(size_t)d * 256]; }
        hid[j][tid] = silu_f(ga) * ua * sW[j];
    }
    __syncthreads();
    float out[4] = {0.f, 0.f, 0.f, 0.f};
#pragma unroll
    for (int j = 0; j < 2; ++j) {
        const float* Dn = wdown + (size_t)sE[j] * 256 * 1024;
        for (int f = 0; f < 256; ++f) { const float hf = hid[j][f];
#pragma unroll
            for (int i = 0; i < 4; ++i) out[i] += hf * Dn[(size_t)f * 1024 + tid + 256 * i]; }
    }
#pragma unroll
    for (int i = 0; i < 4; ++i) x[(size_t)m * DM + tid + 256 * i] += out[i];
}

#define ATOMIC_ROUTE 1
#define ST_WT_OFF 1
#define LOADS_OFF 1
#define PADZERO_OFF 1
#define NO_ENTRY_BARRIER 1
#define NO_EXIT_BARRIER 1
namespace pg8 {
#define PG8_LAS __attribute__((address_space(3)))
typedef short bf16x8 __attribute__((ext_vector_type(8)));
typedef float f32x4 __attribute__((ext_vector_type(4)));
typedef unsigned u32x4 __attribute__((ext_vector_type(4)));
constexpr int BM = 256, BK = 64, HALF = 128, HTB = HALF * BK * 2  , STAGE_BYTES = 8 * HTB, NXCD = 8, WGM = 8;

__host__ __device__ __forceinline__ int lds_byte(int r, int c) { const int st = (r >> 4) * 2 + (c >> 5), rr = r & 15, cc = c & 31, ob = rr * 64 + cc * 2; return st * 1024 + (ob ^ (((ob >> 9) & 1) << 5)); }
__host__ __device__ __forceinline__ void stage_rc(int b, int& R, int& C) { const int st = b / 1024, sb = b % 1024, swz = sb ^ (((sb >> 9) & 1) << 5); R = (st >> 1) * 16 + swz / 64; C = (st & 1) * 32 + (swz % 64) / 2; }
__host__ __device__ __forceinline__ int perm32(int rho) { const int n = rho >> 4, i = rho & 15; return 8 * (i >> 2) + 4 * n + (i & 3); }

struct Unit { int pm, pn; };
struct Dims { int K, lda, ldb; };

struct StaticOrder {
    const bf16_t* A; const bf16_t* Bt; int lda, ldb, K;
    int nM, nN, nwg, G, c;
    __device__ void init(const bf16_t* A_, const bf16_t* Bt_, int lda_, int ldb_, int K_, int Mrows, int N, int G_, int c_) { A = A_; Bt = Bt_; lda = lda_; ldb = ldb_; K = K_; nM = Mrows / BM; nN = N / BM; nwg = nM * nN; G = G_; c = c_; }
    __device__ bool next(int i, Unit& u) const {
        const long L = (long)i * G + c; if (L >= nwg) return false;
        int wgid = (int)L; { const int q = nwg / NXCD, r = nwg % NXCD, xcd = wgid % NXCD, off = wgid / NXCD; wgid = (xcd < r ? xcd * (q + 1) : r * (q + 1) + (xcd - r) * q) + off; }
        const int nig = WGM * nN, gid = wgid / nig, fm = gid * WGM, gsz = (nM - fm) < WGM ? (nM - fm) : WGM;
        u.pm = fm + ((wgid % nig) % gsz); u.pn = (wgid % nig) / gsz; return true;
    }
    __device__ __forceinline__ const char* a_ptr(const Unit& u) const { return (const char*)A + (size_t)u.pm * BM * lda * 2; }
    __device__ __forceinline__ const char* b_ptr(const Unit& u, int half) const { return (const char*)Bt + (size_t)u.pn * BM * ldb * 2 + (half ? (size_t)(K / 2) * 2 : 0); }
};

__device__ __forceinline__ unsigned cvt_pk_bf16(float lo, float hi) { unsigned r; asm volatile("v_cvt_pk_bf16_f32 %0, %1, %2" : "=v"(r) : "v"(lo), "v"(hi)); return r; }

template <class Epi, class Sched>
__device__ __forceinline__ void gemm_phase(PG8_LAS unsigned char* lds, const int wid, const Dims g, const Sched& S, const Epi& E) {
    int lane = (int)__builtin_amdgcn_mbcnt_hi(~0u, __builtin_amdgcn_mbcnt_lo(~0u, 0u)); asm volatile("" : "+v"(lane));
    const int tid = wid * 64 + lane, wr = wid >> 2, wc = wid & 3, fr = lane & 15, fq = lane >> 4;
    int K = g.K, lda = g.lda, ldb = g.ldb; asm volatile("" : "+s"(K), "+s"(lda), "+s"(ldb));
    const int nt = K / BK, nth = nt / 2;
    unsigned voffA[2], voffB[2];
#pragma unroll
    for (int i = 0; i < 2; ++i) { int R, C; stage_rc(tid * 16 + i * 8192, R, C); const int Rb = (R & ~31) + perm32(R & 31);
        voffA[i] = (unsigned)(R * lda + C) * 2u; voffB[i] = (unsigned)(Rb * ldb + C) * 2u; }
    const size_t kstep = (size_t)(BK * 2);
    const size_t hstepA = (size_t)HALF * lda * 2, hstepB = (size_t)HALF * ldb * 2;
    const unsigned ldsw = (unsigned)wid * 1024u;
    const int aoff = lds_byte(wr * 64 + fr, fq * 8), boff = lds_byte(wc * 32 + fr, fq * 8);
#define PG8_SA(b, h) (((b) * 2 + (h)) * HTB)
#define PG8_SB(b, h) ((4 + (b) * 2 + (h)) * HTB)
#define PG8_STAGE(bufoff, gbase, voff) do { _Pragma("unroll") for (int _i = 0; _i < 2; ++_i) \
        __builtin_amdgcn_global_load_lds((const unsigned*)((const char*)(gbase) + (voff)[_i]), (PG8_LAS unsigned*)(lds + (bufoff) + ldsw + _i * 8192), 16, 0, 0); } while (0)
#define PG8_LDA(dst, b, h) do { _Pragma("unroll") for (int m = 0; m < 4; ++m) _Pragma("unroll") for (int k = 0; k < 2; ++k) dst[m][k] = *(const PG8_LAS bf16x8*)(lds + PG8_SA(b, h) + aoff + m * 2048 + k * 1024); } while (0)
#define PG8_LDB(dst, b, h) do { _Pragma("unroll") for (int n = 0; n < 2; ++n) _Pragma("unroll") for (int k = 0; k < 2; ++k) dst[n][k] = *(const PG8_LAS bf16x8*)(lds + PG8_SB(b, h) + boff + n * 2048 + k * 1024); } while (0)
#define PG8_MMA(ai, bj, At, Bt) do { __builtin_amdgcn_s_setprio(1); _Pragma("unroll") for (int m = 0; m < 4; ++m) _Pragma("unroll") for (int n = 0; n < 2; ++n) _Pragma("unroll") for (int k = 0; k < 2; ++k) \
        acc[ai][bj][m][n] = __builtin_amdgcn_mfma_f32_16x16x32_bf16(Bt[n][k], At[m][k], acc[ai][bj][m][n], 0, 0, 0); __builtin_amdgcn_s_setprio(0); } while (0)
#define PG8_WAIT_V(n) asm volatile("s_waitcnt vmcnt(" #n ")" ::: "memory")
#define PG8_WAIT_L(n) asm volatile("s_waitcnt lgkmcnt(" #n ")" ::: "memory")
#define PG8_BAR __builtin_amdgcn_s_barrier()
#define PG8_SCHED __builtin_amdgcn_sched_barrier(0)
#define PG8_BP(b0, b1, t) (((t) < nth) ? ((b0) + (size_t)(t) * kstep) : ((b1) + (size_t)((t) - nth) * kstep))
    Unit cur, nxt; int ui = 0;
    if (!S.next(0, cur)) return;
    f32x4 acc[2][2][4][2];
#pragma unroll
    for (int a = 0; a < 2; ++a)
#pragma unroll
        for (int b = 0; b < 2; ++b)
#pragma unroll
            for (int m = 0; m < 4; ++m)
#pragma unroll
                for (int n = 0; n < 2; ++n) acc[a][b][m][n] = (f32x4){0.f, 0.f, 0.f, 0.f};
    bf16x8 At[4][2], B0[2][2], B1[2][2];
    const char* cA = S.a_ptr(cur); const char* cB0 = S.b_ptr(cur, 0); const char* cB1 = S.b_ptr(cur, 1);
    {
        const char* b0 = PG8_BP(cB0, cB1, 0); const char* b1 = PG8_BP(cB0, cB1, 1);
        PG8_STAGE(PG8_SB(0, 0), b0, voffB); PG8_STAGE(PG8_SB(0, 1), b0 + hstepB, voffB); PG8_STAGE(PG8_SA(0, 0), cA, voffA); PG8_STAGE(PG8_SA(0, 1), cA + hstepA, voffA);
        if (wr == 1) PG8_BAR;
        PG8_WAIT_V(2); PG8_BAR;
        PG8_STAGE(PG8_SB(1, 0), b1, voffB); PG8_STAGE(PG8_SA(1, 0), cA + kstep, voffA); PG8_STAGE(PG8_SB(1, 1), b1 + hstepB, voffB);
        PG8_WAIT_V(6); PG8_BAR;
    }
    for (;;) {
        const bool has_next = S.next(ui + 1, nxt);
        const char* nA = has_next ? S.a_ptr(nxt) : cA; const char* nB0 = has_next ? S.b_ptr(nxt, 0) : cB0; const char* nB1 = has_next ? S.b_ptr(nxt, 1) : cB1;
        for (int t = 0; t < nt; t += 2) {
            const bool last = (t == nt - 2);
            const char* a1 = cA + (size_t)(t + 1) * kstep;
            const char* a2 = last ? nA : cA + (size_t)(t + 2) * kstep;
            const char* a3 = a2 + kstep;
            const char* b2 = last ? PG8_BP(nB0, nB1, 0) : PG8_BP(cB0, cB1, t + 2);
            const char* b3 = last ? PG8_BP(nB0, nB1, 1) : PG8_BP(cB0, cB1, t + 3);
            PG8_LDB(B0, 0, 0); PG8_LDB(B1, 0, 1); PG8_SCHED; PG8_LDA(At, 0, 0); PG8_STAGE(PG8_SA(1, 1), a1 + hstepA, voffA);
            PG8_WAIT_V(8); PG8_WAIT_L(0); PG8_BAR; PG8_MMA(0, 0, At, B0); PG8_MMA(0, 1, At, B1); PG8_BAR; PG8_SCHED;
            PG8_LDA(At, 0, 1); PG8_STAGE(PG8_SB(0, 0), b2, voffB); PG8_STAGE(PG8_SB(0, 1), b2 + hstepB, voffB); PG8_STAGE(PG8_SA(0, 0), a2, voffA);
            PG8_WAIT_V(8); PG8_WAIT_L(0); PG8_BAR; PG8_MMA(1, 0, At, B0); PG8_MMA(1, 1, At, B1); PG8_BAR; PG8_SCHED;
            PG8_LDB(B0, 1, 0); PG8_LDB(B1, 1, 1); PG8_SCHED; PG8_LDA(At, 1, 0); PG8_STAGE(PG8_SA(0, 1), a2 + hstepA, voffA);
            PG8_WAIT_V(8); PG8_WAIT_L(0); PG8_BAR; PG8_MMA(0, 0, At, B0); PG8_MMA(0, 1, At, B1); PG8_BAR; PG8_SCHED;
            PG8_LDA(At, 1, 1); PG8_STAGE(PG8_SB(1, 0), b3, voffB); PG8_STAGE(PG8_SB(1, 1), b3 + hstepB, voffB); PG8_STAGE(PG8_SA(1, 0), a3, voffA);
            PG8_WAIT_V(8); PG8_WAIT_L(0); PG8_BAR; PG8_MMA(1, 0, At, B0); PG8_MMA(1, 1, At, B1); PG8_BAR; PG8_SCHED;
        }
        if (wr == 0) PG8_BAR;
        E(acc, cur, wr, wc, fr, fq);
        if (!has_next) break;
#pragma unroll
        for (int a = 0; a < 2; ++a)
#pragma unroll
            for (int b = 0; b < 2; ++b)
#pragma unroll
                for (int m = 0; m < 4; ++m)
#pragma unroll
                    for (int n = 0; n < 2; ++n) acc[a][b][m][n] = (f32x4){0.f, 0.f, 0.f, 0.f};
        cur = nxt; cA = nA; cB0 = nB0; cB1 = nB1; ++ui;
        if (wr == 1) PG8_BAR;
    }
    PG8_WAIT_V(0);
    PG8_BAR;
#undef PG8_SA
#undef PG8_SB
#undef PG8_STAGE
#undef PG8_LDA
#undef PG8_LDB
#undef PG8_MMA
#undef PG8_WAIT_V
#undef PG8_WAIT_L
#undef PG8_BAR
#undef PG8_SCHED
#undef PG8_BP
}
}
#define GAS __attribute__((address_space(1)))
#define LAS __attribute__((address_space(3)))
typedef GAS unsigned gu32;
#define RLX_AGENT __ATOMIC_RELAXED, __HIP_MEMORY_SCOPE_AGENT
#define XB_TMO      128
#define XB_XCNT(j)  (256  + 64 * (j))
#define XB_XSUB(j)  (1280 + 64 * (j))
#define XB_XGEN(j)  (2304 + 64 * (j))
#define XB_TOP      3328
#define XB_TOPGEN   3392
#define XCD_BAR_WORDS 3456
#define XB_SPIN_CAP (1u << 18)

__device__ __forceinline__ unsigned xb_ld(unsigned* p)              { return __hip_atomic_load(p, __ATOMIC_RELAXED, __HIP_MEMORY_SCOPE_AGENT); }
__device__ __forceinline__ unsigned xb_add(unsigned* p, unsigned v) { return __hip_atomic_fetch_add(p, v, __ATOMIC_RELAXED, __HIP_MEMORY_SCOPE_AGENT); }
__device__ __forceinline__ unsigned xb_xcc_id() { return (unsigned)__builtin_amdgcn_s_getreg((3 << 11) | 20) & 0xFu; }
#define XB_SPIN(cond, bar) do { unsigned _sp = 0; while (cond) { __builtin_amdgcn_s_sleep(1); \
    if ((++_sp & 255u) == 0u) { if (xb_ld(&(bar)[XB_TMO])) break; if (_sp > XB_SPIN_CAP) { atomicAdd(&(bar)[XB_TMO], 1u); break; } } } } while (0)

struct XcdBarrier {
    unsigned* bar; unsigned x;
    unsigned w0;
    volatile LAS unsigned* st;
};

__device__ __forceinline__ XcdBarrier xcd_barrier_post(unsigned* bar, volatile LAS unsigned* st) {
    XcdBarrier b; b.bar = bar; b.x = xb_xcc_id(); b.st = st; b.w0 = (__builtin_amdgcn_readfirstlane(threadIdx.x >> 6) == 0) ? 1u : 0u;
    if (threadIdx.x == 0) (void)xb_add(&bar[XB_XCNT(b.x)], 1u);
    return b;
}
__device__ __forceinline__ void xcd_barrier_complete(unsigned* bar, unsigned x, unsigned& nloc, unsigned& nx) {
    const unsigned G = gridDim.x * gridDim.y * gridDim.z;
    unsigned sum, cnt, mine, sp = 0u;
    for (;;) {
        sum = 0u; cnt = 0u; mine = 0u;
#pragma unroll
        for (unsigned j = 0; j < 16; ++j) { const unsigned c = xb_ld(&bar[XB_XCNT(j)]); sum += c; cnt += (c > 0u) ? 1u : 0u; mine = (j == x) ? c : mine; }
        if (sum == G) break;
        __builtin_amdgcn_s_sleep(1);
        if ((++sp & 255u) == 0u) { if (xb_ld(&bar[XB_TMO])) break; if (sp > XB_SPIN_CAP) { atomicAdd(&bar[XB_TMO], 1u); break; } }
    }
    nloc = mine > 0u ? mine : 1u; nx = cnt > 0u ? cnt : 1u;
}

__device__ __forceinline__ void xcd_barrier(const XcdBarrier& b) {
    asm volatile("s_waitcnt vmcnt(0)" ::: "memory");
    __syncthreads();
    if (b.w0 && __builtin_amdgcn_mbcnt_hi(~0u, __builtin_amdgcn_mbcnt_lo(~0u, 0u)) == 0u) {
        unsigned* bar = b.bar;
        __builtin_amdgcn_s_waitcnt(0);
        unsigned nloc = b.st[0], nx = b.st[1];
        if (nloc == 0u) { xcd_barrier_complete(bar, b.x, nloc, nx); b.st[0] = nloc; b.st[1] = nx; }
        const unsigned old = xb_add(&bar[XB_XSUB(b.x)], 1u);
        const unsigned gen = old / nloc;
        if (old + 1u == (gen + 1u) * nloc) {
            __builtin_amdgcn_fence(__ATOMIC_RELEASE, "agent");
            asm volatile("s_waitcnt vmcnt(0)" ::: "memory");
            const unsigned og = xb_add(&bar[XB_TOP], 1u);
            const unsigned tg = og / nx;
            if (og + 1u == (tg + 1u) * nx) xb_add(&bar[XB_TOPGEN], 1u);
            else XB_SPIN(xb_ld(&bar[XB_TOPGEN]) == tg, bar);
            __builtin_amdgcn_fence(__ATOMIC_ACQUIRE, "agent");
            xb_add(&bar[XB_XGEN(b.x)], 1u);
            asm volatile("s_waitcnt vmcnt(0)" ::: "memory");
        } else {
            XB_SPIN(xb_ld(&bar[XB_XGEN(b.x)]) == gen, bar);
            __builtin_amdgcn_fence(__ATOMIC_ACQUIRE, "agent");
            asm volatile("s_waitcnt vmcnt(0)" ::: "memory");
        }
    }
    __syncthreads();
}
constexpr int NWAVES = 8;
constexpr size_t MiB = 1u << 20;
constexpr size_t WS_CTL = 0, CTL_ZERO_BYTES = 1 * MiB;
constexpr size_t WS_KMEAN = 1 * MiB;
constexpr size_t WS_WIN = 2 * MiB, WS_WOUT = 9 * MiB, WS_WUQ = 11 * MiB, WS_WUKV = 11 * MiB + 512 * 1024;
constexpr size_t WS_ACT = 12 * MiB, WS_PROJ = 44 * MiB, WS_PROJF = 140 * MiB, WS_XBCA = 156 * MiB, WS_QKA = 180 * MiB, WS_QM = 196 * MiB, WS_KM = 208 * MiB, WS_VM = 220 * MiB;
constexpr size_t WS_PREVT = 242 * MiB, WS_CST = 250 * MiB, WS_NST = 254 * MiB;
constexpr size_t WS_ROPE = 228 * MiB, WS_CQN = 230 * MiB, WS_CKVN = 238 * MiB, WS_ST = 230 * MiB  , WS_END = 256 * MiB;
constexpr int CW_BAR = 4096;
constexpr int MAX_BAR_REGIONS = 24;
static_assert((CW_BAR + MAX_BAR_REGIONS * 3456) * 4 <= (int)CTL_ZERO_BYTES, "CTL words inside the memset region");
constexpr int PROJ_N = 3328;
constexpr int RING_OFF = 0, RING_BYTES = 131072, LDSCTL_OFF = RING_BYTES, MISC_OFF = LDSCTL_OFF + 320, PTR_OFF = MISC_OFF + 128, LDS_BYTES = 147456;

__host__ __device__ inline int src_col(int c) {
    if (c < 1792) return c;
    if (c < 2304) return 1796 + (c - 1792);
    if (c < 2560) return 2308 + (c - 2304);
    if (c < 2816) return 2572 + (c - 2560);
    if (c < 3072) return 2828 + (c - 2816);
    const int f = c - 3072;
    if (f < 128) return 3084 + f;
    if (f < 160) return 3212 + (f - 128);
    if (f < 164) return 1792 + (f - 160);
    if (f < 168) return 2564 + (f - 164);
    if (f < 172) return 2568 + (f - 168);
    return -1;
}

typedef unsigned v4u __attribute__((ext_vector_type(4)));
typedef float f32x4 __attribute__((ext_vector_type(4)));
#define LDS_WAIT() asm volatile("s_waitcnt lgkmcnt(0)" ::: "memory")
#define VM_WAIT() asm volatile("s_waitcnt vmcnt(0)" ::: "memory")
__device__ __forceinline__ unsigned pk2(float lo, float hi) { return (unsigned)f2bf(lo) | ((unsigned)f2bf(hi) << 16); }

__device__ __forceinline__ const float* in_ptr(LAS unsigned char* lds, int i) {
    const unsigned long long v = ((const LAS unsigned long long*)(lds + PTR_OFF))[i];
    const unsigned lo = __builtin_amdgcn_readfirstlane((unsigned)v), hi = __builtin_amdgcn_readfirstlane((unsigned)(v >> 32));
    return (const float*)(((unsigned long long)hi << 32) | lo);
}
#ifdef ST_WT_OFF
__device__ __forceinline__ void st_wt(float* p, float v) { *p = v; }
__device__ __forceinline__ void st_wt(int* p, int v) { *p = v; }
#else
__device__ __forceinline__ void st_wt(float* p, float v) { __hip_atomic_store(p, v, __ATOMIC_RELAXED, __HIP_MEMORY_SCOPE_AGENT); }
__device__ __forceinline__ void st_wt(int* p, int v) { __hip_atomic_store(p, v, __ATOMIC_RELAXED, __HIP_MEMORY_SCOPE_AGENT); }
#endif
struct Args {
    const float* in[29]; float* out; unsigned char* ws; int ph_lo, ph_hi, bli, pad;
};

struct MapInProj { const float* W; __device__ const float* ptr(int) const { return W; } __device__ int col(int n) const { return src_col(n); } __device__ float scale(int n) const { return n < 256 ? C2A : 1.f; } };
struct MapPlain { const float* W; int ncols; float sc; __device__ const float* ptr(int) const { return W; } __device__ int col(int n) const { return n < ncols ? n : -1; } __device__ float scale(int) const { return sc; } };
template <class Map>
__device__ __forceinline__ void conv_item(const Map& mp, int ldw, int K, bf16_t* WT, int nblk, LAS float* scr, int item, int lane) {
    const int kb = item / nblk, nb = item % nblk, k0 = 64 * kb, n0 = 32 * nb;
    const int c4 = lane & 7, kr = lane >> 3;
    const int nd = n0 + 4 * c4; const int sc = mp.col(nd); const float scl = mp.scale(nd); const float* base = mp.ptr(nd);
    f32x4 v[8];
#pragma unroll
    for (int i = 0; i < 8; ++i) v[i] = sc >= 0 ? __builtin_nontemporal_load((const GAS f32x4*)(base + (size_t)(k0 + 8 * i + kr) * ldw + sc)) : (f32x4){0.f, 0.f, 0.f, 0.f};
#pragma unroll
    for (int i = 0; i < 8; ++i) { LAS float* d = scr + (8 * i + kr) * 33 + 4 * c4; d[0] = v[i].x * scl; d[1] = v[i].y * scl; d[2] = v[i].z * scl; d[3] = v[i].w * scl; }
    LDS_WAIT(); asm volatile("" ::: "memory");
    const int c = lane & 7;
#pragma unroll
    for (int j = 0; j < 4; ++j) { const int n = (lane >> 3) + 8 * j; const LAS float* s = scr + (8 * c) * 33 + n;
        v4u o; o.x = pk2(s[0 * 33], s[1 * 33]); o.y = pk2(s[2 * 33], s[3 * 33]); o.z = pk2(s[4 * 33], s[5 * 33]); o.w = pk2(s[6 * 33], s[7 * 33]);
        *(GAS v4u*)(WT + (size_t)(n0 + n) * K + k0 + 8 * c) = o; }
    LDS_WAIT(); asm volatile("" ::: "memory");
}
__device__ __forceinline__ void rms_row_to_bf16(const float* xrow, const float* g, bf16_t* orow, float* xcopy, int lane) {
    const GAS f32x4* xr = (const GAS f32x4*)xrow + lane; const GAS f32x4* gr = (const GAS f32x4*)g + lane;
    f32x4 v[4]; float s = 0.f;
#pragma unroll
    for (int j = 0; j < 4; ++j) { v[j] = __builtin_nontemporal_load(xr + 64 * j); s += (v[j].x * v[j].x + v[j].y * v[j].y) + (v[j].z * v[j].z + v[j].w * v[j].w); }
    const float rstd = rsqrtf(wave_sum(s) * (1.f / DM) + EPS);
    if (xcopy) { GAS f32x4* xc = (GAS f32x4*)xcopy + lane;
#pragma unroll
        for (int j = 0; j < 4; ++j) xc[64 * j] = v[j]; }
    GAS unsigned long long* o8 = (GAS unsigned long long*)orow + lane;
#pragma unroll
    for (int j = 0; j < 4; ++j) { const f32x4 gg = gr[64 * j];
        o8[64 * j] = (unsigned long long)pk2(v[j].x * rstd * gg.x, v[j].y * rstd * gg.y) | ((unsigned long long)pk2(v[j].z * rstd * gg.z, v[j].w * rstd * gg.w) << 32); }
}
__device__ __forceinline__ void rms_row_to_f32(const float* xrow, const float* g, float* orow, int lane) {
    const GAS f32x4* xr = (const GAS f32x4*)xrow + lane; const GAS f32x4* gr = (const GAS f32x4*)g + lane;
    f32x4 v[4]; float s = 0.f;
#pragma unroll
    for (int j = 0; j < 4; ++j) { v[j] = __builtin_nontemporal_load(xr + 64 * j); s += (v[j].x * v[j].x + v[j].y * v[j].y) + (v[j].z * v[j].z + v[j].w * v[j].w); }
    const float rstd = rsqrtf(wave_sum(s) * (1.f / DM) + EPS);
    GAS f32x4* o = (GAS f32x4*)orow + lane;
#pragma unroll
    for (int j = 0; j < 4; ++j) { const f32x4 gg = gr[64 * j]; __builtin_nontemporal_store((f32x4){v[j].x * rstd * gg.x, v[j].y * rstd * gg.y, v[j].z * rstd * gg.z, v[j].w * rstd * gg.w}, o + 64 * j); }
}

struct EpiInProj {
    bf16_t* proj; float* projf;
    __device__ __forceinline__ void operator()(const pg8::f32x4 (&acc)[2][2][4][2], const pg8::Unit& u, int wr, int wc, int fr, int fq) const {
        const int row0 = u.pm * 256 + wr * 64 + fr, col0 = wc * 32 + 8 * fq;
        if (u.pn < 12) {
#pragma unroll
            for (int ai = 0; ai < 2; ++ai)
#pragma unroll
                for (int m = 0; m < 4; ++m) { bf16_t* rowp = proj + (size_t)(row0 + ai * 128 + m * 16) * PROJ_W + u.pn * 256 + col0;
#pragma unroll
                    for (int bj = 0; bj < 2; ++bj) { const pg8::f32x4 v0 = acc[ai][bj][m][0], v1 = acc[ai][bj][m][1]; pg8::u32x4 w;
                        w.x = pg8::cvt_pk_bf16(v0[0], v0[1]); w.y = pg8::cvt_pk_bf16(v0[2], v0[3]); w.z = pg8::cvt_pk_bf16(v1[0], v1[1]); w.w = pg8::cvt_pk_bf16(v1[2], v1[3]);
                        *(pg8::u32x4*)(rowp + bj * 128) = w; } }
        } else {
#pragma unroll
            for (int ai = 0; ai < 2; ++ai)
#pragma unroll
                for (int m = 0; m < 4; ++m) { float* rowp = projf + (size_t)(row0 + ai * 128 + m * 16) * PROJF_W + col0;
#pragma unroll
                    for (int bj = 0; bj < 2; ++bj) { *(pg8::f32x4*)(rowp + bj * 128) = acc[ai][bj][m][0]; *(pg8::f32x4*)(rowp + bj * 128 + 4) = acc[ai][bj][m][1]; } }
        }
    }
};
struct EpiResidualF32 {
    float* x; const float* src;
    __device__ __forceinline__ void operator()(const pg8::f32x4 (&acc)[2][2][4][2], const pg8::Unit& u, int wr, int wc, int fr, int fq) const {
        const int row0 = u.pm * 256 + wr * 64 + fr, col0 = u.pn * 256 + wc * 32 + 8 * fq;
#pragma unroll
        for (int ai = 0; ai < 2; ++ai)
#pragma unroll
            for (int m = 0; m < 4; m += 2) {
                pg8::f32x4 xv[2][2][2];
#pragma unroll
                for (int mm = 0; mm < 2; ++mm) { const float* srcp = src + (size_t)(row0 + ai * 128 + (m + mm) * 16) * DM + col0;
#pragma unroll
                    for (int bj = 0; bj < 2; ++bj) { const GAS pg8::f32x4* q = (const GAS pg8::f32x4*)(srcp + bj * 128); xv[mm][bj][0] = q[0]; xv[mm][bj][1] = q[1]; } }
#pragma unroll
                for (int mm = 0; mm < 2; ++mm) { float* rowp = x + (size_t)(row0 + ai * 128 + (m + mm) * 16) * DM + col0;
#pragma unroll
                    for (int bj = 0; bj < 2; ++bj) { pg8::f32x4* p = (pg8::f32x4*)(rowp + bj * 128); p[0] = xv[mm][bj][0] + acc[ai][bj][m + mm][0]; p[1] = xv[mm][bj][1] + acc[ai][bj][m + mm][1]; } }
                asm volatile("" ::: "memory"); }
    }
};


struct EpiMlaQ {
    bf16_t* qm; const float* rope;
    __device__ __forceinline__ void operator()(const pg8::f32x4 (&acc)[2][2][4][2], const pg8::Unit& u, int wr, int wc, int fr, int fq) const {
        const int row0 = u.pm * 256 + wr * 64 + fr;
#pragma unroll
        for (int bj = 0; bj < 2; ++bj) {
            const int colg = u.pn * 256 + bj * 128 + wc * 32;
            if (colg >= 384) continue;
            const bool is_rope = ((colg >> 5) % 3) == 2;
#pragma unroll
            for (int ai = 0; ai < 2; ++ai)
#pragma unroll
                for (int m = 0; m < 4; ++m) {
                    const int row = row0 + ai * 128 + m * 16;
                    pg8::f32x4 v0 = acc[ai][bj][m][0], v1 = acc[ai][bj][m][1];
                    if (is_rope) {
                        pg8::f32x4 w0, w1;
#pragma unroll
                        for (int j = 0; j < 4; ++j) { w0[j] = __shfl_xor(v0[j], 32); w1[j] = __shfl_xor(v1[j], 32); }
                        const int i0 = (8 * fq) & 15;
                        const float* rp = rope + (size_t)row * 32 + i0;
                        const pg8::f32x4 c0 = *(const pg8::f32x4*)rp, c1 = *(const pg8::f32x4*)(rp + 4), s0 = *(const pg8::f32x4*)(rp + 16), s1 = *(const pg8::f32x4*)(rp + 20);
                        if (fq < 2) { v0 = v0 * c0 - w0 * s0; v1 = v1 * c1 - w1 * s1; } else { v0 = v0 * c0 + w0 * s0; v1 = v1 * c1 + w1 * s1; }
                    }
                    pg8::u32x4 w; w.x = pg8::cvt_pk_bf16(v0[0], v0[1]); w.y = pg8::cvt_pk_bf16(v0[2], v0[3]); w.z = pg8::cvt_pk_bf16(v1[0], v1[1]); w.w = pg8::cvt_pk_bf16(v1[2], v1[3]);
                    *(pg8::u32x4*)(qm + (size_t)row * 384 + colg + 8 * fq) = w;
                }
        }
    }
};
struct EpiMlaKVf {
    bf16_t* km; bf16_t* vm;
    __device__ __forceinline__ void operator()(const pg8::f32x4 (&acc)[2][2][4][2], const pg8::Unit& u, int wr, int wc, int fr, int fq) const {
        const int row0 = u.pm * 256 + wr * 64 + fr;
#pragma unroll
        for (int bj = 0; bj < 2; ++bj) {
            const int col = u.pn * 256 + bj * 128 + wc * 32 + 8 * fq, hh = col >> 7, d = col & 127;
#pragma unroll
            for (int ai = 0; ai < 2; ++ai)
#pragma unroll
                for (int m = 0; m < 4; ++m) {
                    const int row = row0 + ai * 128 + m * 16;
                    const pg8::f32x4 v0 = acc[ai][bj][m][0], v1 = acc[ai][bj][m][1];
                    pg8::u32x4 w; w.x = pg8::cvt_pk_bf16(v0[0], v0[1]); w.y = pg8::cvt_pk_bf16(v0[2], v0[3]); w.z = pg8::cvt_pk_bf16(v1[0], v1[1]); w.w = pg8::cvt_pk_bf16(v1[2], v1[3]);
                    bf16_t* dst = (d < 64) ? km + (size_t)row * 384 + hh * 96 + d : vm + (size_t)row * 256 + hh * 64 + (d - 64);
                    *(pg8::u32x4*)dst = w;
                }
        }
    }
};

__device__ __forceinline__ void conv_chunk(const bf16_t* proj, int m, int c0, int ch, int C, const float* w, const float* bias, bf16_t* dst, float osc) {
    const int t = m & (SEQ - 1);
    float acc[8];
    { const f32x4 b0 = *(const f32x4*)(bias + ch * 8), b1 = *(const f32x4*)(bias + ch * 8 + 4);
      acc[0] = b0.x; acc[1] = b0.y; acc[2] = b0.z; acc[3] = b0.w; acc[4] = b1.x; acc[5] = b1.y; acc[6] = b1.z; acc[7] = b1.w; }
#pragma unroll
    for (int i = 0; i < 4; ++i) {
        if (t - 3 + i >= 0) {
            const us8 x = *(const us8*)(proj + (size_t)(m - 3 + i) * PROJ_W + c0 + ch * 8);
            const f32x4 w0 = *(const f32x4*)(w + i * C + ch * 8), w1 = *(const f32x4*)(w + i * C + ch * 8 + 4);
            acc[0] += w0.x * bf2f(x[0]); acc[1] += w0.y * bf2f(x[1]); acc[2] += w0.z * bf2f(x[2]); acc[3] += w0.w * bf2f(x[3]);
            acc[4] += w1.x * bf2f(x[4]); acc[5] += w1.y * bf2f(x[5]); acc[6] += w1.z * bf2f(x[6]); acc[7] += w1.w * bf2f(x[7]);
        }
    }
    v4u o; o.x = pk2(silu_f(acc[0]) * osc, silu_f(acc[1]) * osc); o.y = pk2(silu_f(acc[2]) * osc, silu_f(acc[3]) * osc); o.z = pk2(silu_f(acc[4]) * osc, silu_f(acc[5]) * osc); o.w = pk2(silu_f(acc[6]) * osc, silu_f(acc[7]) * osc);
    *(v4u*)(dst + (size_t)m * C + ch * 8) = o;
}
__device__ __forceinline__ void conv_seg(const bf16_t* proj, int m0, int c0, int ch, int C, const float* w, const float* bias, bf16_t* dst, float osc) {
    const int t0 = m0 & (SEQ - 1);
    f32x4 wa[4], wb[4];
#pragma unroll
    for (int i = 0; i < 4; ++i) { wa[i] = *(const f32x4*)(w + i * C + ch * 8); wb[i] = *(const f32x4*)(w + i * C + ch * 8 + 4); }
    const f32x4 b0 = *(const f32x4*)(bias + ch * 8), b1 = *(const f32x4*)(bias + ch * 8 + 4);
    const bf16_t* src = proj + (size_t)m0 * PROJ_W + c0 + ch * 8;
    us8 x0 = us8{}, x1 = us8{}, x2 = us8{};
    if (t0 > 0) { x0 = *(const us8*)(src - 3 * (ptrdiff_t)PROJ_W); x1 = *(const us8*)(src - 2 * (ptrdiff_t)PROJ_W); x2 = *(const us8*)(src - (ptrdiff_t)PROJ_W); }
    for (int j = 0; j < 32; j += 8) {
        us8 xn[8];
#pragma unroll
        for (int k = 0; k < 8; ++k) xn[k] = __builtin_nontemporal_load((const us8*)(src + (size_t)(j + k) * PROJ_W));
#pragma unroll
        for (int k = 0; k < 8; ++k) {
            float acc[8] = {b0.x, b0.y, b0.z, b0.w, b1.x, b1.y, b1.z, b1.w};
#define CS_TAP(i, xv) do { acc[0] += wa[i].x * bf2f(xv[0]); acc[1] += wa[i].y * bf2f(xv[1]); acc[2] += wa[i].z * bf2f(xv[2]); acc[3] += wa[i].w * bf2f(xv[3]); \
                           acc[4] += wb[i].x * bf2f(xv[4]); acc[5] += wb[i].y * bf2f(xv[5]); acc[6] += wb[i].z * bf2f(xv[6]); acc[7] += wb[i].w * bf2f(xv[7]); } while (0)
            const bool h3 = (t0 + j + k) >= 3, h2 = (t0 + j + k) >= 2, h1 = (t0 + j + k) >= 1;
            if (h3) CS_TAP(0, x0);
            if (h2) CS_TAP(1, x1);
            if (h1) CS_TAP(2, x2);
            CS_TAP(3, xn[k]);
#undef CS_TAP
            v4u o; o.x = pk2(silu_f(acc[0]) * osc, silu_f(acc[1]) * osc); o.y = pk2(silu_f(acc[2]) * osc, silu_f(acc[3]) * osc); o.z = pk2(silu_f(acc[4]) * osc, silu_f(acc[5]) * osc); o.w = pk2(silu_f(acc[6]) * osc, silu_f(acc[7]) * osc);
            *(v4u*)(dst + (size_t)(m0 + j + k) * C + ch * 8) = o;
            x0 = x1; x1 = x2; x2 = xn[k];
        }
    }
}
__device__ __forceinline__ void mla_prep_token(int m, int lane, const bf16_t* proj, const float* projf, const int* positions, const float* gq, const float* gkv,
                                               bf16_t* cqn, bf16_t* ckvn, bf16_t* km, float* rope) {
    const us4 v = *(const us4*)(proj + (size_t)m * PROJ_W + PC_CQ + lane * 4);
    const float ka = projf[(size_t)m * PROJF_W + PF_CKV + lane * 2], kb = projf[(size_t)m * PROJF_W + PF_CKV + lane * 2 + 1];
    const f32x4 g = *(const f32x4*)(gq + lane * 4);
    const float gk0 = gkv[lane * 2], gk1 = gkv[lane * 2 + 1];
    float pos = 0.f, x1 = 0.f, x2 = 0.f;
    if (lane < 16) { pos = (float)positions[m]; x1 = projf[(size_t)m * PROJF_W + PF_KR + lane]; x2 = projf[(size_t)m * PROJF_W + PF_KR + 16 + lane]; }
    { const float a = bf2f(v.x), b = bf2f(v.y), c = bf2f(v.z), d = bf2f(v.w);
      const float r = rsqrtf(wave_sum(a * a + b * b + c * c + d * d) * (1.f / 256.f) + EPS);
      *(unsigned long long*)(cqn + (size_t)m * 256 + lane * 4) = (unsigned long long)pk2(a * r * g.x, b * r * g.y) | ((unsigned long long)pk2(c * r * g.z, d * r * g.w) << 32); }
    { const float a = ka, b = kb;
      const float r = rsqrtf(wave_sum(a * a + b * b) * (1.f / 128.f) + EPS);
      *(unsigned*)(ckvn + (size_t)m * 128 + lane * 2) = pk2(a * r * gk0, b * r * gk1); }
    if (lane < 16) {
        const float inv = powf(10000.f, -(float)(2 * lane) / 32.f);
        float sn, cs; sincosf(pos * inv, &sn, &cs);
        rope[(size_t)m * 32 + lane] = cs; rope[(size_t)m * 32 + 16 + lane] = sn;
        const bf16_t o1 = f2bf(x1 * cs - x2 * sn), o2 = f2bf(x2 * cs + x1 * sn);
#pragma unroll
        for (int hh = 0; hh < 4; ++hh) { km[(size_t)m * 384 + hh * 96 + 64 + lane] = o1; km[(size_t)m * 384 + hh * 96 + 80 + lane] = o2; }
    }
}
__device__ __forceinline__ void kmean_item(int item, int lane, const bf16_t* proj, float* kmean) {
    const int jg = item >> 2, hh = item & 3, cc = lane & 7, rg = lane >> 3;
    float acc[8];
#pragma unroll
    for (int i = 0; i < 8; ++i) acc[i] = 0.f;
#pragma unroll 8
    for (int r = 0; r < 32; ++r) { const us8 x = *(const us8*)(proj + (size_t)(jg * 256 + rg * 32 + r) * PROJ_W + PC_AK + hh * 64 + cc * 8);
#pragma unroll
        for (int i = 0; i < 8; ++i) acc[i] += bf2f(x[i]); }
#pragma unroll
    for (int i = 0; i < 8; ++i) { float v = acc[i]; v += __shfl_xor(v, 8); v += __shfl_xor(v, 16); v += __shfl_xor(v, 32); acc[i] = v * (1.f / 256.f); }
    if (rg == 0) { *(f32x4*)(kmean + jg * 256 + hh * 64 + cc * 8) = (f32x4){acc[0], acc[1], acc[2], acc[3]}; *(f32x4*)(kmean + jg * 256 + hh * 64 + cc * 8 + 4) = (f32x4){acc[4], acc[5], acc[6], acc[7]}; }
}

constexpr size_t WS_WUP = 44 * MiB, WS_WDN = 60 * MiB, WS_XS = 68 * MiB, WS_HID = 112 * MiB, WS_STOK = 134 * MiB, WS_SW1 = WS_STOK + 128 * 1024, WS_SW2 = WS_STOK + 256 * 1024,
                 WS_TCLS = 135 * MiB, WS_TPOS = WS_TCLS + 64 * 1024, WS_TW1 = WS_TCLS + 128 * 1024, WS_TW2 = WS_TCLS + 192 * 1024;
constexpr int MOE_MAXTILES = 88, CW_MOECNT = 200000;
constexpr int TCLS_OFF = LDSCTL_OFF, OFFS_OFF = LDSCTL_OFF + 128;
__device__ __forceinline__ void pair_decode(int pr, int& a, int& b) { a = (pr < 3) ? 0 : ((pr < 5) ? 1 : 2); b = (pr < 3) ? pr + 1 : ((pr < 5) ? pr - 1 : 3); }
__device__ __forceinline__ int moe_tiles(const unsigned* cnt, LAS unsigned char* lds, bool t0) {
    LAS unsigned char* tcls = lds + TCLS_OFF; LAS int* offs = (LAS int*)(lds + OFFS_OFF);
    __syncthreads();
    if (threadIdx.x < 24) offs[threadIdx.x] = (int)cnt[32 * threadIdx.x];
    __syncthreads();
    if (t0) { int off = 0;
        _Pragma("unroll 1") for (int c = 0; c < 24; ++c) { const int n = offs[c]; offs[c] = off; const int nt = (n + 255) >> 8; _Pragma("unroll 1") for (int t = 0; t < nt; ++t) tcls[(off >> 8) + t] = (unsigned char)c; off += nt << 8; }
        offs[24] = off; }
    __syncthreads();
    return offs[24] >> 8;
}
struct MoeOrder {
    const bf16_t* A; const bf16_t* W; int lda, ldb; size_t estride; int K; int ntile, G, c; const LAS unsigned char* tcls; bool down;
    __device__ bool next(int i, pg8::Unit& u) const { const int L = i * G + c; if (L >= ntile * 4) return false; u.pm = L >> 2; u.pn = L & 3; return true; }
    __device__ __forceinline__ const char* a_ptr(const pg8::Unit& u) const { return (const char*)A + (size_t)u.pm * 256 * lda * 2; }
    __device__ __forceinline__ const char* b_ptr(const pg8::Unit& u, int half) const {
        const int cls = tcls[u.pm], g = cls / 6; int ea, eb; pair_decode(cls - g * 6, ea, eb);
        if (down) { const int e = g * 4 + (half ? eb : ea); return (const char*)(W + (size_t)e * estride + (size_t)u.pn * 256 * ldb); }
        const int e = g * 4 + ((u.pn < 2) ? ea : eb); return (const char*)(W + (size_t)e * estride + (size_t)(u.pn & 1) * 256 * ldb + (half ? K / 2 : 0));
    }
};
struct EpiMoeUp {
    bf16_t* hid; const float* w1; const float* w2;
    __device__ __forceinline__ void operator()(const pg8::f32x4 (&acc)[2][2][4][2], const pg8::Unit& u, int wr, int wc, int fr, int fq) const {
        const int row0 = u.pm * 256 + wr * 64 + fr; const float* ws = (u.pn < 2) ? w1 : w2;
#pragma unroll
        for (int ai = 0; ai < 2; ++ai)
#pragma unroll
            for (int m = 0; m < 4; ++m) { const int row = row0 + ai * 128 + m * 16; const float wt = ws[row];
                const pg8::f32x4 g0 = acc[ai][0][m][0], g1 = acc[ai][0][m][1], u0 = acc[ai][1][m][0], u1 = acc[ai][1][m][1];
                pg8::u32x4 w;
                w.x = pg8::cvt_pk_bf16(silu_f(g0[0]) * u0[0] * wt, silu_f(g0[1]) * u0[1] * wt); w.y = pg8::cvt_pk_bf16(silu_f(g0[2]) * u0[2] * wt, silu_f(g0[3]) * u0[3] * wt);
                w.z = pg8::cvt_pk_bf16(silu_f(g1[0]) * u1[0] * wt, silu_f(g1[1]) * u1[1] * wt); w.w = pg8::cvt_pk_bf16(silu_f(g1[2]) * u1[2] * wt, silu_f(g1[3]) * u1[3] * wt);
                *(pg8::u32x4*)(hid + (size_t)row * 512 + u.pn * 128 + wc * 32 + 8 * fq) = w; }
    }
};
struct EpiMoeDown {
    float* x; const int* stok;
    __device__ __forceinline__ void operator()(const pg8::f32x4 (&acc)[2][2][4][2], const pg8::Unit& u, int wr, int wc, int fr, int fq) const {
        const int row0 = u.pm * 256 + wr * 64 + fr, col0 = u.pn * 256 + wc * 32 + 8 * fq;
        int toks[2][4];
#pragma unroll
        for (int ai = 0; ai < 2; ++ai)
#pragma unroll
            for (int m = 0; m < 4; ++m) toks[ai][m] = stok[row0 + ai * 128 + m * 16];
#pragma unroll
        for (int ai = 0; ai < 2; ++ai)
#pragma unroll
            for (int m = 0; m < 4; m += 2) {
                pg8::f32x4 xv[2][2][2];
#pragma unroll
                for (int mm = 0; mm < 2; ++mm) { const int tok = toks[ai][m + mm];
                    if (tok >= 0) { const float* rowp = x + (size_t)tok * DM + col0;
#pragma unroll
                        for (int bj = 0; bj < 2; ++bj) { const pg8::f32x4* p = (const pg8::f32x4*)(rowp + bj * 128); xv[mm][bj][0] = p[0]; xv[mm][bj][1] = p[1]; } } }
#pragma unroll
                for (int mm = 0; mm < 2; ++mm) { const int tok = toks[ai][m + mm];
                    if (tok >= 0) { float* rowp = x + (size_t)tok * DM + col0;
#pragma unroll
                        for (int bj = 0; bj < 2; ++bj) { pg8::f32x4* p = (pg8::f32x4*)(rowp + bj * 128); p[0] = xv[mm][bj][0] + acc[ai][bj][m + mm][0]; p[1] = xv[mm][bj][1] + acc[ai][bj][m + mm][1]; } } }
                asm volatile("" ::: "memory"); }
    }
};
struct MapMoeUp { const float* W; int fbase;
    __device__ const float* ptr(int) const { return W; } __device__ int col(int n) const { return fbase + (n & 127); } __device__ float scale(int) const { return 1.f; } };
constexpr int RW_PITCH = 1028;
__device__ __forceinline__ void route_token(int m, int lane, const float* X, const float* g, const LAS float* rw, const float* bg, const float* br, bf16_t* xn2,
                                            unsigned* cnt, int* tcls, int* tpos, float* tw1, float* tw2) {
    asm volatile("" : "+v"(lane));
    const GAS f32x4* xr = (const GAS f32x4*)(X + (size_t)m * DM) + lane; const GAS f32x4* gr = (const GAS f32x4*)g + lane;
    f32x4 v[4]; float s = 0.f;
#pragma unroll
    for (int j = 0; j < 4; ++j) { v[j] = __builtin_nontemporal_load(xr + 64 * j); s += (v[j].x * v[j].x + v[j].y * v[j].y) + (v[j].z * v[j].z + v[j].w * v[j].w); }
    const float rstd = rsqrtf(wave_sum(s) * (1.f / DM) + EPS);
    GAS unsigned long long* o8 = (GAS unsigned long long*)(xn2 + (size_t)m * DM) + lane;
#pragma unroll
    for (int j = 0; j < 4; ++j) { const f32x4 gg = gr[64 * j]; v[j] = (f32x4){v[j].x * rstd * gg.x, v[j].y * rstd * gg.y, v[j].z * rstd * gg.z, v[j].w * rstd * gg.w};
        o8[64 * j] = (unsigned long long)pk2(v[j].x, v[j].y) | ((unsigned long long)pk2(v[j].z, v[j].w) << 32); }
    float lg[20];
#pragma unroll
    for (int q = 0; q < 20; ++q) { float p = 0.f;
#pragma unroll
        for (int j = 0; j < 4; ++j) { const f32x4 w = *(const LAS f32x4*)(rw + q * RW_PITCH + 4 * (64 * j + lane)); p += (v[j].x * w.x + v[j].y * w.y) + (v[j].z * w.z + v[j].w * w.w); }
        lg[q] = wave_sum(p) + (q < 4 ? bg[q] : br[q - 4]); }
    int gi = 0; float gm = lg[0];
#pragma unroll
    for (int j = 1; j < 4; ++j) if (lg[j] > gm) { gm = lg[j]; gi = j; }
    float gs = 0.f;
#pragma unroll
    for (int j = 0; j < 4; ++j) gs += __expf(lg[j] - gm);
    const float g_w = 1.f / gs;
    float el[4];
#pragma unroll
    for (int j = 0; j < 4; ++j) el[j] = (gi == 0) ? lg[4 + j] : (gi == 1) ? lg[8 + j] : (gi == 2) ? lg[12 + j] : lg[16 + j];
    const float em = fmaxf(fmaxf(el[0], el[1]), fmaxf(el[2], el[3]));
    float pe[4]; float es = 0.f;
#pragma unroll
    for (int j = 0; j < 4; ++j) { pe[j] = __expf(el[j] - em); es += pe[j]; }
    int e0 = 0; float p0 = pe[0];
#pragma unroll
    for (int j = 1; j < 4; ++j) if (pe[j] > p0) { p0 = pe[j]; e0 = j; }
    int e1 = -1; float p1 = -1.f;
#pragma unroll
    for (int j = 0; j < 4; ++j) if (j != e0 && pe[j] > p1) { p1 = pe[j]; e1 = j; }
    p0 /= es; p1 /= es;
    const float sw = p0 + p1; const float w0 = g_w * p0 / sw, w1 = g_w * p1 / sw;
    const int ea = e0 < e1 ? e0 : e1, eb = e0 < e1 ? e1 : e0; const float wa = e0 < e1 ? w0 : w1, wb = e0 < e1 ? w1 : w0;
    const int pr = (ea == 0) ? eb - 1 : (ea == 1) ? eb + 1 : 5;
    const int cls = gi * 6 + pr;
    if (lane == 0) { const unsigned pos = __hip_atomic_fetch_add(cnt + 32 * cls, 1u, __ATOMIC_RELAXED, __HIP_MEMORY_SCOPE_AGENT);
        tcls[m] = cls; tpos[m] = (int)pos; tw1[m] = wa; tw2[m] = wb; }
}
namespace att {
using bf16x8 = __attribute__((ext_vector_type(8))) short;
using s16x4 = __attribute__((ext_vector_type(4))) short;
using f32x16 = __attribute__((ext_vector_type(16))) float;
using u32x4 = __attribute__((ext_vector_type(4))) unsigned;
typedef short v4i16_t __attribute__((ext_vector_type(4)));
constexpr int NW = 8, QBLK = 32, QB = 256, KVBLK = 64;
constexpr int NSLOT = 3, KSLOT = 12288, VSLOT = 8192;
constexpr int LDS_K = 0, LDS_V = NSLOT * KSLOT, LDS_WS = LDS_V + NSLOT * VSLOT, LDS_OST = LDS_WS + NW * 256, LDS_BYTES_ATT = LDS_OST + NW * 4096;
__device__ __forceinline__ int crow(int r, int hi) { return (r & 3) + 8 * (r >> 2) + 4 * hi; }
__device__ __forceinline__ void glds16(const void* gsrc, unsigned lds_dst) { unsigned keep;
    asm volatile("s_mov_b32 %0, m0\n\ts_mov_b32 m0, %2\n\ts_nop 0\n\tglobal_load_lds_dwordx4 %1, off\n\ts_mov_b32 m0, %0" : "=&s"(keep) : "v"(gsrc), "s"(lds_dst) : "memory"); }
__device__ __forceinline__ unsigned cvtpk(float lo, float hi) { unsigned r; asm("v_cvt_pk_bf16_f32 %0, %1, %2" : "=v"(r) : "v"(lo), "v"(hi)); return r; }
__device__ __forceinline__ float xhalf_max(float m) { auto rr = __builtin_amdgcn_permlane32_swap(__float_as_uint(m), __float_as_uint(m), false, false); return fmaxf(__uint_as_float(rr[0]), __uint_as_float(rr[1])); }
__device__ __forceinline__ float xhalf_sum(float m) { auto rr = __builtin_amdgcn_permlane32_swap(__float_as_uint(m), __float_as_uint(m), false, false); return __uint_as_float(rr[0]) + __uint_as_float(rr[1]); }
__device__ __forceinline__ void pv(f32x16* o, int vb, bf16x8 pa0, bf16x8 pa1, bf16x8 pa2, bf16x8 pa3) {
#pragma unroll
    for (int d0 = 0; d0 < 2; ++d0) { s16x4 lo[4], hi[4];
#pragma unroll
        for (int ks = 0; ks < 4; ++ks) {
            asm volatile("ds_read_b64_tr_b16 %0,%1 offset:%c2" : "=&v"(lo[ks]) : "v"(vb), "i"(d0 * 4096 + ks * 1024) : "memory");
            asm volatile("ds_read_b64_tr_b16 %0,%1 offset:%c2" : "=&v"(hi[ks]) : "v"(vb), "i"(d0 * 4096 + ks * 1024 + 512) : "memory"); }
        asm volatile("s_waitcnt lgkmcnt(0)" ::: "memory"); __builtin_amdgcn_sched_barrier(0);
#define ATT_PK(k) (bf16x8){lo[k][0], lo[k][1], lo[k][2], lo[k][3], hi[k][0], hi[k][1], hi[k][2], hi[k][3]}
        o[d0] = __builtin_amdgcn_mfma_f32_32x32x16_bf16(pa0, ATT_PK(0), o[d0], 0, 0, 0);
        o[d0] = __builtin_amdgcn_mfma_f32_32x32x16_bf16(pa1, ATT_PK(1), o[d0], 0, 0, 0);
        o[d0] = __builtin_amdgcn_mfma_f32_32x32x16_bf16(pa2, ATT_PK(2), o[d0], 0, 0, 0);
        o[d0] = __builtin_amdgcn_mfma_f32_32x32x16_bf16(pa3, ATT_PK(3), o[d0], 0, 0, 0);
#undef ATT_PK
    }
}
#define ATT_WAIT_BAR(N) asm volatile("s_waitcnt vmcnt(" #N ") lgkmcnt(0)\n\ts_barrier" ::: "memory")

template <int DQK, bool MOBA>
__device__ __forceinline__ void attn_unit(int b, int h, int qb, const bf16_t* Q, int qpitch, int qcol0, const bf16_t* K, int kpitch, int kcol0, const bf16_t* V, int vpitch, int vcol0,
                                          bf16_t* O, int ocol0, const float* kmean, LAS unsigned char* shm, const int wid) {
    constexpr int ND0 = DQK / 16;
    int lane = (int)__builtin_amdgcn_mbcnt_hi(~0u, __builtin_amdgcn_mbcnt_lo(~0u, 0u)); asm volatile("" : "+v"(lane));
    const int r32 = lane & 31, hi = lane >> 5;
    const long rowbase = (long)b * SEQ; const int q0 = qb * QB;
    const bf16_t* Qw = Q + (rowbase + q0 + wid * QBLK) * qpitch + qcol0;
    const bf16_t* Kh = K + rowbase * kpitch + kcol0; const bf16_t* Vh = V + rowbase * vpitch + vcol0;
    const unsigned lds0 = (unsigned)(size_t)shm;
    LAS float* wsf = (LAS float*)(shm + LDS_WS) + wid * 64;
    const bf16_t* ksrc0 = Kh + (long)lane * kpitch + wid * 8;
    const bf16_t* ksrc1 = Kh + (long)lane * kpitch + (8 + (wid & 3)) * 8;
    const bf16_t* vsrc = Vh + (long)(16 * (wid & 3) + (lane >> 2)) * vpitch + (wid >> 2) * 32 + (lane & 3) * 8;
    const unsigned kdst0 = lds0 + LDS_K + wid * 1024, kdst1 = lds0 + LDS_K + (8 + (wid & 3)) * 1024, vdst = lds0 + LDS_V + wid * 1024;
#define ATT_DMA(t, slot) do { glds16(ksrc0 + (long)(t) * KVBLK * kpitch, (unsigned)__builtin_amdgcn_readfirstlane(kdst0 + (slot) * KSLOT)); \
        if (DQK == 96) glds16(ksrc1 + (long)(t) * KVBLK * kpitch, (unsigned)__builtin_amdgcn_readfirstlane(kdst1 + (slot) * KSLOT)); \
        glds16(vsrc + (long)(t) * KVBLK * vpitch, (unsigned)__builtin_amdgcn_readfirstlane(vdst + (slot) * VSLOT)); } while (0)
    const int NT = (q0 + QB) / KVBLK;
    ATT_DMA(0, 0); ATT_DMA(1, 1);
    bf16x8 qr[ND0];
#pragma unroll
    for (int d0 = 0; d0 < ND0; ++d0) qr[d0] = *reinterpret_cast<const bf16x8*>(&Qw[(long)r32 * qpitch + d0 * 16 + hi * 8]);
    unsigned sel = 0xffffffffu;
    if (MOBA) {
        float v0 = -INFINITY, v1 = -INFINITY, v2 = -INFINITY; int i0 = -1, i1 = -1, i2 = -1;
#ifdef ATT_KM_GLOBAL
        const float* kmb = kmean + (size_t)(b * 32) * 256 + h * 64 + hi * 8;
#else
        constexpr int LDS_KM = 98304;
        static_assert(NSLOT == 3, "LDS_KM assumes the 3-slot layout");
        LAS float* kml = (LAS float*)(shm + LDS_KM);
        { const float* kmg = kmean + (size_t)(b * 32) * 256 + h * 64; const int tid_ = wid * 64 + lane;
          for (int i = tid_; i < qb * 16; i += NW * 64) { const int j = i >> 4, c4 = i & 15; *(LAS pg8::f32x4*)(kml + j * 64 + c4 * 4) = *(const pg8::f32x4*)(kmg + (size_t)j * 256 + c4 * 4); }
          asm volatile("s_waitcnt vmcnt(0) lgkmcnt(0)\n\ts_barrier" ::: "memory"); }
        const LAS float* kmb = kml + hi * 8;
#endif
        for (int j = 0; j < qb; ++j) {
            float g = 0.f;
#pragma unroll
            for (int d0 = 0; d0 < 4; ++d0) {
#ifdef ATT_KM_GLOBAL
                const pg8::f32x4 ka = *(const pg8::f32x4*)(kmb + j * 256 + d0 * 16), kb2 = *(const pg8::f32x4*)(kmb + j * 256 + d0 * 16 + 4);
#else
                const pg8::f32x4 ka = *(const LAS pg8::f32x4*)(kmb + j * 64 + d0 * 16), kb2 = *(const LAS pg8::f32x4*)(kmb + j * 64 + d0 * 16 + 4);
#endif
                const bf16x8 qq = qr[d0];
                g += bf2f((bf16_t)qq[0]) * ka.x + bf2f((bf16_t)qq[1]) * ka.y + bf2f((bf16_t)qq[2]) * ka.z + bf2f((bf16_t)qq[3]) * ka.w
                   + bf2f((bf16_t)qq[4]) * kb2.x + bf2f((bf16_t)qq[5]) * kb2.y + bf2f((bf16_t)qq[6]) * kb2.z + bf2f((bf16_t)qq[7]) * kb2.w; }
            g = xhalf_sum(g);
            if (g > v0) { v2 = v1; i2 = i1; v1 = v0; i1 = i0; v0 = g; i0 = j; }
            else if (g > v1) { v2 = v1; i2 = i1; v1 = g; i1 = j; }
            else if (g > v2) { v2 = g; i2 = j; }
        }
        sel = 0u;
        if (i0 >= 0) sel |= 1u << i0;
        if (i1 >= 0) sel |= 1u << i1;
        if (i2 >= 0) sel |= 1u << i2;
    }
    float m_run = -1e30f, l_run = 0.f; f32x16 o[2]; o[0] = f32x16{}; o[1] = f32x16{};
    const int qrel = wid * QBLK + r32;
    const int vb0 = (int)(lds0 + LDS_V) + ((lane >> 4) & 1) * 32 + (lane & 3) * 8 + (4 * hi + ((lane & 15) >> 2)) * 64;
    int slot = 0;
    for (int t = 0; t < NT; ++t) {
        if (t + 1 < NT) { if (DQK == 96) ATT_WAIT_BAR(3); else ATT_WAIT_BAR(2); } else ATT_WAIT_BAR(0);
        if (t + 2 < NT) { const int s2 = (slot == 0) ? 2 : slot - 1; ATT_DMA(t + 2, s2); }
        f32x16 p0, p1;
        { const LAS unsigned char* kb = shm + LDS_K + slot * KSLOT + hi * 1024 + r32 * 16;
#pragma unroll
          for (int d0 = 0; d0 < ND0; ++d0) {
              const bf16x8 b0 = *(const LAS bf16x8*)(kb + d0 * 2048), b1 = *(const LAS bf16x8*)(kb + d0 * 2048 + 512);
              if (d0 == 0) { p0 = __builtin_amdgcn_mfma_f32_32x32x16_bf16(b0, qr[0], f32x16{}, 0, 0, 0); p1 = __builtin_amdgcn_mfma_f32_32x32x16_bf16(b1, qr[0], f32x16{}, 0, 0, 0); }
              else { p0 = __builtin_amdgcn_mfma_f32_32x32x16_bf16(b0, qr[d0], p0, 0, 0, 0); p1 = __builtin_amdgcn_mfma_f32_32x32x16_bf16(b1, qr[d0], p1, 0, 0, 0); } } }
        const int jb = t - (NT - 4);
        if (jb >= 0) { const int kb0 = 64 * jb + 4 * hi;
#pragma unroll
            for (int r = 0; r < 16; ++r) { const int kv = kb0 + (r & 3) + 8 * (r >> 2); if (kv > qrel) p0[r] = -INFINITY; if (kv + 32 > qrel) p1[r] = -INFINITY; } }
        else if (MOBA) { if (!((sel >> (t >> 2)) & 1u)) {
#pragma unroll
            for (int r = 0; r < 16; ++r) { p0[r] = -INFINITY; p1[r] = -INFINITY; } } }
        float rm = fmaxf(p0[0], p1[0]);
#pragma unroll
        for (int r = 1; r < 16; ++r) rm = fmaxf(rm, fmaxf(p0[r], p1[r]));
        rm = xhalf_max(rm);
        const float m_new = fmaxf(m_run, rm); const float alpha = __builtin_amdgcn_exp2f(m_run - m_new); m_run = m_new;
        float ls = 0.f;
#pragma unroll
        for (int r = 0; r < 16; ++r) { p0[r] = __builtin_amdgcn_exp2f(p0[r] - m_new); p1[r] = __builtin_amdgcn_exp2f(p1[r] - m_new); ls += p0[r] + p1[r]; }
        l_run = l_run * alpha + ls;
        if (hi == 0) wsf[r32] = alpha;
        asm volatile("s_waitcnt lgkmcnt(0)" ::: "memory");
#pragma unroll
        for (int r = 0; r < 16; ++r) { const float a = wsf[crow(r, hi)]; o[0][r] *= a; o[1][r] *= a; }
        u32x4 pw0, pw1, pw2, pw3;
        pw0 = (u32x4){cvtpk(p0[0], p0[1]), cvtpk(p0[2], p0[3]), cvtpk(p0[4], p0[5]), cvtpk(p0[6], p0[7])};
        pw1 = (u32x4){cvtpk(p0[8], p0[9]), cvtpk(p0[10], p0[11]), cvtpk(p0[12], p0[13]), cvtpk(p0[14], p0[15])};
        pw2 = (u32x4){cvtpk(p1[0], p1[1]), cvtpk(p1[2], p1[3]), cvtpk(p1[4], p1[5]), cvtpk(p1[6], p1[7])};
        pw3 = (u32x4){cvtpk(p1[8], p1[9]), cvtpk(p1[10], p1[11]), cvtpk(p1[12], p1[13]), cvtpk(p1[14], p1[15])};
        asm volatile("s_waitcnt lgkmcnt(0)" ::: "memory");
        pv(o, vb0 + slot * VSLOT, __builtin_bit_cast(bf16x8, pw0), __builtin_bit_cast(bf16x8, pw1), __builtin_bit_cast(bf16x8, pw2), __builtin_bit_cast(bf16x8, pw3));
        slot = (slot == 2) ? 0 : slot + 1;
    }
    l_run = xhalf_sum(l_run);
    if (hi == 0) wsf[32 + r32] = l_run;
    asm volatile("s_waitcnt lgkmcnt(0)" ::: "memory");
    float rli[16];
#pragma unroll
    for (int r = 0; r < 16; ++r) rli[r] = __builtin_amdgcn_rcpf(wsf[32 + crow(r, hi)]);
    bf16_t* Ow = O + (rowbase + q0 + wid * QBLK) * DM + ocol0;
    { LAS bf16_t* stg = (LAS bf16_t*)(shm + LDS_OST) + wid * 2048;
#pragma unroll
      for (int r = 0; r < 16; ++r) { const int orow = crow(r, hi);
#pragma unroll
          for (int d0 = 0; d0 < 2; ++d0) stg[orow * 64 + d0 * 32 + r32] = f2bf(o[d0][r] * rli[r]); }
      asm volatile("s_waitcnt lgkmcnt(0)" ::: "memory");
#pragma unroll
      for (int i = 0; i < 4; ++i) { const int row = i * 8 + (lane >> 3), ch = lane & 7; const u32x4 v = *(const LAS u32x4*)(stg + row * 64 + ch * 8); *(u32x4*)(Ow + (long)row * DM + ch * 8) = v; } }
    asm volatile("s_waitcnt vmcnt(0) lgkmcnt(0)\n\ts_barrier" ::: "memory");
#undef ATT_DMA
}
#undef ATT_WAIT_BAR
}
namespace ck {
using att::bf16x8; using att::s16x4; using att::f32x16; using att::u32x4; using att::crow; using att::cvtpk; using att::xhalf_sum;
constexpr int CL = 128, NCH = SEQ / CL;
__device__ __forceinline__ int lane_id() { return (int)__builtin_amdgcn_mbcnt_hi(~0u, __builtin_amdgcn_mbcnt_lo(~0u, 0u)); }
#define CK_TRF(dst, vb, OFF) do { s16x4 lo_, hi_; \
    asm volatile("ds_read_b64_tr_b16 %0,%1 offset:%c2" : "=&v"(lo_) : "v"(vb), "i"(OFF) : "memory"); \
    asm volatile("ds_read_b64_tr_b16 %0,%1 offset:%c2" : "=&v"(hi_) : "v"(vb), "i"((OFF) + 512) : "memory"); \
    asm volatile("s_waitcnt lgkmcnt(0)" ::: "memory"); \
    dst = (bf16x8){lo_[0], lo_[1], lo_[2], lo_[3], hi_[0], hi_[1], hi_[2], hi_[3]}; } while (0)
__device__ __forceinline__ int tr_lane_off(int lane) { const int hi = lane >> 5; return ((lane >> 4) & 1) * 32 + (lane & 3) * 8 + (4 * hi + ((lane & 15) >> 2)) * 64; }
__device__ __forceinline__ void stage_v64(LAS unsigned char* dst, const bf16_t* src, int gp, int tid, const LAS float* rowscale) {
    const int row = tid >> 3, j = tid & 7;
    us8 v = *(const us8*)(src + (size_t)row * gp + 8 * j);
    if (rowscale) { const float s = rowscale[row];
#pragma unroll
        for (int i = 0; i < 8; ++i) v[i] = f2bf(bf2f(v[i]) * s); }
    *(LAS us8*)(dst + (j >> 2) * 4096 + row * 64 + (j & 3) * 16) = v;
}
template <int DQ> __device__ __forceinline__ void stage_k64(LAS unsigned char* dst, const bf16_t* src, int gp, int tid) {
#pragma unroll
    for (int pc = tid; pc < 64 * (DQ / 8); pc += 512) { const int row = pc / (DQ / 8), c = pc % (DQ / 8);
        *(LAS us8*)(dst + c * 1024 + row * 16) = *(const us8*)(src + (size_t)row * gp + 8 * c); }
}
__device__ __forceinline__ void scan128(float a0, float a1, int lane, float& s0, float& s1) {
    float t = a0 + a1;
#pragma unroll
    for (int o = 1; o < 64; o <<= 1) { const float u = __shfl_up(t, o); if (lane >= o) t += u; }
    s1 = t; s0 = t - a1;
}

__device__ __forceinline__ void ssd_s1_unit(int unit, const bf16_t* xbca, const float* projf, const float* dt_bias, const float* a_log, float* S, float* dec, LAS unsigned char* shm, int wave) {
    const int g = unit & 1, c = (unit >> 1) & (NCH - 1), b = unit >> 7;
    int lane = lane_id(); asm volatile("" : "+v"(lane));
    const int tid = wave * 64 + lane; const size_t m0 = (size_t)b * SEQ + (size_t)c * CL;
    LAS float* wtab = (LAS float*)(shm + 65536);
    if (wave < 2) { const int h = 2 * g + wave; const float a = -__expf(a_log[h]), dtb = dt_bias[h];
        const float d0 = softplus_f(projf[(m0 + 2 * lane) * PROJF_W + PF_DT + h] + dtb), d1 = softplus_f(projf[(m0 + 2 * lane + 1) * PROJF_W + PF_DT + h] + dtb);
        float s0, s1; scan128(d0 * a, d1 * a, lane, s0, s1);
        const float alast = __shfl(s1, 63);
        wtab[wave * 128 + 2 * lane] = __expf(alast - s0) * d0; wtab[wave * 128 + 2 * lane + 1] = __expf(alast - s1) * d1;
        if (lane == 0) dec[((size_t)b * NCH + c) * 4 + h] = __expf(alast); }
    __syncthreads();
#pragma unroll
    for (int hh = 0; hh < 2; ++hh)
#pragma unroll
        for (int rt = 0; rt < 2; ++rt) stage_v64(shm + (hh * 2 + rt) * 8192, xbca + (m0 + rt * 64) * 768 + (2 * g + hh) * 64, 768, tid, wtab + hh * 128 + rt * 64);
#pragma unroll
    for (int rt = 0; rt < 2; ++rt)
#pragma unroll
        for (int ct = 0; ct < 2; ++ct) stage_v64(shm + 32768 + (rt * 2 + ct) * 8192, xbca + (m0 + rt * 64) * 768 + 256 + g * 128 + ct * 64, 768, tid, nullptr);
    __syncthreads();
    const int hh = wave >> 2, j = wave & 3, r32 = lane & 31, hi = lane >> 5; const int lo = tr_lane_off(lane);
    f32x16 acc0 = f32x16{}, acc1 = f32x16{};
#pragma unroll
    for (int rt = 0; rt < 2; ++rt) {
        const int vx = (int)(unsigned)(size_t)(shm + (hh * 2 + rt) * 8192) + lo, vbm = (int)(unsigned)(size_t)(shm + 32768 + (rt * 2 + (j >> 1)) * 8192) + lo + (j & 1) * 4096;
#define CK_STEP(ks) do { bf16x8 fb, fa0, fa1; CK_TRF(fb, vbm, (ks) * 1024); CK_TRF(fa0, vx, (ks) * 1024); CK_TRF(fa1, vx, 4096 + (ks) * 1024); \
        acc0 = __builtin_amdgcn_mfma_f32_32x32x16_bf16(fa0, fb, acc0, 0, 0, 0); acc1 = __builtin_amdgcn_mfma_f32_32x32x16_bf16(fa1, fb, acc1, 0, 0, 0); } while (0)
        CK_STEP(0); CK_STEP(1); CK_STEP(2); CK_STEP(3);
#undef CK_STEP
    }
    float* Sp = S + (((size_t)b * NCH + c) * 4 + 2 * g + hh) * 8192 + (size_t)(32 * j + r32) * 64;
#pragma unroll
    for (int q = 0; q < 4; ++q) { *(pg8::f32x4*)(Sp + 8 * q + 4 * hi) = (pg8::f32x4){acc0[4 * q], acc0[4 * q + 1], acc0[4 * q + 2], acc0[4 * q + 3]};
                                  *(pg8::f32x4*)(Sp + 32 + 8 * q + 4 * hi) = (pg8::f32x4){acc1[4 * q], acc1[4 * q + 1], acc1[4 * q + 2], acc1[4 * q + 3]}; }
    __syncthreads();
}

__device__ __forceinline__ void ml_s1_unit(int unit, const bf16_t* qka, const bf16_t* proj, const float* projf, const float* ig_bias, const float* fg_bias, float* U, float* nU, float* dec,
                                           LAS unsigned char* shm, int wave) {
    const int hp = unit & 1, c = (unit >> 1) & (NCH - 1), b = unit >> 7;
    int lane = lane_id(); asm volatile("" : "+v"(lane));
    const int tid = wave * 64 + lane; const size_t m0 = (size_t)b * SEQ + (size_t)c * CL;
    LAS float* wtab = (LAS float*)(shm + 65536);
    if (wave < 2) { const int h = 2 * hp + wave; const float igb = ig_bias[h], fgb = fg_bias[h];
        const float f0 = projf[(m0 + 2 * lane) * PROJF_W + PF_MF + h] + fgb, f1 = projf[(m0 + 2 * lane + 1) * PROJF_W + PF_MF + h] + fgb;
        const float l0 = fminf(f0, 0.f) - log1pf(__expf(-fabsf(f0))), l1 = fminf(f1, 0.f) - log1pf(__expf(-fabsf(f1)));
        const float i0 = projf[(m0 + 2 * lane) * PROJF_W + PF_MI + h] + igb, i1 = projf[(m0 + 2 * lane + 1) * PROJF_W + PF_MI + h] + igb;
        float s0, s1; scan128(l0, l1, lane, s0, s1);
        const float blast = __shfl(s1, 63);
        wtab[wave * 128 + 2 * lane] = __expf(blast - s0 + i0); wtab[wave * 128 + 2 * lane + 1] = __expf(blast - s1 + i1);
        if (lane == 0) dec[((size_t)b * NCH + c) * 4 + h] = __expf(blast); }
    __syncthreads();
#pragma unroll
    for (int hh = 0; hh < 2; ++hh)
#pragma unroll
        for (int rt = 0; rt < 2; ++rt) {
            stage_v64(shm + (hh * 2 + rt) * 8192, qka + (m0 + rt * 64) * 512 + 256 + (2 * hp + hh) * 64, 512, tid, wtab + hh * 128 + rt * 64);
            stage_v64(shm + 32768 + (hh * 2 + rt) * 8192, proj + (m0 + rt * 64) * PROJ_W + PC_MV + (2 * hp + hh) * 64, PROJ_W, tid, nullptr); }
    __syncthreads();
    const int hh = wave >> 2, db = (wave >> 1) & 1, eb = wave & 1, r32 = lane & 31, hi = lane >> 5; const int lo = tr_lane_off(lane);
    f32x16 acc = f32x16{};
#pragma unroll
    for (int rt = 0; rt < 2; ++rt) {
        const int vk = (int)(unsigned)(size_t)(shm + (hh * 2 + rt) * 8192) + lo + db * 4096, vv = (int)(unsigned)(size_t)(shm + 32768 + (hh * 2 + rt) * 8192) + lo + eb * 4096;
#define CK_STEP(ks) do { bf16x8 fa, fb; CK_TRF(fa, vv, (ks) * 1024); CK_TRF(fb, vk, (ks) * 1024); acc = __builtin_amdgcn_mfma_f32_32x32x16_bf16(fa, fb, acc, 0, 0, 0); } while (0)
        CK_STEP(0); CK_STEP(1); CK_STEP(2); CK_STEP(3);
#undef CK_STEP
    }
    const size_t ub = ((size_t)b * NCH + c) * 4 + 2 * hp + hh;
    float* Up = U + ub * 4096 + (size_t)(32 * db + r32) * 64 + 32 * eb;
#pragma unroll
    for (int q = 0; q < 4; ++q) *(pg8::f32x4*)(Up + 8 * q + 4 * hi) = (pg8::f32x4){acc[4 * q], acc[4 * q + 1], acc[4 * q + 2], acc[4 * q + 3]};
    if (tid < 128) { const int h2 = tid >> 6, d = tid & 63; float s = 0.f;
        for (int rt = 0; rt < 2; ++rt) { const LAS bf16_t* kp = (const LAS bf16_t*)(shm + (h2 * 2 + rt) * 8192 + (d >> 5) * 4096) + (d & 31);
            for (int r = 0; r < 64; ++r) s += bf2f(kp[r * 32]); }
        nU[(((size_t)b * NCH + c) * 4 + 2 * hp + h2) * 64 + d] = s; }
    __syncthreads();
}

__device__ __forceinline__ void scan_phase(int gtid, int ngt, const float* S, const float* sdec, bf16_t* prevT, const float* U, const float* nU, const float* mdec, bf16_t* Cst, float* nst) {
    constexpr int N1 = 2 * 4 * 8192, N2 = 2 * 4 * 4096, N3 = 2 * 4 * 64;
#define SCAN_RUN(SRC, DEC, STRIDE, STORE) do { float st = 0.f; \
        for (int c0 = 0; c0 < NCH; c0 += 16) { float sv[16], dv[16]; \
            _Pragma("unroll") for (int k = 0; k < 16; ++k) { const size_t u = ((size_t)b * NCH + c0 + k) * 4 + h; sv[k] = SRC[u * STRIDE + e]; dv[k] = DEC[u]; } \
            _Pragma("unroll") for (int k = 0; k < 16; ++k) { const size_t u = ((size_t)b * NCH + c0 + k) * 4 + h; STORE; st = dv[k] * st + sv[k]; } } } while (0)
    for (int idx = gtid; idx < N1 + N2 + N3; idx += ngt) {
        if (idx < N1) { const int e = idx & 8191, h = (idx >> 13) & 3, b = idx >> 15; SCAN_RUN(S, sdec, 8192, prevT[u * 8192 + e] = f2bf(st)); }
        else if (idx < N1 + N2) { const int i2 = idx - N1, e = i2 & 4095, h = (i2 >> 12) & 3, b = i2 >> 14; SCAN_RUN(U, mdec, 4096, Cst[u * 4096 + e] = f2bf(st)); }
        else { const int i3 = idx - N1 - N2, e = i3 & 63, h = (i3 >> 6) & 3, b = i3 >> 8; SCAN_RUN(nU, mdec, 64, nst[u * 64 + e] = st); }
    }
#undef SCAN_RUN
}

#define CK_PACK(p0, p1, pw0, pw1, pw2, pw3) do { \
    pw0 = (u32x4){cvtpk(p0[0], p0[1]), cvtpk(p0[2], p0[3]), cvtpk(p0[4], p0[5]), cvtpk(p0[6], p0[7])}; \
    pw1 = (u32x4){cvtpk(p0[8], p0[9]), cvtpk(p0[10], p0[11]), cvtpk(p0[12], p0[13]), cvtpk(p0[14], p0[15])}; \
    pw2 = (u32x4){cvtpk(p1[0], p1[1]), cvtpk(p1[2], p1[3]), cvtpk(p1[4], p1[5]), cvtpk(p1[6], p1[7])}; \
    pw3 = (u32x4){cvtpk(p1[8], p1[9]), cvtpk(p1[10], p1[11]), cvtpk(p1[12], p1[13]), cvtpk(p1[14], p1[15])}; } while (0)
__device__ __forceinline__ bf16x8 pv_afrag(const bf16_t* rowp, int ks, int hi, float scale) {
    const us4 a = *(const us4*)(rowp + 16 * ks + 4 * hi), b2 = *(const us4*)(rowp + 16 * ks + 8 + 4 * hi);
    u32x4 w; w.x = cvtpk(bf2f(a.x) * scale, bf2f(a.y) * scale); w.y = cvtpk(bf2f(a.z) * scale, bf2f(a.w) * scale);
    w.z = cvtpk(bf2f(b2.x) * scale, bf2f(b2.y) * scale); w.w = cvtpk(bf2f(b2.z) * scale, bf2f(b2.w) * scale);
    return __builtin_bit_cast(bf16x8, w);
}

__device__ __forceinline__ void ssd_s3_unit(int unit, const bf16_t* xbca, const bf16_t* proj, const float* projf, const float* dt_bias, const float* a_log, const float* d_skip, const float* norm_g,
                                            const bf16_t* prevT, bf16_t* ycat, LAS unsigned char* shm, int wave) {
    const int g = unit & 1, c = (unit >> 1) & (NCH - 1), b = unit >> 7;
    int lane = lane_id(); asm volatile("" : "+v"(lane));
    const int tid = wave * 64 + lane; const size_t m0 = (size_t)b * SEQ + (size_t)c * CL;
    LAS float* acum = (LAS float*)(shm + 98304); LAS float* dtt = acum + 256; LAS float* ssq = dtt + 256;
    if (wave < 2) { const int h = 2 * g + wave; const float a = -__expf(a_log[h]), dtb = dt_bias[h];
        const float d0 = softplus_f(projf[(m0 + 2 * lane) * PROJF_W + PF_DT + h] + dtb), d1 = softplus_f(projf[(m0 + 2 * lane + 1) * PROJF_W + PF_DT + h] + dtb);
        float s0, s1; scan128(d0 * a, d1 * a, lane, s0, s1);
        acum[wave * 128 + 2 * lane] = s0; acum[wave * 128 + 2 * lane + 1] = s1; dtt[wave * 128 + 2 * lane] = d0; dtt[wave * 128 + 2 * lane + 1] = d1; }
#pragma unroll
    for (int rt = 0; rt < 2; ++rt) stage_k64<128>(shm + rt * 16384, xbca + (m0 + rt * 64) * 768 + 256 + g * 128, 768, tid);
#pragma unroll
    for (int hh = 0; hh < 2; ++hh)
#pragma unroll
        for (int rt = 0; rt < 2; ++rt) {
            stage_v64(shm + 32768 + (hh * 2 + rt) * 8192, xbca + (m0 + rt * 64) * 768 + (2 * g + hh) * 64, 768, tid, nullptr);
            stage_v64(shm + 65536 + (hh * 2 + rt) * 8192, prevT + (((size_t)b * NCH + c) * 4 + 2 * g + hh) * 8192 + rt * 64 * 64, 64, tid, nullptr); }
    __syncthreads();
    const int hh = wave >> 2, rw = wave & 3, r32 = lane & 31, hi = lane >> 5, h = 2 * g + hh; const int lo = tr_lane_off(lane);
    const int l = 32 * rw + r32;
    const bf16_t* crowp = xbca + (m0 + l) * 768 + 512 + g * 128;
    f32x16 o[2]; o[0] = f32x16{}; o[1] = f32x16{};
    {
        bf16x8 qr[8];
#pragma unroll
        for (int d0 = 0; d0 < 8; ++d0) qr[d0] = *reinterpret_cast<const bf16x8*>(crowp + d0 * 16 + hi * 8);
        const float al = acum[hh * 128 + l];
        const int ntile = (rw >= 2) ? 2 : 1;
        for (int t = 0; t < ntile; ++t) {
            f32x16 p0 = f32x16{}, p1 = f32x16{};
            const LAS unsigned char* kb = shm + t * 16384 + hi * 1024 + r32 * 16;
#pragma unroll
            for (int d0 = 0; d0 < 8; ++d0) { const bf16x8 b0 = *(const LAS bf16x8*)(kb + d0 * 2048), b1 = *(const LAS bf16x8*)(kb + d0 * 2048 + 512);
                p0 = __builtin_amdgcn_mfma_f32_32x32x16_bf16(b0, qr[d0], p0, 0, 0, 0); p1 = __builtin_amdgcn_mfma_f32_32x32x16_bf16(b1, qr[d0], p1, 0, 0, 0); }
#pragma unroll
            for (int r = 0; r < 16; ++r) { const int s = 64 * t + crow(r, hi);
                const float w0 = (s <= l) ? __expf(al - acum[hh * 128 + s]) * dtt[hh * 128 + s] : 0.f, w1 = (s + 32 <= l) ? __expf(al - acum[hh * 128 + s + 32]) * dtt[hh * 128 + s + 32] : 0.f;
                p0[r] *= w0; p1[r] *= w1; }
            u32x4 pw0, pw1, pw2, pw3; CK_PACK(p0, p1, pw0, pw1, pw2, pw3);
            att::pv(o, (int)(unsigned)(size_t)(shm + 32768 + (hh * 2 + t) * 8192) + lo, __builtin_bit_cast(bf16x8, pw0), __builtin_bit_cast(bf16x8, pw1), __builtin_bit_cast(bf16x8, pw2), __builtin_bit_cast(bf16x8, pw3));
        }
        const float ea = __expf(al);
#pragma unroll
        for (int nt = 0; nt < 2; ++nt)
            att::pv(o, (int)(unsigned)(size_t)(shm + 65536 + (hh * 2 + nt) * 8192) + lo, pv_afrag(crowp + 64 * nt, 0, hi, ea), pv_afrag(crowp + 64 * nt, 1, hi, ea), pv_afrag(crowp + 64 * nt, 2, hi, ea), pv_afrag(crowp + 64 * nt, 3, hi, ea));
    }
    __syncthreads();
    LAS float* stg = (LAS float*)(shm + wave * 8704);
#pragma unroll
    for (int r = 0; r < 16; ++r) { const int orow = crow(r, hi); stg[orow * 68 + r32] = o[0][r]; stg[orow * 68 + 32 + r32] = o[1][r]; }
    asm volatile("s_waitcnt lgkmcnt(0)" ::: "memory");
    {
        const int row = lane >> 1, ch = lane & 1, lr = 32 * rw + row; const size_t m = m0 + lr;
        const float dsk = d_skip[h];
        float y[32]; float ss = 0.f;
#pragma unroll
        for (int q = 0; q < 4; ++q) { const us8 xv = *(const us8*)(xbca + m * 768 + h * 64 + ch * 32 + 8 * q), zv = *(const us8*)(proj + m * PROJ_W + PC_Z + h * 64 + ch * 32 + 8 * q);
#pragma unroll
            for (int i = 0; i < 8; ++i) { const float v = (stg[row * 68 + ch * 32 + 8 * q + i] + dsk * bf2f(xv[i])) * silu_f(bf2f(zv[i])); y[8 * q + i] = v; ss += v * v; } }
        ss += __shfl_xor(ss, 1);
        if (ch == 0) ssq[hh * 128 + lr] = ss;
        __syncthreads();
        const float tot = ssq[lr] + ssq[128 + lr];
        const float rstd = rsqrtf(tot * (1.f / 128.f) + EPS);
        const float* gp = norm_g + h * 64 + ch * 32;
        bf16_t* op = ycat + m * DM + 256 + h * 64 + ch * 32;
#pragma unroll
        for (int q = 0; q < 4; ++q) { v4u w; w.x = pk2(y[8 * q] * rstd * gp[8 * q], y[8 * q + 1] * rstd * gp[8 * q + 1]); w.y = pk2(y[8 * q + 2] * rstd * gp[8 * q + 2], y[8 * q + 3] * rstd * gp[8 * q + 3]);
            w.z = pk2(y[8 * q + 4] * rstd * gp[8 * q + 4], y[8 * q + 5] * rstd * gp[8 * q + 5]); w.w = pk2(y[8 * q + 6] * rstd * gp[8 * q + 6], y[8 * q + 7] * rstd * gp[8 * q + 7]);
            *(v4u*)(op + 8 * q) = w; }
    }
    __syncthreads();
}

__device__ __forceinline__ void ml_s3_unit(int unit, const bf16_t* qka, const bf16_t* proj, const float* projf, const float* ig_bias, const float* fg_bias, const float* norm_g,
                                           const bf16_t* Cst, const float* nst, bf16_t* ycat, LAS unsigned char* shm, int wave) {
    const int hp = unit & 1, c = (unit >> 1) & (NCH - 1), b = unit >> 7;
    int lane = lane_id(); asm volatile("" : "+v"(lane));
    const int tid = wave * 64 + lane; const size_t m0 = (size_t)b * SEQ + (size_t)c * CL;
    LAS float* bt = (LAS float*)(shm + 98304); LAS float* igt = bt + 256; LAS float* nt_ = igt + 256;
    LAS float* wsf = (LAS float*)(shm + 98304 + 4096) + wave * 64;
    if (wave < 2) { const int h = 2 * hp + wave; const float igb = ig_bias[h], fgb = fg_bias[h];
        const float f0 = projf[(m0 + 2 * lane) * PROJF_W + PF_MF + h] + fgb, f1 = projf[(m0 + 2 * lane + 1) * PROJF_W + PF_MF + h] + fgb;
        const float l0 = fminf(f0, 0.f) - log1pf(__expf(-fabsf(f0))), l1 = fminf(f1, 0.f) - log1pf(__expf(-fabsf(f1)));
        float s0, s1; scan128(l0, l1, lane, s0, s1);
        bt[wave * 128 + 2 * lane] = s0; bt[wave * 128 + 2 * lane + 1] = s1;
        igt[wave * 128 + 2 * lane] = projf[(m0 + 2 * lane) * PROJF_W + PF_MI + h] + igb; igt[wave * 128 + 2 * lane + 1] = projf[(m0 + 2 * lane + 1) * PROJF_W + PF_MI + h] + igb;
        nt_[wave * 64 + lane] = nst[(((size_t)b * NCH + c) * 4 + h) * 64 + lane]; }
#pragma unroll
    for (int hh = 0; hh < 2; ++hh) {
#pragma unroll
        for (int rt = 0; rt < 2; ++rt) {
            stage_k64<64>(shm + (hh * 2 + rt) * 8192, qka + (m0 + rt * 64) * 512 + 256 + (2 * hp + hh) * 64, 512, tid);
            stage_v64(shm + 32768 + (hh * 2 + rt) * 8192, proj + (m0 + rt * 64) * PROJ_W + PC_MV + (2 * hp + hh) * 64, PROJ_W, tid, nullptr); }
        stage_v64(shm + 65536 + hh * 8192, Cst + (((size_t)b * NCH + c) * 4 + 2 * hp + hh) * 4096, 64, tid, nullptr); }
    __syncthreads();
    const int hh = wave >> 2, rw = wave & 3, r32 = lane & 31, hi = lane >> 5, h = 2 * hp + hh; const int lo = tr_lane_off(lane);
    const int l = 32 * rw + r32;
    const bf16_t* qrowp = qka + (m0 + l) * 512 + h * 64;
    f32x16 o[2]; o[0] = f32x16{}; o[1] = f32x16{};
    float den = 0.f;
    {
        bf16x8 qr[4];
#pragma unroll
        for (int d0 = 0; d0 < 4; ++d0) qr[d0] = *reinterpret_cast<const bf16x8*>(qrowp + d0 * 16 + hi * 8);
        const float bl = bt[hh * 128 + l];
        const int ntile = (rw >= 2) ? 2 : 1;
        for (int t = 0; t < ntile; ++t) {
            f32x16 p0 = f32x16{}, p1 = f32x16{};
            const LAS unsigned char* kb = shm + (hh * 2 + t) * 8192 + hi * 1024 + r32 * 16;
#pragma unroll
            for (int d0 = 0; d0 < 4; ++d0) { const bf16x8 b0 = *(const LAS bf16x8*)(kb + d0 * 2048), b1 = *(const LAS bf16x8*)(kb + d0 * 2048 + 512);
                p0 = __builtin_amdgcn_mfma_f32_32x32x16_bf16(b0, qr[d0], p0, 0, 0, 0); p1 = __builtin_amdgcn_mfma_f32_32x32x16_bf16(b1, qr[d0], p1, 0, 0, 0); }
#pragma unroll
            for (int r = 0; r < 16; ++r) { const int s = 64 * t + crow(r, hi);
                const float w0 = (s <= l) ? __expf(bl - bt[hh * 128 + s] + igt[hh * 128 + s]) : 0.f, w1 = (s + 32 <= l) ? __expf(bl - bt[hh * 128 + s + 32] + igt[hh * 128 + s + 32]) : 0.f;
                p0[r] *= w0; p1[r] *= w1; den += p0[r] + p1[r]; }
            u32x4 pw0, pw1, pw2, pw3; CK_PACK(p0, p1, pw0, pw1, pw2, pw3);
            att::pv(o, (int)(unsigned)(size_t)(shm + 32768 + (hh * 2 + t) * 8192) + lo, __builtin_bit_cast(bf16x8, pw0), __builtin_bit_cast(bf16x8, pw1), __builtin_bit_cast(bf16x8, pw2), __builtin_bit_cast(bf16x8, pw3));
        }
        const float eb = __expf(bl);
        att::pv(o, (int)(unsigned)(size_t)(shm + 65536 + hh * 8192) + lo, pv_afrag(qrowp, 0, hi, eb), pv_afrag(qrowp, 1, hi, eb), pv_afrag(qrowp, 2, hi, eb), pv_afrag(qrowp, 3, hi, eb));
        float qn = 0.f;
#pragma unroll
        for (int d0 = 0; d0 < 4; ++d0)
#pragma unroll
            for (int i = 0; i < 8; ++i) qn += bf2f((bf16_t)qr[d0][i]) * nt_[hh * 64 + 16 * d0 + 8 * hi + i];
        den = xhalf_sum(den + eb * qn);
    }
    if (hi == 0) wsf[r32] = 1.f / fmaxf(fabsf(den), 1.f);
    asm volatile("s_waitcnt lgkmcnt(0)" ::: "memory");
    float rli[16];
#pragma unroll
    for (int r = 0; r < 16; ++r) rli[r] = wsf[crow(r, hi)];
    __syncthreads();
    LAS float* stg = (LAS float*)(shm + wave * 8704);
#pragma unroll
    for (int r = 0; r < 16; ++r) { const int orow = crow(r, hi); stg[orow * 68 + r32] = o[0][r] * rli[r]; stg[orow * 68 + 32 + r32] = o[1][r] * rli[r]; }
    asm volatile("s_waitcnt lgkmcnt(0)" ::: "memory");
    {
        const int row = lane >> 1, ch = lane & 1, lr = 32 * rw + row; const size_t m = m0 + lr;
        float y[32]; float ss = 0.f;
#pragma unroll
        for (int q = 0; q < 4; ++q) { const us8 ov = *(const us8*)(proj + m * PROJ_W + PC_MO + h * 64 + ch * 32 + 8 * q);
#pragma unroll
            for (int i = 0; i < 8; ++i) { const float v = stg[row * 68 + ch * 32 + 8 * q + i] * sigmoid_f(bf2f(ov[i])); y[8 * q + i] = v; ss += v * v; } }
        ss += __shfl_xor(ss, 1);
        const float rstd = rsqrtf(ss * (1.f / 64.f) + EPS);
        const float* gp = norm_g + h * 64 + ch * 32;
        bf16_t* op = ycat + m * DM + 512 + h * 64 + ch * 32;
#pragma unroll
        for (int q = 0; q < 4; ++q) { v4u w; w.x = pk2(y[8 * q] * rstd * gp[8 * q], y[8 * q + 1] * rstd * gp[8 * q + 1]); w.y = pk2(y[8 * q + 2] * rstd * gp[8 * q + 2], y[8 * q + 3] * rstd * gp[8 * q + 3]);
            w.z = pk2(y[8 * q + 4] * rstd * gp[8 * q + 4], y[8 * q + 5] * rstd * gp[8 * q + 5]); w.w = pk2(y[8 * q + 6] * rstd * gp[8 * q + 6], y[8 * q + 7] * rstd * gp[8 * q + 7]);
            *(v4u*)(op + 8 * q) = w; }
    }
    __syncthreads();
}
#undef CK_TRF
#undef CK_PACK
}
#ifndef EN_P_MOE
#define EN_P_MOE 1
#endif
#ifndef EN_P_SCAN
#define EN_P_SCAN 1
#endif
#ifndef EN_P_CONV
#define EN_P_CONV 1
#endif
#ifndef EN_P_INPROJ
#define EN_P_INPROJ 1
#endif
#ifndef EN_P_PREP
#define EN_P_PREP 1
#endif
#ifndef EN_P_MLAUP
#define EN_P_MLAUP 1
#endif
#ifndef EN_P_ATTN
#define EN_P_ATTN 1
#endif
#ifndef EN_P_OUTPROJ
#define EN_P_OUTPROJ 1
#endif
constexpr int NPH = 11, PH_FINAL = 2 * NPH;
enum { P_CONV = 0, P_INPROJ = 1, P_PREP = 2, P_MLAUP = 3, P_SCAN = 4, P_ATTN = 5, P_OUTPROJ = 6, P_ROUTE = 7, P_SORT = 8, P_MOEUP = 9, P_MOEDOWN = 10 };

__global__ void __launch_bounds__(NWAVES * 64, 2) mk_fwd(Args args) {
    extern __shared__ __attribute__((aligned(16))) unsigned char lds_raw[];
    LAS unsigned char* lds0p = (LAS unsigned char*)lds_raw; LAS unsigned char* lds = lds0p;
    volatile LAS unsigned* MISC = (volatile LAS unsigned*)(lds + MISC_OFF);
    const int tid = threadIdx.x, lane0 = tid & 63, wave = __builtin_amdgcn_readfirstlane(tid >> 6);
    const int G = gridDim.x; const int bx = blockIdx.x; const int vcu = (G % 8 == 0) ? (bx % 8) * (G / 8) + bx / 8 : bx;
    unsigned char* ws = args.ws;
    gu32* ctl = (gu32*)(ws + WS_CTL);
    for (int u = tid; u < (LDS_BYTES - LDSCTL_OFF) / 4; u += NWAVES * 64) ((LAS unsigned*)(lds + LDSCTL_OFF))[u] = 0u;
    __syncthreads();
    if (tid == 0) { LAS unsigned long long* tb = (LAS unsigned long long*)(lds + PTR_OFF);
#pragma unroll
        for (int i = 0; i < 29; ++i) tb[i] = (unsigned long long)args.in[i]; }
    __syncthreads();
#define INP(i) in_ptr(lds, (i))
    XcdBarrier bar = xcd_barrier_post((unsigned*)(ctl + CW_BAR) + args.bli * XCD_BAR_WORDS, MISC + 8);
    const int lo = args.ph_lo, hi = args.ph_hi;
#define IN(k) (lo <= (k) && (k) < hi)
#define SEAM(k) do { if (IN(k) && IN((k) + 1)) xcd_barrier(bar); } while (0)
    float* X = args.out;
    bf16_t* ACT = (bf16_t*)(ws + WS_ACT); bf16_t* PROJ = (bf16_t*)(ws + WS_PROJ); float* PROJF = (float*)(ws + WS_PROJF);
    bf16_t* WinT = (bf16_t*)(ws + WS_WIN); bf16_t* WoutT = (bf16_t*)(ws + WS_WOUT); bf16_t* WuqT = (bf16_t*)(ws + WS_WUQ); bf16_t* WukvT = (bf16_t*)(ws + WS_WUKV);
    bf16_t* XBCA = (bf16_t*)(ws + WS_XBCA); bf16_t* QKA = (bf16_t*)(ws + WS_QKA); bf16_t* QM = (bf16_t*)(ws + WS_QM); bf16_t* KM = (bf16_t*)(ws + WS_KM); bf16_t* VM = (bf16_t*)(ws + WS_VM);
    bf16_t* WupT = (bf16_t*)(ws + WS_WUP); bf16_t* WdnT = (bf16_t*)(ws + WS_WDN); bf16_t* XS = (bf16_t*)(ws + WS_XS); bf16_t* HID = (bf16_t*)(ws + WS_HID);
    int* STOK = (int*)(ws + WS_STOK); float* SW1 = (float*)(ws + WS_SW1); float* SW2 = (float*)(ws + WS_SW2);
    int* TCLS = (int*)(ws + WS_TCLS); int* TPOS = (int*)(ws + WS_TPOS); float* TW1 = (float*)(ws + WS_TW1); float* TW2 = (float*)(ws + WS_TW2);
    float* S1S = (float*)(ws + WS_ACT); float* S1U = (float*)(ws + WS_ACT + 16 * MiB); float* S1N = (float*)(ws + WS_ACT + 24 * MiB); float* S1SD = (float*)(ws + WS_ACT + 25 * MiB); float* S1MD = S1SD + 1024;
    bf16_t* PREVT = (bf16_t*)(ws + WS_PREVT); bf16_t* CST = (bf16_t*)(ws + WS_CST); float* NST = (float*)(ws + WS_NST);
    bf16_t* CQN = (bf16_t*)(ws + WS_CQN); bf16_t* CKVN = (bf16_t*)(ws + WS_CKVN); float* ROPE = (float*)(ws + WS_ROPE); float* KMEAN = (float*)(ws + WS_KMEAN);
    const int gw = vcu * NWAVES + wave, NGW = G * NWAVES;

    for (int l = 0; l < DEPTH; ++l) {
        const int pb = l * NPH;
        { unsigned lv = (unsigned)(size_t)lds0p; asm volatile("" : "+s"(lv)); lds = (LAS unsigned char*)(size_t)lv; }
        if (EN_P_CONV && IN(pb + P_CONV)) {
            int lane = (int)__builtin_amdgcn_mbcnt_hi(~0u, __builtin_amdgcn_mbcnt_lo(~0u, 0u)); asm volatile("" : "+v"(lane));
            LAS float* scr = (LAS float*)(lds + RING_OFF + wave * 16384);
            constexpr int I_IN = (DM / 64) * (PROJ_N / 32), I_OUT = (DM / 64) * (DM / 32), I_UQ = (256 / 64) * (512 / 32), I_UKV = (128 / 64) * (512 / 32);
            const MapInProj mi{INP(3) + (size_t)l * DM * NIN};
            const MapPlain mo{INP(19) + (size_t)l * DM * DM, DM, 1.f};
            const MapPlain muq{INP(16) + (size_t)l * 256 * 384, 384, C2M};
            const MapPlain mukv{INP(18) + (size_t)l * 128 * 512, 512, 1.f};
            for (int it = gw; it < I_IN + I_OUT + I_UQ + I_UKV; it += NGW) {
                if (it < I_IN) conv_item(mi, NIN, DM, WinT, PROJ_N / 32, scr, it, lane);
                else if (it < I_IN + I_OUT) conv_item(mo, DM, DM, WoutT, DM / 32, scr, it - I_IN, lane);
                else if (it < I_IN + I_OUT + I_UQ) conv_item(muq, 384, 256, WuqT, 512 / 32, scr, it - I_IN - I_OUT, lane);
                else conv_item(mukv, 512, 128, WukvT, 512 / 32, scr, it - I_IN - I_OUT - I_UQ, lane);
            }
            const float* xsrc = (l == 0) ? INP(0) : X;
            for (int m = gw; m < M; m += NGW) rms_row_to_bf16(xsrc + (size_t)m * DM, INP(2) + l * DM, ACT + (size_t)m * DM, nullptr, lane);
        }
        SEAM(pb + P_CONV);
        if (EN_P_INPROJ && IN(pb + P_INPROJ)) {
            pg8::StaticOrder S; S.init(ACT, WinT, DM, DM, DM, M, PROJ_N, G, bx);
            const EpiInProj E{PROJ, PROJF};
            pg8::gemm_phase(lds + RING_OFF, wave, pg8::Dims{DM, DM, DM}, S, E);
        }
        SEAM(pb + P_INPROJ);
        if (EN_P_PREP && IN(pb + P_PREP)) {
            int lane = (int)__builtin_amdgcn_mbcnt_hi(~0u, __builtin_amdgcn_mbcnt_lo(~0u, 0u)); asm volatile("" : "+v"(lane));
            if (wave == 0) for (int it = vcu; it < 256; it += G) kmean_item(it, lane, PROJ, KMEAN);
            for (int m = gw; m < M; m += NGW) mla_prep_token(m, lane, PROJ, PROJF, (const int*)INP(1), INP(15) + l * 256, INP(17) + l * 128, CQN, CKVN, KM, ROPE);
            for (int wt = gw; wt < (M / 32) * 3; wt += NGW) { const int seg = wt / 3, part = wt - seg * 3;
                if (part == 0) conv_seg(PROJ, seg * 32, PC_XBC, lane, 768, INP(4) + l * 4 * 768, INP(5) + l * 768, XBCA, 1.f);
                else if (part == 1) { if (lane < 32) conv_seg(PROJ, seg * 32, PC_XBC, 64 + lane, 768, INP(4) + l * 4 * 768, INP(5) + l * 768, XBCA, 1.f); }
                else conv_seg(PROJ, seg * 32, PC_MQK, lane, 512, INP(10) + l * 4 * 512, INP(11) + l * 512, QKA, lane >= 32 ? 0.125f : 1.f); }
        }
        SEAM(pb + P_PREP);
        if (EN_P_MLAUP && IN(pb + P_MLAUP)) {
            const int half = G / 2;
            if (bx < half) { pg8::StaticOrder S; S.init(CQN, WuqT, 256, 256, 256, M, 512, half, bx); const EpiMlaQ E{QM, ROPE}; pg8::gemm_phase(lds + RING_OFF, wave, pg8::Dims{256, 256, 256}, S, E); }
            else { pg8::StaticOrder S; S.init(CKVN, WukvT, 128, 128, 128, M, 512, G - half, bx - half); const EpiMlaKVf E{KM, VM}; pg8::gemm_phase(lds + RING_OFF, wave, pg8::Dims{128, 128, 128}, S, E); }
            for (int u = vcu; u < 512; u += G) {
                if (u < 256) ck::ssd_s1_unit(u, XBCA, PROJF, INP(6) + l * 4, INP(7) + l * 4, S1S, S1SD, lds + RING_OFF, wave);
                else ck::ml_s1_unit(u - 256, QKA, PROJ, PROJF, INP(12) + l * 4, INP(13) + l * 4, S1U, S1N, S1MD, lds + RING_OFF, wave);
            }
        }
        SEAM(pb + P_MLAUP);
        if (EN_P_SCAN && IN(pb + P_SCAN)) {
            const int lane = (int)__builtin_amdgcn_mbcnt_hi(~0u, __builtin_amdgcn_mbcnt_lo(~0u, 0u));
            ck::scan_phase(gw * 64 + lane, NGW * 64, S1S, S1SD, PREVT, S1U, S1N, S1MD, CST, NST);
        }
        SEAM(pb + P_SCAN);
        if (EN_P_ATTN && IN(pb + P_ATTN)) {
            for (int u = vcu; u < 512; u += G) {
                const int bh = (u & 255) >> 5, qs = u & 31, b = bh >> 2, hh = bh & 3;
                if (u < 256) att::attn_unit<96, false>(b, hh, qs, QM, 384, hh * 96, KM, 384, hh * 96, VM, 256, hh * 64, ACT, 768 + hh * 64, nullptr, lds + RING_OFF, wave);
                else att::attn_unit<64, true>(b, hh, 31 - qs, PROJ, PROJ_W, PC_AQ + hh * 64, PROJ, PROJ_W, PC_AK + hh * 64, PROJ, PROJ_W, PC_AV + hh * 64, ACT, hh * 64, KMEAN, lds + RING_OFF, wave);
            }
            for (int u = vcu; u < 512; u += G) {
                if (u < 256) ck::ssd_s3_unit(u, XBCA, PROJ, PROJF, INP(6) + l * 4, INP(7) + l * 4, INP(8) + l * 4, INP(9) + l * 256, PREVT, ACT, lds + RING_OFF, wave);
                else ck::ml_s3_unit(u - 256, QKA, PROJ, PROJF, INP(12) + l * 4, INP(13) + l * 4, INP(14) + l * 256, CST, NST, ACT, lds + RING_OFF, wave);
            }
        }
        SEAM(pb + P_ATTN);
        if (EN_P_OUTPROJ && IN(pb + P_OUTPROJ)) {
            pg8::StaticOrder S; S.init(ACT, WoutT, DM, DM, DM, M, DM, G, bx);
            const EpiResidualF32 E{X, (l == 0) ? INP(0) : (const float*)X};
            pg8::gemm_phase(lds + RING_OFF, wave, pg8::Dims{DM, DM, DM}, S, E);
            int lane = (int)__builtin_amdgcn_mbcnt_hi(~0u, __builtin_amdgcn_mbcnt_lo(~0u, 0u)); asm volatile("" : "+v"(lane));
            LAS float* scr = (LAS float*)(lds + RING_OFF + wave * 16384);
            const float* wgate = INP(25) + (size_t)l * 16 * 1024 * 256; const float* wup = INP(26) + (size_t)l * 16 * 1024 * 256; const float* wdn = INP(27) + (size_t)l * 16 * 256 * 1024;
            for (int it = gw; it < 16 * 256 + 16 * 128; it += NGW) {
                if (it < 16 * 256) { const int e = it >> 8, q = ((it & 255) & 15) >> 2;
                    if (q & 1) { const MapMoeUp mu{wup + (size_t)e * 1024 * 256, (q >> 1) * 128}; conv_item(mu, 256, 1024, WupT + (size_t)e * 512 * 1024, 512 / 32, scr, it & 255, lane); }
                    else { const MapMoeUp mu{wgate + (size_t)e * 1024 * 256, (q >> 1) * 128}; conv_item(mu, 256, 1024, WupT + (size_t)e * 512 * 1024, 512 / 32, scr, it & 255, lane); } }
                else { const int r = it - 16 * 256, e = r >> 7; const MapPlain md{wdn + (size_t)e * 256 * 1024, 1024, 1.f};
                    conv_item(md, 1024, 256, WdnT + (size_t)e * 1024 * 256, 1024 / 32, scr, r & 127, lane); }
            }
        }
        SEAM(pb + P_OUTPROJ);
        unsigned* mcnt = (unsigned*)(ctl + CW_MOECNT + l * 1024);
        if (EN_P_MOE && IN(pb + P_ROUTE)) {
            int lane = (int)__builtin_amdgcn_mbcnt_hi(~0u, __builtin_amdgcn_mbcnt_lo(~0u, 0u)); asm volatile("" : "+v"(lane));
            LAS float* rw = (LAS float*)(lds + RING_OFF);
            { const float* wg = INP(21) + (size_t)l * DM * 4; const float* wr = INP(23) + (size_t)l * DM * 16; const int tid2 = wave * 64 + lane;
              for (int i = tid2; i < DM; i += NWAVES * 64) { const f32x4 w = *(const GAS f32x4*)(wg + 4 * i); rw[0 * RW_PITCH + i] = w.x; rw[1 * RW_PITCH + i] = w.y; rw[2 * RW_PITCH + i] = w.z; rw[3 * RW_PITCH + i] = w.w; }
              for (int i = tid2; i < DM * 4; i += NWAVES * 64) { const int k = i >> 2, c = i & 3; const f32x4 w = *(const GAS f32x4*)(wr + 4 * i);
                  rw[(4 + 4 * c) * RW_PITCH + k] = w.x; rw[(5 + 4 * c) * RW_PITCH + k] = w.y; rw[(6 + 4 * c) * RW_PITCH + k] = w.z; rw[(7 + 4 * c) * RW_PITCH + k] = w.w; } }
            __syncthreads();
            for (int m = gw; m < M; m += NGW) route_token(m, lane, X, INP(20) + l * DM, rw, INP(22) + l * 4, INP(24) + l * 16, ACT, mcnt, TCLS, TPOS, TW1, TW2);
            __syncthreads();
        }
        SEAM(pb + P_ROUTE);
        if (EN_P_MOE && IN(pb + P_SORT)) {
            int lane = (int)__builtin_amdgcn_mbcnt_hi(~0u, __builtin_amdgcn_mbcnt_lo(~0u, 0u)); asm volatile("" : "+v"(lane));
            (void)moe_tiles(mcnt, lds, wave == 0 && lane == 0);
            const LAS int* offs = (const LAS int*)(lds + OFFS_OFF);
            if (bx < 24) { const int beg = offs[bx] + (int)mcnt[32 * bx], end = offs[bx + 1];
                for (int r = beg + wave * 64 + lane; r < end; r += NWAVES * 64) { st_wt(STOK + r, -1); st_wt(SW1 + r, 0.f); st_wt(SW2 + r, 0.f); }
#ifndef PADZERO_OFF
                for (int r = beg + wave; r < end; r += NWAVES) { v4u* dst = (v4u*)(XS + (size_t)r * DM); dst[lane] = (v4u){0u, 0u, 0u, 0u}; dst[64 + lane] = (v4u){0u, 0u, 0u, 0u}; }
#endif
            }
            for (int m = gw; m < M; m += NGW) { const int row = offs[TCLS[m]] + TPOS[m];
                if (lane == 0) { st_wt(STOK + row, m); st_wt(SW1 + row, TW1[m]); st_wt(SW2 + row, TW2[m]); }
                const v4u* src = (const v4u*)(ACT + (size_t)m * DM); v4u* dst = (v4u*)(XS + (size_t)row * DM);
                const v4u a = __builtin_nontemporal_load(src + lane), b = __builtin_nontemporal_load(src + 64 + lane); dst[lane] = a; dst[64 + lane] = b; }
        }
        SEAM(pb + P_SORT);
        if (EN_P_MOE && IN(pb + P_MOEUP)) {
            const int lane = (int)__builtin_amdgcn_mbcnt_hi(~0u, __builtin_amdgcn_mbcnt_lo(~0u, 0u));
            const int ntile = moe_tiles(mcnt, lds, wave == 0 && lane == 0);
            const int nu = ntile * 4;
            unsigned* tdone = (unsigned*)(ctl + 210000 + l * 128);
            const EpiMoeUp E{HID, SW1, SW2};
            for (int L = bx; L < nu; L += G) {
                const MoeOrder S{XS, WupT, DM, DM, (size_t)512 * 1024, DM, ntile, 1 << 20, L, lds + TCLS_OFF, false};
                pg8::gemm_phase(lds + RING_OFF, wave, pg8::Dims{DM, DM, DM}, S, E);
                asm volatile("s_waitcnt vmcnt(0)" ::: "memory");
                __syncthreads();
                if (wave == 0 && lane == 0) { __builtin_amdgcn_fence(__ATOMIC_RELEASE, "agent"); asm volatile("s_waitcnt vmcnt(0)" ::: "memory");
                    (void)__hip_atomic_fetch_add(tdone + (L >> 2), 1u, __ATOMIC_RELAXED, __HIP_MEMORY_SCOPE_AGENT); }
            }
            const int maxu = (nu + G - 1) / G; int two = nu - (maxu - 1) * G; if (two >= G) two = 0;
            const int c2 = (bx >= two) ? bx - two : bx + (G - two);
            const EpiMoeDown E2{X, STOK};
            for (int L = c2; L < nu; L += G) {
                if (wave == 0 && lane == 0) { unsigned sp = 0u;
                    while (__hip_atomic_load(tdone + (L >> 2), __ATOMIC_RELAXED, __HIP_MEMORY_SCOPE_AGENT) < 4u && ++sp < (1u << 22)) __builtin_amdgcn_s_sleep(2);
                    __builtin_amdgcn_fence(__ATOMIC_ACQUIRE, "agent"); asm volatile("s_waitcnt vmcnt(0)" ::: "memory"); }
                __syncthreads();
                const MoeOrder S2{HID, WdnT, 512, 256, (size_t)1024 * 256, 512, ntile, 1 << 20, L, lds + TCLS_OFF, true};
                pg8::gemm_phase(lds + RING_OFF, wave, pg8::Dims{512, 512, 256}, S2, E2);
            }
        }
        SEAM(pb + P_MOEDOWN);
    }
    if (IN(PH_FINAL)) {
        int lane = (int)__builtin_amdgcn_mbcnt_hi(~0u, __builtin_amdgcn_mbcnt_lo(~0u, 0u)); asm volatile("" : "+v"(lane));
        for (int m = gw; m < M; m += NGW) rms_row_to_f32(X + (size_t)m * DM, INP(28), X + (size_t)m * DM, lane);
    }
#undef IN
#undef SEAM
}
static void launch_mk(Args a, int lo, int hi, int bli, int grid, hipStream_t stream) {
    a.ph_lo = lo; a.ph_hi = hi; a.bli = bli; a.pad = 0;
    hipLaunchKernelGGL(mk_fwd, dim3(grid), dim3(NWAVES * 64), LDS_BYTES, stream, a);
}
extern "C" void kernel_launch(void* const* d_in, const int* in_sizes, int n_in, void* d_out, int out_size, void* d_ws, size_t ws_size, hipStream_t stream) {
    static int grid = 0;
    if (grid == 0) {
        int dev = 0, cus = 0;
        if (hipGetDevice(&dev) != hipSuccess || hipDeviceGetAttribute(&cus, hipDeviceAttributeMultiprocessorCount, dev) != hipSuccess) { grid = -1; return; }
        if (hipFuncSetAttribute((const void*)mk_fwd, hipFuncAttributeMaxDynamicSharedMemorySize, LDS_BYTES) != hipSuccess) { grid = -1; return; }
        int per_cu = 0;
        (void)hipOccupancyMaxActiveBlocksPerMultiprocessor(&per_cu, (const void*)mk_fwd, NWAVES * 64, LDS_BYTES);
        (void)hipGetLastError();
        grid = cus;
        if (n_in != 29 || ws_size < WS_END) { grid = -1; return; }
    }
    if (grid < 0) return;
    (void)hipMemsetAsync((char*)d_ws + WS_CTL, 0, CTL_ZERO_BYTES, stream);
    Args a{};
    for (int i = 0; i < 29; ++i) a.in[i] = (const float*)d_in[i];
    a.out = (float*)d_out; a.ws = (unsigned char*)d_ws;
    launch_mk(a, 0, PH_FINAL + 1, 0, grid, stream);
}
```
